# Optimizing an MI355X kernel written in HIP

```python
import jax, jax.numpy as jnp
from jax import lax
import numpy as np

D_MODEL = 1024
BATCH = 2
SEQ = 8192
DEPTH = 4

DN_HEADS = 8
DN_DK = 128
DN_DV = 128
DN_CONV = 4
DN_CHUNK = 64
SW_Q_HEADS = 16
SW_KV_HEADS = 2
SW_HEAD_DIM = 64
SW_WINDOW = 128
SW_BLOCK = 128
ROPE_THETA = 500000.0
ROT_DIM = SW_HEAD_DIM // 4
D_FF = 4 * D_MODEL
EPS = 1e-6

DN_QK_W = DN_HEADS * DN_DK
DN_V_W = DN_HEADS * DN_DV
SW_Q_W = SW_Q_HEADS * SW_HEAD_DIM
SW_KV_W = SW_KV_HEADS * SW_HEAD_DIM
IN_SPLITS = [DN_QK_W, DN_QK_W, DN_V_W, DN_V_W, DN_HEADS, DN_HEADS,
             SW_Q_W, SW_KV_W, SW_KV_W, D_MODEL, D_MODEL]
D_IN = sum(IN_SPLITS)
IN_OFFSETS = np.cumsum(IN_SPLITS)[:-1].tolist()

kernel_name = 'hybrid_gdn_swa_sink_parallel_block'


def rmsnorm(x, g):
    xf = x.astype(jnp.float32)
    y = xf * lax.rsqrt(jnp.mean(xf * xf, axis=-1, keepdims=True) + EPS)
    return (y * g.astype(jnp.float32)).astype(x.dtype)


def l2norm(t):
    tf = t.astype(jnp.float32)
    return tf * lax.rsqrt(jnp.sum(tf * tf, axis=-1, keepdims=True) + EPS)


def causal_conv_silu(x, w):
    S = x.shape[1]
    K = w.shape[0]
    xp = jnp.pad(x, ((0, 0), (K - 1, 0), (0, 0)))
    y = sum(xp[:, j:j + S] * w[j] for j in range(K))
    return jax.nn.silu(y)


def gated_delta_rule(q, k, v, g, beta):
    B, S, H, dk = q.shape
    dv = v.shape[-1]
    C = DN_CHUNK
    N = S // C

    def chunks(t):
        return t.reshape(B, N, C, H, -1).transpose(0, 3, 1, 2, 4)

    q, k, v = chunks(q), chunks(k), chunks(v)
    g = g.reshape(B, N, C, H).transpose(0, 3, 1, 2)
    beta = beta.reshape(B, N, C, H).transpose(0, 3, 1, 2)
    g = jnp.cumsum(g, axis=-1)

    idx = jnp.arange(C)
    causal = idx[:, None] >= idx[None, :]
    strict = idx[:, None] > idx[None, :]
    diff = g[..., :, None] - g[..., None, :]
    decay = jnp.where(causal, jnp.exp(jnp.where(causal, diff, 0.0)), 0.0)

    kb = k * beta[..., None]
    L = jnp.where(strict, jnp.einsum('bhnid,bhnjd->bhnij', kb, k) * decay, 0.0)
    u = lax.linalg.triangular_solve(L, v * beta[..., None], left_side=True,
                                    lower=True, unit_diagonal=True)
    w = lax.linalg.triangular_solve(L, kb * jnp.exp(g)[..., None], left_side=True,
                                    lower=True, unit_diagonal=True)
    a_intra = jnp.einsum('bhnid,bhnjd->bhnij', q, k) * decay
    q_dec = q * jnp.exp(g)[..., None]
    g_last = g[..., -1]
    k_dec = k * jnp.exp(g_last[..., None] - g)[..., None]

    def to_front(t):
        return jnp.moveaxis(t, 2, 0)

    xs = (to_front(q_dec), to_front(k_dec), to_front(u), to_front(w),
          to_front(a_intra), jnp.moveaxis(g_last, 2, 0))

    def step(state, inp):
        qd, kd, u_c, w_c, a_c, gl = inp
        v_new = u_c - jnp.einsum('bhcd,bhde->bhce', w_c, state)
        o = (jnp.einsum('bhcd,bhde->bhce', qd, state)
             + jnp.einsum('bhij,bhje->bhie', a_c, v_new))
        state = state * jnp.exp(gl)[..., None, None] + jnp.einsum('bhcd,bhce->bhde', kd, v_new)
        return state, o

    state0 = jnp.zeros((B, H, dk, dv), jnp.float32)
    _, o = lax.scan(step, state0, xs)
    return o.transpose(1, 0, 3, 2, 4).reshape(B, S, H, dv)


def deltanet_branch(q_in, k_in, v_in, z, b_in, a_in, conv_w, a_log, dt_bias, norm_g):
    B, S, _ = q_in.shape
    qkv = causal_conv_silu(jnp.concatenate([q_in, k_in, v_in], axis=-1), conv_w)
    q, k, v = jnp.split(qkv, [DN_QK_W, 2 * DN_QK_W], axis=-1)
    q = l2norm(q.reshape(B, S, DN_HEADS, DN_DK)) * (DN_DK ** -0.5)
    k = l2norm(k.reshape(B, S, DN_HEADS, DN_DK))
    v = v.reshape(B, S, DN_HEADS, DN_DV).astype(jnp.float32)
    beta = jax.nn.sigmoid(b_in.astype(jnp.float32))
    g = -jnp.exp(a_log.astype(jnp.float32)) * jax.nn.softplus(
        a_in.astype(jnp.float32) + dt_bias.astype(jnp.float32))
    o = gated_delta_rule(q, k, v, g, beta)
    o = rmsnorm(o, norm_g) * jax.nn.silu(z.reshape(B, S, DN_HEADS, DN_DV).astype(jnp.float32))
    return o.reshape(B, S, DN_V_W).astype(q_in.dtype)


def partial_rope(x, positions):
    half = ROT_DIM // 2
    inv_freq = ROPE_THETA ** (-jnp.arange(half, dtype=jnp.float32) * (2.0 / ROT_DIM))
    ang = positions.astype(jnp.float32)[..., None] * inv_freq
    cos = jnp.cos(ang)[:, :, None, :]
    sin = jnp.sin(ang)[:, :, None, :]
    xr = x[..., :ROT_DIM].astype(jnp.float32)
    x1, x2 = xr[..., :half], xr[..., half:]
    rot = jnp.concatenate([x1 * cos - x2 * sin, x2 * cos + x1 * sin], axis=-1)
    return jnp.concatenate([rot.astype(x.dtype), x[..., ROT_DIM:]], axis=-1)


def swa_sink_branch(q_in, k_in, v_in, positions, sinks):
    B, S, _ = q_in.shape
    G = SW_Q_HEADS // SW_KV_HEADS
    nb = S // SW_BLOCK
    q = partial_rope(q_in.reshape(B, S, SW_Q_HEADS, SW_HEAD_DIM), positions)
    k = partial_rope(k_in.reshape(B, S, SW_KV_HEADS, SW_HEAD_DIM), positions)
    v = v_in.reshape(B, S, SW_KV_HEADS, SW_HEAD_DIM)

    qb = q.reshape(B, nb, SW_BLOCK, SW_KV_HEADS, G, SW_HEAD_DIM).astype(jnp.float32)

    def band(t):
        tp = jnp.pad(t, ((0, 0), (SW_BLOCK, 0), (0, 0), (0, 0)))
        tb = tp.reshape(B, nb + 1, SW_BLOCK, SW_KV_HEADS, SW_HEAD_DIM)
        return jnp.concatenate([tb[:, :-1], tb[:, 1:]], axis=2)

    kw = band(k).astype(jnp.float32)
    vw = band(v)
    scores = jnp.einsum('bnqhgd,bnkhd->bnhgqk', qb, kw) * (SW_HEAD_DIM ** -0.5)

    qi = jnp.arange(SW_BLOCK)[:, None] + SW_BLOCK
    ki = jnp.arange(2 * SW_BLOCK)[None, :]
    off = qi - ki
    in_band = (off >= 0) & (off < SW_WINDOW)
    blk = jnp.arange(nb)[:, None, None]
    valid = (blk * SW_BLOCK + ki[None] - SW_BLOCK) >= 0
    mask = (in_band[None] & valid)[None, :, None, None]
    scores = jnp.where(mask, scores, -jnp.inf)

    sink = sinks.astype(jnp.float32).reshape(SW_KV_HEADS, G)[None, None, :, :, None, None]
    m = jnp.maximum(jnp.max(scores, axis=-1, keepdims=True), sink)
    p = jnp.exp(scores - m)
    probs = p / (jnp.sum(p, axis=-1, keepdims=True) + jnp.exp(sink - m))
    o = jnp.einsum('bnhgqk,bnkhd->bnqhgd', probs.astype(vw.dtype), vw)
    return o.reshape(B, S, SW_Q_W)


def hybrid_layer(x, positions, pre_mix_g, w_in, dn_conv_w, dn_a_log, dn_dt_bias, dn_norm_g,
                 sw_sinks, w_up_dn, w_up_sw, w_o, post_mix_g, pre_mlp_g, w_ff1, w_ff2,
                 post_mlp_g):
    h = rmsnorm(x, pre_mix_g)
    proj = h @ w_in
    (dn_q, dn_k, dn_v, dn_z, dn_b, dn_a, sw_q, sw_k, sw_v,
     gate_a, gate_b) = jnp.split(proj, IN_OFFSETS, axis=-1)
    y_a = deltanet_branch(dn_q, dn_k, dn_v, dn_z, dn_b, dn_a, dn_conv_w, dn_a_log,
                          dn_dt_bias, dn_norm_g) @ w_up_dn
    y_b = swa_sink_branch(sw_q, sw_k, sw_v, positions, sw_sinks) @ w_up_sw
    mix = (jax.nn.sigmoid(gate_a) * y_a + jax.nn.sigmoid(gate_b) * y_b) @ w_o
    x = x + rmsnorm(mix, post_mix_g)

    h2 = rmsnorm(x, pre_mlp_g)
    ff = jnp.square(jax.nn.relu(h2 @ w_ff1)) @ w_ff2
    return x + rmsnorm(ff, post_mlp_g)


def setup_inputs(seed: int = 0) -> dict:
    key = jax.random.key(seed)
    ks = jax.random.split(key, 20)
    f32 = jnp.float32

    def nrm(k, shape, scale):
        return jax.random.normal(k, shape, f32) * scale

    def gain(k, shape):
        return 1.0 + 0.02 * jax.random.normal(k, shape, f32)

    x = jax.random.normal(ks[0], (BATCH, SEQ, D_MODEL), f32)
    positions = jnp.broadcast_to(jnp.arange(SEQ, dtype=jnp.int32), (BATCH, SEQ))
    dt = jnp.exp(jax.random.uniform(ks[5], (DEPTH, DN_HEADS), f32,
                                    np.log(1e-3), np.log(1e-1)))
    return {
        'x': x,
        'positions': positions,
        'pre_mix_g': gain(ks[1], (DEPTH, D_MODEL)),
        'w_in': nrm(ks[2], (DEPTH, D_MODEL, D_IN), D_MODEL ** -0.5),
        'dn_conv_w': nrm(ks[3], (DEPTH, DN_CONV, 2 * DN_QK_W + DN_V_W), DN_CONV ** -0.5),
        'dn_a_log': jnp.log(jax.random.uniform(ks[4], (DEPTH, DN_HEADS), f32, 1.0, 16.0)),
        'dn_dt_bias': dt + jnp.log(-jnp.expm1(-dt)),
        'dn_norm_g': gain(ks[6], (DEPTH, DN_DV)),
        'sw_sinks': nrm(ks[7], (DEPTH, SW_Q_HEADS), 0.5),
        'w_up_dn': nrm(ks[8], (DEPTH, DN_V_W, D_MODEL), DN_V_W ** -0.5),
        'w_up_sw': nrm(ks[9], (DEPTH, SW_Q_W, D_MODEL), SW_Q_W ** -0.5),
        'w_o': nrm(ks[10], (DEPTH, D_MODEL, D_MODEL), D_MODEL ** -0.5),
        'post_mix_g': gain(ks[11], (DEPTH, D_MODEL)),
        'pre_mlp_g': gain(ks[12], (DEPTH, D_MODEL)),
        'w_ff1': nrm(ks[13], (DEPTH, D_MODEL, D_FF), D_MODEL ** -0.5),
        'w_ff2': nrm(ks[14], (DEPTH, D_FF, D_MODEL), D_FF ** -0.5),
        'post_mlp_g': gain(ks[15], (DEPTH, D_MODEL)),
    }


def reference(x, positions, pre_mix_g, w_in, dn_conv_w, dn_a_log, dn_dt_bias, dn_norm_g,
              sw_sinks, w_up_dn, w_up_sw, w_o, post_mix_g, pre_mlp_g, w_ff1, w_ff2,
              post_mlp_g):
    for l in range(DEPTH):
        x = hybrid_layer(x, positions, pre_mix_g[l], w_in[l], dn_conv_w[l], dn_a_log[l],
                         dn_dt_bias[l], dn_norm_g[l], sw_sinks[l], w_up_dn[l], w_up_sw[l],
                         w_o[l], post_mix_g[l], pre_mlp_g[l], w_ff1[l], w_ff2[l],
                         post_mlp_g[l])
    return x
```

```cpp
#include <hip/hip_runtime.h>
#include <hip/hip_cooperative_groups.h>
#include <cstdio>
#include <cstdint>
namespace cg = cooperative_groups;

namespace pg8 {
#define PG8_LAS __attribute__((address_space(3)))
typedef unsigned short bf16_t;
typedef short bf16x8 __attribute__((ext_vector_type(8)));
typedef float f32x4 __attribute__((ext_vector_type(4)));
typedef unsigned u32x4 __attribute__((ext_vector_type(4)));
constexpr int BM = 256, BK = 64, HALF = 128, HTB = HALF * BK * 2, STAGE_BYTES = 8 * HTB, NXCD = 8, WGM = 8;

__host__ __device__ __forceinline__ int lds_byte(int r, int c) { const int st = (r >> 4) * 2 + (c >> 5), rr = r & 15, cc = c & 31, ob = rr * 64 + cc * 2; return st * 1024 + (ob ^ (((ob >> 9) & 1) << 5)); }
__host__ __device__ __forceinline__ void stage_rc(int b, int& R, int& C) { const int st = b / 1024, sb = b % 1024, swz = sb ^ (((sb >> 9) & 1) << 5); R = (st >> 1) * 16 + swz / 64; C = (st & 1) * 32 + (swz % 64) / 2; }
__host__ __device__ __forceinline__ int perm32(int rho) { const int n = rho >> 4, i = rho & 15; return 8 * (i >> 2) + 4 * n + (i & 3); }

struct Unit { int pm, pn, src; };
struct Gemm { const bf16_t* A; const bf16_t* Bt; const bf16_t* A2; const bf16_t* Bt2; int M, N, K, lda; };

struct StaticOrder {
    int nM, nN, nwg, G, c;
    __host__ __device__ void init(int M, int N, int G_, int c_) { nM = M / BM; nN = N / BM; nwg = nM * nN; G = G_; c = c_; }
    __host__ __device__ bool tile(long L, Unit& u) const {
        if (L >= nwg) return false;
        int wgid = (int)L; { const int q = nwg / NXCD, r = nwg % NXCD, xcd = wgid % NXCD, off = wgid / NXCD; wgid = (xcd < r ? xcd * (q + 1) : r * (q + 1) + (xcd - r) * q) + off; }
        const int nig = WGM * nN, gid = wgid / nig, fm = gid * WGM, gsz = (nM - fm) < WGM ? (nM - fm) : WGM;
        u.pm = fm + ((wgid % nig) % gsz); u.pn = (wgid % nig) / gsz; u.src = 0; return true;
    }
    __host__ __device__ bool next(int i, Unit& u) const { return tile((long)i * G + c, u); }
};
struct DualOrder {
    StaticOrder S;
    __host__ __device__ bool next(int i, Unit& u) const { const bool ok = S.tile((long)(i >> 1) * S.G + S.c, u); u.src = i & 1; return ok; }
};

typedef float f32x2c __attribute__((ext_vector_type(2)));
typedef __bf16 bf16x2c __attribute__((ext_vector_type(2)));
__device__ __forceinline__ unsigned cvt_pk_bf16(float lo, float hi) { const f32x2c v = {lo, hi}; return __builtin_bit_cast(unsigned, __builtin_convertvector(v, bf16x2c)); }
__device__ __forceinline__ float bf_lo(unsigned w) { return __uint_as_float(w << 16); }
__device__ __forceinline__ float bf_hi(unsigned w) { return __uint_as_float(w & 0xffff0000u); }

template <int ACT  > struct EpiBf16 {
    static constexpr bool PERM = true, DUAL = false, AFTER_DRAIN = false;
    bf16_t* O; int ldc;
    __device__ __forceinline__ void mid(f32x4 (&acc)[2][2][4][2], const Unit& u, int wr, int wc, int fr, int fq) const {}
    __device__ __forceinline__ void operator()(const f32x4 (&acc)[2][2][4][2], const Unit& u, int wr, int wc, int fr, int fq) const {
        const int row0 = u.pm * BM + wr * 64 + fr; const int col0 = u.pn * BM + wc * 32 + 8 * fq;
#pragma unroll
        for (int ai = 0; ai < 2; ++ai)
#pragma unroll
            for (int m = 0; m < 4; ++m) { bf16_t* rowp = O + (size_t)(row0 + ai * HALF + m * 16) * ldc + col0;
#pragma unroll
                for (int bj = 0; bj < 2; ++bj) { f32x4 v0 = acc[ai][bj][m][0], v1 = acc[ai][bj][m][1];
                    if (ACT == 2) {
#pragma unroll
                        for (int e = 0; e < 4; ++e) { const float a = fmaxf(v0[e], 0.f), b = fmaxf(v1[e], 0.f); v0[e] = a * a; v1[e] = b * b; } }
                    u32x4 w; w.x = cvt_pk_bf16(v0[0], v0[1]); w.y = cvt_pk_bf16(v0[2], v0[3]); w.z = cvt_pk_bf16(v1[0], v1[1]); w.w = cvt_pk_bf16(v1[2], v1[3]);
                    *(u32x4*)(rowp + bj * HALF) = w; } }
    }
};
struct EpiF32 {
    static constexpr bool PERM = false, DUAL = false, AFTER_DRAIN = false;
    float* O; int ldc;
    __device__ __forceinline__ void mid(f32x4 (&acc)[2][2][4][2], const Unit& u, int wr, int wc, int fr, int fq) const {}
    __device__ __forceinline__ void operator()(const f32x4 (&acc)[2][2][4][2], const Unit& u, int wr, int wc, int fr, int fq) const {
        float* rowp = O + (size_t)(u.pm * BM + wr * 64 + fr) * ldc + (u.pn * BM + wc * 32 + 4 * fq);
#pragma unroll
        for (int ai = 0; ai < 2; ++ai) {
#pragma unroll
            for (int m = 0; m < 4; ++m) {
#pragma unroll
                for (int bj = 0; bj < 2; ++bj)
#pragma unroll
                    for (int n = 0; n < 2; ++n) *(f32x4*)(rowp + bj * HALF + n * 16) = acc[ai][bj][m][n];
                rowp += (size_t)16 * ldc; asm volatile("" : "+v"(rowp) :: "memory"); }
            rowp += (size_t)64 * ldc; }
    }
};
struct EpiMerge {
    static constexpr bool PERM = true, DUAL = true, AFTER_DRAIN = false;
    bf16_t* O; int ldc; const bf16_t* GA; const bf16_t* GB; int ldg;
    __device__ __forceinline__ void mid(f32x4 (&acc)[2][2][4][2], const Unit& u, int wr, int wc, int fr, int fq) const {
        const int row0 = u.pm * BM + wr * 64 + fr; const int col0 = u.pn * BM + wc * 32 + 8 * fq;
#pragma unroll
        for (int ai = 0; ai < 2; ++ai)
#pragma unroll
            for (int m = 0; m < 4; ++m) { const size_t ro = (size_t)(row0 + ai * HALF + m * 16) * ldg + col0;
#pragma unroll
                for (int bj = 0; bj < 2; ++bj) { const u32x4 ga = *(const u32x4*)(GA + ro + bj * HALF), gb = *(const u32x4*)(GB + ro + bj * HALF);
#pragma unroll
                    for (int e = 0; e < 4; ++e) { const unsigned wa = ga[e], wb = gb[e];
                        const float r0 = (1.f + __expf(-bf_lo(wb))) / (1.f + __expf(-bf_lo(wa))), r1 = (1.f + __expf(-bf_hi(wb))) / (1.f + __expf(-bf_hi(wa)));
                        if (e < 2) { acc[ai][bj][m][0][2 * e] *= r0; acc[ai][bj][m][0][2 * e + 1] *= r1; } else { acc[ai][bj][m][1][2 * (e - 2)] *= r0; acc[ai][bj][m][1][2 * (e - 2) + 1] *= r1; } } } }
    }
    __device__ __forceinline__ void operator()(const f32x4 (&acc)[2][2][4][2], const Unit& u, int wr, int wc, int fr, int fq) const {
        const int row0 = u.pm * BM + wr * 64 + fr; const int col0 = u.pn * BM + wc * 32 + 8 * fq;
#pragma unroll
        for (int ai = 0; ai < 2; ++ai)
#pragma unroll
            for (int m = 0; m < 4; ++m) { const size_t ro = (size_t)(row0 + ai * HALF + m * 16) * ldg + col0; bf16_t* rowp = O + (size_t)(row0 + ai * HALF + m * 16) * ldc + col0;
#pragma unroll
                for (int bj = 0; bj < 2; ++bj) { const u32x4 gb = *(const u32x4*)(GB + ro + bj * HALF); f32x4 v0 = acc[ai][bj][m][0], v1 = acc[ai][bj][m][1];
                    float s[8];
#pragma unroll
                    for (int e = 0; e < 4; ++e) { s[2 * e] = 1.f / (1.f + __expf(-bf_lo(gb[e]))); s[2 * e + 1] = 1.f / (1.f + __expf(-bf_hi(gb[e]))); }
                    u32x4 w; w.x = cvt_pk_bf16(v0[0] * s[0], v0[1] * s[1]); w.y = cvt_pk_bf16(v0[2] * s[2], v0[3] * s[3]); w.z = cvt_pk_bf16(v1[0] * s[4], v1[1] * s[5]); w.w = cvt_pk_bf16(v1[2] * s[6], v1[3] * s[7]);
                    *(u32x4*)(rowp + bj * HALF) = w; } }
    }
};

struct EpiYb {
    static constexpr bool PERM = true, DUAL = false, AFTER_DRAIN = false;
    bf16_t* O; int ldc; const bf16_t* GB; int ldg;
    __device__ __forceinline__ void mid(f32x4 (&acc)[2][2][4][2], const Unit& u, int wr, int wc, int fr, int fq) const {}
    __device__ __forceinline__ void operator()(const f32x4 (&acc)[2][2][4][2], const Unit& u, int wr, int wc, int fr, int fq) const {
        const int row0 = u.pm * BM + wr * 64 + fr; const int col0 = u.pn * BM + wc * 32 + 8 * fq;
#pragma unroll
        for (int ai = 0; ai < 2; ++ai)
#pragma unroll
            for (int m = 0; m < 4; ++m) { const size_t ro = (size_t)(row0 + ai * HALF + m * 16) * ldg + col0; bf16_t* rowp = O + (size_t)(row0 + ai * HALF + m * 16) * ldc + col0;
#pragma unroll
                for (int bj = 0; bj < 2; ++bj) { const u32x4 gb = *(const u32x4*)(GB + ro + bj * HALF); const f32x4 v0 = acc[ai][bj][m][0], v1 = acc[ai][bj][m][1];
                    float s[8];
#pragma unroll
                    for (int e = 0; e < 4; ++e) { s[2 * e] = __builtin_amdgcn_rcpf(1.f + __expf(-bf_lo(gb[e]))); s[2 * e + 1] = __builtin_amdgcn_rcpf(1.f + __expf(-bf_hi(gb[e]))); }
                    u32x4 w; w.x = cvt_pk_bf16(v0[0] * s[0], v0[1] * s[1]); w.y = cvt_pk_bf16(v0[2] * s[2], v0[3] * s[3]); w.z = cvt_pk_bf16(v1[0] * s[4], v1[1] * s[5]); w.w = cvt_pk_bf16(v1[2] * s[6], v1[3] * s[7]);
                    *(u32x4*)(rowp + bj * HALF) = w; } }
    }
};
struct EpiMerge2 {
    static constexpr bool PERM = true, DUAL = false, AFTER_DRAIN = false;
    bf16_t* O; int ldc; const bf16_t* GA; const bf16_t* YB; int ldg;
    __device__ __forceinline__ void mid(f32x4 (&acc)[2][2][4][2], const Unit& u, int wr, int wc, int fr, int fq) const {}
    __device__ __forceinline__ void operator()(const f32x4 (&acc)[2][2][4][2], const Unit& u, int wr, int wc, int fr, int fq) const {
        const int row0 = u.pm * BM + wr * 64 + fr; const int col0 = u.pn * BM + wc * 32 + 8 * fq;
#pragma unroll
        for (int ai = 0; ai < 2; ++ai)
#pragma unroll
            for (int m = 0; m < 4; ++m) { const size_t ro = (size_t)(row0 + ai * HALF + m * 16) * ldg + col0; bf16_t* rowp = O + (size_t)(row0 + ai * HALF + m * 16) * ldc + col0;
#pragma unroll
                for (int bj = 0; bj < 2; ++bj) { const u32x4 ga = *(const u32x4*)(GA + ro + bj * HALF), yb = *(const u32x4*)(YB + ro + bj * HALF); const f32x4 v0 = acc[ai][bj][m][0], v1 = acc[ai][bj][m][1];
                    float o[8];
#pragma unroll
                    for (int e = 0; e < 4; ++e) { const float a0 = (e < 2) ? v0[2 * e] : v1[2 * (e - 2)], a1 = (e < 2) ? v0[2 * e + 1] : v1[2 * (e - 2) + 1];
                        o[2 * e] = a0 * __builtin_amdgcn_rcpf(1.f + __expf(-bf_lo(ga[e]))) + bf_lo(yb[e]); o[2 * e + 1] = a1 * __builtin_amdgcn_rcpf(1.f + __expf(-bf_hi(ga[e]))) + bf_hi(yb[e]); }
                    u32x4 w; w.x = cvt_pk_bf16(o[0], o[1]); w.y = cvt_pk_bf16(o[2], o[3]); w.z = cvt_pk_bf16(o[4], o[5]); w.w = cvt_pk_bf16(o[6], o[7]);
                    *(u32x4*)(rowp + bj * HALF) = w; } }
    }
};
struct RmsExchange {
    float* slots;
    unsigned* cnt;
    __device__ __forceinline__ void run(const f32x4 (&v)[2][2][4][2], const Unit& u, int wr, int wc, int fr, int fq, PG8_LAS unsigned char* lds, int wid, int lane) const {
        PG8_LAS float* P = (PG8_LAS float*)lds;
        PG8_LAS float* S = (PG8_LAS float*)(lds + 4096);
#pragma unroll
        for (int ai = 0; ai < 2; ++ai)
#pragma unroll
            for (int m = 0; m < 4; ++m) { float s = 0.f;
#pragma unroll
                for (int bj = 0; bj < 2; ++bj)
#pragma unroll
                    for (int n = 0; n < 2; ++n) { const f32x4 x = v[ai][bj][m][n]; s += (x[0] * x[0] + x[1] * x[1]) + (x[2] * x[2] + x[3] * x[3]); }
                s += __shfl_xor(s, 16); s += __shfl_xor(s, 32);
                if (fq == 0) P[(ai * HALF + wr * 64 + m * 16 + fr) * 4 + wc] = s; }
        asm volatile("s_waitcnt lgkmcnt(0)" ::: "memory"); __builtin_amdgcn_s_barrier(); asm volatile("" ::: "memory");
        const int row = wid * 64 + lane;
        if (wid < 4) {
            const f32x4 p = *(const PG8_LAS f32x4*)(P + row * 4);
            __hip_atomic_store(slots + ((size_t)(u.pm * BM + row) * 4 + u.pn), (p[0] + p[1]) + (p[2] + p[3]), __ATOMIC_RELAXED, __HIP_MEMORY_SCOPE_AGENT);
            asm volatile("s_waitcnt vmcnt(0)" ::: "memory");
            if (lane == 0) __hip_atomic_fetch_add(cnt + 16 * u.pm, 1u, __ATOMIC_RELAXED, __HIP_MEMORY_SCOPE_AGENT);
        }
        if (wid == 0) {
            unsigned sp = 0;
            while ((unsigned)__builtin_amdgcn_readfirstlane(__hip_atomic_load(cnt + 16 * u.pm, __ATOMIC_RELAXED, __HIP_MEMORY_SCOPE_AGENT)) < 16u) { __builtin_amdgcn_s_sleep(1); if (++sp > (1u << 22)) break; }
            __builtin_amdgcn_fence(__ATOMIC_ACQUIRE, "agent");
        }
        asm volatile("s_waitcnt vmcnt(0) lgkmcnt(0)" ::: "memory"); __builtin_amdgcn_s_barrier(); asm volatile("" ::: "memory");
        if (wid < 4) {
            const float* sl = slots + (size_t)(u.pm * BM + row) * 4; float t = 0.f;
#pragma unroll
            for (int k = 0; k < 4; ++k) t += __hip_atomic_load(sl + k, __ATOMIC_RELAXED, __HIP_MEMORY_SCOPE_AGENT);
            S[row] = rsqrtf(t * (1.0f / 1024.0f) + 1e-6f);
        }
        asm volatile("s_waitcnt vmcnt(0) lgkmcnt(0)" ::: "memory"); __builtin_amdgcn_s_barrier(); asm volatile("" ::: "memory");
    }
};
struct EpiRmsRes {
    static constexpr bool PERM = false, DUAL = false, AFTER_DRAIN = true;
    float* x; const float* gpost; const float* gnext; bf16_t* xn; RmsExchange e1, e2;
    __device__ __forceinline__ void mid(f32x4 (&acc)[2][2][4][2], const Unit& u, int wr, int wc, int fr, int fq) const {}
    __device__ __forceinline__ void operator()(const f32x4 (&acc)[2][2][4][2], const Unit& u, int wr, int wc, int fr, int fq) const {}
    __device__ __forceinline__ void fused(f32x4 (&acc)[2][2][4][2], const Unit& u, int wr, int wc, int fr, int fq, PG8_LAS unsigned char* lds, int wid, int lane) const {
        typedef unsigned u32x2v __attribute__((ext_vector_type(2)));
        const PG8_LAS float* S = (const PG8_LAS float*)(lds + 4096);
        const int col0 = u.pn * BM + wc * 32 + 4 * fq;
        e1.run(acc, u, wr, wc, fr, fq, lds, wid, lane);
        f32x4 g[2][2];
#pragma unroll
        for (int bj = 0; bj < 2; ++bj)
#pragma unroll
            for (int n = 0; n < 2; ++n) g[bj][n] = *(const f32x4*)(gpost + col0 + bj * HALF + n * 16);
#pragma unroll
        for (int ai = 0; ai < 2; ++ai)
#pragma unroll
            for (int m = 0; m < 4; ++m) { const int r = ai * HALF + wr * 64 + m * 16 + fr; const float sr = S[r]; float* xp = x + (size_t)(u.pm * BM + r) * 1024 + col0;
#pragma unroll
                for (int bj = 0; bj < 2; ++bj)
#pragma unroll
                    for (int n = 0; n < 2; ++n) { const f32x4 xv = *(const f32x4*)(xp + bj * HALF + n * 16); const f32x4 o = xv + acc[ai][bj][m][n] * sr * g[bj][n]; acc[ai][bj][m][n] = o; *(f32x4*)(xp + bj * HALF + n * 16) = o; }
                asm volatile("" : "+v"(acc[ai][0][m][0]), "+v"(acc[ai][0][m][1]), "+v"(acc[ai][1][m][0]), "+v"(acc[ai][1][m][1]));
                if (m & 1) asm volatile("" ::: "memory"); }
        if (gnext) {
            e2.run(acc, u, wr, wc, fr, fq, lds, wid, lane);
#pragma unroll
            for (int bj = 0; bj < 2; ++bj)
#pragma unroll
                for (int n = 0; n < 2; ++n) g[bj][n] = *(const f32x4*)(gnext + col0 + bj * HALF + n * 16);
#pragma unroll
            for (int ai = 0; ai < 2; ++ai)
#pragma unroll
                for (int m = 0; m < 4; ++m) { const int r = ai * HALF + wr * 64 + m * 16 + fr; const float sr = S[r]; bf16_t* op = xn + (size_t)(u.pm * BM + r) * 1024 + col0;
#pragma unroll
                    for (int bj = 0; bj < 2; ++bj)
#pragma unroll
                        for (int n = 0; n < 2; ++n) { const f32x4 o = acc[ai][bj][m][n] * sr * g[bj][n]; u32x2v w; w.x = cvt_pk_bf16(o[0], o[1]); w.y = cvt_pk_bf16(o[2], o[3]); *(u32x2v*)(op + bj * HALF + n * 16) = w; } }
        }
    }
};
template <class Epi, class Sched, bool ALIGN_EPI = false, bool SP2 = false>
__device__ __forceinline__ void gemm_phase(PG8_LAS unsigned char* lds, const Gemm g, const Sched& S, const Epi& E) {
    int tid_ = threadIdx.x; asm volatile("" : "+v"(tid_)); const int tid = tid_, wid = __builtin_amdgcn_readfirstlane(tid >> 6), lane = tid & 63, wr = wid >> 2, wc = wid & 3, fr = lane & 15, fq = lane >> 4;
    const int K = g.K, nt = K / BK, lda = g.lda;
    unsigned voffA[2], voffB[2];
#pragma unroll
    for (int i = 0; i < 2; ++i) { int R, C; stage_rc(tid * 16 + i * 8192, R, C); const int Rb = Epi::PERM ? ((R & ~31) + perm32(R & 31)) : R;
        voffA[i] = (unsigned)(R * lda + C) * 2u; voffB[i] = (unsigned)(Rb * K + C) * 2u; }
    const size_t kstep = (size_t)(BK * 2);
    const size_t hstepA = (size_t)HALF * lda * 2, hstepB = (size_t)HALF * K * 2;
    const size_t tstepA = 2 * hstepA, tstepB = 2 * hstepB;
    const unsigned ldsw = (unsigned)wid * 1024u;
    const int aoff = lds_byte(wr * 64 + fr, fq * 8), boff = lds_byte(wc * 32 + fr, fq * 8);
#define PG8_SA(b, h) (((b) * 2 + (h)) * HTB)
#define PG8_SB(b, h) ((4 + (b) * 2 + (h)) * HTB)
#define PG8_STAGE(bufoff, gbase, voff) do { _Pragma("unroll") for (int _i = 0; _i < 2; ++_i) \
        __builtin_amdgcn_global_load_lds((const unsigned*)((const char*)(gbase) + (voff)[_i]), (PG8_LAS unsigned*)(lds + (bufoff) + ldsw + _i * 8192), 16, 0, 0); } while (0)
#define PG8_LDA(dst, b, h) do { _Pragma("unroll") for (int m = 0; m < 4; ++m) _Pragma("unroll") for (int k = 0; k < 2; ++k) dst[m][k] = *(const PG8_LAS bf16x8*)(lds + PG8_SA(b, h) + aoff + m * 2048 + k * 1024); } while (0)
#define PG8_LDB(dst, b, h) do { _Pragma("unroll") for (int n = 0; n < 2; ++n) _Pragma("unroll") for (int k = 0; k < 2; ++k) dst[n][k] = *(const PG8_LAS bf16x8*)(lds + PG8_SB(b, h) + boff + n * 2048 + k * 1024); } while (0)
#define PG8_MMA(ai, bj, At, Bt) do { __builtin_amdgcn_s_setprio(1); _Pragma("unroll") for (int m = 0; m < 4; ++m) _Pragma("unroll") for (int n = 0; n < 2; ++n) _Pragma("unroll") for (int k = 0; k < 2; ++k) \
        acc[ai][bj][m][n] = __builtin_amdgcn_mfma_f32_16x16x32_bf16(Bt[n][k], At[m][k], acc[ai][bj][m][n], 0, 0, 0); __builtin_amdgcn_s_setprio(0); } while (0)
#define PG8_WAIT_V(n) asm volatile("s_waitcnt vmcnt(" #n ")" ::: "memory")
#define PG8_WAIT_L(n) asm volatile("s_waitcnt lgkmcnt(" #n ")" ::: "memory")
#define PG8_BAR __builtin_amdgcn_s_barrier()
#define PG8_SCHED __builtin_amdgcn_sched_barrier(0)
    Unit cur, nxt; int ui = 0;
    if (!S.next(0, cur)) return;
    f32x4 acc[2][2][4][2];
#pragma unroll
    for (int a = 0; a < 2; ++a)
#pragma unroll
        for (int b = 0; b < 2; ++b)
#pragma unroll
            for (int m = 0; m < 4; ++m)
#pragma unroll
                for (int n = 0; n < 2; ++n) acc[a][b][m][n] = (f32x4){0.f, 0.f, 0.f, 0.f};
    bf16x8 At[4][2], B0[2][2], B1[2][2];
    const char* cA = (const char*)(cur.src ? g.A2 : g.A) + (size_t)cur.pm * tstepA; const char* cB = (const char*)(cur.src ? g.Bt2 : g.Bt) + (size_t)cur.pn * tstepB;
    if constexpr (SP2) {
        PG8_STAGE(PG8_SB(0, 0), cB, voffB); PG8_STAGE(PG8_SB(0, 1), cB + hstepB, voffB); PG8_STAGE(PG8_SA(0, 0), cA, voffA); PG8_STAGE(PG8_SA(0, 1), cA + hstepA, voffA);
        if (wr == 1) PG8_BAR;
        PG8_WAIT_V(2); PG8_BAR;
        PG8_STAGE(PG8_SB(1, 0), cB + kstep, voffB); PG8_STAGE(PG8_SA(1, 0), cA + kstep, voffA); PG8_STAGE(PG8_SB(1, 1), cB + hstepB + kstep, voffB);
        PG8_WAIT_V(6); PG8_BAR;
    } else {
        PG8_STAGE(PG8_SB(0, 0), cB, voffB); PG8_STAGE(PG8_SA(0, 0), cA, voffA); PG8_STAGE(PG8_SB(0, 1), cB + hstepB, voffB); PG8_STAGE(PG8_SA(0, 1), cA + hstepA, voffA);
        if (wr == 1) PG8_BAR;
        PG8_WAIT_V(4); PG8_BAR;
        PG8_STAGE(PG8_SB(1, 0), cB + kstep, voffB); PG8_STAGE(PG8_SA(1, 0), cA + kstep, voffA); PG8_STAGE(PG8_SB(1, 1), cB + hstepB + kstep, voffB);
        PG8_WAIT_V(6); PG8_BAR;
    }
    for (;;) {
        const bool has_next = S.next(ui + 1, nxt);
        const char* nA = has_next ? (const char*)(nxt.src ? g.A2 : g.A) + (size_t)nxt.pm * tstepA : cA; const char* nB = has_next ? (const char*)(nxt.src ? g.Bt2 : g.Bt) + (size_t)nxt.pn * tstepB : cB;
        for (int t = 0; t < nt; t += 2) {
            const bool last = (t == nt - 2);
            const char* a1 = cA + (size_t)(t + 1) * kstep;
            const char* a2 = last ? nA : cA + (size_t)(t + 2) * kstep; const char* b2 = last ? nB : cB + (size_t)(t + 2) * kstep;
            const char* a3 = a2 + kstep; const char* b3 = b2 + kstep;
            if constexpr (SP2) {
            PG8_LDB(B0, 0, 0); PG8_LDB(B1, 0, 1); PG8_SCHED; PG8_LDA(At, 0, 0); PG8_STAGE(PG8_SA(1, 1), a1 + hstepA, voffA);
            PG8_WAIT_V(8); PG8_WAIT_L(0); PG8_BAR; PG8_MMA(0, 0, At, B0); PG8_MMA(0, 1, At, B1); PG8_BAR; PG8_SCHED;
            PG8_LDA(At, 0, 1); PG8_STAGE(PG8_SB(0, 0), b2, voffB); PG8_STAGE(PG8_SB(0, 1), b2 + hstepB, voffB); PG8_STAGE(PG8_SA(0, 0), a2, voffA);
            PG8_WAIT_V(8); PG8_WAIT_L(0); PG8_BAR; PG8_MMA(1, 0, At, B0); PG8_MMA(1, 1, At, B1); PG8_BAR; PG8_SCHED;
            PG8_LDB(B0, 1, 0); PG8_LDB(B1, 1, 1); PG8_SCHED; PG8_LDA(At, 1, 0); PG8_STAGE(PG8_SA(0, 1), a2 + hstepA, voffA);
            PG8_WAIT_V(8); PG8_WAIT_L(0); PG8_BAR; PG8_MMA(0, 0, At, B0); PG8_MMA(0, 1, At, B1); PG8_BAR; PG8_SCHED;
            PG8_LDA(At, 1, 1); PG8_STAGE(PG8_SB(1, 0), b3, voffB); PG8_STAGE(PG8_SB(1, 1), b3 + hstepB, voffB); PG8_STAGE(PG8_SA(1, 0), a3, voffA);
            PG8_WAIT_V(8); PG8_WAIT_L(0); PG8_BAR; PG8_MMA(1, 0, At, B0); PG8_MMA(1, 1, At, B1); PG8_BAR; PG8_SCHED;
            } else {
            PG8_LDB(B0, 0, 0); PG8_SCHED; PG8_LDA(At, 0, 0); PG8_STAGE(PG8_SA(1, 1), a1 + hstepA, voffA);
            PG8_WAIT_L(8); PG8_BAR; PG8_WAIT_L(0); PG8_MMA(0, 0, At, B0); PG8_BAR; PG8_SCHED;
            PG8_LDB(B1, 0, 1); PG8_STAGE(PG8_SB(0, 0), b2, voffB);
            PG8_BAR; PG8_WAIT_L(0); PG8_MMA(0, 1, At, B1); PG8_BAR;
            PG8_LDA(At, 0, 1); PG8_STAGE(PG8_SA(0, 0), a2, voffA);
            PG8_BAR; PG8_WAIT_L(0); PG8_MMA(1, 0, At, B0); PG8_BAR; PG8_SCHED;
            PG8_STAGE(PG8_SB(0, 1), b2 + hstepB, voffB);
            PG8_WAIT_V(6); PG8_BAR; PG8_MMA(1, 1, At, B1); PG8_BAR;
            PG8_LDB(B0, 1, 0); PG8_SCHED; PG8_LDA(At, 1, 0); PG8_STAGE(PG8_SA(0, 1), a2 + hstepA, voffA);
            PG8_WAIT_L(8); PG8_BAR; PG8_WAIT_L(0); PG8_MMA(0, 0, At, B0); PG8_BAR; PG8_SCHED;
            PG8_LDB(B1, 1, 1); PG8_STAGE(PG8_SB(1, 0), b3, voffB);
            PG8_BAR; PG8_WAIT_L(0); PG8_MMA(0, 1, At, B1); PG8_BAR;
            PG8_LDA(At, 1, 1); PG8_STAGE(PG8_SA(1, 0), a3, voffA);
            PG8_BAR; PG8_WAIT_L(0); PG8_MMA(1, 0, At, B0); PG8_BAR; PG8_SCHED;
            PG8_STAGE(PG8_SB(1, 1), b3 + hstepB, voffB);
            PG8_WAIT_V(6); PG8_BAR; PG8_MMA(1, 1, At, B1); PG8_BAR;
            }
        }
        if constexpr (ALIGN_EPI) { if (wr == 0) PG8_BAR; }
        const bool midu = Epi::DUAL && cur.src == 0;
        if constexpr (!Epi::AFTER_DRAIN) { if (midu) E.mid(acc, cur, wr, wc, fr, fq); else E(acc, cur, wr, wc, fr, fq); }
        if (!has_next) break;
        if (!midu) {
#pragma unroll
        for (int a = 0; a < 2; ++a)
#pragma unroll
            for (int b = 0; b < 2; ++b)
#pragma unroll
                for (int m = 0; m < 4; ++m)
#pragma unroll
                    for (int n = 0; n < 2; ++n) acc[a][b][m][n] = (f32x4){0.f, 0.f, 0.f, 0.f};
        }
        cur = nxt; cA = nA; cB = nB; ++ui;
        if constexpr (ALIGN_EPI) { if (wr == 1) PG8_BAR; }
    }
    PG8_WAIT_V(0);
    if constexpr (!ALIGN_EPI) { if (wr == 0) PG8_BAR; }
    PG8_BAR;
    if constexpr (Epi::AFTER_DRAIN) E.fused(acc, cur, wr, wc, fr, fq, lds, wid, lane);
#undef PG8_SA
#undef PG8_SB
#undef PG8_STAGE
#undef PG8_LDA
#undef PG8_LDB
#undef PG8_MMA
#undef PG8_WAIT_V
#undef PG8_WAIT_L
#undef PG8_BAR
#undef PG8_SCHED
}
}

#define GAS __attribute__((address_space(1)))
#define LAS __attribute__((address_space(3)))
typedef unsigned short bf16;
typedef unsigned v4u __attribute__((ext_vector_type(4)));
typedef unsigned v2u __attribute__((ext_vector_type(2)));
typedef float f32x4 __attribute__((ext_vector_type(4)));
typedef short bf16x8 __attribute__((ext_vector_type(8)));
constexpr int NWAVES = 8, NTHR = 512;
constexpr int BATCH = 2, SEQ = 8192, D = 1024, FF = 4096, DEPTH = 4, M = BATCH * SEQ;
constexpr int DIN = 7440, DINP = 7680;
constexpr int C_DNQ = 0, C_DNK = 1024, C_DNV = 2048, C_DNZ = 3072, C_SWQ = 4096, C_GA = 5120, C_GB = 6144, C_SWK = 7168, C_SWV = 7296, C_DNB = 7424, C_DNA = 7432;
constexpr float EPS = 1e-6f;
constexpr size_t MiB = 1u << 20;
constexpr size_t WS_WIN = 1 * MiB, WS_WUPDN = 16 * MiB, WS_WUPSW = 18 * MiB, WS_WO = 20 * MiB, WS_WFF1 = 22 * MiB, WS_WFF2 = 30 * MiB, WS_ROPE = 38 * MiB;
constexpr size_t WS_PROJ = 40 * MiB, WS_H = 40 * MiB, WS_XN = 280 * MiB, WS_YF = 312 * MiB, WS_MIX = 376 * MiB, WS_END = 456 * MiB;
constexpr int LDS_BYTES = 147456;

typedef float f32x2_t __attribute__((ext_vector_type(2)));
typedef __bf16 bf16x2_t __attribute__((ext_vector_type(2)));
__device__ __forceinline__ unsigned pk2(float lo, float hi) { const f32x2_t v = {lo, hi}; return __builtin_bit_cast(unsigned, __builtin_convertvector(v, bf16x2_t)); }
__device__ __forceinline__ unsigned f2bf(float f) { return pk2(f, 0.f) & 0xffffu; }
__device__ __forceinline__ float bflo(unsigned w) { return __uint_as_float(w << 16); }
__device__ __forceinline__ float bfhi(unsigned w) { return __uint_as_float(w & 0xffff0000u); }
__device__ __forceinline__ float bf1(bf16 h) { return __uint_as_float((unsigned)h << 16); }
__device__ __forceinline__ float wave_sum(float v) {
#pragma unroll
    for (int o = 1; o < 64; o <<= 1) v += __shfl_xor(v, o);
    return v;
}
__device__ __forceinline__ float wave_max(float v) {
#pragma unroll
    for (int o = 1; o < 64; o <<= 1) v = fmaxf(v, __shfl_xor(v, o));
    return v;
}
__device__ __forceinline__ float sigmoidf_(float x) { return __builtin_amdgcn_rcpf(1.f + __expf(-x)); }
__device__ __forceinline__ float siluf_(float x) { return x * __builtin_amdgcn_rcpf(1.f + __expf(-x)); }

struct Frame {
    LAS unsigned char* lds;
    int tid, lane, wave, G, bid;
};
__device__ __forceinline__ LAS unsigned char* lds_base() { extern __shared__ __attribute__((aligned(16))) unsigned char lds_dyn[]; return (LAS unsigned char*)lds_dyn; }
__device__ __forceinline__ Frame mkframe() {
    Frame F; F.lds = lds_base(); int tid = threadIdx.x; asm volatile("" : "+v"(tid)); int bid = blockIdx.x; asm volatile("" : "+s"(bid)); int G = gridDim.x; asm volatile("" : "+s"(G));
    F.tid = tid; F.lane = tid & 63; F.wave = __builtin_amdgcn_readfirstlane(tid >> 6); F.G = G; F.bid = bid; return F; }
typedef __attribute__((address_space(4))) const unsigned char* kargp_t;
__device__ __forceinline__ kargp_t kargs() { kargp_t p = (kargp_t)__builtin_amdgcn_kernarg_segment_ptr(); asm volatile("" : "+s"(p)); return p; }
__device__ __forceinline__ const float* inp(int k) { return *(const float* __attribute__((address_space(4))) const*)(kargs() + 8 * k); }
__device__ __forceinline__ float* outp() { return *(float* __attribute__((address_space(4))) const*)(kargs() + 8 * 17); }
__device__ __forceinline__ unsigned char* wsp() { return *(unsigned char* __attribute__((address_space(4))) const*)(kargs() + 8 * 18); }

__device__ __forceinline__ int orig_col(int nc) {
    if (nc < 4096) return nc;
    if (nc < 5120) return nc - 4096 + 4112;
    if (nc < 6144) return nc - 5120 + 5392;
    if (nc < 7168) return nc - 6144 + 6416;
    if (nc < 7296) return nc - 7168 + 5136;
    if (nc < 7424) return nc - 7296 + 5264;
    if (nc < 7440) return nc - 7424 + 4096;
    return -1;
}
template <bool PERMW>
__device__ __forceinline__ void transpose_item(const float* W, int K, int ldw, int nblk, bf16* WT, LAS float* scr, int item, int lane) {
    const int kb = item / nblk, nb = item % nblk, k0 = 64 * kb, n0 = 32 * nb;
    const int ncol = n0 + (lane & 31); const int oc = PERMW ? orig_col(ncol) : ncol;
#pragma unroll 8
    for (int i = 0; i < 32; ++i) { const int kk = 2 * i + (lane >> 5); scr[kk * 33 + (lane & 31)] = (oc >= 0) ? W[(size_t)(k0 + kk) * ldw + oc] : 0.f; }
    asm volatile("s_waitcnt lgkmcnt(0)" ::: "memory");
    const int c = lane & 7;
#pragma unroll
    for (int j = 0; j < 4; ++j) { const int n = (lane >> 3) + 8 * j; const LAS float* s = scr + (8 * c) * 33 + n;
        v4u o; o.x = pk2(s[0 * 33], s[1 * 33]); o.y = pk2(s[2 * 33], s[3 * 33]); o.z = pk2(s[4 * 33], s[5 * 33]); o.w = pk2(s[6 * 33], s[7 * 33]);
        *(v4u*)(WT + (size_t)(n0 + n) * K + k0 + 8 * c) = o; }
    asm volatile("s_waitcnt lgkmcnt(0)" ::: "memory");
}
__device__ __forceinline__ void phase_convert(Frame& F_, int lrest, int lin, int nskip) {
    Frame F = mkframe();
    LAS float* scr = (LAS float*)(F.lds + F.wave * 16384);
    const int gw = (F.bid - nskip) * NWAVES + F.wave, NGW = (F.G - nskip) * NWAVES;
    constexpr int I_IN = 16 * (DINP / 32), I_SQ = 16 * 32, I_F1 = 16 * (FF / 32), I_F2 = 64 * 32;
    const int n_in = (lin >= 0) ? I_IN : 0, n_rest = (lrest >= 0) ? 3 * I_SQ + I_F1 + I_F2 : 0;
    for (int it = gw; it < n_in + n_rest; it += NGW) {
        int r = it;
        if (r < n_in) { transpose_item<true>(inp(3) + (size_t)lin * D * DIN, D, DIN, DINP / 32, (bf16*)(wsp() + WS_WIN), scr, r, F.lane); continue; } r -= n_in;
        const int l = lrest;
        if (r < I_SQ) { transpose_item<false>(inp(9) + (size_t)l * D * D, D, D, 32, (bf16*)(wsp() + WS_WUPDN), scr, r, F.lane); continue; } r -= I_SQ;
        if (r < I_SQ) { transpose_item<false>(inp(10) + (size_t)l * D * D, D, D, 32, (bf16*)(wsp() + WS_WUPSW), scr, r, F.lane); continue; } r -= I_SQ;
        if (r < I_SQ) { transpose_item<false>(inp(11) + (size_t)l * D * D, D, D, 32, (bf16*)(wsp() + WS_WO), scr, r, F.lane); continue; } r -= I_SQ;
        if (r < I_F1) { transpose_item<false>(inp(14) + (size_t)l * D * FF, D, FF, FF / 32, (bf16*)(wsp() + WS_WFF1), scr, r, F.lane); continue; } r -= I_F1;
        transpose_item<false>(inp(15) + (size_t)l * FF * D, FF, D, 32, (bf16*)(wsp() + WS_WFF2), scr, r, F.lane);
    }
}
__device__ __forceinline__ void phase_rope(Frame& F_) {
    Frame F = mkframe();
    const int* pos = (const int*)inp(1); float* R = (float*)(wsp() + WS_ROPE);
    for (int i = F.bid * NTHR + F.tid; i < M * 8; i += F.G * NTHR) {
        const int m = i >> 3, j = i & 7;
        const float invf = exp2f(-(float)j * (0.125f * 18.931568569324174f));
        const float angf = (float)pos[m] * invf;
        const double a = (double)angf; const double n = rint(a * 0.15915494309189535);
        const float r = (float)(a - n * 6.283185307179586);
        R[m * 16 + j] = __cosf(r); R[m * 16 + 8 + j] = __sinf(r);
    }
}
__device__ __forceinline__ void phase_norm(Frame& F_, const float* y, const float* gpost, const float* xin, float* x, const float* gnext, bf16* XN) {
    Frame F = mkframe();
    const int gw = F.bid * NWAVES + F.wave, NGW = F.G * NWAVES;
    for (int m = gw; m < M; m += NGW) {
        f32x4 v[4];
        const f32x4* xr = (const f32x4*)(xin + (size_t)m * D) + F.lane;
#pragma unroll
        for (int j = 0; j < 4; ++j) v[j] = xr[64 * j];
        if (y) {
            const f32x4* yr = (const f32x4*)(y + (size_t)m * D) + F.lane; f32x4 w[4]; float s = 0.f;
#pragma unroll
            for (int j = 0; j < 4; ++j) { w[j] = yr[64 * j]; s += (w[j].x * w[j].x + w[j].y * w[j].y) + (w[j].z * w[j].z + w[j].w * w[j].w); }
            const float r = rsqrtf(wave_sum(s) * (1.f / D) + EPS);
#pragma unroll
            for (int j = 0; j < 4; ++j) { const f32x4 g = ((const f32x4*)gpost)[F.lane + 64 * j]; v[j] = v[j] + w[j] * r * g; }
        }
        f32x4* xo = (f32x4*)(x + (size_t)m * D) + F.lane;
#pragma unroll
        for (int j = 0; j < 4; ++j) xo[64 * j] = v[j];
        if (gnext) {
            float s = 0.f;
#pragma unroll
            for (int j = 0; j < 4; ++j) s += (v[j].x * v[j].x + v[j].y * v[j].y) + (v[j].z * v[j].z + v[j].w * v[j].w);
            const float r = rsqrtf(wave_sum(s) * (1.f / D) + EPS);
            v2u* o = (v2u*)(XN + (size_t)m * D) + F.lane;
#pragma unroll
            for (int j = 0; j < 4; ++j) { const f32x4 g = ((const f32x4*)gnext)[F.lane + 64 * j]; v2u w; w.x = pk2(v[j].x * r * g.x, v[j].y * r * g.y); w.y = pk2(v[j].z * r * g.z, v[j].w * r * g.w); o[64 * j] = w; }
        }
    }
}
constexpr size_t WS_SUBCNT = 196608, WS_BAR = 65536, WS_XCNT = 131072, WS_XSLOT = 39 * MiB;
#define XB_TMO      128
#define XB_XCNT(j)  (256  + 64 * (j))
#define XB_XSUB(j)  (1280 + 64 * (j))
#define XB_XGEN(j)  (2304 + 64 * (j))
#define XB_TOP      3328
#define XB_TOPGEN   3392
#define XCD_BAR_WORDS 3456
#define XB_SPIN_CAP (1u << 22)
constexpr int LDS_BARST = LDS_BYTES - 16;
__device__ __forceinline__ unsigned xb_ld(unsigned* p)              { return __hip_atomic_load(p, __ATOMIC_RELAXED, __HIP_MEMORY_SCOPE_AGENT); }
__device__ __forceinline__ unsigned xb_add(unsigned* p, unsigned v) { return __hip_atomic_fetch_add(p, v, __ATOMIC_RELAXED, __HIP_MEMORY_SCOPE_AGENT); }
__device__ __forceinline__ unsigned xb_xcc_id() { return (unsigned)__builtin_amdgcn_s_getreg((3 << 11) | 20) & 0xFu; }
#define XB_SPIN(cond, bar) do { unsigned _sp = 0; while (cond) { __builtin_amdgcn_s_sleep(1); \
    if ((++_sp & 255u) == 0u) { if (xb_ld(&(bar)[XB_TMO])) break; if (_sp > XB_SPIN_CAP) { atomicAdd(&(bar)[XB_TMO], 1u); break; } } } } while (0)
__device__ __forceinline__ void xcd_barrier_post() {
    if (threadIdx.x == 0) { unsigned* bar = (unsigned*)(wsp() + WS_BAR); (void)xb_add(&bar[XB_XCNT(xb_xcc_id())], 1u); }
}
__device__ __forceinline__ void xcd_barrier_complete(unsigned* bar, unsigned x, unsigned& nloc, unsigned& nx) {
    const unsigned G = gridDim.x * gridDim.y * gridDim.z;
    unsigned sum, cnt, mine, sp = 0u;
    for (;;) {
        sum = 0u; cnt = 0u; mine = 0u;
#pragma unroll
        for (unsigned j = 0; j < 16; ++j) { const unsigned c = xb_ld(&bar[XB_XCNT(j)]); sum += c; cnt += (c > 0u) ? 1u : 0u; mine = (j == x) ? c : mine; }
        if (sum == G) break;
        __builtin_amdgcn_s_sleep(1);
        if ((++sp & 255u) == 0u) { if (xb_ld(&bar[XB_TMO])) break; if (sp > XB_SPIN_CAP) { atomicAdd(&bar[XB_TMO], 1u); break; } }
    }
    nloc = mine > 0u ? mine : 1u; nx = cnt > 0u ? cnt : 1u;
}
__device__ __forceinline__ void grid_bar() {
    asm volatile("s_waitcnt vmcnt(0)" ::: "memory");
    __syncthreads();
    if (threadIdx.x == 0) {
        unsigned* bar = (unsigned*)(wsp() + WS_BAR); const unsigned x = xb_xcc_id();
        volatile LAS unsigned* st = (volatile LAS unsigned*)(lds_base() + LDS_BARST);
        __builtin_amdgcn_s_waitcnt(0);
        unsigned nloc = st[0], nx = st[1];
        if (nloc == 0u) { xcd_barrier_complete(bar, x, nloc, nx); st[0] = nloc; st[1] = nx; }
        const unsigned old = xb_add(&bar[XB_XSUB(x)], 1u);
        const unsigned gen = old / nloc;
        if (old + 1u == (gen + 1u) * nloc) {
            __builtin_amdgcn_fence(__ATOMIC_RELEASE, "agent");
            asm volatile("s_waitcnt vmcnt(0)" ::: "memory");
            const unsigned og = xb_add(&bar[XB_TOP], 1u);
            const unsigned tg = og / nx;
            if (og + 1u == (tg + 1u) * nx) xb_add(&bar[XB_TOPGEN], 1u);
            else XB_SPIN(xb_ld(&bar[XB_TOPGEN]) == tg, bar);
            __builtin_amdgcn_fence(__ATOMIC_ACQUIRE, "agent");
            xb_add(&bar[XB_XGEN(x)], 1u);
            asm volatile("s_waitcnt vmcnt(0)" ::: "memory");
        } else {
            XB_SPIN(xb_ld(&bar[XB_XGEN(x)]) == gen, bar);
            __builtin_amdgcn_fence(__ATOMIC_ACQUIRE, "agent");
            asm volatile("s_waitcnt vmcnt(0)" ::: "memory");
        }
    }
    __syncthreads();
}

__device__ __forceinline__ void sub_bar(unsigned* cnt, unsigned n) {
    asm volatile("s_waitcnt vmcnt(0)" ::: "memory");
    __syncthreads();
    if (threadIdx.x == 0) {
        __builtin_amdgcn_fence(__ATOMIC_RELEASE, "agent");
        asm volatile("s_waitcnt vmcnt(0)" ::: "memory");
        xb_add(cnt, 1u);
        unsigned sp = 0; while (xb_ld(cnt) < n) { __builtin_amdgcn_s_sleep(1); if (++sp > XB_SPIN_CAP) break; }
        __builtin_amdgcn_fence(__ATOMIC_ACQUIRE, "agent");
        asm volatile("s_waitcnt vmcnt(0)" ::: "memory");
    }
    __syncthreads();
}
#define MFMA16(a, b, c) __builtin_amdgcn_mfma_f32_16x16x32_bf16(a, b, c, 0, 0, 0)
constexpr size_t WS_GL = 0, WS_W = 312 * MiB, WS_QD = 344 * MiB, WS_KDT = 376 * MiB, WS_UT = 408 * MiB, WS_AI = 440 * MiB;
typedef LAS unsigned short* lbf;
template <int PMODE>
__device__ __forceinline__ void dn_prep(Frame& F_, int l) {
    Frame F = mkframe();
    const bf16* PROJ = (const bf16*)(wsp() + WS_PROJ);
    lbf QS = (lbf)(F.lds), KS = (lbf)(F.lds + 17408), VT = (lbf)(F.lds + 34816), KGT = (lbf)(F.lds + 53248), KDT = (lbf)(F.lds + 71680), TB = (lbf)(F.lds + 107520);
    LAS float* LM = (LAS float*)(F.lds + 90112); LAS float* GC = (LAS float*)(F.lds + 116736); LAS float* BT = (LAS float*)(F.lds + 116992);
    const int lane = F.lane, wave = F.wave, fr = lane & 15, fq = lane >> 4;
    struct PrepIn { unsigned xr[3][11]; float cw[3][4][2]; bf16 a, b; };
#define PREP_LOAD(X, chx) do { const int ch_ = (chx), h_ = (ch_ >> 7) & 7, n_ = ch_ & 127, m0_ = (ch_ >> 10) * SEQ + n_ * 64; \
        X.a = PROJ[(size_t)(m0_ + lane) * DINP + C_DNA + h_]; X.b = PROJ[(size_t)(m0_ + lane) * DINP + C_DNB + h_]; \
        _Pragma("unroll") for (int ts = 0; ts < 3; ++ts) _Pragma("unroll") for (int j = 0; j < 11; ++j) { const int ii = 8 * wave - 3 + j; \
            X.xr[ts][j] = (n_ * 64 + ii >= 0) ? *(const unsigned*)(PROJ + (size_t)(m0_ + ii) * DINP + ts * 1024 + h_ * 128 + 2 * lane) : 0u; } \
        { const float* cwp = inp(4) + (size_t)l * 4 * 3072 + h_ * 128 + 2 * lane; \
          _Pragma("unroll") for (int ts = 0; ts < 3; ++ts) _Pragma("unroll") for (int j = 0; j < 4; ++j) { X.cw[ts][j][0] = cwp[j * 3072 + ts * 1024]; X.cw[ts][j][1] = cwp[j * 3072 + ts * 1024 + 1]; } } } while (0)
    PrepIn cur; unsigned eat = 0u;
    for (int ch = F.bid; ch < 2048; ch += F.G) {
        const int b = ch >> 10, h = (ch >> 7) & 7, n = ch & 127, m0 = b * SEQ + n * 64;
        PREP_LOAD(cur, ch);
        unsigned touch = 0u;
        if (ch + F.G < 2048 && F.tid < 402) { const int cn = ch + F.G, hn = (cn >> 7) & 7, nn = cn & 127, mn = (cn >> 10) * SEQ + nn * 64; const int rowt = F.tid / 6 - 3, ln = F.tid % 6;
            if (nn * 64 + rowt >= 0) touch = *(const unsigned*)(PROJ + (size_t)(mn + rowt) * DINP + (ln >> 1) * 1024 + hn * 128 + (ln & 1) * 64); }
        const float a_neg = -__expf(inp(5)[l * 8 + h]), dtb = inp(6)[l * 8 + h];
        float gc, beta, gl;
        { const float a_in = bf1(cur.a), b_in = bf1(cur.b);
          const float z = a_in + dtb; const float sp = (z > 20.f) ? z : log1pf(__expf(z)); gc = a_neg * sp;
#pragma unroll
          for (int o = 1; o < 64; o <<= 1) { const float t = __shfl_up(gc, o); if (lane >= o) gc += t; }
          beta = sigmoidf_(b_in); gl = __shfl(gc, 63);
          if (wave == 0) { GC[lane] = gc; BT[lane] = beta; } }
        float sv[8][3][2], pp[16];
#pragma unroll
        for (int rr = 0; rr < 8; ++rr) {
#pragma unroll
            for (int ts = 0; ts < 3; ++ts) { float y0 = 0.f, y1 = 0.f;
#pragma unroll
                for (int j = 0; j < 4; ++j) { const unsigned xw = cur.xr[ts][rr + j]; y0 += cur.cw[ts][j][0] * bflo(xw); y1 += cur.cw[ts][j][1] * bfhi(xw); }
                sv[rr][ts][0] = siluf_(y0); sv[rr][ts][1] = siluf_(y1); }
            pp[2 * rr] = sv[rr][0][0] * sv[rr][0][0] + sv[rr][0][1] * sv[rr][0][1]; pp[2 * rr + 1] = sv[rr][1][0] * sv[rr][1][0] + sv[rr][1][1] * sv[rr][1][1];
        }
        float tot;
        { const bool b5 = (lane & 32) != 0, b4 = (lane & 16) != 0, b3 = (lane & 8) != 0, b2 = (lane & 4) != 0;
          float p8[8], p4[4], p2[2];
#pragma unroll
          for (int k = 0; k < 8; ++k) p8[k] = (b5 ? pp[k + 8] : pp[k]) + __shfl_xor(b5 ? pp[k] : pp[k + 8], 32);
#pragma unroll
          for (int k = 0; k < 4; ++k) p4[k] = (b4 ? p8[k + 4] : p8[k]) + __shfl_xor(b4 ? p8[k] : p8[k + 4], 16);
#pragma unroll
          for (int k = 0; k < 2; ++k) p2[k] = (b3 ? p4[k + 2] : p4[k]) + __shfl_xor(b3 ? p4[k] : p4[k + 2], 8);
          tot = (b2 ? p2[1] : p2[0]) + __shfl_xor(b2 ? p2[0] : p2[1], 4);
          tot += __shfl_xor(tot, 2); tot += __shfl_xor(tot, 1); }
        unsigned kg[2][4], kd[2][4], vb[2][4];
#pragma unroll
        for (int rr = 0; rr < 8; ++rr) {
            const int i = 8 * wave + rr;
            const float gci = __int_as_float(__builtin_amdgcn_readlane(__float_as_int(gc), i)), bi = __int_as_float(__builtin_amdgcn_readlane(__float_as_int(beta), i));
            const float scq = rsqrtf(__int_as_float(__builtin_amdgcn_readlane(__float_as_int(tot), 8 * rr)) + EPS) * 0.08838834764831845f;
            const float sck = rsqrtf(__int_as_float(__builtin_amdgcn_readlane(__float_as_int(tot), 8 * rr + 4)) + EPS);
            const float q0 = sv[rr][0][0] * scq, q1 = sv[rr][0][1] * scq, k0 = sv[rr][1][0] * sck, k1 = sv[rr][1][1] * sck, v0 = sv[rr][2][0], v1 = sv[rr][2][1];
            const float eg = __expf(gci), egl = __expf(gl - gci);
            *(LAS unsigned*)(QS + i * 136 + 2 * lane) = pk2(q0, q1); *(LAS unsigned*)(KS + i * 136 + 2 * lane) = pk2(k0, k1);
            *(unsigned*)((bf16*)(wsp() + WS_QD) + (size_t)ch * 8192 + ((((i >> 4) * 4 + (lane >> 4)) * 64 + ((lane >> 2) & 3) * 16 + (i & 15)) * 8 + 2 * (lane & 3))) = pk2(q0 * eg, q1 * eg);
            const unsigned g0 = f2bf(k0 * bi * eg), g1 = f2bf(k1 * bi * eg), d0 = f2bf(k0 * egl), d1 = f2bf(k1 * egl), u0 = f2bf(v0 * bi), u1 = f2bf(v1 * bi);
            if (rr & 1) { kg[0][rr >> 1] |= g0 << 16; kg[1][rr >> 1] |= g1 << 16; kd[0][rr >> 1] |= d0 << 16; kd[1][rr >> 1] |= d1 << 16; vb[0][rr >> 1] |= u0 << 16; vb[1][rr >> 1] |= u1 << 16; }
            else { kg[0][rr >> 1] = g0; kg[1][rr >> 1] = g1; kd[0][rr >> 1] = d0; kd[1][rr >> 1] = d1; vb[0][rr >> 1] = u0; vb[1][rr >> 1] = u1; }
        }
#pragma unroll
        for (int c = 0; c < 2; ++c) {
            *(LAS v4u*)(KGT + (2 * lane + c) * 72 + 8 * wave) = (v4u){kg[c][0], kg[c][1], kg[c][2], kg[c][3]};
            *(LAS v4u*)(KDT + (2 * lane + c) * 72 + 8 * wave) = (v4u){kd[c][0], kd[c][1], kd[c][2], kd[c][3]};
            *(LAS v4u*)(VT + (2 * lane + c) * 72 + 8 * wave) = (v4u){vb[c][0], vb[c][1], vb[c][2], vb[c][3]};
        }
        __syncthreads();
        if (PMODE == 2) continue;
        { const int ti = wave >> 1;
          bf16x8 kfi[4], qfi[4];
#pragma unroll
          for (int ks = 0; ks < 4; ++ks) { kfi[ks] = *(const LAS bf16x8*)(KS + (16 * ti + fr) * 136 + 32 * ks + 8 * fq); qfi[ks] = *(const LAS bf16x8*)(QS + (16 * ti + fr) * 136 + 32 * ks + 8 * fq); }
#pragma unroll
          for (int tt = 0; tt < 2; ++tt) { const int tj = 2 * (wave & 1) + tt;
              f32x4 akk = {0.f, 0.f, 0.f, 0.f}, aqk = {0.f, 0.f, 0.f, 0.f};
#pragma unroll
              for (int ks = 0; ks < 4; ++ks) { const bf16x8 kfj = *(const LAS bf16x8*)(KS + (16 * tj + fr) * 136 + 32 * ks + 8 * fq); akk = MFMA16(kfi[ks], kfj, akk); aqk = MFMA16(kfj, qfi[ks], aqk); }
              { const int j = 16 * tj + fr; const float gcj = GC[j];
#pragma unroll
                for (int r = 0; r < 4; ++r) { const int i = 16 * ti + 4 * fq + r; LM[i * 68 + j] = (i > j) ? BT[i] * akk[r] * __expf(GC[i] - gcj) : 0.f; } }
              { const int i = 16 * ti + fr; const float gci = GC[i]; float v[4];
#pragma unroll
                for (int r = 0; r < 4; ++r) { const int j = 16 * tj + 4 * fq + r; v[r] = (i >= j) ? aqk[r] * __expf(gci - GC[j]) : 0.f; }
                v2u w; w.x = pk2(v[0], v[1]); w.y = pk2(v[2], v[3]);
                *(v2u*)((bf16*)(wsp() + WS_AI) + (size_t)ch * 4096 + (((ti * 2 + (tj >> 1)) * 64 + ((2 * tj + (fq >> 1)) & 3) * 16 + fr) * 8 + 4 * (fq & 1))) = w; } } }
        __syncthreads();
        if (wave == 0 && PMODE != 1) {
            float x[64]; float lanef = (float)lane; asm volatile("" : "+v"(lanef)); LAS float* LMv = LM; asm volatile("" : "+v"(LMv));
#pragma unroll
            for (int i = 0; i < 64; ++i) x[i] = 0.f;
#pragma unroll
            for (int i = 0; i < 64; ++i) {
                float a0 = fmaxf(0.f, 1.f - fabsf(lanef - (float)i)), a1 = 0.f, a2 = 0.f, a3 = 0.f;
#pragma unroll
                for (int j4 = 0; j4 < (i + 3) / 4; ++j4) { const f32x4 Lv = *(const LAS f32x4*)(LMv + i * 68 + 4 * j4);
                    a0 -= Lv.x * x[4 * j4]; a1 -= Lv.y * x[4 * j4 + 1]; a2 -= Lv.z * x[4 * j4 + 2]; a3 -= Lv.w * x[4 * j4 + 3]; }
                x[i] = (a0 + a1) + (a2 + a3);
            }
#pragma unroll
            for (int i = 0; i < 64; ++i) TB[i * 72 + lane] = (bf16)f2bf(x[i]);
        }
        __syncthreads();
        eat ^= touch;
        { const int ti = wave & 3;
          bf16x8 tf[2];
#pragma unroll
          for (int ks = 0; ks < 2; ++ks) tf[ks] = *(const LAS bf16x8*)(TB + (16 * ti + fr) * 72 + 32 * ks + 8 * fq);
#pragma unroll
          for (int q4 = 0; q4 < 4; ++q4) { const int te = (wave >> 2) * 4 + q4;
              f32x4 au = {0.f, 0.f, 0.f, 0.f}, aw = {0.f, 0.f, 0.f, 0.f};
#pragma unroll
              for (int ks = 0; ks < 2; ++ks) { const bf16x8 vf = *(const LAS bf16x8*)(VT + (16 * te + fr) * 72 + 32 * ks + 8 * fq), gf = *(const LAS bf16x8*)(KGT + (16 * te + fr) * 72 + 32 * ks + 8 * fq);
                  au = MFMA16(tf[ks], vf, au); aw = MFMA16(gf, tf[ks], aw); }
              v2u w; w.x = pk2(au[0], au[1]); w.y = pk2(au[2], au[3]);
              *(v2u*)((bf16*)(wsp() + WS_UT) + (size_t)ch * 8192 + ((te * 4 + ti) * 64 + lane) * 4) = w;
              w.x = pk2(aw[0], aw[1]); w.y = pk2(aw[2], aw[3]);
              *(v2u*)((bf16*)(wsp() + WS_W) + (size_t)ch * 8192 + (((ti * 4 + (te >> 1)) * 64 + ((2 * te + (fq >> 1)) & 3) * 16 + fr) * 8 + 4 * (fq & 1))) = w; }
          { const int d = F.tid >> 2, part = F.tid & 3; const LAS v4u* src = (const LAS v4u*)((LAS unsigned char*)KDT + d * 144 + part * 32);
            bf16* dstb = (bf16*)(wsp() + WS_KDT) + (size_t)ch * 8192 + (((d >> 4) * 2 + (part >> 1)) * 64 + (2 * (part & 1)) * 16 + (d & 15)) * 8; *(v4u*)dstb = src[0]; *(v4u*)(dstb + 128) = src[1]; }
          if (F.tid == 0) ((float*)(wsp() + WS_GL))[ch] = gl; }
        __syncthreads();
    }
    if (eat == 0x12345u && fq == 77) GC[0] = 1.f;
}
#undef PREP_LOAD
struct DnSetC { bf16x8 wf[4], qf[4], af[2]; v2u ut[2]; };
struct DnSetS { bf16x8 kf[2][2]; float gl; unsigned pf; };
template <int MODE>
__device__ __forceinline__ void dn_scan(Frame& F_, int sid) {
    Frame F = mkframe();
    const int bh = sid >> 2, slice = sid & 3, b = bh >> 3, h = bh & 7;
    const int lane = F.lane, wave = F.wave, fr = lane & 15, fq = lane >> 4;
    lbf ST = (lbf)(F.lds); lbf VT2 = (lbf)(F.lds + 8704);
    for (int i = F.tid; i < (8704 + 4608) / 4; i += NTHR) ((LAS unsigned*)F.lds)[i] = 0u;
    const bf16* pW = (const bf16*)(wsp() + WS_W) + (size_t)bh * 128 * 8192; const bf16* pQ = (const bf16*)(wsp() + WS_QD) + (size_t)bh * 128 * 8192;
    const bf16* pA = (const bf16*)(wsp() + WS_AI) + (size_t)bh * 128 * 4096; const bf16* pK = (const bf16*)(wsp() + WS_KDT) + (size_t)bh * 128 * 8192;
    const bf16* pU = (const bf16*)(wsp() + WS_UT) + (size_t)bh * 128 * 8192; const float* pG = (const float*)(wsp() + WS_GL) + bh * 128;
    bf16* pO = (bf16*)(wsp() + WS_XN) + (size_t)b * SEQ * D + h * 128 + 32 * slice;
    short eat = 0;
    __syncthreads();
    if (wave < 4) {
        const int mi = wave;
        const unsigned oW = (mi * 4 * 64 + lane) * 8, oA = (mi * 2 * 64 + lane) * 8, oU = ((2 * slice) * 4 + mi) * 256 + lane * 4, oO = (16 * mi + fr) * D + 4 * fq;
#define DNC_LOAD(X, nn) do { const int c_ = (nn) < 128 ? (nn) : 127; \
            X.ut[0] = *(const v2u*)(pU + (size_t)c_ * 8192 + oU); X.ut[1] = *(const v2u*)(pU + (size_t)c_ * 8192 + oU + 1024); \
            _Pragma("unroll") for (int ks = 0; ks < 4; ++ks) { X.wf[ks] = *(const bf16x8*)(pW + (size_t)c_ * 8192 + (oW + 512 * ks)); X.qf[ks] = *(const bf16x8*)(pQ + (size_t)c_ * 8192 + (oW + 512 * ks)); } \
            _Pragma("unroll") for (int ks = 0; ks < 2; ++ks) X.af[ks] = *(const bf16x8*)(pA + (size_t)c_ * 4096 + (oA + 512 * ks)); } while (0)
#define DNC_STEP(X, nn) do { \
            f32x4 c1[2], c2[2]; \
            _Pragma("unroll") for (int ni = 0; ni < 2; ++ni) { c1[ni] = (f32x4){0.f, 0.f, 0.f, 0.f}; c2[ni] = (f32x4){0.f, 0.f, 0.f, 0.f}; \
                _Pragma("unroll") for (int ks = 0; ks < 4; ++ks) { const bf16x8 sf = *(const LAS bf16x8*)(ST + (16 * ni + fr) * 136 + 32 * ks + 8 * fq); c1[ni] = MFMA16(X.wf[ks], sf, c1[ni]); c2[ni] = MFMA16(sf, X.qf[ks], c2[ni]); } \
                v2u w_; w_.x = pk2(bflo(X.ut[ni].x) - c1[ni][0], bfhi(X.ut[ni].x) - c1[ni][1]); w_.y = pk2(bflo(X.ut[ni].y) - c1[ni][2], bfhi(X.ut[ni].y) - c1[ni][3]); \
                *(LAS v2u*)(VT2 + (16 * ni + fr) * 72 + 16 * mi + 4 * fq) = w_; } \
            __syncthreads(); \
            _Pragma("unroll") for (int ni = 0; ni < 2; ++ni) { \
                _Pragma("unroll") for (int ks = 0; ks < 2; ++ks) { const bf16x8 vf = *(const LAS bf16x8*)(VT2 + (16 * ni + fr) * 72 + 32 * ks + 8 * fq); c2[ni] = MFMA16(vf, X.af[ks], c2[ni]); } \
                v2u w_; w_.x = pk2(c2[ni][0], c2[ni][1]); w_.y = pk2(c2[ni][2], c2[ni][3]); if (MODE == 0) *(v2u*)(pO + (size_t)(nn) * 64 * D + oO + 16 * ni) = w_; } \
            __syncthreads(); } while (0)
        DnSetC SA, SB, SC;
        DNC_LOAD(SA, 0); DNC_LOAD(SB, 1);
        for (int n = 0; n < 126; n += 3) {
            DNC_LOAD(SC, n + 2); __builtin_amdgcn_sched_barrier(0); DNC_STEP(SA, n); __builtin_amdgcn_sched_barrier(0);
            DNC_LOAD(SA, n + 3); __builtin_amdgcn_sched_barrier(0); DNC_STEP(SB, n + 1); __builtin_amdgcn_sched_barrier(0);
            DNC_LOAD(SB, n + 4); __builtin_amdgcn_sched_barrier(0); DNC_STEP(SC, n + 2); __builtin_amdgcn_sched_barrier(0);
        }
        DNC_STEP(SA, 126); DNC_STEP(SB, 127);
#undef DNC_LOAD
#undef DNC_STEP
    } else {
        const int dq = wave - 4;
        f32x4 accS[2][2];
#pragma unroll
        for (int k = 0; k < 2; ++k)
#pragma unroll
            for (int ni = 0; ni < 2; ++ni) accS[k][ni] = (f32x4){0.f, 0.f, 0.f, 0.f};
        const int lt = F.tid - 256, li = slice * 112 + lt; const bool toucher = lt < 144;
        const bf16* pfBase = (lt >= 112) ? pU + 2048 * slice + (lt - 112) * 64 : (li < 128) ? pW + li * 64 : (li < 256) ? pQ + (li - 128) * 64 : (li < 384) ? pK + (li - 256) * 64 : pA + (li - 384) * 64;
        const unsigned pfStride = (lt >= 112 || li < 384) ? 8192u : 4096u;
        const unsigned oK = (2 * dq * 2 * 64 + lane) * 8;
#define DNS_LOAD(X, nn) do { const int c_ = (nn) < 128 ? (nn) : 127; eat ^= (short)X.pf; X.gl = pG[c_]; \
            _Pragma("unroll") for (int ks = 0; ks < 2; ++ks) { X.kf[0][ks] = *(const bf16x8*)(pK + (size_t)c_ * 8192 + (oK + 512 * ks)); X.kf[1][ks] = *(const bf16x8*)(pK + (size_t)c_ * 8192 + (oK + 1024 + 512 * ks)); } \
            { const int c2_ = (nn) + 2 < 128 ? (nn) + 2 : 127; X.pf = toucher ? *(const unsigned*)(pfBase + (size_t)c2_ * pfStride) : 0u; } } while (0)
#define DNS_STEP(X, nn) do { \
            const float egl = __expf(X.gl); \
            __syncthreads(); \
            _Pragma("unroll") for (int ni = 0; ni < 2; ++ni) { bf16x8 vf[2]; \
                _Pragma("unroll") for (int ks = 0; ks < 2; ++ks) vf[ks] = *(const LAS bf16x8*)(VT2 + (16 * ni + fr) * 72 + 32 * ks + 8 * fq); \
                _Pragma("unroll") for (int k = 0; k < 2; ++k) { accS[k][ni] = accS[k][ni] * egl; \
                    _Pragma("unroll") for (int ks = 0; ks < 2; ++ks) accS[k][ni] = MFMA16(X.kf[k][ks], vf[ks], accS[k][ni]); \
                    v2u w_; w_.x = pk2(accS[k][ni][0], accS[k][ni][1]); w_.y = pk2(accS[k][ni][2], accS[k][ni][3]); \
                    *(LAS v2u*)(ST + (16 * ni + fr) * 136 + 16 * (2 * dq + k) + 4 * fq) = w_; } } \
            __syncthreads(); } while (0)
        DnSetS SA, SB, SC; SA.pf = 0u; SB.pf = 0u; SC.pf = 0u;
        DNS_LOAD(SA, 0); DNS_LOAD(SB, 1);
        for (int n = 0; n < 126; n += 3) {
            DNS_LOAD(SC, n + 2); __builtin_amdgcn_sched_barrier(0); DNS_STEP(SA, n); __builtin_amdgcn_sched_barrier(0);
            DNS_LOAD(SA, n + 3); __builtin_amdgcn_sched_barrier(0); DNS_STEP(SB, n + 1); __builtin_amdgcn_sched_barrier(0);
            DNS_LOAD(SB, n + 4); __builtin_amdgcn_sched_barrier(0); DNS_STEP(SC, n + 2); __builtin_amdgcn_sched_barrier(0);
        }
        DNS_STEP(SA, 126); DNS_STEP(SB, 127);
#undef DNS_LOAD
#undef DNS_STEP
    }
    if (eat == 12345 && fq == 77) VT2[0] = (bf16)eat;
}
__device__ __forceinline__ void rope16(v4u& w0, v4u& w1, const float* rp) {
    float x[8], y[8];
#pragma unroll
    for (int j = 0; j < 4; ++j) { x[2 * j] = bflo(w0[j]); x[2 * j + 1] = bfhi(w0[j]); y[2 * j] = bflo(w1[j]); y[2 * j + 1] = bfhi(w1[j]); }
    const f32x4 c0 = *(const f32x4*)rp, c1 = *(const f32x4*)(rp + 4), s0 = *(const f32x4*)(rp + 8), s1 = *(const f32x4*)(rp + 12);
    float c[8] = {c0.x, c0.y, c0.z, c0.w, c1.x, c1.y, c1.z, c1.w}, s[8] = {s0.x, s0.y, s0.z, s0.w, s1.x, s1.y, s1.z, s1.w};
#pragma unroll
    for (int j = 0; j < 8; ++j) { const float a = x[j], bb = y[j]; x[j] = a * c[j] - bb * s[j]; y[j] = bb * c[j] + a * s[j]; }
#pragma unroll
    for (int j = 0; j < 4; ++j) { w0[j] = pk2(x[2 * j], x[2 * j + 1]); w1[j] = pk2(y[2 * j], y[2 * j + 1]); }
}
__device__ __forceinline__ void swa_mfma(Frame& F_, int l, int nskip) {
    Frame F = mkframe();
    bf16* PROJ = (bf16*)(wsp() + WS_PROJ); const float* ROPE = (const float*)(wsp() + WS_ROPE);
    lbf KL = (lbf)(F.lds), VTL = (lbf)(F.lds + 29952), QL = (lbf)(F.lds + 57600 + F.wave * 9216);
    const int tid = F.tid, lane = F.lane, wave = F.wave, fr = lane & 15, fq = lane >> 4;
    for (int unit = F.bid - nskip; unit < 512; unit += F.G - nskip) {
        const int b = unit >> 8, kvh = (unit >> 7) & 1, q0 = (unit & 127) * 64;
        for (int task = tid; task < 208 * 4; task += NTHR) { const int kl = task >> 2, seg = task & 3, tk = q0 - 128 + kl; v4u w0 = {0u, 0u, 0u, 0u}, w1 = {0u, 0u, 0u, 0u};
            if (kl < 192 && tk >= 0) { const int mk = b * SEQ + tk; const v4u* p = (const v4u*)(PROJ + (size_t)mk * DINP + C_SWK + kvh * 64 + 16 * seg); w0 = p[0]; w1 = p[1];
                if (seg == 0) rope16(w0, w1, ROPE + mk * 16); }
            *(LAS v4u*)(KL + kl * 72 + 16 * seg) = w0; *(LAS v4u*)(KL + kl * 72 + 16 * seg + 8) = w1; }
        for (int task = tid; task < 192 * 8; task += NTHR) { const int kl = task >> 3, seg = task & 7, tk = q0 - 128 + kl; v4u w = {0u, 0u, 0u, 0u};
            if (tk >= 0) w = *(const v4u*)(PROJ + (size_t)(b * SEQ + tk) * DINP + C_SWV + kvh * 64 + 8 * seg);
#pragma unroll
            for (int j = 0; j < 4; ++j) { VTL[(8 * seg + 2 * j) * 216 + kl] = (bf16)(w[j] & 0xffffu); VTL[(8 * seg + 2 * j + 1) * 216 + kl] = (bf16)(w[j] >> 16); } }
        for (int i = tid; i < 1024; i += NTHR) VTL[(i >> 4) * 216 + 192 + (i & 15)] = 0;
        { const int mq = b * SEQ + q0 + lane; const v4u* qp = (const v4u*)(PROJ + (size_t)mq * DINP + C_SWQ + (kvh * 8 + wave) * 64);
          v4u w[8];
#pragma unroll
          for (int i = 0; i < 8; ++i) w[i] = qp[i];
          rope16(w[0], w[1], ROPE + mq * 16);
#pragma unroll
          for (int i = 0; i < 8; ++i) { v4u o;
#pragma unroll
              for (int j = 0; j < 4; ++j) o[j] = pk2(bflo(w[i][j]) * 0.125f, bfhi(w[i][j]) * 0.125f);
              *(LAS v4u*)(QL + lane * 72 + 8 * i) = o; } }
        __syncthreads();
        const float sink = inp(8)[l * 16 + kvh * 8 + wave];
#pragma unroll 1
        for (int qt = 0; qt < 4; ++qt) {
            bf16x8 qf[2];
#pragma unroll
            for (int ks = 0; ks < 2; ++ks) qf[ks] = *(const LAS bf16x8*)(QL + (16 * qt + fr) * 72 + 32 * ks + 8 * fq);
            f32x4 st[10];
#pragma unroll
            for (int t = 0; t < 10; ++t) { st[t] = (f32x4){0.f, 0.f, 0.f, 0.f};
#pragma unroll
                for (int ks = 0; ks < 2; ++ks) { const bf16x8 kf = *(const LAS bf16x8*)(KL + (16 * (qt + t) + fr) * 72 + 32 * ks + 8 * fq); st[t] = MFMA16(kf, qf[ks], st[t]); } }
            const int qr = 16 * qt + fr; float mx = -1e30f;
#pragma unroll
            for (int t = 0; t < 10; ++t)
#pragma unroll
                for (int r = 0; r < 4; ++r) { const int kl = 16 * (qt + t) + 4 * fq + r; const bool ok = (kl > qr) && (kl <= qr + 128) && (q0 - 128 + kl >= 0);
                    st[t][r] = ok ? st[t][r] : -1e30f; mx = fmaxf(mx, st[t][r]); }
            mx = fmaxf(mx, __shfl_xor(mx, 16)); mx = fmaxf(mx, __shfl_xor(mx, 32)); mx = fmaxf(mx, sink);
            float sum = 0.f;
#pragma unroll
            for (int t = 0; t < 10; ++t)
#pragma unroll
                for (int r = 0; r < 4; ++r) { const float p = (st[t][r] > -1e29f) ? __expf(st[t][r] - mx) : 0.f; st[t][r] = p; sum += p; }
            sum += __shfl_xor(sum, 16); sum += __shfl_xor(sum, 32);
            const float inv = 1.f / (sum + __expf(sink - mx));
            bf16x8 pf[5];
#pragma unroll
            for (int pr = 0; pr < 5; ++pr) { v4u w; w.x = pk2(st[2 * pr][0] * inv, st[2 * pr][1] * inv); w.y = pk2(st[2 * pr][2] * inv, st[2 * pr][3] * inv);
                w.z = pk2(st[2 * pr + 1][0] * inv, st[2 * pr + 1][1] * inv); w.w = pk2(st[2 * pr + 1][2] * inv, st[2 * pr + 1][3] * inv); pf[pr] = __builtin_bit_cast(bf16x8, w); }
#pragma unroll
            for (int dt = 0; dt < 4; ++dt) { f32x4 acc = {0.f, 0.f, 0.f, 0.f};
#pragma unroll
                for (int pr = 0; pr < 5; ++pr) { const v2u a0 = *(const LAS v2u*)(VTL + (16 * dt + fr) * 216 + 16 * (qt + 2 * pr) + 4 * fq), a1 = *(const LAS v2u*)(VTL + (16 * dt + fr) * 216 + 16 * (qt + 2 * pr + 1) + 4 * fq);
                    v4u aw; aw.x = a0.x; aw.y = a0.y; aw.z = a1.x; aw.w = a1.y; acc = MFMA16(__builtin_bit_cast(bf16x8, aw), pf[pr], acc); }
                v2u w; w.x = pk2(acc[0], acc[1]); w.y = pk2(acc[2], acc[3]);
                *(v2u*)(PROJ + (size_t)(b * SEQ + q0 + 16 * qt + fr) * DINP + C_SWQ + (kvh * 8 + wave) * 64 + 16 * dt + 4 * fq) = w; }
        }
        __syncthreads();
    }
}
__device__ __forceinline__ void dn_naive(Frame& F_, int l) {
    Frame F = mkframe(); const int b = F.bid >> 3, h = F.bid & 7;
    const bf16* PROJ = (const bf16*)(wsp() + WS_PROJ); bf16* ORAW = (bf16*)(wsp() + WS_XN);
    LAS float* vals = (LAS float*)F.lds;
    LAS float* part = vals + 768;
    LAS float* bg = part + 16;
    LAS float* red = bg + 4;
    LAS float* red2 = red + 1024;
    const int tid = F.tid, lane = F.lane, wave = F.wave;
    const int e = tid & 127, r = tid >> 7;
    int col; float cw0 = 0.f, cw1 = 0.f, cw2 = 0.f, cw3 = 0.f;
    if (tid < 384) { const int chan = (tid >> 7) * 1024 + h * 128 + (tid & 127); col = chan; const float* cw = inp(4) + (size_t)l * 4 * 3072;
        cw0 = cw[chan]; cw1 = cw[3072 + chan]; cw2 = cw[2 * 3072 + chan]; cw3 = cw[3 * 3072 + chan]; }
    else if (tid == 384) col = C_DNB + h; else if (tid == 385) col = C_DNA + h; else col = 0;
    const float a_neg = -__expf(inp(5)[l * 8 + h]), dtb = inp(6)[l * 8 + h];
    float S[32];
#pragma unroll
    for (int i = 0; i < 32; ++i) S[i] = 0.f;
    float x0 = 0.f, x1 = 0.f, x2 = 0.f;
    const bf16* pcol = PROJ + (size_t)b * SEQ * DINP + col;
    float cur[16], nxt[16];
#pragma unroll
    for (int i = 0; i < 16; ++i) cur[i] = bf1(pcol[(size_t)i * DINP]);
    for (int tb = 0; tb < SEQ; tb += 16) {
        if (tb + 16 < SEQ) {
#pragma unroll
            for (int i = 0; i < 16; ++i) nxt[i] = bf1(pcol[(size_t)(tb + 16 + i) * DINP]);
        }
#pragma unroll
        for (int i = 0; i < 16; ++i) {
            const int t = tb + i, buf = i & 1;
            const float xin = cur[i];
            if (tid < 384) {
                const float y = cw0 * x0 + cw1 * x1 + cw2 * x2 + cw3 * xin; x0 = x1; x1 = x2; x2 = xin;
                const float s = siluf_(y); vals[buf * 384 + tid] = s;
                const float ss = wave_sum(s * s); if (lane == 0) part[buf * 8 + wave] = ss;
            } else if (tid == 384) { bg[buf * 2 + 0] = sigmoidf_(xin); }
            else if (tid == 385) { const float z = xin + dtb; const float sp = (z > 20.f) ? z : log1pf(__expf(z)); bg[buf * 2 + 1] = __expf(a_neg * sp); }
            __syncthreads();
            const float sq = rsqrtf(part[buf * 8 + 0] + part[buf * 8 + 1] + EPS) * 0.08838834764831845f;
            const float sk = rsqrtf(part[buf * 8 + 2] + part[buf * 8 + 3] + EPS);
            const float beta = bg[buf * 2 + 0], eg = bg[buf * 2 + 1];
            const LAS float* qv = vals + buf * 384 + 32 * r; const LAS float* kv = vals + buf * 384 + 128 + 32 * r;
            float pk = 0.f, pq = 0.f, pqk = 0.f;
#pragma unroll
            for (int dd = 0; dd < 32; ++dd) { const float kd = kv[dd], qd = qv[dd]; pk += kd * S[dd]; pq += qd * S[dd]; pqk += qd * kd; }
            red[(buf * 4 + r) * 128 + e] = pk * sk; red[((1 - buf) * 4 + r) * 128 + e] = pq * sq;
            if (e == 0) red2[r] = pqk;
            __syncthreads();
            float kS = 0.f, qS = 0.f;
#pragma unroll
            for (int rr = 0; rr < 4; ++rr) { kS += red[(buf * 4 + rr) * 128 + e]; qS += red[((1 - buf) * 4 + rr) * 128 + e]; }
            const float qk = (red2[0] + red2[1] + red2[2] + red2[3]) * sq * sk;
            const float ve = vals[buf * 384 + 256 + e];
            const float delta = beta * (ve - eg * kS);
            if (r == 0) ORAW[(size_t)(b * SEQ + t) * D + h * 128 + e] = (bf16)f2bf(eg * qS + qk * delta);
            const float kdl = sk * delta;
#pragma unroll
            for (int dd = 0; dd < 32; ++dd) S[dd] = eg * S[dd] + kv[dd] * kdl;
            __syncthreads();
        }
#pragma unroll
        for (int i = 0; i < 16; ++i) cur[i] = nxt[i];
    }
}
__device__ __forceinline__ void swa_naive(Frame& F_, int l, int nskip) {
    Frame F = mkframe(); const int w0 = (F.bid - nskip) * NWAVES + F.wave, nw = (F.G - nskip) * NWAVES;
    bf16* PROJ = (bf16*)(wsp() + WS_PROJ); const float* ROPE = (const float*)(wsp() + WS_ROPE);
    LAS float* qs = (LAS float*)(F.lds + F.wave * 8192);
    LAS float* ps = qs + 512;
    const int lane = F.lane;
    for (int task = w0; task < M * 2; task += nw) {
        const int m = task >> 1, kvh = task & 1, b = m / SEQ, t = m % SEQ;
        { const float c = ROPE[m * 16 + (lane & 7)], s = ROPE[m * 16 + 8 + (lane & 7)];
#pragma unroll
          for (int g = 0; g < 8; ++g) { const float x = bf1(PROJ[(size_t)m * DINP + C_SWQ + (kvh * 8 + g) * 64 + lane]); const float p = __shfl_xor(x, 8);
              const float y = (lane < 8) ? (x * c - p * s) : ((lane < 16) ? (x * c + p * s) : x); qs[g * 64 + lane] = y * 0.125f; } }
        asm volatile("s_waitcnt lgkmcnt(0)" ::: "memory");
#pragma unroll 1
        for (int kk = 0; kk < 2; ++kk) {
            const int tk = t - 127 + lane + 64 * kk; const bool valid = tk >= 0; const int mk = b * SEQ + (valid ? tk : 0);
            float kf[64];
            const v4u* kr = (const v4u*)(PROJ + (size_t)mk * DINP + C_SWK + kvh * 64);
#pragma unroll
            for (int i = 0; i < 8; ++i) { const v4u w = kr[i];
#pragma unroll
                for (int j = 0; j < 4; ++j) { kf[8 * i + 2 * j] = bflo(w[j]); kf[8 * i + 2 * j + 1] = bfhi(w[j]); } }
#pragma unroll
            for (int j = 0; j < 8; ++j) { const float c = ROPE[mk * 16 + j], s = ROPE[mk * 16 + 8 + j]; const float a = kf[j], bb = kf[j + 8]; kf[j] = a * c - bb * s; kf[j + 8] = bb * c + a * s; }
#pragma unroll
            for (int g = 0; g < 8; ++g) { float a = 0.f;
#pragma unroll
                for (int d4 = 0; d4 < 16; ++d4) { const f32x4 q = *(const LAS f32x4*)(qs + g * 64 + 4 * d4); a += q.x * kf[4 * d4] + q.y * kf[4 * d4 + 1] + q.z * kf[4 * d4 + 2] + q.w * kf[4 * d4 + 3]; }
                ps[(lane + 64 * kk) * 8 + g] = valid ? a : -1e30f; }
        }
        asm volatile("s_waitcnt lgkmcnt(0)" ::: "memory");
#pragma unroll
        for (int g = 0; g < 8; ++g) {
            const float sink = inp(8)[l * 16 + kvh * 8 + g];
            const float s0 = ps[lane * 8 + g], s1 = ps[(lane + 64) * 8 + g];
            const float mx = fmaxf(wave_max(fmaxf(s0, s1)), sink);
            const float p0 = (s0 > -1e29f) ? __expf(s0 - mx) : 0.f, p1 = (s1 > -1e29f) ? __expf(s1 - mx) : 0.f;
            const float den = wave_sum(p0 + p1) + __expf(sink - mx); const float inv = 1.f / den;
            ps[lane * 8 + g] = p0 * inv; ps[(lane + 64) * 8 + g] = p1 * inv;
        }
        asm volatile("s_waitcnt lgkmcnt(0)" ::: "memory");
        float o[8];
#pragma unroll
        for (int g = 0; g < 8; ++g) o[g] = 0.f;
        const int j0 = (t >= 127) ? 0 : (127 - t);
        for (int j = j0; j < 128; ++j) {
            const int mk = b * SEQ + t - 127 + j;
            const float v = bf1(PROJ[(size_t)mk * DINP + C_SWV + kvh * 64 + lane]);
            const f32x4 pa = *(const LAS f32x4*)(ps + j * 8), pb = *(const LAS f32x4*)(ps + j * 8 + 4);
            o[0] += pa.x * v; o[1] += pa.y * v; o[2] += pa.z * v; o[3] += pa.w * v; o[4] += pb.x * v; o[5] += pb.y * v; o[6] += pb.z * v; o[7] += pb.w * v;
        }
#pragma unroll
        for (int g = 0; g < 8; ++g) PROJ[(size_t)m * DINP + C_SWQ + (kvh * 8 + g) * 64 + lane] = (bf16)f2bf(o[g]);
        asm volatile("s_waitcnt lgkmcnt(0)" ::: "memory");
    }
}
__device__ __forceinline__ void phase_gnorm(Frame& F_, int l) {
    Frame F = mkframe();
    bf16* PROJ = (bf16*)(wsp() + WS_PROJ); const bf16* ORAW = (const bf16*)(wsp() + WS_XN);
    const int gw = F.bid * NWAVES + F.wave, NGW = F.G * NWAVES;
    const float g0 = inp(7)[l * 128 + 2 * F.lane], g1 = inp(7)[l * 128 + 2 * F.lane + 1];
    for (int m = gw; m < M; m += NGW) {
#pragma unroll
        for (int h = 0; h < 8; ++h) {
            const unsigned ow = *(const unsigned*)(ORAW + (size_t)m * D + h * 128 + 2 * F.lane);
            const unsigned zw = *(const unsigned*)(PROJ + (size_t)m * DINP + C_DNZ + h * 128 + 2 * F.lane);
            const float o0 = bflo(ow), o1 = bfhi(ow);
            const float r = rsqrtf(wave_sum(o0 * o0 + o1 * o1) * (1.f / 128.f) + EPS);
            *(unsigned*)(PROJ + (size_t)m * DINP + C_DNQ + h * 128 + 2 * F.lane) = pk2(o0 * r * g0 * siluf_(bflo(zw)), o1 * r * g1 * siluf_(bfhi(zw)));
        }
    }
}

#ifndef PROBE_DUP
#define PROBE_DUP 0
#endif
#ifndef DN_NAIVE
#define DN_NAIVE 0
#endif
struct Args { const float* in[17]; float* out; unsigned char* ws; };
__global__ void __launch_bounds__(NTHR, 2) hybrid_fwd(Args args) {
    cg::grid_group grid = cg::this_grid();
    Frame F;
    F.lds = lds_base();
    F.tid = threadIdx.x; F.lane = F.tid & 63; F.wave = __builtin_amdgcn_readfirstlane(F.tid >> 6);
    F.G = gridDim.x; F.bid = blockIdx.x;
#define PROJ ((bf16*)(wsp() + WS_PROJ))
#define XN ((bf16*)(wsp() + WS_XN))
#define YF ((float*)(wsp() + WS_YF))
#define MIX ((bf16*)(wsp() + WS_MIX))
#define HB ((bf16*)(wsp() + WS_H))

    if (F.bid == 0) { for (int i = F.tid; i < XCD_BAR_WORDS; i += NTHR) ((unsigned*)(wsp() + WS_BAR))[i] = 0u; for (int i = F.tid; i < 16384; i += NTHR) ((unsigned*)(wsp() + WS_XCNT))[i] = 0u; if (F.tid < 256) ((unsigned*)(wsp() + WS_SUBCNT))[F.tid] = 0u; }
    if (F.tid < 4) ((LAS unsigned*)(lds_base() + LDS_BARST))[F.tid] = 0u;
    grid.sync();
    xcd_barrier_post();
    phase_rope(F);
    phase_norm(F, nullptr, nullptr, inp(0), outp(), inp(2), XN);
    phase_convert(F, -1, 0, 0);
    grid_bar();
    for (int l = 0; l < DEPTH; ++l) {
        {
            pg8::Gemm g{XN, (const bf16*)(wsp() + WS_WIN), nullptr, nullptr, M, DINP, D, D}; pg8::StaticOrder S; { Frame Fg = mkframe(); S.init(M, DINP, Fg.G, Fg.bid); }
            pg8::EpiBf16<0> E{PROJ, DINP};
            pg8::gemm_phase<pg8::EpiBf16<0>, pg8::StaticOrder, true, true>(F.lds, g, S, E);
#if PROBE_DUP == 5
            pg8::gemm_phase<pg8::EpiBf16<0>, pg8::StaticOrder, true, true>(F.lds, g, S, E);
#endif
        }
        grid_bar();
#if DN_NAIVE
        if (F.bid < 16) dn_naive(F, l);
        else swa_naive(F, l, 16);
#else
#if PROBE_DUP == 1
        dn_prep<0>(F, l);
#elif PROBE_DUP == 11
        dn_prep<1>(F, l);
#elif PROBE_DUP == 12
        dn_prep<2>(F, l);
#elif PROBE_DUP == 13
        dn_prep<3>(F, l);
#elif PROBE_DUP == 14
        dn_prep<4>(F, l);
#endif
        dn_prep<0>(F, l);
        grid_bar();
        { Frame Fg = mkframe(); if (Fg.bid < 64) { const int sid_ = (((Fg.bid & 7) * 2 + (Fg.bid >> 5)) << 2) | ((Fg.bid >> 3) & 3); dn_scan<0>(F, sid_);
#if PROBE_DUP == 2
            dn_scan<0>(F, sid_);
#elif PROBE_DUP == 3
            dn_scan<1>(F, sid_);
#elif PROBE_DUP == 4
            dn_scan<2>(F, sid_);
#endif
        }
        else {
            phase_convert(F, l, (l + 1 < DEPTH) ? l + 1 : -1, 64);
            __syncthreads();
            swa_mfma(F, l, 64);
            sub_bar((unsigned*)(wsp() + WS_SUBCNT) + 64 * l, (unsigned)(Fg.G - 64));
            pg8::Gemm g{PROJ + C_SWQ, (const bf16*)(wsp() + WS_WUPSW), nullptr, nullptr, M, D, D, DINP}; pg8::StaticOrder S; S.init(M, D, Fg.G - 64, Fg.bid - 64);
            pg8::EpiYb E{PROJ + C_DNK, DINP, PROJ + C_GB, DINP};
            pg8::gemm_phase<pg8::EpiYb, pg8::StaticOrder, true, true>(F.lds, g, S, E);
        } }
#endif
        grid_bar();
        phase_gnorm(F, l);
#if PROBE_DUP == 6
        phase_gnorm(F, l);
#endif
        grid_bar();
        {
            pg8::Gemm g{PROJ + C_DNQ, (const bf16*)(wsp() + WS_WUPDN), nullptr, nullptr, M, D, D, DINP}; pg8::StaticOrder S; { Frame Fg = mkframe(); S.init(M, D, Fg.G, Fg.bid); }
            pg8::EpiMerge2 E{MIX, D, PROJ + C_GA, PROJ + C_DNK, DINP};
            pg8::gemm_phase<pg8::EpiMerge2, pg8::StaticOrder, false, true>(F.lds, g, S, E);
        }
        grid_bar();
        {
            pg8::Gemm g{MIX, (const bf16*)(wsp() + WS_WO), nullptr, nullptr, M, D, D, D}; pg8::StaticOrder S; { Frame Fg = mkframe(); S.init(M, D, Fg.G, Fg.bid); }
            pg8::RmsExchange e1{(float*)(wsp() + WS_XSLOT), (unsigned*)(wsp() + WS_XCNT) + ((l * 4 + 0) * 64) * 16}, e2{(float*)(wsp() + WS_XSLOT + 262144), (unsigned*)(wsp() + WS_XCNT) + ((l * 4 + 1) * 64) * 16};
            pg8::EpiRmsRes E{outp(), inp(12) + l * D, inp(13) + l * D, XN, e1, e2};
            pg8::gemm_phase<pg8::EpiRmsRes, pg8::StaticOrder, false, true>(F.lds, g, S, E);
        }
        grid_bar();
        {
            pg8::Gemm g{XN, (const bf16*)(wsp() + WS_WFF1), nullptr, nullptr, M, FF, D, D}; pg8::StaticOrder S; { Frame Fg = mkframe(); S.init(M, FF, Fg.G, Fg.bid); }
            pg8::EpiBf16<2> E{HB, FF};
            pg8::gemm_phase<pg8::EpiBf16<2>, pg8::StaticOrder, true, true>(F.lds, g, S, E);
#if PROBE_DUP == 7
            pg8::gemm_phase<pg8::EpiBf16<2>, pg8::StaticOrder, true, true>(F.lds, g, S, E);
#endif
        }
        grid_bar();
        {
            pg8::Gemm g{HB, (const bf16*)(wsp() + WS_WFF2), nullptr, nullptr, M, D, FF, FF}; pg8::StaticOrder S; { Frame Fg = mkframe(); S.init(M, D, Fg.G, Fg.bid); }
            pg8::RmsExchange e1{(float*)(wsp() + WS_XSLOT), (unsigned*)(wsp() + WS_XCNT) + ((l * 4 + 2) * 64) * 16}, e2{(float*)(wsp() + WS_XSLOT + 262144), (unsigned*)(wsp() + WS_XCNT) + ((l * 4 + 3) * 64) * 16};
            pg8::EpiRmsRes E{outp(), inp(16) + l * D, (l + 1 < DEPTH) ? inp(2) + (l + 1) * D : nullptr, XN, e1, e2};
            pg8::gemm_phase<pg8::EpiRmsRes, pg8::StaticOrder, false, true>(F.lds, g, S, E);
        }
        if (l + 1 < DEPTH) grid_bar();
    }
#undef PROJ
#undef XN
#undef YF
#undef MIX
#undef HB
}

extern "C" void kernel_launch(void* const* d_in, const int* in_sizes, int n_in, void* d_out, int out_size, void* d_ws, size_t ws_size, hipStream_t stream) {
    static int init = 0;
    if (!init) {
        if (n_in != 17 || out_size != M * D || ws_size < WS_END) { fprintf(stderr, "kernel_launch: unexpected shapes (n_in %d out %d ws %zu)\n", n_in, out_size, ws_size); init = -1; return; }
        if (hipFuncSetAttribute((const void*)hybrid_fwd, hipFuncAttributeMaxDynamicSharedMemorySize, LDS_BYTES) != hipSuccess) { fprintf(stderr, "hipFuncSetAttribute failed\n"); init = -1; return; }
        init = 1;
    }
    if (init < 0) return;
    Args a{};
    for (int i = 0; i < 17; ++i) a.in[i] = (const float*)d_in[i];
    a.out = (float*)d_out; a.ws = (unsigned char*)d_ws;
    void* args[] = {&a};
    hipError_t e = hipLaunchCooperativeKernel((void*)hybrid_fwd, dim3(256), dim3(NTHR), args, LDS_BYTES, stream);
    if (e != hipSuccess) fprintf(stderr, "cooperative launch failed: %s\n", hipGetErrorString(e));
}
```

```cpp
#include <hip/hip_runtime.h>
#include <hip/hip_cooperative_groups.h>
#include <cstdio>
#include <cstdint>
namespace cg = cooperative_groups;

namespace pg8 {
#define PG8_LAS __attribute__((address_space(3)))
typedef unsigned short bf16_t;
typedef short bf16x8 __attribute__((ext_vector_type(8)));
typedef float f32x4 __attribute__((ext_vector_type(4)));
typedef unsigned u32x4 __attribute__((ext_vector_type(4)));
constexpr int BM = 256, BK = 64, HALF = 128, HTB = HALF * BK * 2, STAGE_BYTES = 8 * HTB, NXCD = 8, WGM = 8;

__host__ __device__ __forceinline__ int lds_byte(int r, int c) { const int st = (r >> 4) * 2 + (c >> 5), rr = r & 15, cc = c & 31, ob = rr * 64 + cc * 2; return st * 1024 + (ob ^ (((ob >> 9) & 1) << 5)); }
__host__ __device__ __forceinline__ void stage_rc(int b, int& R, int& C) { const int st = b / 1024, sb = b % 1024, swz = sb ^ (((sb >> 9) & 1) << 5); R = (st >> 1) * 16 + swz / 64; C = (st & 1) * 32 + (swz % 64) / 2; }
__host__ __device__ __forceinline__ int perm32(int rho) { const int n = rho >> 4, i = rho & 15; return 8 * (i >> 2) + 4 * n + (i & 3); }

struct Unit { int pm, pn, src; };
struct Gemm { const bf16_t* A; const bf16_t* Bt; const bf16_t* A2; const bf16_t* Bt2; int M, N, K, lda; };

struct StaticOrder {
    int nM, nN, nwg, G, c;
    __host__ __device__ void init(int M, int N, int G_, int c_) { nM = M / BM; nN = N / BM; nwg = nM * nN; G = G_; c = c_; }
    __host__ __device__ bool tile(long L, Unit& u) const {
        if (L >= nwg) return false;
        int wgid = (int)L; { const int q = nwg / NXCD, r = nwg % NXCD, xcd = wgid % NXCD, off = wgid / NXCD; wgid = (xcd < r ? xcd * (q + 1) : r * (q + 1) + (xcd - r) * q) + off; }
        const int nig = WGM * nN, gid = wgid / nig, fm = gid * WGM, gsz = (nM - fm) < WGM ? (nM - fm) : WGM;
        u.pm = fm + ((wgid % nig) % gsz); u.pn = (wgid % nig) / gsz; u.src = 0; return true;
    }
    __host__ __device__ bool next(int i, Unit& u) const { return tile((long)i * G + c, u); }
};
struct DualOrder {
    StaticOrder S;
    __host__ __device__ bool next(int i, Unit& u) const { const bool ok = S.tile((long)(i >> 1) * S.G + S.c, u); u.src = i & 1; return ok; }
};

typedef float f32x2c __attribute__((ext_vector_type(2)));
typedef __bf16 bf16x2c __attribute__((ext_vector_type(2)));
__device__ __forceinline__ unsigned cvt_pk_bf16(float lo, float hi) { const f32x2c v = {lo, hi}; return __builtin_bit_cast(unsigned, __builtin_convertvector(v, bf16x2c)); }
__device__ __forceinline__ float bf_lo(unsigned w) { return __uint_as_float(w << 16); }
__device__ __forceinline__ float bf_hi(unsigned w) { return __uint_as_float(w & 0xffff0000u); }

template <int ACT  > struct EpiBf16 {
    static constexpr bool PERM = true, DUAL = false, AFTER_DRAIN = false;
    bf16_t* O; int ldc;
    __device__ __forceinline__ void mid(f32x4 (&acc)[2][2][4][2], const Unit& u, int wr, int wc, int fr, int fq) const {}
    __device__ __forceinline__ void operator()(const f32x4 (&acc)[2][2][4][2], const Unit& u, int wr, int wc, int fr, int fq) const {
        const int row0 = u.pm * BM + wr * 64 + fr; const int col0 = u.pn * BM + wc * 32 + 8 * fq;
#pragma unroll
        for (int ai = 0; ai < 2; ++ai)
#pragma unroll
            for (int m = 0; m < 4; ++m) { bf16_t* rowp = O + (size_t)(row0 + ai * HALF + m * 16) * ldc + col0;
#pragma unroll
                for (int bj = 0; bj < 2; ++bj) { f32x4 v0 = acc[ai][bj][m][0], v1 = acc[ai][bj][m][1];
                    if (ACT == 2) {
#pragma unroll
                        for (int e = 0; e < 4; ++e) { const float a = fmaxf(v0[e], 0.f), b = fmaxf(v1[e], 0.f); v0[e] = a * a; v1[e] = b * b; } }
                    u32x4 w; w.x = cvt_pk_bf16(v0[0], v0[1]); w.y = cvt_pk_bf16(v0[2], v0[3]); w.z = cvt_pk_bf16(v1[0], v1[1]); w.w = cvt_pk_bf16(v1[2], v1[3]);
                    *(u32x4*)(rowp + bj * HALF) = w; } }
    }
};
struct EpiF32 {
    static constexpr bool PERM = false, DUAL = false, AFTER_DRAIN = false;
    float* O; int ldc;
    __device__ __forceinline__ void mid(f32x4 (&acc)[2][2][4][2], const Unit& u, int wr, int wc, int fr, int fq) const {}
    __device__ __forceinline__ void operator()(const f32x4 (&acc)[2][2][4][2], const Unit& u, int wr, int wc, int fr, int fq) const {
        float* rowp = O + (size_t)(u.pm * BM + wr * 64 + fr) * ldc + (u.pn * BM + wc * 32 + 4 * fq);
#pragma unroll
        for (int ai = 0; ai < 2; ++ai) {
#pragma unroll
            for (int m = 0; m < 4; ++m) {
#pragma unroll
                for (int bj = 0; bj < 2; ++bj)
#pragma unroll
                    for (int n = 0; n < 2; ++n) *(f32x4*)(rowp + bj * HALF + n * 16) = acc[ai][bj][m][n];
                rowp += (size_t)16 * ldc; asm volatile("" : "+v"(rowp) :: "memory"); }
            rowp += (size_t)64 * ldc; }
    }
};
struct EpiMerge {
    static constexpr bool PERM = true, DUAL = true, AFTER_DRAIN = false;
    bf16_t* O; int ldc; const bf16_t* GA; const bf16_t* GB; int ldg;
    __device__ __forceinline__ void mid(f32x4 (&acc)[2][2][4][2], const Unit& u, int wr, int wc, int fr, int fq) const {
        const int row0 = u.pm * BM + wr * 64 + fr; const int col0 = u.pn * BM + wc * 32 + 8 * fq;
#pragma unroll
        for (int ai = 0; ai < 2; ++ai)
#pragma unroll
            for (int m = 0; m < 4; ++m) { const size_t ro = (size_t)(row0 + ai * HALF + m * 16) * ldg + col0;
#pragma unroll
                for (int bj = 0; bj < 2; ++bj) { const u32x4 ga = *(const u32x4*)(GA + ro + bj * HALF), gb = *(const u32x4*)(GB + ro + bj * HALF);
#pragma unroll
                    for (int e = 0; e < 4; ++e) { const unsigned wa = ga[e], wb = gb[e];
                        const float r0 = (1.f + __expf(-bf_lo(wb))) / (1.f + __expf(-bf_lo(wa))), r1 = (1.f + __expf(-bf_hi(wb))) / (1.f + __expf(-bf_hi(wa)));
                        if (e < 2) { acc[ai][bj][m][0][2 * e] *= r0; acc[ai][bj][m][0][2 * e + 1] *= r1; } else { acc[ai][bj][m][1][2 * (e - 2)] *= r0; acc[ai][bj][m][1][2 * (e - 2) + 1] *= r1; } } } }
    }
    __device__ __forceinline__ void operator()(const f32x4 (&acc)[2][2][4][2], const Unit& u, int wr, int wc, int fr, int fq) const {
        const int row0 = u.pm * BM + wr * 64 + fr; const int col0 = u.pn * BM + wc * 32 + 8 * fq;
#pragma unroll
        for (int ai = 0; ai < 2; ++ai)
#pragma unroll
            for (int m = 0; m < 4; ++m) { const size_t ro = (size_t)(row0 + ai * HALF + m * 16) * ldg + col0; bf16_t* rowp = O + (size_t)(row0 + ai * HALF + m * 16) * ldc + col0;
#pragma unroll
                for (int bj = 0; bj < 2; ++bj) { const u32x4 gb = *(const u32x4*)(GB + ro + bj * HALF); f32x4 v0 = acc[ai][bj][m][0], v1 = acc[ai][bj][m][1];
                    float s[8];
#pragma unroll
                    for (int e = 0; e < 4; ++e) { s[2 * e] = 1.f / (1.f + __expf(-bf_lo(gb[e]))); s[2 * e + 1] = 1.f / (1.f + __expf(-bf_hi(gb[e]))); }
                    u32x4 w; w.x = cvt_pk_bf16(v0[0] * s[0], v0[1] * s[1]); w.y = cvt_pk_bf16(v0[2] * s[2], v0[3] * s[3]); w.z = cvt_pk_bf16(v1[0] * s[4], v1[1] * s[5]); w.w = cvt_pk_bf16(v1[2] * s[6], v1[3] * s[7]);
                    *(u32x4*)(rowp + bj * HALF) = w; } }
    }
};

struct EpiYb {
    static constexpr bool PERM = true, DUAL = false, AFTER_DRAIN = false;
    bf16_t* O; int ldc; const bf16_t* GB; int ldg;
    __device__ __forceinline__ void mid(f32x4 (&acc)[2][2][4][2], const Unit& u, int wr, int wc, int fr, int fq) const {}
    __device__ __forceinline__ void operator()(const f32x4 (&acc)[2][2][4][2], const Unit& u, int wr, int wc, int fr, int fq) const {
        const int row0 = u.pm * BM + wr * 64 + fr; const int col0 = u.pn * BM + wc * 32 + 8 * fq;
#pragma unroll
        for (int ai = 0; ai < 2; ++ai)
#pragma unroll
            for (int m = 0; m < 4; ++m) { const size_t ro = (size_t)(row0 + ai * HALF + m * 16) * ldg + col0; bf16_t* rowp = O + (size_t)(row0 + ai * HALF + m * 16) * ldc + col0;
#pragma unroll
                for (int bj = 0; bj < 2; ++bj) { const u32x4 gb = *(const u32x4*)(GB + ro + bj * HALF); const f32x4 v0 = acc[ai][bj][m][0], v1 = acc[ai][bj][m][1];
                    float s[8];
#pragma unroll
                    for (int e = 0; e < 4; ++e) { s[2 * e] = __builtin_amdgcn_rcpf(1.f + __expf(-bf_lo(gb[e]))); s[2 * e + 1] = __builtin_amdgcn_rcpf(1.f + __expf(-bf_hi(gb[e]))); }
                    u32x4 w; w.x = cvt_pk_bf16(v0[0] * s[0], v0[1] * s[1]); w.y = cvt_pk_bf16(v0[2] * s[2], v0[3] * s[3]); w.z = cvt_pk_bf16(v1[0] * s[4], v1[1] * s[5]); w.w = cvt_pk_bf16(v1[2] * s[6], v1[3] * s[7]);
                    *(u32x4*)(rowp + bj * HALF) = w; } }
    }
};
struct EpiMerge2 {
    static constexpr bool PERM = true, DUAL = false, AFTER_DRAIN = false;
    bf16_t* O; int ldc; const bf16_t* GA; const bf16_t* YB; int ldg;
    __device__ __forceinline__ void mid(f32x4 (&acc)[2][2][4][2], const Unit& u, int wr, int wc, int fr, int fq) const {}
    __device__ __forceinline__ void operator()(const f32x4 (&acc)[2][2][4][2], const Unit& u, int wr, int wc, int fr, int fq) const {
        const int row0 = u.pm * BM + wr * 64 + fr; const int col0 = u.pn * BM + wc * 32 + 8 * fq;
#pragma unroll
        for (int ai = 0; ai < 2; ++ai)
#pragma unroll
            for (int m = 0; m < 4; ++m) { const size_t ro = (size_t)(row0 + ai * HALF + m * 16) * ldg + col0; bf16_t* rowp = O + (size_t)(row0 + ai * HALF + m * 16) * ldc + col0;
#pragma unroll
                for (int bj = 0; bj < 2; ++bj) { const u32x4 ga = *(const u32x4*)(GA + ro + bj * HALF), yb = *(const u32x4*)(YB + ro + bj * HALF); const f32x4 v0 = acc[ai][bj][m][0], v1 = acc[ai][bj][m][1];
                    float o[8];
#pragma unroll
                    for (int e = 0; e < 4; ++e) { const float a0 = (e < 2) ? v0[2 * e] : v1[2 * (e - 2)], a1 = (e < 2) ? v0[2 * e + 1] : v1[2 * (e - 2) + 1];
                        o[2 * e] = a0 * __builtin_amdgcn_rcpf(1.f + __expf(-bf_lo(ga[e]))) + bf_lo(yb[e]); o[2 * e + 1] = a1 * __builtin_amdgcn_rcpf(1.f + __expf(-bf_hi(ga[e]))) + bf_hi(yb[e]); }
                    u32x4 w; w.x = cvt_pk_bf16(o[0], o[1]); w.y = cvt_pk_bf16(o[2], o[3]); w.z = cvt_pk_bf16(o[4], o[5]); w.w = cvt_pk_bf16(o[6], o[7]);
                    *(u32x4*)(rowp + bj * HALF) = w; } }
    }
};
struct RmsExchange {
    float* slots;
    unsigned* cnt;
    __device__ __forceinline__ void run(const f32x4 (&v)[2][2][4][2], const Unit& u, int wr, int wc, int fr, int fq, PG8_LAS unsigned char* lds, int wid, int lane) const {
        PG8_LAS float* P = (PG8_LAS float*)lds;
        PG8_LAS float* S = (PG8_LAS float*)(lds + 4096);
#pragma unroll
        for (int ai = 0; ai < 2; ++ai)
#pragma unroll
            for (int m = 0; m < 4; ++m) { float s = 0.f;
#pragma unroll
                for (int bj = 0; bj < 2; ++bj)
#pragma unroll
                    for (int n = 0; n < 2; ++n) { const f32x4 x = v[ai][bj][m][n]; s += (x[0] * x[0] + x[1] * x[1]) + (x[2] * x[2] + x[3] * x[3]); }
                s += __shfl_xor(s, 16); s += __shfl_xor(s, 32);
                if (fq == 0) P[(ai * HALF + wr * 64 + m * 16 + fr) * 4 + wc] = s; }
        asm volatile("s_waitcnt lgkmcnt(0)" ::: "memory"); __builtin_amdgcn_s_barrier(); asm volatile("" ::: "memory");
        const int row = wid * 64 + lane;
        if (wid < 4) {
            const f32x4 p = *(const PG8_LAS f32x4*)(P + row * 4);
            __hip_atomic_store(slots + ((size_t)(u.pm * BM + row) * 4 + u.pn), (p[0] + p[1]) + (p[2] + p[3]), __ATOMIC_RELAXED, __HIP_MEMORY_SCOPE_AGENT);
            asm volatile("s_waitcnt vmcnt(0)" ::: "memory");
            if (lane == 0) __hip_atomic_fetch_add(cnt + 16 * u.pm, 1u, __ATOMIC_RELAXED, __HIP_MEMORY_SCOPE_AGENT);
        }
        if (wid == 0) {
            unsigned sp = 0;
            while ((unsigned)__builtin_amdgcn_readfirstlane(__hip_atomic_load(cnt + 16 * u.pm, __ATOMIC_RELAXED, __HIP_MEMORY_SCOPE_AGENT)) < 16u) { __builtin_amdgcn_s_sleep(1); if (++sp > (1u << 22)) break; }
            __builtin_amdgcn_fence(__ATOMIC_ACQUIRE, "agent");
        }
        asm volatile("s_waitcnt vmcnt(0) lgkmcnt(0)" ::: "memory"); __builtin_amdgcn_s_barrier(); asm volatile("" ::: "memory");
        if (wid < 4) {
            const float* sl = slots + (size_t)(u.pm * BM + row) * 4; float t = 0.f;
#pragma unroll
            for (int k = 0; k < 4; ++k) t += __hip_atomic_load(sl + k, __ATOMIC_RELAXED, __HIP_MEMORY_SCOPE_AGENT);
            S[row] = rsqrtf(t * (1.0f / 1024.0f) + 1e-6f);
        }
        asm volatile("s_waitcnt vmcnt(0) lgkmcnt(0)" ::: "memory"); __builtin_amdgcn_s_barrier(); asm volatile("" ::: "memory");
    }
};
struct EpiRmsRes {
    static constexpr bool PERM = false, DUAL = false, AFTER_DRAIN = true;
    float* x; const float* gpost; const float* gnext; bf16_t* xn; RmsExchange e1, e2;
    __device__ __forceinline__ void mid(f32x4 (&acc)[2][2][4][2], const Unit& u, int wr, int wc, int fr, int fq) const {}
    __device__ __forceinline__ void operator()(const f32x4 (&acc)[2][2][4][2], const Unit& u, int wr, int wc, int fr, int fq) const {}
    __device__ __forceinline__ void fused(f32x4 (&acc)[2][2][4][2], const Unit& u, int wr, int wc, int fr, int fq, PG8_LAS unsigned char* lds, int wid, int lane) const {
        typedef unsigned u32x2v __attribute__((ext_vector_type(2)));
        const PG8_LAS float* S = (const PG8_LAS float*)(lds + 4096);
        const int col0 = u.pn * BM + wc * 32 + 4 * fq;
        e1.run(acc, u, wr, wc, fr, fq, lds, wid, lane);
        f32x4 g[2][2];
#pragma unroll
        for (int bj = 0; bj < 2; ++bj)
#pragma unroll
            for (int n = 0; n < 2; ++n) g[bj][n] = *(const f32x4*)(gpost + col0 + bj * HALF + n * 16);
#pragma unroll
        for (int ai = 0; ai < 2; ++ai)
#pragma unroll
            for (int m = 0; m < 4; ++m) { const int r = ai * HALF + wr * 64 + m * 16 + fr; const float sr = S[r]; float* xp = x + (size_t)(u.pm * BM + r) * 1024 + col0;
#pragma unroll
                for (int bj = 0; bj < 2; ++bj)
#pragma unroll
                    for (int n = 0; n < 2; ++n) { const f32x4 xv = *(const f32x4*)(xp + bj * HALF + n * 16); const f32x4 o = xv + acc[ai][bj][m][n] * sr * g[bj][n]; acc[ai][bj][m][n] = o; *(f32x4*)(xp + bj * HALF + n * 16) = o; }
                asm volatile("" : "+v"(acc[ai][0][m][0]), "+v"(acc[ai][0][m][1]), "+v"(acc[ai][1][m][0]), "+v"(acc[ai][1][m][1]));
                if (m & 1) asm volatile("" ::: "memory"); }
        if (gnext) {
            e2.run(acc, u, wr, wc, fr, fq, lds, wid, lane);
#pragma unroll
            for (int bj = 0; bj < 2; ++bj)
#pragma unroll
                for (int n = 0; n < 2; ++n) g[bj][n] = *(const f32x4*)(gnext + col0 + bj * HALF + n * 16);
#pragma unroll
            for (int ai = 0; ai < 2; ++ai)
#pragma unroll
                for (int m = 0; m < 4; ++m) { const int r = ai * HALF + wr * 64 + m * 16 + fr; const float sr = S[r]; bf16_t* op = xn + (size_t)(u.pm * BM + r) * 1024 + col0;
#pragma unroll
                    for (int bj = 0; bj < 2; ++bj)
#pragma unroll
                        for (int n = 0; n < 2; ++n) { const f32x4 o = acc[ai][bj][m][n] * sr * g[bj][n]; u32x2v w; w.x = cvt_pk_bf16(o[0], o[1]); w.y = cvt_pk_bf16(o[2], o[3]); *(u32x2v*)(op + bj * HALF + n * 16) = w; } }
        }
    }
};
template <class Epi, class Sched, bool ALIGN_EPI = false, bool SP2 = false>
__device__ __forceinline__ void gemm_phase(PG8_LAS unsigned char* lds, const Gemm g, const Sched& S, const Epi& E) {
    int tid_ = threadIdx.x; asm volatile("" : "+v"(tid_)); const int tid = tid_, wid = __builtin_amdgcn_readfirstlane(tid >> 6), lane = tid & 63, wr = wid >> 2, wc = wid & 3, fr = lane & 15, fq = lane >> 4;
    const int K = g.K, nt = K / BK, lda = g.lda;
    unsigned voffA[2], voffB[2];
#pragma unroll
    for (int i = 0; i < 2; ++i) { int R, C; stage_rc(tid * 16 + i * 8192, R, C); const int Rb = Epi::PERM ? ((R & ~31) + perm32(R & 31)) : R;
        voffA[i] = (unsigned)(R * lda + C) * 2u; voffB[i] = (unsigned)(Rb * K + C) * 2u; }
    const size_t kstep = (size_t)(BK * 2);
    const size_t hstepA = (size_t)HALF * lda * 2, hstepB = (size_t)HALF * K * 2;
    const size_t tstepA = 2 * hstepA, tstepB = 2 * hstepB;
    const unsigned ldsw = (unsigned)wid * 1024u;
    const int aoff = lds_byte(wr * 64 + fr, fq * 8), boff = lds_byte(wc * 32 + fr, fq * 8);
#define PG8_SA(b, h) (((b) * 2 + (h)) * HTB)
#define PG8_SB(b, h) ((4 + (b) * 2 + (h)) * HTB)
#define PG8_STAGE(bufoff, gbase, voff) do { _Pragma("unroll") for (int _i = 0; _i < 2; ++_i) \
        __builtin_amdgcn_global_load_lds((const unsigned*)((const char*)(gbase) + (voff)[_i]), (PG8_LAS unsigned*)(lds + (bufoff) + ldsw + _i * 8192), 16, 0, 0); } while (0)
#define PG8_LDA(dst, b, h) do { _Pragma("unroll") for (int m = 0; m < 4; ++m) _Pragma("unroll") for (int k = 0; k < 2; ++k) dst[m][k] = *(const PG8_LAS bf16x8*)(lds + PG8_SA(b, h) + aoff + m * 2048 + k * 1024); } while (0)
#define PG8_LDB(dst, b, h) do { _Pragma("unroll") for (int n = 0; n < 2; ++n) _Pragma("unroll") for (int k = 0; k < 2; ++k) dst[n][k] = *(const PG8_LAS bf16x8*)(lds + PG8_SB(b, h) + boff + n * 2048 + k * 1024); } while (0)
#define PG8_MMA(ai, bj, At, Bt) do { __builtin_amdgcn_s_setprio(1); _Pragma("unroll") for (int m = 0; m < 4; ++m) _Pragma("unroll") for (int n = 0; n < 2; ++n) _Pragma("unroll") for (int k = 0; k < 2; ++k) \
        acc[ai][bj][m][n] = __builtin_amdgcn_mfma_f32_16x16x32_bf16(Bt[n][k], At[m][k], acc[ai][bj][m][n], 0, 0, 0); __builtin_amdgcn_s_setprio(0); } while (0)
#define PG8_WAIT_V(n) asm volatile("s_waitcnt vmcnt(" #n ")" ::: "memory")
#define PG8_WAIT_L(n) asm volatile("s_waitcnt lgkmcnt(" #n ")" ::: "memory")
#define PG8_BAR __builtin_amdgcn_s_barrier()
#define PG8_SCHED __builtin_amdgcn_sched_barrier(0)
    Unit cur, nxt; int ui = 0;
    if (!S.next(0, cur)) return;
    f32x4 acc[2][2][4][2];
#pragma unroll
    for (int a = 0; a < 2; ++a)
#pragma unroll
        for (int b = 0; b < 2; ++b)
#pragma unroll
            for (int m = 0; m < 4; ++m)
#pragma unroll
                for (int n = 0; n < 2; ++n) acc[a][b][m][n] = (f32x4){0.f, 0.f, 0.f, 0.f};
    bf16x8 At[4][2], B0[2][2], B1[2][2];
    const char* cA = (const char*)(cur.src ? g.A2 : g.A) + (size_t)cur.pm * tstepA; const char* cB = (const char*)(cur.src ? g.Bt2 : g.Bt) + (size_t)cur.pn * tstepB;
    if constexpr (SP2) {
        PG8_STAGE(PG8_SB(0, 0), cB, voffB); PG8_STAGE(PG8_SB(0, 1), cB + hstepB, voffB); PG8_STAGE(PG8_SA(0, 0), cA, voffA); PG8_STAGE(PG8_SA(0, 1), cA + hstepA, voffA);
        if (wr == 1) PG8_BAR;
        PG8_WAIT_V(2); PG8_BAR;
        PG8_STAGE(PG8_SB(1, 0), cB + kstep, voffB); PG8_STAGE(PG8_SA(1, 0), cA + kstep, voffA); PG8_STAGE(PG8_SB(1, 1), cB + hstepB + kstep, voffB);
        PG8_WAIT_V(6); PG8_BAR;
    } else {
        PG8_STAGE(PG8_SB(0, 0), cB, voffB); PG8_STAGE(PG8_SA(0, 0), cA, voffA); PG8_STAGE(PG8_SB(0, 1), cB + hstepB, voffB); PG8_STAGE(PG8_SA(0, 1), cA + hstepA, voffA);
        if (wr == 1) PG8_BAR;
        PG8_WAIT_V(4); PG8_BAR;
        PG8_STAGE(PG8_SB(1, 0), cB + kstep, voffB); PG8_STAGE(PG8_SA(1, 0), cA + kstep, voffA); PG8_STAGE(PG8_SB(1, 1), cB + hstepB + kstep, voffB);
        PG8_WAIT_V(6); PG8_BAR;
    }
    for (;;) {
        const bool has_next = S.next(ui + 1, nxt);
        const char* nA = has_next ? (const char*)(nxt.src ? g.A2 : g.A) + (size_t)nxt.pm * tstepA : cA; const char* nB = has_next ? (const char*)(nxt.src ? g.Bt2 : g.Bt) + (size_t)nxt.pn * tstepB : cB;
        for (int t = 0; t < nt; t += 2) {
            const bool last = (t == nt - 2);
            const char* a1 = cA + (size_t)(t + 1) * kstep;
            const char* a2 = last ? nA : cA + (size_t)(t + 2) * kstep; const char* b2 = last ? nB : cB + (size_t)(t + 2) * kstep;
            const char* a3 = a2 + kstep; const char* b3 = b2 + kstep;
            if constexpr (SP2) {
            PG8_LDB(B0, 0, 0); PG8_LDB(B1, 0, 1); PG8_SCHED; PG8_LDA(At, 0, 0); PG8_STAGE(PG8_SA(1, 1), a1 + hstepA, voffA);
            PG8_WAIT_V(8); PG8_WAIT_L(0); PG8_BAR; PG8_MMA(0, 0, At, B0); PG8_MMA(0, 1, At, B1); PG8_BAR; PG8_SCHED;
            PG8_LDA(At, 0, 1); PG8_STAGE(PG8_SB(0, 0), b2, voffB); PG8_STAGE(PG8_SB(0, 1), b2 + hstepB, voffB); PG8_STAGE(PG8_SA(0, 0), a2, voffA);
            PG8_WAIT_V(8); PG8_WAIT_L(0); PG8_BAR; PG8_MMA(1, 0, At, B0); PG8_MMA(1, 1, At, B1); PG8_BAR; PG8_SCHED;
            PG8_LDB(B0, 1, 0); PG8_LDB(B1, 1, 1); PG8_SCHED; PG8_LDA(At, 1, 0); PG8_STAGE(PG8_SA(0, 1), a2 + hstepA, voffA);
            PG8_WAIT_V(8); PG8_WAIT_L(0); PG8_BAR; PG8_MMA(0, 0, At, B0); PG8_MMA(0, 1, At, B1); PG8_BAR; PG8_SCHED;
            PG8_LDA(At, 1, 1); PG8_STAGE(PG8_SB(1, 0), b3, voffB); PG8_STAGE(PG8_SB(1, 1), b3 + hstepB, voffB); PG8_STAGE(PG8_SA(1, 0), a3, voffA);
            PG8_WAIT_V(8); PG8_WAIT_L(0); PG8_BAR; PG8_MMA(1, 0, At, B0); PG8_MMA(1, 1, At, B1); PG8_BAR; PG8_SCHED;
            } else {
            PG8_LDB(B0, 0, 0); PG8_SCHED; PG8_LDA(At, 0, 0); PG8_STAGE(PG8_SA(1, 1), a1 + hstepA, voffA);
            PG8_WAIT_L(8); PG8_BAR; PG8_WAIT_L(0); PG8_MMA(0, 0, At, B0); PG8_BAR; PG8_SCHED;
            PG8_LDB(B1, 0, 1); PG8_STAGE(PG8_SB(0, 0), b2, voffB);
            PG8_BAR; PG8_WAIT_L(0); PG8_MMA(0, 1, At, B1); PG8_BAR;
            PG8_LDA(At, 0, 1); PG8_STAGE(PG8_SA(0, 0), a2, voffA);
            PG8_BAR; PG8_WAIT_L(0); PG8_MMA(1, 0, At, B0); PG8_BAR; PG8_SCHED;
            PG8_STAGE(PG8_SB(0, 1), b2 + hstepB, voffB);
            PG8_WAIT_V(6); PG8_BAR; PG8_MMA(1, 1, At, B1); PG8_BAR;
            PG8_LDB(B0, 1, 0); PG8_SCHED; PG8_LDA(At, 1, 0); PG8_STAGE(PG8_SA(0, 1), a2 + hstepA, voffA);
            PG8_WAIT_L(8); PG8_BAR; PG8_WAIT_L(0); PG8_MMA(0, 0, At, B0); PG8_BAR; PG8_SCHED;
            PG8_LDB(B1, 1, 1); PG8_STAGE(PG8_SB(1, 0), b3, voffB);
            PG8_BAR; PG8_WAIT_L(0); PG8_MMA(0, 1, At, B1); PG8_BAR;
            PG8_LDA(At, 1, 1); PG8_STAGE(PG8_SA(1, 0), a3, voffA);
            PG8_BAR; PG8_WAIT_L(0); PG8_MMA(1, 0, At, B0); PG8_BAR; PG8_SCHED;
            PG8_STAGE(PG8_SB(1, 1), b3 + hstepB, voffB);
            PG8_WAIT_V(6); PG8_BAR; PG8_MMA(1, 1, At, B1); PG8_BAR;
            }
        }
        if constexpr (ALIGN_EPI) { if (wr == 0) PG8_BAR; }
        const bool midu = Epi::DUAL && cur.src == 0;
        if constexpr (!Epi::AFTER_DRAIN) { if (midu) E.mid(acc, cur, wr, wc, fr, fq); else E(acc, cur, wr, wc, fr, fq); }
        if (!has_next) break;
        if (!midu) {
#pragma unroll
        for (int a = 0; a < 2; ++a)
#pragma unroll
            for (int b = 0; b < 2; ++b)
#pragma unroll
                for (int m = 0; m < 4; ++m)
#pragma unroll
                    for (int n = 0; n < 2; ++n) acc[a][b][m][n] = (f32x4){0.f, 0.f, 0.f, 0.f};
        }
        cur = nxt; cA = nA; cB = nB; ++ui;
        if constexpr (ALIGN_EPI) { if (wr == 1) PG8_BAR; }
    }
    PG8_WAIT_V(0);
    if constexpr (!ALIGN_EPI) { if (wr == 0) PG8_BAR; }
    PG8_BAR;
    if constexpr (Epi::AFTER_DRAIN) E.fused(acc, cur, wr, wc, fr, fq, lds, wid, lane);
#undef PG8_SA
#undef PG8_SB
#undef PG8_STAGE
#undef PG8_LDA
#undef PG8_LDB
#undef PG8_MMA
#undef PG8_WAIT_V
#undef PG8_WAIT_L
#undef PG8_BAR
#undef PG8_SCHED
}
}

#define GAS __attribute__((address_space(1)))
#define LAS __attribute__((address_space(3)))
typedef unsigned short bf16;
typedef unsigned v4u __attribute__((ext_vector_type(4)));
typedef unsigned v2u __attribute__((ext_vector_type(2)));
typedef float f32x4 __attribute__((ext_vector_type(4)));
typedef short bf16x8 __attribute__((ext_vector_type(8)));
constexpr int NWAVES = 8, NTHR = 512;
constexpr int BATCH = 2, SEQ = 8192, D = 1024, FF = 4096, DEPTH = 4, M = BATCH * SEQ;
constexpr int DIN = 7440, DINP = 7680;
constexpr int C_DNQ = 0, C_DNK = 1024, C_DNV = 2048, C_DNZ = 3072, C_SWQ = 4096, C_GA = 5120, C_GB = 6144, C_SWK = 7168, C_SWV = 7296, C_DNB = 7424, C_DNA = 7432;
constexpr float EPS = 1e-6f;
constexpr size_t MiB = 1u << 20;
constexpr size_t WS_WIN = 1 * MiB, WS_WUPDN = 16 * MiB, WS_WUPSW = 18 * MiB, WS_WO = 20 * MiB, WS_WFF1 = 22 * MiB, WS_WFF2 = 30 * MiB, WS_ROPE = 38 * MiB;
constexpr size_t WS_PROJ = 40 * MiB, WS_H = 40 * MiB, WS_XN = 280 * MiB, WS_YF = 312 * MiB, WS_MIX = 376 * MiB, WS_END = 456 * MiB;
constexpr int LDS_BYTES = 147456;

typedef float f32x2_t __attribute__((ext_vector_type(2)));
typedef __bf16 bf16x2_t __attribute__((ext_vector_type(2)));
__device__ __forceinline__ unsigned pk2(float lo, float hi) { const f32x2_t v = {lo, hi}; return __builtin_bit_cast(unsigned, __builtin_convertvector(v, bf16x2_t)); }
__device__ __forceinline__ unsigned f2bf(float f) { return pk2(f, 0.f) & 0xffffu; }
__device__ __forceinline__ float bflo(unsigned w) { return __uint_as_float(w << 16); }
__device__ __forceinline__ float bfhi(unsigned w) { return __uint_as_float(w & 0xffff0000u); }
__device__ __forceinline__ float bf1(bf16 h) { return __uint_as_float((unsigned)h << 16); }
__device__ __forceinline__ float wave_sum(float v) {
#pragma unroll
    for (int o = 1; o < 64; o <<= 1) v += __shfl_xor(v, o);
    return v;
}
__device__ __forceinline__ float wave_max(float v) {
#pragma unroll
    for (int o = 1; o < 64; o <<= 1) v = fmaxf(v, __shfl_xor(v, o));
    return v;
}
__device__ __forceinline__ float sigmoidf_(float x) { return __builtin_amdgcn_rcpf(1.f + __expf(-x)); }
__device__ __forceinline__ float siluf_(float x) { return x * __builtin_amdgcn_rcpf(1.f + __expf(-x)); }

struct Frame {
    LAS unsigned char* lds;
    int tid, lane, wave, G, bid;
};
__device__ __forceinline__ LAS unsigned char* lds_base() { extern __shared__ __attribute__((aligned(16))) unsigned char lds_dyn[]; return (LAS unsigned char*)lds_dyn; }
__device__ __forceinline__ Frame mkframe() {
    Frame F; F.lds = lds_base(); int tid = threadIdx.x; asm volatile("" : "+v"(tid)); int bid = blockIdx.x; asm volatile("" : "+s"(bid)); int G = gridDim.x; asm volatile("" : "+s"(G));
    F.tid = tid; F.lane = tid & 63; F.wave = __builtin_amdgcn_readfirstlane(tid >> 6); F.G = G; F.bid = bid; return F; }
typedef __attribute__((address_space(4))) const unsigned char* kargp_t;
__device__ __forceinline__ kargp_t kargs() { kargp_t p = (kargp_t)__builtin_amdgcn_kernarg_segment_ptr(); asm volatile("" : "+s"(p)); return p; }
__device__ __forceinline__ const float* inp(int k) { return *(const float* __attribute__((address_space(4))) const*)(kargs() + 8 * k); }
__device__ __forceinline__ float* outp() { return *(float* __attribute__((address_space(4))) const*)(kargs() + 8 * 17); }
__device__ __forceinline__ unsigned char* wsp() { return *(unsigned char* __attribute__((address_space(4))) const*)(kargs() + 8 * 18); }

__device__ __forceinline__ int orig_col(int nc) {
    if (nc < 4096) return nc;
    if (nc < 5120) return nc - 4096 + 4112;
    if (nc < 6144) return nc - 5120 + 5392;
    if (nc < 7168) return nc - 6144 + 6416;
    if (nc < 7296) return nc - 7168 + 5136;
    if (nc < 7424) return nc - 7296 + 5264;
    if (nc < 7440) return nc - 7424 + 4096;
    return -1;
}
template <bool PERMW>
__device__ __forceinline__ void transpose_item(const float* W, int K, int ldw, int nblk, bf16* WT, LAS float* scr, int item, int lane) {
    const int kb = item / nblk, nb = item % nblk, k0 = 64 * kb, n0 = 32 * nb;
    const int ncol = n0 + (lane & 31); const int oc = PERMW ? orig_col(ncol) : ncol;
#pragma unroll 8
    for (int i = 0; i < 32; ++i) { const int kk = 2 * i + (lane >> 5); scr[kk * 33 + (lane & 31)] = (oc >= 0) ? W[(size_t)(k0 + kk) * ldw + oc] : 0.f; }
    asm volatile("s_waitcnt lgkmcnt(0)" ::: "memory");
    const int c = lane & 7;
#pragma unroll
    for (int j = 0; j < 4; ++j) { const int n = (lane >> 3) + 8 * j; const LAS float* s = scr + (8 * c) * 33 + n;
        v4u o; o.x = pk2(s[0 * 33], s[1 * 33]); o.y = pk2(s[2 * 33], s[3 * 33]); o.z = pk2(s[4 * 33], s[5 * 33]); o.w = pk2(s[6 * 33], s[7 * 33]);
        *(v4u*)(WT + (size_t)(n0 + n) * K + k0 + 8 * c) = o; }
    asm volatile("s_waitcnt lgkmcnt(0)" ::: "memory");
}
__device__ __forceinline__ void phase_convert(Frame& F_, int lrest, int lin, int nskip) {
    Frame F = mkframe();
    LAS float* scr = (LAS float*)(F.lds + F.wave * 16384);
    const int gw = (F.bid - nskip) * NWAVES + F.wave, NGW = (F.G - nskip) * NWAVES;
    constexpr int I_IN = 16 * (DINP / 32), I_SQ = 16 * 32, I_F1 = 16 * (FF / 32), I_F2 = 64 * 32;
    const int n_in = (lin >= 0) ? I_IN : 0, n_rest = (lrest >= 0) ? 3 * I_SQ + I_F1 + I_F2 : 0;
    for (int it = gw; it < n_in + n_rest; it += NGW) {
        int r = it;
        if (r < n_in) { transpose_item<true>(inp(3) + (size_t)lin * D * DIN, D, DIN, DINP / 32, (bf16*)(wsp() + WS_WIN), scr, r, F.lane); continue; } r -= n_in;
        const int l = lrest;
        if (r < I_SQ) { transpose_item<false>(inp(9) + (size_t)l * D * D, D, D, 32, (bf16*)(wsp() + WS_WUPDN), scr, r, F.lane); continue; } r -= I_SQ;
        if (r < I_SQ) { transpose_item<false>(inp(10) + (size_t)l * D * D, D, D, 32, (bf16*)(wsp() + WS_WUPSW), scr, r, F.lane); continue; } r -= I_SQ;
        if (r < I_SQ) { transpose_item<false>(inp(11) + (size_t)l * D * D, D, D, 32, (bf16*)(wsp() + WS_WO), scr, r, F.lane); continue; } r -= I_SQ;
        if (r < I_F1) { transpose_item<false>(inp(14) + (size_t)l * D * FF, D, FF, FF / 32, (bf16*)(wsp() + WS_WFF1), scr, r, F.lane); continue; } r -= I_F1;
        transpose_item<false>(inp(15) + (size_t)l * FF * D, FF, D, 32, (bf16*)(wsp() + WS_WFF2), scr, r, F.lane);
    }
}
__device__ __forceinline__ void phase_rope(Frame& F_) {
    Frame F = mkframe();
    const int* pos = (const int*)inp(1); float* R = (float*)(wsp() + WS_ROPE);
    for (int i = F.bid * NTHR + F.tid; i < M * 8; i += F.G * NTHR) {
        const int m = i >> 3, j = i & 7;
        const float invf = exp2f(-(float)j * (0.125f * 18.931568569324174f));
        const float angf = (float)pos[m] * invf;
        const double a = (double)angf; const double n = rint(a * 0.15915494309189535);
        const float r = (float)(a - n * 6.283185307179586);
        R[m * 16 + j] = __cosf(r); R[m * 16 + 8 + j] = __sinf(r);
    }
}
__device__ __forceinline__ void phase_norm(Frame& F_, const float* y, const float* gpost, const float* xin, float* x, const float* gnext, bf16* XN) {
    Frame F = mkframe();
    const int gw = F.bid * NWAVES + F.wave, NGW = F.G * NWAVES;
    for (int m = gw; m < M; m += NGW) {
        f32x4 v[4];
        const f32x4* xr = (const f32x4*)(xin + (size_t)m * D) + F.lane;
#pragma unroll
        for (int j = 0; j < 4; ++j) v[j] = xr[64 * j];
        if (y) {
            const f32x4* yr = (const f32x4*)(y + (size_t)m * D) + F.lane; f32x4 w[4]; float s = 0.f;
#pragma unroll
            for (int j = 0; j < 4; ++j) { w[j] = yr[64 * j]; s += (w[j].x * w[j].x + w[j].y * w[j].y) + (w[j].z * w[j].z + w[j].w * w[j].w); }
            const float r = rsqrtf(wave_sum(s) * (1.f / D) + EPS);
#pragma unroll
            for (int j = 0; j < 4; ++j) { const f32x4 g = ((const f32x4*)gpost)[F.lane + 64 * j]; v[j] = v[j] + w[j] * r * g; }
        }
        f32x4* xo = (f32x4*)(x + (size_t)m * D) + F.lane;
#pragma unroll
        for (int j = 0; j < 4; ++j) xo[64 * j] = v[j];
        if (gnext) {
            float s = 0.f;
#pragma unroll
            for (int j = 0; j < 4; ++j) s += (v[j].x * v[j].x + v[j].y * v[j].y) + (v[j].z * v[j].z + v[j].w * v[j].w);
            const float r = rsqrtf(wave_sum(s) * (1.f / D) + EPS);
            v2u* o = (v2u*)(XN + (size_t)m * D) + F.lane;
#pragma unroll
            for (int j = 0; j < 4; ++j) { const f32x4 g = ((const f32x4*)gnext)[F.lane + 64 * j]; v2u w; w.x = pk2(v[j].x * r * g.x, v[j].y * r * g.y); w.y = pk2(v[j].z * r * g.z, v[j].w * r * g.w); o[64 * j] = w; }
        }
    }
}
constexpr size_t WS_SUBCNT = 196608, WS_BAR = 65536, WS_XCNT = 131072, WS_XSLOT = 39 * MiB;
#define XB_TMO      128
#define XB_XCNT(j)  (256  + 64 * (j))
#define XB_XSUB(j)  (1280 + 64 * (j))
#define XB_XGEN(j)  (2304 + 64 * (j))
#define XB_TOP      3328
#define XB_TOPGEN   3392
#define XCD_BAR_WORDS 3456
#define XB_SPIN_CAP (1u << 22)
constexpr int LDS_BARST = LDS_BYTES - 16;
__device__ __forceinline__ unsigned xb_ld(unsigned* p)              { return __hip_atomic_load(p, __ATOMIC_RELAXED, __HIP_MEMORY_SCOPE_AGENT); }
__device__ __forceinline__ unsigned xb_add(unsigned* p, unsigned v) { return __hip_atomic_fetch_add(p, v, __ATOMIC_RELAXED, __HIP_MEMORY_SCOPE_AGENT); }
__device__ __forceinline__ unsigned xb_xcc_id() { return (unsigned)__builtin_amdgcn_s_getreg((3 << 11) | 20) & 0xFu; }
#define XB_SPIN(cond, bar) do { unsigned _sp = 0; while (cond) { __builtin_amdgcn_s_sleep(1); \
    if ((++_sp & 255u) == 0u) { if (xb_ld(&(bar)[XB_TMO])) break; if (_sp > XB_SPIN_CAP) { atomicAdd(&(bar)[XB_TMO], 1u); break; } } } } while (0)
__device__ __forceinline__ void xcd_barrier_post() {
    if (threadIdx.x == 0) { unsigned* bar = (unsigned*)(wsp() + WS_BAR); (void)xb_add(&bar[XB_XCNT(xb_xcc_id())], 1u); }
}
__device__ __forceinline__ void xcd_barrier_complete(unsigned* bar, unsigned x, unsigned& nloc, unsigned& nx) {
    const unsigned G = gridDim.x * gridDim.y * gridDim.z;
    unsigned sum, cnt, mine, sp = 0u;
    for (;;) {
        sum = 0u; cnt = 0u; mine = 0u;
#pragma unroll
        for (unsigned j = 0; j < 16; ++j) { const unsigned c = xb_ld(&bar[XB_XCNT(j)]); sum += c; cnt += (c > 0u) ? 1u : 0u; mine = (j == x) ? c : mine; }
        if (sum == G) break;
        __builtin_amdgcn_s_sleep(1);
        if ((++sp & 255u) == 0u) { if (xb_ld(&bar[XB_TMO])) break; if (sp > XB_SPIN_CAP) { atomicAdd(&bar[XB_TMO], 1u); break; } }
    }
    nloc = mine > 0u ? mine : 1u; nx = cnt > 0u ? cnt : 1u;
}
__device__ __forceinline__ void grid_bar() {
    asm volatile("s_waitcnt vmcnt(0)" ::: "memory");
    __syncthreads();
    if (threadIdx.x == 0) {
        unsigned* bar = (unsigned*)(wsp() + WS_BAR); const unsigned x = xb_xcc_id();
        volatile LAS unsigned* st = (volatile LAS unsigned*)(lds_base() + LDS_BARST);
        __builtin_amdgcn_s_waitcnt(0);
        unsigned nloc = st[0], nx = st[1];
        if (nloc == 0u) { xcd_barrier_complete(bar, x, nloc, nx); st[0] = nloc; st[1] = nx; }
        const unsigned old = xb_add(&bar[XB_XSUB(x)], 1u);
        const unsigned gen = old / nloc;
        if (old + 1u == (gen + 1u) * nloc) {
            __builtin_amdgcn_fence(__ATOMIC_RELEASE, "agent");
            asm volatile("s_waitcnt vmcnt(0)" ::: "memory");
            const unsigned og = xb_add(&bar[XB_TOP], 1u);
            const unsigned tg = og / nx;
            if (og + 1u == (tg + 1u) * nx) xb_add(&bar[XB_TOPGEN], 1u);
            else XB_SPIN(xb_ld(&bar[XB_TOPGEN]) == tg, bar);
            __builtin_amdgcn_fence(__ATOMIC_ACQUIRE, "agent");
            xb_add(&bar[XB_XGEN(x)], 1u);
            asm volatile("s_waitcnt vmcnt(0)" ::: "memory");
        } else {
            XB_SPIN(xb_ld(&bar[XB_XGEN(x)]) == gen, bar);
            __builtin_amdgcn_fence(__ATOMIC_ACQUIRE, "agent");
            asm volatile("s_waitcnt vmcnt(0)" ::: "memory");
        }
    }
    __syncthreads();
}

__device__ __forceinline__ void sub_bar(unsigned* cnt, unsigned n) {
    asm volatile("s_waitcnt vmcnt(0)" ::: "memory");
    __syncthreads();
    if (threadIdx.x == 0) {
        __builtin_amdgcn_fence(__ATOMIC_RELEASE, "agent");
        asm volatile("s_waitcnt vmcnt(0)" ::: "memory");
        xb_add(cnt, 1u);
        unsigned sp = 0; while (xb_ld(cnt) < n) { __builtin_amdgcn_s_sleep(1); if (++sp > XB_SPIN_CAP) break; }
        __builtin_amdgcn_fence(__ATOMIC_ACQUIRE, "agent");
        asm volatile("s_waitcnt vmcnt(0)" ::: "memory");
    }
    __syncthreads();
}
#define MFMA16(a, b, c) __builtin_amdgcn_mfma_f32_16x16x32_bf16(a, b, c, 0, 0, 0)
constexpr size_t WS_GL = 0, WS_W = 312 * MiB, WS_QD = 344 * MiB, WS_KDT = 376 * MiB, WS_UT = 408 * MiB, WS_AI = 440 * MiB;
typedef LAS unsigned short* lbf;
template <int PMODE>
__device__ __forceinline__ void dn_prep(Frame& F_, int l) {
    Frame F = mkframe();
    const bf16* PROJ = (const bf16*)(wsp() + WS_PROJ);
    lbf QS = (lbf)(F.lds), KS = (lbf)(F.lds + 17408), VT = (lbf)(F.lds + 34816), KGT = (lbf)(F.lds + 53248), KDT = (lbf)(F.lds + 71680), TB = (lbf)(F.lds + 107520);
    LAS float* LM = (LAS float*)(F.lds + 90112); LAS float* GC = (LAS float*)(F.lds + 116736); LAS float* BT = (LAS float*)(F.lds + 116992);
    const int lane = F.lane, wave = F.wave, fr = lane & 15, fq = lane >> 4;
    struct PrepIn { unsigned xr[3][11]; float cw[3][4][2]; bf16 a, b; };
#define PREP_LOAD(X, chx) do { const int ch_ = (chx), h_ = (ch_ >> 7) & 7, n_ = ch_ & 127, m0_ = (ch_ >> 10) * SEQ + n_ * 64; \
        X.a = PROJ[(size_t)(m0_ + lane) * DINP + C_DNA + h_]; X.b = PROJ[(size_t)(m0_ + lane) * DINP + C_DNB + h_]; \
        _Pragma("unroll") for (int ts = 0; ts < 3; ++ts) _Pragma("unroll") for (int j = 0; j < 11; ++j) { const int ii = 8 * wave - 3 + j; \
            X.xr[ts][j] = (n_ * 64 + ii >= 0) ? *(const unsigned*)(PROJ + (size_t)(m0_ + ii) * DINP + ts * 1024 + h_ * 128 + 2 * lane) : 0u; } \
        { const float* cwp = inp(4) + (size_t)l * 4 * 3072 + h_ * 128 + 2 * lane; \
          _Pragma("unroll") for (int ts = 0; ts < 3; ++ts) _Pragma("unroll") for (int j = 0; j < 4; ++j) { X.cw[ts][j][0] = cwp[j * 3072 + ts * 1024]; X.cw[ts][j][1] = cwp[j * 3072 + ts * 1024 + 1]; } } } while (0)
    PrepIn cur; unsigned eat = 0u;
    for (int ch = F.bid; ch < 2048; ch += F.G) {
        const int b = ch >> 10, h = (ch >> 7) & 7, n = ch & 127, m0 = b * SEQ + n * 64;
        PREP_LOAD(cur, ch);
        unsigned touch = 0u;
        if (ch + F.G < 2048 && F.tid < 402) { const int cn = ch + F.G, hn = (cn >> 7) & 7, nn = cn & 127, mn = (cn >> 10) * SEQ + nn * 64; const int rowt = F.tid / 6 - 3, ln = F.tid % 6;
            if (nn * 64 + rowt >= 0) touch = *(const unsigned*)(PROJ + (size_t)(mn + rowt) * DINP + (ln >> 1) * 1024 + hn * 128 + (ln & 1) * 64); }
        const float a_neg = -__expf(inp(5)[l * 8 + h]), dtb = inp(6)[l * 8 + h];
        float gc, beta, gl;
        { const float a_in = bf1(cur.a), b_in = bf1(cur.b);
          const float z = a_in + dtb; const float sp = (z > 20.f) ? z : log1pf(__expf(z)); gc = a_neg * sp;
#pragma unroll
          for (int o = 1; o < 64; o <<= 1) { const float t = __shfl_up(gc, o); if (lane >= o) gc += t; }
          beta = sigmoidf_(b_in); gl = __shfl(gc, 63);
          if (wave == 0) { GC[lane] = gc; BT[lane] = beta; } }
        float sv[8][3][2], pp[16];
#pragma unroll
        for (int rr = 0; rr < 8; ++rr) {
#pragma unroll
            for (int ts = 0; ts < 3; ++ts) { float y0 = 0.f, y1 = 0.f;
#pragma unroll
                for (int j = 0; j < 4; ++j) { const unsigned xw = cur.xr[ts][rr + j]; y0 += cur.cw[ts][j][0] * bflo(xw); y1 += cur.cw[ts][j][1] * bfhi(xw); }
                sv[rr][ts][0] = siluf_(y0); sv[rr][ts][1] = siluf_(y1); }
            pp[2 * rr] = sv[rr][0][0] * sv[rr][0][0] + sv[rr][0][1] * sv[rr][0][1]; pp[2 * rr + 1] = sv[rr][1][0] * sv[rr][1][0] + sv[rr][1][1] * sv[rr][1][1];
        }
        float tot;
        { const bool b5 = (lane & 32) != 0, b4 = (lane & 16) != 0, b3 = (lane & 8) != 0, b2 = (lane & 4) != 0;
          float p8[8], p4[4], p2[2];
#pragma unroll
          for (int k = 0; k < 8; ++k) p8[k] = (b5 ? pp[k + 8] : pp[k]) + __shfl_xor(b5 ? pp[k] : pp[k + 8], 32);
#pragma unroll
          for (int k = 0; k < 4; ++k) p4[k] = (b4 ? p8[k + 4] : p8[k]) + __shfl_xor(b4 ? p8[k] : p8[k + 4], 16);
#pragma unroll
          for (int k = 0; k < 2; ++k) p2[k] = (b3 ? p4[k + 2] : p4[k]) + __shfl_xor(b3 ? p4[k] : p4[k + 2], 8);
          tot = (b2 ? p2[1] : p2[0]) + __shfl_xor(b2 ? p2[0] : p2[1], 4);
          tot += __shfl_xor(tot, 2); tot += __shfl_xor(tot, 1); }
        unsigned kg[2][4], kd[2][4], vb[2][4];
#pragma unroll
        for (int rr = 0; rr < 8; ++rr) {
            const int i = 8 * wave + rr;
            const float gci = __int_as_float(__builtin_amdgcn_readlane(__float_as_int(gc), i)), bi = __int_as_float(__builtin_amdgcn_readlane(__float_as_int(beta), i));
            const float scq = rsqrtf(__int_as_float(__builtin_amdgcn_readlane(__float_as_int(tot), 8 * rr)) + EPS) * 0.08838834764831845f;
            const float sck = rsqrtf(__int_as_float(__builtin_amdgcn_readlane(__float_as_int(tot), 8 * rr + 4)) + EPS);
            const float q0 = sv[rr][0][0] * scq, q1 = sv[rr][0][1] * scq, k0 = sv[rr][1][0] * sck, k1 = sv[rr][1][1] * sck, v0 = sv[rr][2][0], v1 = sv[rr][2][1];
            const float eg = __expf(gci), egl = __expf(gl - gci);
            *(LAS unsigned*)(QS + i * 136 + 2 * lane) = pk2(q0, q1); *(LAS unsigned*)(KS + i * 136 + 2 * lane) = pk2(k0, k1);
            *(unsigned*)((bf16*)(wsp() + WS_QD) + (size_t)ch * 8192 + ((((i >> 4) * 4 + (lane >> 4)) * 64 + ((lane >> 2) & 3) * 16 + (i & 15)) * 8 + 2 * (lane & 3))) = pk2(q0 * eg, q1 * eg);
            const unsigned g0 = f2bf(k0 * bi * eg), g1 = f2bf(k1 * bi * eg), d0 = f2bf(k0 * egl), d1 = f2bf(k1 * egl), u0 = f2bf(v0 * bi), u1 = f2bf(v1 * bi);
            if (rr & 1) { kg[0][rr >> 1] |= g0 << 16; kg[1][rr >> 1] |= g1 << 16; kd[0][rr >> 1] |= d0 << 16; kd[1][rr >> 1] |= d1 << 16; vb[0][rr >> 1] |= u0 << 16; vb[1][rr >> 1] |= u1 << 16; }
            else { kg[0][rr >> 1] = g0; kg[1][rr >> 1] = g1; kd[0][rr >> 1] = d0; kd[1][rr >> 1] = d1; vb[0][rr >> 1] = u0; vb[1][rr >> 1] = u1; }
        }
#pragma unroll
        for (int c = 0; c < 2; ++c) {
            *(LAS v4u*)(KGT + (2 * lane + c) * 72 + 8 * wave) = (v4u){kg[c][0], kg[c][1], kg[c][2], kg[c][3]};
            *(LAS v4u*)(KDT + (2 * lane + c) * 72 + 8 * wave) = (v4u){kd[c][0], kd[c][1], kd[c][2], kd[c][3]};
            *(LAS v4u*)(VT + (2 * lane + c) * 72 + 8 * wave) = (v4u){vb[c][0], vb[c][1], vb[c][2], vb[c][3]};
        }
        __syncthreads();
        if (PMODE == 2) continue;
        { const int ti = wave >> 1;
          bf16x8 kfi[4], qfi[4];
#pragma unroll
          for (int ks = 0; ks < 4; ++ks) { kfi[ks] = *(const LAS bf16x8*)(KS + (16 * ti + fr) * 136 + 32 * ks + 8 * fq); qfi[ks] = *(const LAS bf16x8*)(QS + (16 * ti + fr) * 136 + 32 * ks + 8 * fq); }
#pragma unroll
          for (int tt = 0; tt < 2; ++tt) { const int tj = 2 * (wave & 1) + tt;
              f32x4 akk = {0.f, 0.f, 0.f, 0.f}, aqk = {0.f, 0.f, 0.f, 0.f};
#pragma unroll
              for (int ks = 0; ks < 4; ++ks) { const bf16x8 kfj = *(const LAS bf16x8*)(KS + (16 * tj + fr) * 136 + 32 * ks + 8 * fq); akk = MFMA16(kfi[ks], kfj, akk); aqk = MFMA16(kfj, qfi[ks], aqk); }
              { const int j = 16 * tj + fr; const float gcj = GC[j];
#pragma unroll
                for (int r = 0; r < 4; ++r) { const int i = 16 * ti + 4 * fq + r; LM[i * 68 + j] = (i > j) ? BT[i] * akk[r] * __expf(GC[i] - gcj) : 0.f; } }
              { const int i = 16 * ti + fr; const float gci = GC[i]; float v[4];
#pragma unroll
                for (int r = 0; r < 4; ++r) { const int j = 16 * tj + 4 * fq + r; v[r] = (i >= j) ? aqk[r] * __expf(gci - GC[j]) : 0.f; }
                v2u w; w.x = pk2(v[0], v[1]); w.y = pk2(v[2], v[3]);
                *(v2u*)((bf16*)(wsp() + WS_AI) + (size_t)ch * 4096 + (((ti * 2 + (tj >> 1)) * 64 + ((2 * tj + (fq >> 1)) & 3) * 16 + fr) * 8 + 4 * (fq & 1))) = w; } } }
        __syncthreads();
        if (wave == 0 && PMODE != 1) {
            float x[64]; float lanef = (float)lane; asm volatile("" : "+v"(lanef)); LAS float* LMv = LM; asm volatile("" : "+v"(LMv));
#pragma unroll
            for (int i = 0; i < 64; ++i) x[i] = 0.f;
#pragma unroll
            for (int i = 0; i < 64; ++i) {
                float a0 = fmaxf(0.f, 1.f - fabsf(lanef - (float)i)), a1 = 0.f, a2 = 0.f, a3 = 0.f;
#pragma unroll
                for (int j4 = 0; j4 < (i + 3) / 4; ++j4) { const f32x4 Lv = *(const LAS f32x4*)(LMv + i * 68 + 4 * j4);
                    a0 -= Lv.x * x[4 * j4]; a1 -= Lv.y * x[4 * j4 + 1]; a2 -= Lv.z * x[4 * j4 + 2]; a3 -= Lv.w * x[4 * j4 + 3]; }
                x[i] = (a0 + a1) + (a2 + a3);
            }
#pragma unroll
            for (int i = 0; i < 64; ++i) TB[i * 72 + lane] = (bf16)f2bf(x[i]);
        }
        __syncthreads();
        eat ^= touch;
        { const int ti = wave & 3;
          bf16x8 tf[2];
#pragma unroll
          for (int ks = 0; ks < 2; ++ks) tf[ks] = *(const LAS bf16x8*)(TB + (16 * ti + fr) * 72 + 32 * ks + 8 * fq);
#pragma unroll
          for (int q4 = 0; q4 < 4; ++q4) { const int te = (wave >> 2) * 4 + q4;
              f32x4 au = {0.f, 0.f, 0.f, 0.f}, aw = {0.f, 0.f, 0.f, 0.f};
#pragma unroll
              for (int ks = 0; ks < 2; ++ks) { const bf16x8 vf = *(const LAS bf16x8*)(VT + (16 * te + fr) * 72 + 32 * ks + 8 * fq), gf = *(const LAS bf16x8*)(KGT + (16 * te + fr) * 72 + 32 * ks + 8 * fq);
                  au = MFMA16(tf[ks], vf, au); aw = MFMA16(gf, tf[ks], aw); }
              v2u w; w.x = pk2(au[0], au[1]); w.y = pk2(au[2], au[3]);
              *(v2u*)((bf16*)(wsp() + WS_UT) + (size_t)ch * 8192 + ((te * 4 + ti) * 64 + lane) * 4) = w;
              w.x = pk2(aw[0], aw[1]); w.y = pk2(aw[2], aw[3]);
              *(v2u*)((bf16*)(wsp() + WS_W) + (size_t)ch * 8192 + (((ti * 4 + (te >> 1)) * 64 + ((2 * te + (fq >> 1)) & 3) * 16 + fr) * 8 + 4 * (fq & 1))) = w; }
          { const int d = F.tid >> 2, part = F.tid & 3; const LAS v4u* src = (const LAS v4u*)((LAS unsigned char*)KDT + d * 144 + part * 32);
            bf16* dstb = (bf16*)(wsp() + WS_KDT) + (size_t)ch * 8192 + (((d >> 4) * 2 + (part >> 1)) * 64 + (2 * (part & 1)) * 16 + (d & 15)) * 8; *(v4u*)dstb = src[0]; *(v4u*)(dstb + 128) = src[1]; }
          if (F.tid == 0) ((float*)(wsp() + WS_GL))[ch] = gl; }
        __syncthreads();
    }
    if (eat == 0x12345u && fq == 77) GC[0] = 1.f;
}
#undef PREP_LOAD
struct DnSetC { bf16x8 wf[4], qf[4], af[2]; v2u ut[2]; };
struct DnSetS { bf16x8 kf[2][2]; float gl; unsigned pf; };
template <int MODE>
__device__ __forceinline__ void dn_scan(Frame& F_, int sid) {
    Frame F = mkframe();
    const int bh = sid >> 2, slice = sid & 3, b = bh >> 3, h = bh & 7;
    const int lane = F.lane, wave = F.wave, fr = lane & 15, fq = lane >> 4;
    lbf ST = (lbf)(F.lds); lbf VT2 = (lbf)(F.lds + 8704);
    for (int i = F.tid; i < (8704 + 4608) / 4; i += NTHR) ((LAS unsigned*)F.lds)[i] = 0u;
    const bf16* pW = (const bf16*)(wsp() + WS_W) + (size_t)bh * 128 * 8192; const bf16* pQ = (const bf16*)(wsp() + WS_QD) + (size_t)bh * 128 * 8192;
    const bf16* pA = (const bf16*)(wsp() + WS_AI) + (size_t)bh * 128 * 4096; const bf16* pK = (const bf16*)(wsp() + WS_KDT) + (size_t)bh * 128 * 8192;
    const bf16* pU = (const bf16*)(wsp() + WS_UT) + (size_t)bh * 128 * 8192; const float* pG = (const float*)(wsp() + WS_GL) + bh * 128;
    bf16* pO = (bf16*)(wsp() + WS_XN) + (size_t)b * SEQ * D + h * 128 + 32 * slice;
    short eat = 0;
    __syncthreads();
    if (wave < 4) {
        const int mi = wave;
        const unsigned oW = (mi * 4 * 64 + lane) * 8, oA = (mi * 2 * 64 + lane) * 8, oU = ((2 * slice) * 4 + mi) * 256 + lane * 4, oO = (16 * mi + fr) * D + 4 * fq;
#define DNC_LOAD(X, nn) do { const int c_ = (nn) < 128 ? (nn) : 127; \
            X.ut[0] = *(const v2u*)(pU + (size_t)c_ * 8192 + oU); X.ut[1] = *(const v2u*)(pU + (size_t)c_ * 8192 + oU + 1024); \
            _Pragma("unroll") for (int ks = 0; ks < 4; ++ks) { X.wf[ks] = *(const bf16x8*)(pW + (size_t)c_ * 8192 + (oW + 512 * ks)); X.qf[ks] = *(const bf16x8*)(pQ + (size_t)c_ * 8192 + (oW + 512 * ks)); } \
            _Pragma("unroll") for (int ks = 0; ks < 2; ++ks) X.af[ks] = *(const bf16x8*)(pA + (size_t)c_ * 4096 + (oA + 512 * ks)); } while (0)
#define DNC_STEP(X, nn) do { \
            f32x4 c1[2], c2[2]; \
            _Pragma("unroll") for (int ni = 0; ni < 2; ++ni) { c1[ni] = (f32x4){0.f, 0.f, 0.f, 0.f}; c2[ni] = (f32x4){0.f, 0.f, 0.f, 0.f}; \
                _Pragma("unroll") for (int ks = 0; ks < 4; ++ks) { const bf16x8 sf = *(const LAS bf16x8*)(ST + (16 * ni + fr) * 136 + 32 * ks + 8 * fq); c1[ni] = MFMA16(X.wf[ks], sf, c1[ni]); c2[ni] = MFMA16(sf, X.qf[ks], c2[ni]); } \
                v2u w_; w_.x = pk2(bflo(X.ut[ni].x) - c1[ni][0], bfhi(X.ut[ni].x) - c1[ni][1]); w_.y = pk2(bflo(X.ut[ni].y) - c1[ni][2], bfhi(X.ut[ni].y) - c1[ni][3]); \
                *(LAS v2u*)(VT2 + (16 * ni + fr) * 72 + 16 * mi + 4 * fq) = w_; } \
            __syncthreads(); \
            _Pragma("unroll") for (int ni = 0; ni < 2; ++ni) { \
                _Pragma("unroll") for (int ks = 0; ks < 2; ++ks) { const bf16x8 vf = *(const LAS bf16x8*)(VT2 + (16 * ni + fr) * 72 + 32 * ks + 8 * fq); c2[ni] = MFMA16(vf, X.af[ks], c2[ni]); } \
                v2u w_; w_.x = pk2(c2[ni][0], c2[ni][1]); w_.y = pk2(c2[ni][2], c2[ni][3]); if (MODE == 0) *(v2u*)(pO + (size_t)(nn) * 64 * D + oO + 16 * ni) = w_; } \
            __syncthreads(); } while (0)
        DnSetC SA, SB, SC;
        DNC_LOAD(SA, 0); DNC_LOAD(SB, 1);
        for (int n = 0; n < 126; n += 3) {
            DNC_LOAD(SC, n + 2); __builtin_amdgcn_sched_barrier(0); DNC_STEP(SA, n); __builtin_amdgcn_sched_barrier(0);
            DNC_LOAD(SA, n + 3); __builtin_amdgcn_sched_barrier(0); DNC_STEP(SB, n + 1); __builtin_amdgcn_sched_barrier(0);
            DNC_LOAD(SB, n + 4); __builtin_amdgcn_sched_barrier(0); DNC_STEP(SC, n + 2); __builtin_amdgcn_sched_barrier(0);
        }
        DNC_STEP(SA, 126); DNC_STEP(SB, 127);
#undef DNC_LOAD
#undef DNC_STEP
    } else {
        const int dq = wave - 4;
        f32x4 accS[2][2];
#pragma unroll
        for (int k = 0; k < 2; ++k)
#pragma unroll
            for (int ni = 0; ni < 2; ++ni) accS[k][ni] = (f32x4){0.f, 0.f, 0.f, 0.f};
        const int lt = F.tid - 256, li = slice * 112 + lt; const bool toucher = lt < 144;
        const bf16* pfBase = (lt >= 112) ? pU + 2048 * slice + (lt - 112) * 64 : (li < 128) ? pW + li * 64 : (li < 256) ? pQ + (li - 128) * 64 : (li < 384) ? pK + (li - 256) * 64 : pA + (li - 384) * 64;
        const unsigned pfStride = (lt >= 112 || li < 384) ? 8192u : 4096u;
        const unsigned oK = (2 * dq * 2 * 64 + lane) * 8;
#define DNS_LOAD(X, nn) do { const int c_ = (nn) < 128 ? (nn) : 127; eat ^= (short)X.pf; X.gl = pG[c_]; \
            _Pragma("unroll") for (int ks = 0; ks < 2; ++ks) { X.kf[0][ks] = *(const bf16x8*)(pK + (size_t)c_ * 8192 + (oK + 512 * ks)); X.kf[1][ks] = *(const bf16x8*)(pK + (size_t)c_ * 8192 + (oK + 1024 + 512 * ks)); } \
            { const int c2_ = (nn) + 2 < 128 ? (nn) + 2 : 127; X.pf = toucher ? *(const unsigned*)(pfBase + (size_t)c2_ * pfStride) : 0u; } } while (0)
#define DNS_STEP(X, nn) do { \
            const float egl = __expf(X.gl); \
            __syncthreads(); \
            _Pragma("unroll") for (int ni = 0; ni < 2; ++ni) { bf16x8 vf[2]; \
                _Pragma("unroll") for (int ks = 0; ks < 2; ++ks) vf[ks] = *(const LAS bf16x8*)(VT2 + (16 * ni + fr) * 72 + 32 * ks + 8 * fq); \
                _Pragma("unroll") for (int k = 0; k < 2; ++k) { accS[k][ni] = accS[k][ni] * egl; \
                    _Pragma("unroll") for (int ks = 0; ks < 2; ++ks) accS[k][ni] = MFMA16(X.kf[k][ks], vf[ks], accS[k][ni]); \
                    v2u w_; w_.x = pk2(accS[k][ni][0], accS[k][ni][1]); w_.y = pk2(accS[k][ni][2], accS[k][ni][3]); \
                    *(LAS v2u*)(ST + (16 * ni + fr) * 136 + 16 * (2 * dq + k) + 4 * fq) = w_; } } \
            __syncthreads(); } while (0)
        DnSetS SA, SB, SC; SA.pf = 0u; SB.pf = 0u; SC.pf = 0u;
        DNS_LOAD(SA, 0); DNS_LOAD(SB, 1);
        for (int n = 0; n < 126; n += 3) {
            DNS_LOAD(SC, n + 2); __builtin_amdgcn_sched_barrier(0); DNS_STEP(SA, n); __builtin_amdgcn_sched_barrier(0);
            DNS_LOAD(SA, n + 3); __builtin_amdgcn_sched_barrier(0); DNS_STEP(SB, n + 1); __builtin_amdgcn_sched_barrier(0);
            DNS_LOAD(SB, n + 4); __builtin_amdgcn_sched_barrier(0); DNS_STEP(SC, n + 2); __builtin_amdgcn_sched_barrier(0);
        }
        DNS_STEP(SA, 126); DNS_STEP(SB, 127);
#undef DNS_LOAD
#undef DNS_STEP
    }
    if (eat == 12345 && fq == 77) VT2[0] = (bf16)eat;
}
__device__ __forceinline__ void rope16(v4u& w0, v4u& w1, const float* rp) {
    float x[8], y[8];
#pragma unroll
    for (int j = 0; j < 4; ++j) { x[2 * j] = bflo(w0[j]); x[2 * j + 1] = bfhi(w0[j]); y[2 * j] = bflo(w1[j]); y[2 * j + 1] = bfhi(w1[j]); }
    const f32x4 c0 = *(const f32x4*)rp, c1 = *(const f32x4*)(rp + 4), s0 = *(const f32x4*)(rp + 8), s1 = *(const f32x4*)(rp + 12);
    float c[8] = {c0.x, c0.y, c0.z, c0.w, c1.x, c1.y, c1.z, c1.w}, s[8] = {s0.x, s0.y, s0.z, s0.w, s1.x, s1.y, s1.z, s1.w};
#pragma unroll
    for (int j = 0; j < 8; ++j) { const float a = x[j], bb = y[j]; x[j] = a * c[j] - bb * s[j]; y[j] = bb * c[j] + a * s[j]; }
#pragma unroll
    for (int j = 0; j < 4; ++j) { w0[j] = pk2(x[2 * j], x[2 * j + 1]); w1[j] = pk2(y[2 * j], y[2 * j + 1]); }
}
__device__ __forceinline__ void swa_mfma(Frame& F_, int l, int nskip) {
    Frame F = mkframe();
    bf16* PROJ = (bf16*)(wsp() + WS_PROJ); const float* ROPE = (const float*)(wsp() + WS_ROPE);
    lbf KL = (lbf)(F.lds), VTL = (lbf)(F.lds + 29952), QL = (lbf)(F.lds + 57600 + F.wave * 9216);
    const int tid = F.tid, lane = F.lane, wave = F.wave, fr = lane & 15, fq = lane >> 4;
    for (int unit = F.bid - nskip; unit < 512; unit += F.G - nskip) {
        const int b = unit >> 8, kvh = (unit >> 7) & 1, q0 = (unit & 127) * 64;
        for (int task = tid; task < 208 * 4; task += NTHR) { const int kl = task >> 2, seg = task & 3, tk = q0 - 128 + kl; v4u w0 = {0u, 0u, 0u, 0u}, w1 = {0u, 0u, 0u, 0u};
            if (kl < 192 && tk >= 0) { const int mk = b * SEQ + tk; const v4u* p = (const v4u*)(PROJ + (size_t)mk * DINP + C_SWK + kvh * 64 + 16 * seg); w0 = p[0]; w1 = p[1];
                if (seg == 0) rope16(w0, w1, ROPE + mk * 16); }
            *(LAS v4u*)(KL + kl * 72 + 16 * seg) = w0; *(LAS v4u*)(KL + kl * 72 + 16 * seg + 8) = w1; }
        for (int task = tid; task < 192 * 8; task += NTHR) { const int kl = task >> 3, seg = task & 7, tk = q0 - 128 + kl; v4u w = {0u, 0u, 0u, 0u};
            if (tk >= 0) w = *(const v4u*)(PROJ + (size_t)(b * SEQ + tk) * DINP + C_SWV + kvh * 64 + 8 * seg);
#pragma unroll
            for (int j = 0; j < 4; ++j) { VTL[(8 * seg + 2 * j) * 216 + kl] = (bf16)(w[j] & 0xffffu); VTL[(8 * seg + 2 * j + 1) * 216 + kl] = (bf16)(w[j] >> 16); } }
        for (int i = tid; i < 1024; i += NTHR) VTL[(i >> 4) * 216 + 192 + (i & 15)] = 0;
        { const int mq = b * SEQ + q0 + lane; const v4u* qp = (const v4u*)(PROJ + (size_t)mq * DINP + C_SWQ + (kvh * 8 + wave) * 64);
          v4u w[8];
#pragma unroll
          for (int i = 0; i < 8; ++i) w[i] = qp[i];
          rope16(w[0], w[1], ROPE + mq * 16);
#pragma unroll
          for (int i = 0; i < 8; ++i) { v4u o;
#pragma unroll
              for (int j = 0; j < 4; ++j) o[j] = pk2(bflo(w[i][j]) * 0.125f, bfhi(w[i][j]) * 0.125f);
              *(LAS v4u*)(QL + lane * 72 + 8 * i) = o; } }
        __syncthreads();
        const float sink = inp(8)[l * 16 + kvh * 8 + wave];
#pragma unroll 1
        for (int qt = 0; qt < 4; ++qt) {
            bf16x8 qf[2];
#pragma unroll
            for (int ks = 0; ks < 2; ++ks) qf[ks] = *(const LAS bf16x8*)(QL + (16 * qt + fr) * 72 + 32 * ks + 8 * fq);
            f32x4 st[10];
#pragma unroll
            for (int t = 0; t < 10; ++t) { st[t] = (f32x4){0.f, 0.f, 0.f, 0.f};
#pragma unroll
                for (int ks = 0; ks < 2; ++ks) { const bf16x8 kf = *(const LAS bf16x8*)(KL + (16 * (qt + t) + fr) * 72 + 32 * ks + 8 * fq); st[t] = MFMA16(kf, qf[ks], st[t]); } }
            const int qr = 16 * qt + fr; float mx = -1e30f;
#pragma unroll
            for (int t = 0; t < 10; ++t)
#pragma unroll
                for (int r = 0; r < 4; ++r) { const int kl = 16 * (qt + t) + 4 * fq + r; const bool ok = (kl > qr) && (kl <= qr + 128) && (q0 - 128 + kl >= 0);
                    st[t][r] = ok ? st[t][r] : -1e30f; mx = fmaxf(mx, st[t][r]); }
            mx = fmaxf(mx, __shfl_xor(mx, 16)); mx = fmaxf(mx, __shfl_xor(mx, 32)); mx = fmaxf(mx, sink);
            float sum = 0.f;
#pragma unroll
            for (int t = 0; t < 10; ++t)
#pragma unroll
                for (int r = 0; r < 4; ++r) { const float p = (st[t][r] > -1e29f) ? __expf(st[t][r] - mx) : 0.f; st[t][r] = p; sum += p; }
            sum += __shfl_xor(sum, 16); sum += __shfl_xor(sum, 32);
            const float inv = 1.f / (sum + __expf(sink - mx));
            bf16x8 pf[5];
#pragma unroll
            for (int pr = 0; pr < 5; ++pr) { v4u w; w.x = pk2(st[2 * pr][0] * inv, st[2 * pr][1] * inv); w.y = pk2(st[2 * pr][2] * inv, st[2 * pr][3] * inv);
                w.z = pk2(st[2 * pr + 1][0] * inv, st[2 * pr + 1][1] * inv); w.w = pk2(st[2 * pr + 1][2] * inv, st[2 * pr + 1][3] * inv); pf[pr] = __builtin_bit_cast(bf16x8, w); }
#pragma unroll
            for (int dt = 0; dt < 4; ++dt) { f32x4 acc = {0.f, 0.f, 0.f, 0.f};
#pragma unroll
                for (int pr = 0; pr < 5; ++pr) { const v2u a0 = *(const LAS v2u*)(VTL + (16 * dt + fr) * 216 + 16 * (qt + 2 * pr) + 4 * fq), a1 = *(const LAS v2u*)(VTL + (16 * dt + fr) * 216 + 16 * (qt + 2 * pr + 1) + 4 * fq);
                    v4u aw; aw.x = a0.x; aw.y = a0.y; aw.z = a1.x; aw.w = a1.y; acc = MFMA16(__builtin_bit_cast(bf16x8, aw), pf[pr], acc); }
                v2u w; w.x = pk2(acc[0], acc[1]); w.y = pk2(acc[2], acc[3]);
                *(v2u*)(PROJ + (size_t)(b * SEQ + q0 + 16 * qt + fr) * DINP + C_SWQ + (kvh * 8 + wave) * 64 + 16 * dt + 4 * fq) = w; }
        }
        __syncthreads();
    }
}
__device__ __forceinline__ void dn_naive(Frame& F_, int l) {
    Frame F = mkframe(); const int b = F.bid >> 3, h = F.bid & 7;
    const bf16* PROJ = (const bf16*)(wsp() + WS_PROJ); bf16* ORAW = (bf16*)(wsp() + WS_XN);
    LAS float* vals = (LAS float*)F.lds;
    LAS float* part = vals + 768;
    LAS float* bg = part + 16;
    LAS float* red = bg + 4;
    LAS float* red2 = red + 1024;
    const int tid = F.tid, lane = F.lane, wave = F.wave;
    const int e = tid & 127, r = tid >> 7;
    int col; float cw0 = 0.f, cw1 = 0.f, cw2 = 0.f, cw3 = 0.f;
    if (tid < 384) { const int chan = (tid >> 7) * 1024 + h * 128 + (tid & 127); col = chan; const float* cw = inp(4) + (size_t)l * 4 * 3072;
        cw0 = cw[chan]; cw1 = cw[3072 + chan]; cw2 = cw[2 * 3072 + chan]; cw3 = cw[3 * 3072 + chan]; }
    else if (tid == 384) col = C_DNB + h; else if (tid == 385) col = C_DNA + h; else col = 0;
    const float a_neg = -__expf(inp(5)[l * 8 + h]), dtb = inp(6)[l * 8 + h];
    float S[32];
#pragma unroll
    for (int i = 0; i < 32; ++i) S[i] = 0.f;
    float x0 = 0.f, x1 = 0.f, x2 = 0.f;
    const bf16* pcol = PROJ + (size_t)b * SEQ * DINP + col;
    float cur[16], nxt[16];
#pragma unroll
    for (int i = 0; i < 16; ++i) cur[i] = bf1(pcol[(size_t)i * DINP]);
    for (int tb = 0; tb < SEQ; tb += 16) {
        if (tb + 16 < SEQ) {
#pragma unroll
            for (int i = 0; i < 16; ++i) nxt[i] = bf1(pcol[(size_t)(tb + 16 + i) * DINP]);
        }
#pragma unroll
        for (int i = 0; i < 16; ++i) {
            const int t = tb + i, buf = i & 1;
            const float xin = cur[i];
            if (tid < 384) {
                const float y = cw0 * x0 + cw1 * x1 + cw2 * x2 + cw3 * xin; x0 = x1; x1 = x2; x2 = xin;
                const float s = siluf_(y); vals[buf * 384 + tid] = s;
                const float ss = wave_sum(s * s); if (lane == 0) part[buf * 8 + wave] = ss;
            } else if (tid == 384) { bg[buf * 2 + 0] = sigmoidf_(xin); }
            else if (tid == 385) { const float z = xin + dtb; const float sp = (z > 20.f) ? z : log1pf(__expf(z)); bg[buf * 2 + 1] = __expf(a_neg * sp); }
            __syncthreads();
            const float sq = rsqrtf(part[buf * 8 + 0] + part[buf * 8 + 1] + EPS) * 0.08838834764831845f;
            const float sk = rsqrtf(part[buf * 8 + 2] + part[buf * 8 + 3] + EPS);
            const float beta = bg[buf * 2 + 0], eg = bg[buf * 2 + 1];
            const LAS float* qv = vals + buf * 384 + 32 * r; const LAS float* kv = vals + buf * 384 + 128 + 32 * r;
            float pk = 0.f, pq = 0.f, pqk = 0.f;
#pragma unroll
            for (int dd = 0; dd < 32; ++dd) { const float kd = kv[dd], qd = qv[dd]; pk += kd * S[dd]; pq += qd * S[dd]; pqk += qd * kd; }
            red[(buf * 4 + r) * 128 + e] = pk * sk; red[((1 - buf) * 4 + r) * 128 + e] = pq * sq;
            if (e == 0) red2[r] = pqk;
            __syncthreads();
            float kS = 0.f, qS = 0.f;
#pragma unroll
            for (int rr = 0; rr < 4; ++rr) { kS += red[(buf * 4 + rr) * 128 + e]; qS += red[((1 - buf) * 4 + rr) * 128 + e]; }
            const float qk = (red2[0] + red2[1] + red2[2] + red2[3]) * sq * sk;
            const float ve = vals[buf * 384 + 256 + e];
            const float delta = beta * (ve - eg * kS);
            if (r == 0) ORAW[(size_t)(b * SEQ + t) * D + h * 128 + e] = (bf16)f2bf(eg * qS + qk * delta);
            const float kdl = sk * delta;
#pragma unroll
            for (int dd = 0; dd < 32; ++dd) S[dd] = eg * S[dd] + kv[dd] * kdl;
            __syncthreads();
        }
#pragma unroll
        for (int i = 0; i < 16; ++i) cur[i] = nxt[i];
    }
}
__device__ __forceinline__ void swa_naive(Frame& F_, int l, int nskip) {
    Frame F = mkframe(); const int w0 = (F.bid - nskip) * NWAVES + F.wave, nw = (F.G - nskip) * NWAVES;
    bf16* PROJ = (bf16*)(wsp() + WS_PROJ); const float* ROPE = (const float*)(wsp() + WS_ROPE);
    LAS float* qs = (LAS float*)(F.lds + F.wave * 8192);
    LAS float* ps = qs + 512;
    const int lane = F.lane;
    for (int task = w0; task < M * 2; task += nw) {
        const int m = task >> 1, kvh = task & 1, b = m / SEQ, t = m % SEQ;
        { const float c = ROPE[m * 16 + (lane & 7)], s = ROPE[m * 16 + 8 + (lane & 7)];
#pragma unroll
          for (int g = 0; g < 8; ++g) { const float x = bf1(PROJ[(size_t)m * DINP + C_SWQ + (kvh * 8 + g) * 64 + lane]); const float p = __shfl_xor(x, 8);
              const float y = (lane < 8) ? (x * c - p * s) : ((lane < 16) ? (x * c + p * s) : x); qs[g * 64 + lane] = y * 0.125f; } }
        asm volatile("s_waitcnt lgkmcnt(0)" ::: "memory");
#pragma unroll 1
        for (int kk = 0; kk < 2; ++kk) {
            const int tk = t - 127 + lane + 64 * kk; const bool valid = tk >= 0; const int mk = b * SEQ + (valid ? tk : 0);
            float kf[64];
            const v4u* kr = (const v4u*)(PROJ + (size_t)mk * DINP + C_SWK + kvh * 64);
#pragma unroll
            for (int i = 0; i < 8; ++i) { const v4u w = kr[i];
#pragma unroll
                for (int j = 0; j < 4; ++j) { kf[8 * i + 2 * j] = bflo(w[j]); kf[8 * i + 2 * j + 1] = bfhi(w[j]); } }
#pragma unroll
            for (int j = 0; j < 8; ++j) { const float c = ROPE[mk * 16 + j], s = ROPE[mk * 16 + 8 + j]; const float a = kf[j], bb = kf[j + 8]; kf[j] = a * c - bb * s; kf[j + 8] = bb * c + a * s; }
#pragma unroll
            for (int g = 0; g < 8; ++g) { float a = 0.f;
#pragma unroll
                for (int d4 = 0; d4 < 16; ++d4) { const f32x4 q = *(const LAS f32x4*)(qs + g * 64 + 4 * d4); a += q.x * kf[4 * d4] + q.y * kf[4 * d4 + 1] + q.z * kf[4 * d4 + 2] + q.w * kf[4 * d4 + 3]; }
                ps[(lane + 64 * kk) * 8 + g] = valid ? a : -1e30f; }
        }
        asm volatile("s_waitcnt lgkmcnt(0)" ::: "memory");
#pragma unroll
        for (int g = 0; g < 8; ++g) {
            const float sink = inp(8)[l * 16 + kvh * 8 + g];
            const float s0 = ps[lane * 8 + g], s1 = ps[(lane + 64) * 8 + g];
            const float mx = fmaxf(wave_max(fmaxf(s0, s1)), sink);
            const float p0 = (s0 > -1e29f) ? __expf(s0 - mx) : 0.f, p1 = (s1 > -1e29f) ? __expf(s1 - mx) : 0.f;
            const float den = wave_sum(p0 + p1) + __expf(sink - mx); const float inv = 1.f / den;
            ps[lane * 8 + g] = p0 * inv; ps[(lane + 64) * 8 + g] = p1 * inv;
        }
        asm volatile("s_waitcnt lgkmcnt(0)" ::: "memory");
        float o[8];
#pragma unroll
        for (int g = 0; g < 8; ++g) o[g] = 0.f;
        const int j0 = (t >= 127) ? 0 : (127 - t);
        for (int j = j0; j < 128; ++j) {
            const int mk = b * SEQ + t - 127 + j;
            const float v = bf1(PROJ[(size_t)mk * DINP + C_SWV + kvh * 64 + lane]);
            const f32x4 pa = *(const LAS f32x4*)(ps + j * 8), pb = *(const LAS f32x4*)(ps + j * 8 + 4);
            o[0] += pa.x * v; o[1] += pa.y * v; o[2] += pa.z * v; o[3] += pa.w * v; o[4] += pb.x * v; o[5] += pb.y * v; o[6] += pb.z * v; o[7] += pb.w * v;
        }
#pragma unroll
        for (int g = 0; g < 8; ++g) PROJ[(size_t)m * DINP + C_SWQ + (kvh * 8 + g) * 64 + lane] = (bf16)f2bf(o[g]);
        asm volatile("s_waitcnt lgkmcnt(0)" ::: "memory");
    }
}
__device__ __forceinline__ void phase_gnorm(Frame& F_, int l) {
    Frame F = mkframe();
    bf16* PROJ = (bf16*)(wsp() + WS_PROJ); const bf16* ORAW = (const bf16*)(wsp() + WS_XN);
    const int gw = F.bid * NWAVES + F.wave, NGW = F.G * NWAVES;
    const float g0 = inp(7)[l * 128 + 2 * F.lane], g1 = inp(7)[l * 128 + 2 * F.lane + 1];
    for (int m = gw; m < M; m += NGW) {
        unsigned ow[8], zw[8];
#pragma unroll
        for (int h = 0; h < 8; ++h) { ow[h] = *(const unsigned*)(ORAW + (size_t)m * D + h * 128 + 2 * F.lane); zw[h] = *(const unsigned*)(PROJ + (size_t)m * DINP + C_DNZ + h * 128 + 2 * F.lane); }
        float ss[8];
#pragma unroll
        for (int h = 0; h < 8; ++h) { const float o0 = bflo(ow[h]), o1 = bfhi(ow[h]); ss[h] = o0 * o0 + o1 * o1; }
#pragma unroll
        for (int o = 1; o < 64; o <<= 1) {
#pragma unroll
            for (int h = 0; h < 8; ++h) ss[h] += __shfl_xor(ss[h], o); }
#pragma unroll
        for (int h = 0; h < 8; ++h) { const float r = rsqrtf(ss[h] * (1.f / 128.f) + EPS);
            *(unsigned*)(PROJ + (size_t)m * DINP + C_DNQ + h * 128 + 2 * F.lane) = pk2(bflo(ow[h]) * r * g0 * siluf_(bflo(zw[h])), bfhi(ow[h]) * r * g1 * siluf_(bfhi(zw[h]))); }
    }
}

#ifndef PROBE_DUP
#define PROBE_DUP 0
#endif
#ifndef DN_NAIVE
#define DN_NAIVE 0
#endif
struct Args { const float* in[17]; float* out; unsigned char* ws; };
__global__ void __launch_bounds__(NTHR, 2) hybrid_fwd(Args args) {
    cg::grid_group grid = cg::this_grid();
    Frame F;
    F.lds = lds_base();
    F.tid = threadIdx.x; F.lane = F.tid & 63; F.wave = __builtin_amdgcn_readfirstlane(F.tid >> 6);
    F.G = gridDim.x; F.bid = blockIdx.x;
#define PROJ ((bf16*)(wsp() + WS_PROJ))
#define XN ((bf16*)(wsp() + WS_XN))
#define YF ((float*)(wsp() + WS_YF))
#define MIX ((bf16*)(wsp() + WS_MIX))
#define HB ((bf16*)(wsp() + WS_H))

    if (F.bid == 0) { for (int i = F.tid; i < XCD_BAR_WORDS; i += NTHR) ((unsigned*)(wsp() + WS_BAR))[i] = 0u; for (int i = F.tid; i < 16384; i += NTHR) ((unsigned*)(wsp() + WS_XCNT))[i] = 0u; if (F.tid < 256) ((unsigned*)(wsp() + WS_SUBCNT))[F.tid] = 0u; }
    if (F.tid < 4) ((LAS unsigned*)(lds_base() + LDS_BARST))[F.tid] = 0u;
    phase_rope(F);
    phase_norm(F, nullptr, nullptr, inp(0), outp(), inp(2), XN);
    phase_convert(F, -1, 0, 0);
    grid.sync();
    xcd_barrier_post();
    for (int l = 0; l < DEPTH; ++l) {
        {
            pg8::Gemm g{XN, (const bf16*)(wsp() + WS_WIN), nullptr, nullptr, M, DINP, D, D}; pg8::StaticOrder S; { Frame Fg = mkframe(); S.init(M, DINP, Fg.G, Fg.bid); }
            pg8::EpiBf16<0> E{PROJ, DINP};
            pg8::gemm_phase<pg8::EpiBf16<0>, pg8::StaticOrder, true, true>(F.lds, g, S, E);
#if PROBE_DUP == 5
            pg8::gemm_phase<pg8::EpiBf16<0>, pg8::StaticOrder, true, true>(F.lds, g, S, E);
#endif
        }
        grid_bar();
#if DN_NAIVE
        if (F.bid < 16) dn_naive(F, l);
        else swa_naive(F, l, 16);
#else
#if PROBE_DUP == 1
        dn_prep<0>(F, l);
#elif PROBE_DUP == 11
        dn_prep<1>(F, l);
#elif PROBE_DUP == 12
        dn_prep<2>(F, l);
#elif PROBE_DUP == 13
        dn_prep<3>(F, l);
#elif PROBE_DUP == 14
        dn_prep<4>(F, l);
#endif
        dn_prep<0>(F, l);
        grid_bar();
        { Frame Fg = mkframe(); if (Fg.bid < 64) { const int sid_ = (((Fg.bid & 7) * 2 + (Fg.bid >> 5)) << 2) | ((Fg.bid >> 3) & 3); dn_scan<0>(F, sid_);
#if PROBE_DUP == 2
            dn_scan<0>(F, sid_);
#elif PROBE_DUP == 3
            dn_scan<1>(F, sid_);
#elif PROBE_DUP == 4
            dn_scan<2>(F, sid_);
#endif
        }
        else {
            phase_convert(F, l, (l + 1 < DEPTH) ? l + 1 : -1, 64);
            __syncthreads();
            swa_mfma(F, l, 64);
            sub_bar((unsigned*)(wsp() + WS_SUBCNT) + 64 * l, (unsigned)(Fg.G - 64));
            pg8::Gemm g{PROJ + C_SWQ, (const bf16*)(wsp() + WS_WUPSW), nullptr, nullptr, M, D, D, DINP}; pg8::StaticOrder S; S.init(M, D, Fg.G - 64, Fg.bid - 64);
            pg8::EpiYb E{PROJ + C_DNK, DINP, PROJ + C_GB, DINP};
            pg8::gemm_phase<pg8::EpiYb, pg8::StaticOrder, true, true>(F.lds, g, S, E);
        } }
#endif
        grid_bar();
        phase_gnorm(F, l);
#if PROBE_DUP == 6
        phase_gnorm(F, l);
#endif
        grid_bar();
        {
            pg8::Gemm g{PROJ + C_DNQ, (const bf16*)(wsp() + WS_WUPDN), nullptr, nullptr, M, D, D, DINP}; pg8::StaticOrder S; { Frame Fg = mkframe(); S.init(M, D, Fg.G, Fg.bid); }
            pg8::EpiMerge2 E{MIX, D, PROJ + C_GA, PROJ + C_DNK, DINP};
            pg8::gemm_phase<pg8::EpiMerge2, pg8::StaticOrder, false, true>(F.lds, g, S, E);
        }
        grid_bar();
        {
            pg8::Gemm g{MIX, (const bf16*)(wsp() + WS_WO), nullptr, nullptr, M, D, D, D}; pg8::StaticOrder S; { Frame Fg = mkframe(); S.init(M, D, Fg.G, Fg.bid); }
            pg8::RmsExchange e1{(float*)(wsp() + WS_XSLOT), (unsigned*)(wsp() + WS_XCNT) + ((l * 4 + 0) * 64) * 16}, e2{(float*)(wsp() + WS_XSLOT + 262144), (unsigned*)(wsp() + WS_XCNT) + ((l * 4 + 1) * 64) * 16};
            pg8::EpiRmsRes E{outp(), inp(12) + l * D, inp(13) + l * D, XN, e1, e2};
            pg8::gemm_phase<pg8::EpiRmsRes, pg8::StaticOrder, false, true>(F.lds, g, S, E);
        }
        grid_bar();
        {
            pg8::Gemm g{XN, (const bf16*)(wsp() + WS_WFF1), nullptr, nullptr, M, FF, D, D}; pg8::StaticOrder S; { Frame Fg = mkframe(); S.init(M, FF, Fg.G, Fg.bid); }
            pg8::EpiBf16<2> E{HB, FF};
            pg8::gemm_phase<pg8::EpiBf16<2>, pg8::StaticOrder, true, true>(F.lds, g, S, E);
#if PROBE_DUP == 7
            pg8::gemm_phase<pg8::EpiBf16<2>, pg8::StaticOrder, true, true>(F.lds, g, S, E);
#endif
        }
        grid_bar();
        {
            pg8::Gemm g{HB, (const bf16*)(wsp() + WS_WFF2), nullptr, nullptr, M, D, FF, FF}; pg8::StaticOrder S; { Frame Fg = mkframe(); S.init(M, D, Fg.G, Fg.bid); }
            pg8::RmsExchange e1{(float*)(wsp() + WS_XSLOT), (unsigned*)(wsp() + WS_XCNT) + ((l * 4 + 2) * 64) * 16}, e2{(float*)(wsp() + WS_XSLOT + 262144), (unsigned*)(wsp() + WS_XCNT) + ((l * 4 + 3) * 64) * 16};
            pg8::EpiRmsRes E{outp(), inp(16) + l * D, (l + 1 < DEPTH) ? inp(2) + (l + 1) * D : nullptr, XN, e1, e2};
            pg8::gemm_phase<pg8::EpiRmsRes, pg8::StaticOrder, false, true>(F.lds, g, S, E);
        }
        if (l + 1 < DEPTH) grid_bar();
    }
#undef PROJ
#undef XN
#undef YF
#undef MIX
#undef HB
}

extern "C" void kernel_launch(void* const* d_in, const int* in_sizes, int n_in, void* d_out, int out_size, void* d_ws, size_t ws_size, hipStream_t stream) {
    static int init = 0;
    if (!init) {
        if (n_in != 17 || out_size != M * D || ws_size < WS_END) { fprintf(stderr, "kernel_launch: unexpected shapes (n_in %d out %d ws %zu)\n", n_in, out_size, ws_size); init = -1; return; }
        if (hipFuncSetAttribute((const void*)hybrid_fwd, hipFuncAttributeMaxDynamicSharedMemorySize, LDS_BYTES) != hipSuccess) { fprintf(stderr, "hipFuncSetAttribute failed\n"); init = -1; return; }
        init = 1;
    }
    if (init < 0) return;
    Args a{};
    for (int i = 0; i < 17; ++i) a.in[i] = (const float*)d_in[i];
    a.out = (float*)d_out; a.ws = (unsigned char*)d_ws;
    void* args[] = {&a};
    hipError_t e = hipLaunchCooperativeKernel((void*)hybrid_fwd, dim3(256), dim3(NTHR), args, LDS_BYTES, stream);
    if (e != hipSuccess) fprintf(stderr, "cooperative launch failed: %s\n", hipGetErrorString(e));
}
```

```cpp
#include <hip/hip_runtime.h>
#include <hip/hip_cooperative_groups.h>
#include <cstdio>
#include <cstdint>
namespace cg = cooperative_groups;

namespace pg8 {
#define PG8_LAS __attribute__((address_space(3)))
typedef unsigned short bf16_t;
typedef short bf16x8 __attribute__((ext_vector_type(8)));
typedef float f32x4 __attribute__((ext_vector_type(4)));
typedef unsigned u32x4 __attribute__((ext_vector_type(4)));
constexpr int BM = 256, BK = 64, HALF = 128, HTB = HALF * BK * 2, STAGE_BYTES = 8 * HTB, NXCD = 8, WGM = 8;

__host__ __device__ __forceinline__ int lds_byte(int r, int c) { const int st = (r >> 4) * 2 + (c >> 5), rr = r & 15, cc = c & 31, ob = rr * 64 + cc * 2; return st * 1024 + (ob ^ (((ob >> 9) & 1) << 5)); }
__host__ __device__ __forceinline__ void stage_rc(int b, int& R, int& C) { const int st = b / 1024, sb = b % 1024, swz = sb ^ (((sb >> 9) & 1) << 5); R = (st >> 1) * 16 + swz / 64; C = (st & 1) * 32 + (swz % 64) / 2; }
__host__ __device__ __forceinline__ int perm32(int rho) { const int n = rho >> 4, i = rho & 15; return 8 * (i >> 2) + 4 * n + (i & 3); }

struct Unit { int pm, pn, src; };
struct Gemm { const bf16_t* A; const bf16_t* Bt; const bf16_t* A2; const bf16_t* Bt2; int M, N, K, lda; };

struct StaticOrder {
    int nM, nN, nwg, G, c;
    __host__ __device__ void init(int M, int N, int G_, int c_) { nM = M / BM; nN = N / BM; nwg = nM * nN; G = G_; c = c_; }
    __host__ __device__ bool tile(long L, Unit& u) const {
        if (L >= nwg) return false;
        int wgid = (int)L; { const int q = nwg / NXCD, r = nwg % NXCD, xcd = wgid % NXCD, off = wgid / NXCD; wgid = (xcd < r ? xcd * (q + 1) : r * (q + 1) + (xcd - r) * q) + off; }
        const int nig = WGM * nN, gid = wgid / nig, fm = gid * WGM, gsz = (nM - fm) < WGM ? (nM - fm) : WGM;
        u.pm = fm + ((wgid % nig) % gsz); u.pn = (wgid % nig) / gsz; u.src = 0; return true;
    }
    __host__ __device__ bool next(int i, Unit& u) const { return tile((long)i * G + c, u); }
};
struct DualOrder {
    StaticOrder S;
    __host__ __device__ bool next(int i, Unit& u) const { const bool ok = S.tile((long)(i >> 1) * S.G + S.c, u); u.src = i & 1; return ok; }
};

typedef float f32x2c __attribute__((ext_vector_type(2)));
typedef __bf16 bf16x2c __attribute__((ext_vector_type(2)));
__device__ __forceinline__ unsigned cvt_pk_bf16(float lo, float hi) { const f32x2c v = {lo, hi}; return __builtin_bit_cast(unsigned, __builtin_convertvector(v, bf16x2c)); }
__device__ __forceinline__ float bf_lo(unsigned w) { return __uint_as_float(w << 16); }
__device__ __forceinline__ float bf_hi(unsigned w) { return __uint_as_float(w & 0xffff0000u); }

template <int ACT  > struct EpiBf16 {
    static constexpr bool PERM = true, DUAL = false, AFTER_DRAIN = false;
    bf16_t* O; int ldc;
    __device__ __forceinline__ void mid(f32x4 (&acc)[2][2][4][2], const Unit& u, int wr, int wc, int fr, int fq) const {}
    __device__ __forceinline__ void operator()(const f32x4 (&acc)[2][2][4][2], const Unit& u, int wr, int wc, int fr, int fq) const {
        const int row0 = u.pm * BM + wr * 64 + fr; const int col0 = u.pn * BM + wc * 32 + 8 * fq;
#pragma unroll
        for (int ai = 0; ai < 2; ++ai)
#pragma unroll
            for (int m = 0; m < 4; ++m) { bf16_t* rowp = O + (size_t)(row0 + ai * HALF + m * 16) * ldc + col0;
#pragma unroll
                for (int bj = 0; bj < 2; ++bj) { f32x4 v0 = acc[ai][bj][m][0], v1 = acc[ai][bj][m][1];
                    if (ACT == 2) {
#pragma unroll
                        for (int e = 0; e < 4; ++e) { const float a = fmaxf(v0[e], 0.f), b = fmaxf(v1[e], 0.f); v0[e] = a * a; v1[e] = b * b; } }
                    u32x4 w; w.x = cvt_pk_bf16(v0[0], v0[1]); w.y = cvt_pk_bf16(v0[2], v0[3]); w.z = cvt_pk_bf16(v1[0], v1[1]); w.w = cvt_pk_bf16(v1[2], v1[3]);
                    *(u32x4*)(rowp + bj * HALF) = w; } }
    }
};
struct EpiF32 {
    static constexpr bool PERM = false, DUAL = false, AFTER_DRAIN = false;
    float* O; int ldc;
    __device__ __forceinline__ void mid(f32x4 (&acc)[2][2][4][2], const Unit& u, int wr, int wc, int fr, int fq) const {}
    __device__ __forceinline__ void operator()(const f32x4 (&acc)[2][2][4][2], const Unit& u, int wr, int wc, int fr, int fq) const {
        float* rowp = O + (size_t)(u.pm * BM + wr * 64 + fr) * ldc + (u.pn * BM + wc * 32 + 4 * fq);
#pragma unroll
        for (int ai = 0; ai < 2; ++ai) {
#pragma unroll
            for (int m = 0; m < 4; ++m) {
#pragma unroll
                for (int bj = 0; bj < 2; ++bj)
#pragma unroll
                    for (int n = 0; n < 2; ++n) *(f32x4*)(rowp + bj * HALF + n * 16) = acc[ai][bj][m][n];
                rowp += (size_t)16 * ldc; asm volatile("" : "+v"(rowp) :: "memory"); }
            rowp += (size_t)64 * ldc; }
    }
};
struct EpiMerge {
    static constexpr bool PERM = true, DUAL = true, AFTER_DRAIN = false;
    bf16_t* O; int ldc; const bf16_t* GA; const bf16_t* GB; int ldg;
    __device__ __forceinline__ void mid(f32x4 (&acc)[2][2][4][2], const Unit& u, int wr, int wc, int fr, int fq) const {
        const int row0 = u.pm * BM + wr * 64 + fr; const int col0 = u.pn * BM + wc * 32 + 8 * fq;
#pragma unroll
        for (int ai = 0; ai < 2; ++ai)
#pragma unroll
            for (int m = 0; m < 4; ++m) { const size_t ro = (size_t)(row0 + ai * HALF + m * 16) * ldg + col0;
#pragma unroll
                for (int bj = 0; bj < 2; ++bj) { const u32x4 ga = *(const u32x4*)(GA + ro + bj * HALF), gb = *(const u32x4*)(GB + ro + bj * HALF);
#pragma unroll
                    for (int e = 0; e < 4; ++e) { const unsigned wa = ga[e], wb = gb[e];
                        const float r0 = (1.f + __expf(-bf_lo(wb))) / (1.f + __expf(-bf_lo(wa))), r1 = (1.f + __expf(-bf_hi(wb))) / (1.f + __expf(-bf_hi(wa)));
                        if (e < 2) { acc[ai][bj][m][0][2 * e] *= r0; acc[ai][bj][m][0][2 * e + 1] *= r1; } else { acc[ai][bj][m][1][2 * (e - 2)] *= r0; acc[ai][bj][m][1][2 * (e - 2) + 1] *= r1; } } } }
    }
    __device__ __forceinline__ void operator()(const f32x4 (&acc)[2][2][4][2], const Unit& u, int wr, int wc, int fr, int fq) const {
        const int row0 = u.pm * BM + wr * 64 + fr; const int col0 = u.pn * BM + wc * 32 + 8 * fq;
#pragma unroll
        for (int ai = 0; ai < 2; ++ai)
#pragma unroll
            for (int m = 0; m < 4; ++m) { const size_t ro = (size_t)(row0 + ai * HALF + m * 16) * ldg + col0; bf16_t* rowp = O + (size_t)(row0 + ai * HALF + m * 16) * ldc + col0;
#pragma unroll
                for (int bj = 0; bj < 2; ++bj) { const u32x4 gb = *(const u32x4*)(GB + ro + bj * HALF); f32x4 v0 = acc[ai][bj][m][0], v1 = acc[ai][bj][m][1];
                    float s[8];
#pragma unroll
                    for (int e = 0; e < 4; ++e) { s[2 * e] = 1.f / (1.f + __expf(-bf_lo(gb[e]))); s[2 * e + 1] = 1.f / (1.f + __expf(-bf_hi(gb[e]))); }
                    u32x4 w; w.x = cvt_pk_bf16(v0[0] * s[0], v0[1] * s[1]); w.y = cvt_pk_bf16(v0[2] * s[2], v0[3] * s[3]); w.z = cvt_pk_bf16(v1[0] * s[4], v1[1] * s[5]); w.w = cvt_pk_bf16(v1[2] * s[6], v1[3] * s[7]);
                    *(u32x4*)(rowp + bj * HALF) = w; } }
    }
};

struct EpiYb {
    static constexpr bool PERM = true, DUAL = false, AFTER_DRAIN = false;
    bf16_t* O; int ldc; const bf16_t* GB; int ldg;
    __device__ __forceinline__ void mid(f32x4 (&acc)[2][2][4][2], const Unit& u, int wr, int wc, int fr, int fq) const {}
    __device__ __forceinline__ void operator()(const f32x4 (&acc)[2][2][4][2], const Unit& u, int wr, int wc, int fr, int fq) const {
        const int row0 = u.pm * BM + wr * 64 + fr; const int col0 = u.pn * BM + wc * 32 + 8 * fq;
#pragma unroll
        for (int ai = 0; ai < 2; ++ai)
#pragma unroll
            for (int m = 0; m < 4; ++m) { const size_t ro = (size_t)(row0 + ai * HALF + m * 16) * ldg + col0; bf16_t* rowp = O + (size_t)(row0 + ai * HALF + m * 16) * ldc + col0;
#pragma unroll
                for (int bj = 0; bj < 2; ++bj) { const u32x4 gb = *(const u32x4*)(GB + ro + bj * HALF); const f32x4 v0 = acc[ai][bj][m][0], v1 = acc[ai][bj][m][1];
                    float s[8];
#pragma unroll
                    for (int e = 0; e < 4; ++e) { s[2 * e] = __builtin_amdgcn_rcpf(1.f + __expf(-bf_lo(gb[e]))); s[2 * e + 1] = __builtin_amdgcn_rcpf(1.f + __expf(-bf_hi(gb[e]))); }
                    u32x4 w; w.x = cvt_pk_bf16(v0[0] * s[0], v0[1] * s[1]); w.y = cvt_pk_bf16(v0[2] * s[2], v0[3] * s[3]); w.z = cvt_pk_bf16(v1[0] * s[4], v1[1] * s[5]); w.w = cvt_pk_bf16(v1[2] * s[6], v1[3] * s[7]);
                    *(u32x4*)(rowp + bj * HALF) = w; } }
    }
};
struct EpiMerge2 {
    static constexpr bool PERM = true, DUAL = false, AFTER_DRAIN = false;
    bf16_t* O; int ldc; const bf16_t* GA; const bf16_t* YB; int ldg;
    __device__ __forceinline__ void mid(f32x4 (&acc)[2][2][4][2], const Unit& u, int wr, int wc, int fr, int fq) const {}
    __device__ __forceinline__ void operator()(const f32x4 (&acc)[2][2][4][2], const Unit& u, int wr, int wc, int fr, int fq) const {
        const int row0 = u.pm * BM + wr * 64 + fr; const int col0 = u.pn * BM + wc * 32 + 8 * fq;
#pragma unroll
        for (int ai = 0; ai < 2; ++ai)
#pragma unroll
            for (int m = 0; m < 4; ++m) { const size_t ro = (size_t)(row0 + ai * HALF + m * 16) * ldg + col0; bf16_t* rowp = O + (size_t)(row0 + ai * HALF + m * 16) * ldc + col0;
#pragma unroll
                for (int bj = 0; bj < 2; ++bj) { const u32x4 ga = *(const u32x4*)(GA + ro + bj * HALF), yb = *(const u32x4*)(YB + ro + bj * HALF); const f32x4 v0 = acc[ai][bj][m][0], v1 = acc[ai][bj][m][1];
                    float o[8];
#pragma unroll
                    for (int e = 0; e < 4; ++e) { const float a0 = (e < 2) ? v0[2 * e] : v1[2 * (e - 2)], a1 = (e < 2) ? v0[2 * e + 1] : v1[2 * (e - 2) + 1];
                        o[2 * e] = a0 * __builtin_amdgcn_rcpf(1.f + __expf(-bf_lo(ga[e]))) + bf_lo(yb[e]); o[2 * e + 1] = a1 * __builtin_amdgcn_rcpf(1.f + __expf(-bf_hi(ga[e]))) + bf_hi(yb[e]); }
                    u32x4 w; w.x = cvt_pk_bf16(o[0], o[1]); w.y = cvt_pk_bf16(o[2], o[3]); w.z = cvt_pk_bf16(o[4], o[5]); w.w = cvt_pk_bf16(o[6], o[7]);
                    *(u32x4*)(rowp + bj * HALF) = w; } }
    }
};
struct RmsExchange {
    float* slots;
    unsigned* cnt;
    __device__ __forceinline__ void run(const f32x4 (&v)[2][2][4][2], const Unit& u, int wr, int wc, int fr, int fq, PG8_LAS unsigned char* lds, int wid, int lane) const {
        PG8_LAS float* P = (PG8_LAS float*)lds;
        PG8_LAS float* S = (PG8_LAS float*)(lds + 4096);
#pragma unroll
        for (int ai = 0; ai < 2; ++ai)
#pragma unroll
            for (int m = 0; m < 4; ++m) { float s = 0.f;
#pragma unroll
                for (int bj = 0; bj < 2; ++bj)
#pragma unroll
                    for (int n = 0; n < 2; ++n) { const f32x4 x = v[ai][bj][m][n]; s += (x[0] * x[0] + x[1] * x[1]) + (x[2] * x[2] + x[3] * x[3]); }
                s += __shfl_xor(s, 16); s += __shfl_xor(s, 32);
                if (fq == 0) P[(ai * HALF + wr * 64 + m * 16 + fr) * 4 + wc] = s; }
        asm volatile("s_waitcnt lgkmcnt(0)" ::: "memory"); __builtin_amdgcn_s_barrier(); asm volatile("" ::: "memory");
        const int row = wid * 64 + lane;
        if (wid < 4) {
            const f32x4 p = *(const PG8_LAS f32x4*)(P + row * 4);
            __hip_atomic_store(slots + ((size_t)(u.pm * BM + row) * 4 + u.pn), (p[0] + p[1]) + (p[2] + p[3]), __ATOMIC_RELAXED, __HIP_MEMORY_SCOPE_AGENT);
            asm volatile("s_waitcnt vmcnt(0)" ::: "memory");
            if (lane == 0) __hip_atomic_fetch_add(cnt + 16 * u.pm, 1u, __ATOMIC_RELAXED, __HIP_MEMORY_SCOPE_AGENT);
        }
        if (wid == 0) {
            unsigned sp = 0;
            while ((unsigned)__builtin_amdgcn_readfirstlane(__hip_atomic_load(cnt + 16 * u.pm, __ATOMIC_RELAXED, __HIP_MEMORY_SCOPE_AGENT)) < 16u) { __builtin_amdgcn_s_sleep(1); if (++sp > (1u << 22)) break; }
            __builtin_amdgcn_fence(__ATOMIC_ACQUIRE, "agent");
        }
        asm volatile("s_waitcnt vmcnt(0) lgkmcnt(0)" ::: "memory"); __builtin_amdgcn_s_barrier(); asm volatile("" ::: "memory");
        if (wid < 4) {
            const float* sl = slots + (size_t)(u.pm * BM + row) * 4; float t = 0.f;
#pragma unroll
            for (int k = 0; k < 4; ++k) t += __hip_atomic_load(sl + k, __ATOMIC_RELAXED, __HIP_MEMORY_SCOPE_AGENT);
            S[row] = rsqrtf(t * (1.0f / 1024.0f) + 1e-6f);
        }
        asm volatile("s_waitcnt vmcnt(0) lgkmcnt(0)" ::: "memory"); __builtin_amdgcn_s_barrier(); asm volatile("" ::: "memory");
    }
};
struct EpiRmsRes {
    static constexpr bool PERM = false, DUAL = false, AFTER_DRAIN = true;
    float* x; const float* gpost; const float* gnext; bf16_t* xn; RmsExchange e1, e2;
    __device__ __forceinline__ void mid(f32x4 (&acc)[2][2][4][2], const Unit& u, int wr, int wc, int fr, int fq) const {}
    __device__ __forceinline__ void operator()(const f32x4 (&acc)[2][2][4][2], const Unit& u, int wr, int wc, int fr, int fq) const {}
    __device__ __forceinline__ void fused(f32x4 (&acc)[2][2][4][2], const Unit& u, int wr, int wc, int fr, int fq, PG8_LAS unsigned char* lds, int wid, int lane) const {
        typedef unsigned u32x2v __attribute__((ext_vector_type(2)));
        const PG8_LAS float* S = (const PG8_LAS float*)(lds + 4096);
        const int col0 = u.pn * BM + wc * 32 + 4 * fq;
        e1.run(acc, u, wr, wc, fr, fq, lds, wid, lane);
        f32x4 g[2][2];
#pragma unroll
        for (int bj = 0; bj < 2; ++bj)
#pragma unroll
            for (int n = 0; n < 2; ++n) g[bj][n] = *(const f32x4*)(gpost + col0 + bj * HALF + n * 16);
#pragma unroll
        for (int ai = 0; ai < 2; ++ai)
#pragma unroll
            for (int m = 0; m < 4; ++m) { const int r = ai * HALF + wr * 64 + m * 16 + fr; const float sr = S[r]; float* xp = x + (size_t)(u.pm * BM + r) * 1024 + col0;
#pragma unroll
                for (int bj = 0; bj < 2; ++bj)
#pragma unroll
                    for (int n = 0; n < 2; ++n) { const f32x4 xv = *(const f32x4*)(xp + bj * HALF + n * 16); const f32x4 o = xv + acc[ai][bj][m][n] * sr * g[bj][n]; acc[ai][bj][m][n] = o; *(f32x4*)(xp + bj * HALF + n * 16) = o; }
                asm volatile("" : "+v"(acc[ai][0][m][0]), "+v"(acc[ai][0][m][1]), "+v"(acc[ai][1][m][0]), "+v"(acc[ai][1][m][1]));
                if (m & 1) asm volatile("" ::: "memory"); }
        if (gnext) {
            e2.run(acc, u, wr, wc, fr, fq, lds, wid, lane);
#pragma unroll
            for (int bj = 0; bj < 2; ++bj)
#pragma unroll
                for (int n = 0; n < 2; ++n) g[bj][n] = *(const f32x4*)(gnext + col0 + bj * HALF + n * 16);
#pragma unroll
            for (int ai = 0; ai < 2; ++ai)
#pragma unroll
                for (int m = 0; m < 4; ++m) { const int r = ai * HALF + wr * 64 + m * 16 + fr; const float sr = S[r]; bf16_t* op = xn + (size_t)(u.pm * BM + r) * 1024 + col0;
#pragma unroll
                    for (int bj = 0; bj < 2; ++bj)
#pragma unroll
                        for (int n = 0; n < 2; ++n) { const f32x4 o = acc[ai][bj][m][n] * sr * g[bj][n]; u32x2v w; w.x = cvt_pk_bf16(o[0], o[1]); w.y = cvt_pk_bf16(o[2], o[3]); *(u32x2v*)(op + bj * HALF + n * 16) = w; } }
        }
    }
};
template <class Epi, class Sched, bool ALIGN_EPI = false, bool SP2 = false>
__device__ __forceinline__ void gemm_phase(PG8_LAS unsigned char* lds, const Gemm g, const Sched& S, const Epi& E) {
    int tid_ = threadIdx.x; asm volatile("" : "+v"(tid_)); const int tid = tid_, wid = __builtin_amdgcn_readfirstlane(tid >> 6), lane = tid & 63, wr = wid >> 2, wc = wid & 3, fr = lane & 15, fq = lane >> 4;
    const int K = g.K, nt = K / BK, lda = g.lda;
    unsigned voffA[2], voffB[2];
#pragma unroll
    for (int i = 0; i < 2; ++i) { int R, C; stage_rc(tid * 16 + i * 8192, R, C); const int Rb = Epi::PERM ? ((R & ~31) + perm32(R & 31)) : R;
        voffA[i] = (unsigned)(R * lda + C) * 2u; voffB[i] = (unsigned)(Rb * K + C) * 2u; }
    const size_t kstep = (size_t)(BK * 2);
    const size_t hstepA = (size_t)HALF * lda * 2, hstepB = (size_t)HALF * K * 2;
    const size_t tstepA = 2 * hstepA, tstepB = 2 * hstepB;
    const unsigned ldsw = (unsigned)wid * 1024u;
    const int aoff = lds_byte(wr * 64 + fr, fq * 8), boff = lds_byte(wc * 32 + fr, fq * 8);
#define PG8_SA(b, h) (((b) * 2 + (h)) * HTB)
#define PG8_SB(b, h) ((4 + (b) * 2 + (h)) * HTB)
#define PG8_STAGE(bufoff, gbase, voff) do { _Pragma("unroll") for (int _i = 0; _i < 2; ++_i) \
        __builtin_amdgcn_global_load_lds((const unsigned*)((const char*)(gbase) + (voff)[_i]), (PG8_LAS unsigned*)(lds + (bufoff) + ldsw + _i * 8192), 16, 0, 0); } while (0)
#define PG8_LDA(dst, b, h) do { _Pragma("unroll") for (int m = 0; m < 4; ++m) _Pragma("unroll") for (int k = 0; k < 2; ++k) dst[m][k] = *(const PG8_LAS bf16x8*)(lds + PG8_SA(b, h) + aoff + m * 2048 + k * 1024); } while (0)
#define PG8_LDB(dst, b, h) do { _Pragma("unroll") for (int n = 0; n < 2; ++n) _Pragma("unroll") for (int k = 0; k < 2; ++k) dst[n][k] = *(const PG8_LAS bf16x8*)(lds + PG8_SB(b, h) + boff + n * 2048 + k * 1024); } while (0)
#define PG8_MMA(ai, bj, At, Bt) do { __builtin_amdgcn_s_setprio(1); _Pragma("unroll") for (int m = 0; m < 4; ++m) _Pragma("unroll") for (int n = 0; n < 2; ++n) _Pragma("unroll") for (int k = 0; k < 2; ++k) \
        acc[ai][bj][m][n] = __builtin_amdgcn_mfma_f32_16x16x32_bf16(Bt[n][k], At[m][k], acc[ai][bj][m][n], 0, 0, 0); __builtin_amdgcn_s_setprio(0); } while (0)
#define PG8_WAIT_V(n) asm volatile("s_waitcnt vmcnt(" #n ")" ::: "memory")
#define PG8_WAIT_L(n) asm volatile("s_waitcnt lgkmcnt(" #n ")" ::: "memory")
#define PG8_BAR __builtin_amdgcn_s_barrier()
#define PG8_SCHED __builtin_amdgcn_sched_barrier(0)
    Unit cur, nxt; int ui = 0;
    if (!S.next(0, cur)) return;
    f32x4 acc[2][2][4][2];
#pragma unroll
    for (int a = 0; a < 2; ++a)
#pragma unroll
        for (int b = 0; b < 2; ++b)
#pragma unroll
            for (int m = 0; m < 4; ++m)
#pragma unroll
                for (int n = 0; n < 2; ++n) acc[a][b][m][n] = (f32x4){0.f, 0.f, 0.f, 0.f};
    bf16x8 At[4][2], B0[2][2], B1[2][2];
    const char* cA = (const char*)(cur.src ? g.A2 : g.A) + (size_t)cur.pm * tstepA; const char* cB = (const char*)(cur.src ? g.Bt2 : g.Bt) + (size_t)cur.pn * tstepB;
    if constexpr (SP2) {
        PG8_STAGE(PG8_SB(0, 0), cB, voffB); PG8_STAGE(PG8_SB(0, 1), cB + hstepB, voffB); PG8_STAGE(PG8_SA(0, 0), cA, voffA); PG8_STAGE(PG8_SA(0, 1), cA + hstepA, voffA);
        if (wr == 1) PG8_BAR;
        PG8_WAIT_V(2); PG8_BAR;
        PG8_STAGE(PG8_SB(1, 0), cB + kstep, voffB); PG8_STAGE(PG8_SA(1, 0), cA + kstep, voffA); PG8_STAGE(PG8_SB(1, 1), cB + hstepB + kstep, voffB);
        PG8_WAIT_V(6); PG8_BAR;
    } else {
        PG8_STAGE(PG8_SB(0, 0), cB, voffB); PG8_STAGE(PG8_SA(0, 0), cA, voffA); PG8_STAGE(PG8_SB(0, 1), cB + hstepB, voffB); PG8_STAGE(PG8_SA(0, 1), cA + hstepA, voffA);
        if (wr == 1) PG8_BAR;
        PG8_WAIT_V(4); PG8_BAR;
        PG8_STAGE(PG8_SB(1, 0), cB + kstep, voffB); PG8_STAGE(PG8_SA(1, 0), cA + kstep, voffA); PG8_STAGE(PG8_SB(1, 1), cB + hstepB + kstep, voffB);
        PG8_WAIT_V(6); PG8_BAR;
    }
    for (;;) {
        const bool has_next = S.next(ui + 1, nxt);
        const char* nA = has_next ? (const char*)(nxt.src ? g.A2 : g.A) + (size_t)nxt.pm * tstepA : cA; const char* nB = has_next ? (const char*)(nxt.src ? g.Bt2 : g.Bt) + (size_t)nxt.pn * tstepB : cB;
        for (int t = 0; t < nt; t += 2) {
            const bool last = (t == nt - 2);
            const char* a1 = cA + (size_t)(t + 1) * kstep;
            const char* a2 = last ? nA : cA + (size_t)(t + 2) * kstep; const char* b2 = last ? nB : cB + (size_t)(t + 2) * kstep;
            const char* a3 = a2 + kstep; const char* b3 = b2 + kstep;
            if constexpr (SP2) {
            PG8_LDB(B0, 0, 0); PG8_LDB(B1, 0, 1); PG8_SCHED; PG8_LDA(At, 0, 0); PG8_STAGE(PG8_SA(1, 1), a1 + hstepA, voffA);
            PG8_WAIT_V(8); PG8_WAIT_L(0); PG8_BAR; PG8_MMA(0, 0, At, B0); PG8_MMA(0, 1, At, B1); PG8_BAR; PG8_SCHED;
            PG8_LDA(At, 0, 1); PG8_STAGE(PG8_SB(0, 0), b2, voffB); PG8_STAGE(PG8_SB(0, 1), b2 + hstepB, voffB); PG8_STAGE(PG8_SA(0, 0), a2, voffA);
            PG8_WAIT_V(8); PG8_WAIT_L(0); PG8_BAR; PG8_MMA(1, 0, At, B0); PG8_MMA(1, 1, At, B1); PG8_BAR; PG8_SCHED;
            PG8_LDB(B0, 1, 0); PG8_LDB(B1, 1, 1); PG8_SCHED; PG8_LDA(At, 1, 0); PG8_STAGE(PG8_SA(0, 1), a2 + hstepA, voffA);
            PG8_WAIT_V(8); PG8_WAIT_L(0); PG8_BAR; PG8_MMA(0, 0, At, B0); PG8_MMA(0, 1, At, B1); PG8_BAR; PG8_SCHED;
            PG8_LDA(At, 1, 1); PG8_STAGE(PG8_SB(1, 0), b3, voffB); PG8_STAGE(PG8_SB(1, 1), b3 + hstepB, voffB); PG8_STAGE(PG8_SA(1, 0), a3, voffA);
            PG8_WAIT_V(8); PG8_WAIT_L(0); PG8_BAR; PG8_MMA(1, 0, At, B0); PG8_MMA(1, 1, At, B1); PG8_BAR; PG8_SCHED;
            } else {
            PG8_LDB(B0, 0, 0); PG8_SCHED; PG8_LDA(At, 0, 0); PG8_STAGE(PG8_SA(1, 1), a1 + hstepA, voffA);
            PG8_WAIT_L(8); PG8_BAR; PG8_WAIT_L(0); PG8_MMA(0, 0, At, B0); PG8_BAR; PG8_SCHED;
            PG8_LDB(B1, 0, 1); PG8_STAGE(PG8_SB(0, 0), b2, voffB);
            PG8_BAR; PG8_WAIT_L(0); PG8_MMA(0, 1, At, B1); PG8_BAR;
            PG8_LDA(At, 0, 1); PG8_STAGE(PG8_SA(0, 0), a2, voffA);
            PG8_BAR; PG8_WAIT_L(0); PG8_MMA(1, 0, At, B0); PG8_BAR; PG8_SCHED;
            PG8_STAGE(PG8_SB(0, 1), b2 + hstepB, voffB);
            PG8_WAIT_V(6); PG8_BAR; PG8_MMA(1, 1, At, B1); PG8_BAR;
            PG8_LDB(B0, 1, 0); PG8_SCHED; PG8_LDA(At, 1, 0); PG8_STAGE(PG8_SA(0, 1), a2 + hstepA, voffA);
            PG8_WAIT_L(8); PG8_BAR; PG8_WAIT_L(0); PG8_MMA(0, 0, At, B0); PG8_BAR; PG8_SCHED;
            PG8_LDB(B1, 1, 1); PG8_STAGE(PG8_SB(1, 0), b3, voffB);
            PG8_BAR; PG8_WAIT_L(0); PG8_MMA(0, 1, At, B1); PG8_BAR;
            PG8_LDA(At, 1, 1); PG8_STAGE(PG8_SA(1, 0), a3, voffA);
            PG8_BAR; PG8_WAIT_L(0); PG8_MMA(1, 0, At, B0); PG8_BAR; PG8_SCHED;
            PG8_STAGE(PG8_SB(1, 1), b3 + hstepB, voffB);
            PG8_WAIT_V(6); PG8_BAR; PG8_MMA(1, 1, At, B1); PG8_BAR;
            }
        }
        if constexpr (ALIGN_EPI) { if (wr == 0) PG8_BAR; }
        const bool midu = Epi::DUAL && cur.src == 0;
        if constexpr (!Epi::AFTER_DRAIN) { if (midu) E.mid(acc, cur, wr, wc, fr, fq); else E(acc, cur, wr, wc, fr, fq); }
        if (!has_next) break;
        if (!midu) {
#pragma unroll
        for (int a = 0; a < 2; ++a)
#pragma unroll
            for (int b = 0; b < 2; ++b)
#pragma unroll
                for (int m = 0; m < 4; ++m)
#pragma unroll
                    for (int n = 0; n < 2; ++n) acc[a][b][m][n] = (f32x4){0.f, 0.f, 0.f, 0.f};
        }
        cur = nxt; cA = nA; cB = nB; ++ui;
        if constexpr (ALIGN_EPI) { if (wr == 1) PG8_BAR; }
    }
    PG8_WAIT_V(0);
    if constexpr (!ALIGN_EPI) { if (wr == 0) PG8_BAR; }
    PG8_BAR;
    if constexpr (Epi::AFTER_DRAIN) E.fused(acc, cur, wr, wc, fr, fq, lds, wid, lane);
#undef PG8_SA
#undef PG8_SB
#undef PG8_STAGE
#undef PG8_LDA
#undef PG8_LDB
#undef PG8_MMA
#undef PG8_WAIT_V
#undef PG8_WAIT_L
#undef PG8_BAR
#undef PG8_SCHED
}
}

#define GAS __attribute__((address_space(1)))
#define LAS __attribute__((address_space(3)))
typedef unsigned short bf16;
typedef unsigned v4u __attribute__((ext_vector_type(4)));
typedef unsigned v2u __attribute__((ext_vector_type(2)));
typedef float f32x4 __attribute__((ext_vector_type(4)));
typedef short bf16x8 __attribute__((ext_vector_type(8)));
constexpr int NWAVES = 8, NTHR = 512;
constexpr int BATCH = 2, SEQ = 8192, D = 1024, FF = 4096, DEPTH = 4, M = BATCH * SEQ;
constexpr int DIN = 7440, DINP = 7680;
constexpr int C_DNQ = 0, C_DNK = 1024, C_DNV = 2048, C_DNZ = 3072, C_SWQ = 4096, C_GA = 5120, C_GB = 6144, C_SWK = 7168, C_SWV = 7296, C_DNB = 7424, C_DNA = 7432;
constexpr float EPS = 1e-6f;
constexpr size_t MiB = 1u << 20;
constexpr size_t WS_WIN = 1 * MiB, WS_WUPDN = 16 * MiB, WS_WUPSW = 18 * MiB, WS_WO = 20 * MiB, WS_WFF1 = 22 * MiB, WS_WFF2 = 30 * MiB, WS_ROPE = 38 * MiB;
constexpr size_t WS_PROJ = 40 * MiB, WS_H = 40 * MiB, WS_XN = 280 * MiB, WS_YF = 312 * MiB, WS_MIX = 376 * MiB, WS_END = 456 * MiB;
constexpr int LDS_BYTES = 147456;

typedef float f32x2_t __attribute__((ext_vector_type(2)));
typedef __bf16 bf16x2_t __attribute__((ext_vector_type(2)));
__device__ __forceinline__ unsigned pk2(float lo, float hi) { const f32x2_t v = {lo, hi}; return __builtin_bit_cast(unsigned, __builtin_convertvector(v, bf16x2_t)); }
__device__ __forceinline__ unsigned f2bf(float f) { return pk2(f, 0.f) & 0xffffu; }
__device__ __forceinline__ float bflo(unsigned w) { return __uint_as_float(w << 16); }
__device__ __forceinline__ float bfhi(unsigned w) { return __uint_as_float(w & 0xffff0000u); }
__device__ __forceinline__ float bf1(bf16 h) { return __uint_as_float((unsigned)h << 16); }
__device__ __forceinline__ float wave_sum(float v) {
#pragma unroll
    for (int o = 1; o < 64; o <<= 1) v += __shfl_xor(v, o);
    return v;
}
__device__ __forceinline__ float wave_max(float v) {
#pragma unroll
    for (int o = 1; o < 64; o <<= 1) v = fmaxf(v, __shfl_xor(v, o));
    return v;
}
__device__ __forceinline__ float sigmoidf_(float x) { return __builtin_amdgcn_rcpf(1.f + __expf(-x)); }
__device__ __forceinline__ float siluf_(float x) { return x * __builtin_amdgcn_rcpf(1.f + __expf(-x)); }

struct Frame {
    LAS unsigned char* lds;
    int tid, lane, wave, G, bid;
};
__device__ __forceinline__ LAS unsigned char* lds_base() { extern __shared__ __attribute__((aligned(16))) unsigned char lds_dyn[]; return (LAS unsigned char*)lds_dyn; }
__device__ __forceinline__ Frame mkframe() {
    Frame F; F.lds = lds_base(); int tid = threadIdx.x; asm volatile("" : "+v"(tid)); int bid = blockIdx.x; asm volatile("" : "+s"(bid)); int G = gridDim.x; asm volatile("" : "+s"(G));
    F.tid = tid; F.lane = tid & 63; F.wave = __builtin_amdgcn_readfirstlane(tid >> 6); F.G = G; F.bid = bid; return F; }
typedef __attribute__((address_space(4))) const unsigned char* kargp_t;
__device__ __forceinline__ kargp_t kargs() { kargp_t p = (kargp_t)__builtin_amdgcn_kernarg_segment_ptr(); asm volatile("" : "+s"(p)); return p; }
__device__ __forceinline__ const float* inp(int k) { return *(const float* __attribute__((address_space(4))) const*)(kargs() + 8 * k); }
__device__ __forceinline__ float* outp() { return *(float* __attribute__((address_space(4))) const*)(kargs() + 8 * 17); }
__device__ __forceinline__ unsigned char* wsp() { return *(unsigned char* __attribute__((address_space(4))) const*)(kargs() + 8 * 18); }

__device__ __forceinline__ int orig_col(int nc) {
    if (nc < 4096) return nc;
    if (nc < 5120) return nc - 4096 + 4112;
    if (nc < 6144) return nc - 5120 + 5392;
    if (nc < 7168) return nc - 6144 + 6416;
    if (nc < 7296) return nc - 7168 + 5136;
    if (nc < 7424) return nc - 7296 + 5264;
    if (nc < 7440) return nc - 7424 + 4096;
    return -1;
}
template <bool PERMW>
__device__ __forceinline__ void transpose_item(const float* W, int K, int ldw, int nblk, bf16* WT, LAS float* scr, int item, int lane) {
    const int kb = item / nblk, nb = item % nblk, k0 = 64 * kb, n0 = 32 * nb;
    const int ncol = n0 + (lane & 31); const int oc = PERMW ? orig_col(ncol) : ncol;
#pragma unroll 8
    for (int i = 0; i < 32; ++i) { const int kk = 2 * i + (lane >> 5); scr[kk * 33 + (lane & 31)] = (oc >= 0) ? W[(size_t)(k0 + kk) * ldw + oc] : 0.f; }
    asm volatile("s_waitcnt lgkmcnt(0)" ::: "memory");
    const int c = lane & 7;
#pragma unroll
    for (int j = 0; j < 4; ++j) { const int n = (lane >> 3) + 8 * j; const LAS float* s = scr + (8 * c) * 33 + n;
        v4u o; o.x = pk2(s[0 * 33], s[1 * 33]); o.y = pk2(s[2 * 33], s[3 * 33]); o.z = pk2(s[4 * 33], s[5 * 33]); o.w = pk2(s[6 * 33], s[7 * 33]);
        *(v4u*)(WT + (size_t)(n0 + n) * K + k0 + 8 * c) = o; }
    asm volatile("s_waitcnt lgkmcnt(0)" ::: "memory");
}
__device__ __forceinline__ void phase_convert(Frame& F_, int lrest, int lin, int nskip) {
    Frame F = mkframe();
    LAS float* scr = (LAS float*)(F.lds + F.wave * 16384);
    const int gw = (F.bid - nskip) * NWAVES + F.wave, NGW = (F.G - nskip) * NWAVES;
    constexpr int I_IN = 16 * (DINP / 32), I_SQ = 16 * 32, I_F1 = 16 * (FF / 32), I_F2 = 64 * 32;
    const int n_in = (lin >= 0) ? I_IN : 0, n_rest = (lrest >= 0) ? 3 * I_SQ + I_F1 + I_F2 : 0;
    for (int it = gw; it < n_in + n_rest; it += NGW) {
        int r = it;
        if (r < n_in) { transpose_item<true>(inp(3) + (size_t)lin * D * DIN, D, DIN, DINP / 32, (bf16*)(wsp() + WS_WIN), scr, r, F.lane); continue; } r -= n_in;
        const int l = lrest;
        if (r < I_SQ) { transpose_item<false>(inp(9) + (size_t)l * D * D, D, D, 32, (bf16*)(wsp() + WS_WUPDN), scr, r, F.lane); continue; } r -= I_SQ;
        if (r < I_SQ) { transpose_item<false>(inp(10) + (size_t)l * D * D, D, D, 32, (bf16*)(wsp() + WS_WUPSW), scr, r, F.lane); continue; } r -= I_SQ;
        if (r < I_SQ) { transpose_item<false>(inp(11) + (size_t)l * D * D, D, D, 32, (bf16*)(wsp() + WS_WO), scr, r, F.lane); continue; } r -= I_SQ;
        if (r < I_F1) { transpose_item<false>(inp(14) + (size_t)l * D * FF, D, FF, FF / 32, (bf16*)(wsp() + WS_WFF1), scr, r, F.lane); continue; } r -= I_F1;
        transpose_item<false>(inp(15) + (size_t)l * FF * D, FF, D, 32, (bf16*)(wsp() + WS_WFF2), scr, r, F.lane);
    }
}
__device__ __forceinline__ void phase_rope(Frame& F_) {
    Frame F = mkframe();
    const int* pos = (const int*)inp(1); float* R = (float*)(wsp() + WS_ROPE);
    for (int i = F.bid * NTHR + F.tid; i < M * 8; i += F.G * NTHR) {
        const int m = i >> 3, j = i & 7;
        const float invf = exp2f(-(float)j * (0.125f * 18.931568569324174f));
        const float angf = (float)pos[m] * invf;
        const double a = (double)angf; const double n = rint(a * 0.15915494309189535);
        const float r = (float)(a - n * 6.283185307179586);
        R[m * 16 + j] = __cosf(r); R[m * 16 + 8 + j] = __sinf(r);
    }
}
__device__ __forceinline__ void phase_norm(Frame& F_, const float* y, const float* gpost, const float* xin, float* x, const float* gnext, bf16* XN) {
    Frame F = mkframe();
    const int gw = F.bid * NWAVES + F.wave, NGW = F.G * NWAVES;
    for (int m = gw; m < M; m += NGW) {
        f32x4 v[4];
        const f32x4* xr = (const f32x4*)(xin + (size_t)m * D) + F.lane;
#pragma unroll
        for (int j = 0; j < 4; ++j) v[j] = xr[64 * j];
        if (y) {
            const f32x4* yr = (const f32x4*)(y + (size_t)m * D) + F.lane; f32x4 w[4]; float s = 0.f;
#pragma unroll
            for (int j = 0; j < 4; ++j) { w[j] = yr[64 * j]; s += (w[j].x * w[j].x + w[j].y * w[j].y) + (w[j].z * w[j].z + w[j].w * w[j].w); }
            const float r = rsqrtf(wave_sum(s) * (1.f / D) + EPS);
#pragma unroll
            for (int j = 0; j < 4; ++j) { const f32x4 g = ((const f32x4*)gpost)[F.lane + 64 * j]; v[j] = v[j] + w[j] * r * g; }
        }
        f32x4* xo = (f32x4*)(x + (size_t)m * D) + F.lane;
#pragma unroll
        for (int j = 0; j < 4; ++j) xo[64 * j] = v[j];
        if (gnext) {
            float s = 0.f;
#pragma unroll
            for (int j = 0; j < 4; ++j) s += (v[j].x * v[j].x + v[j].y * v[j].y) + (v[j].z * v[j].z + v[j].w * v[j].w);
            const float r = rsqrtf(wave_sum(s) * (1.f / D) + EPS);
            v2u* o = (v2u*)(XN + (size_t)m * D) + F.lane;
#pragma unroll
            for (int j = 0; j < 4; ++j) { const f32x4 g = ((const f32x4*)gnext)[F.lane + 64 * j]; v2u w; w.x = pk2(v[j].x * r * g.x, v[j].y * r * g.y); w.y = pk2(v[j].z * r * g.z, v[j].w * r * g.w); o[64 * j] = w; }
        }
    }
}
constexpr size_t WS_SUBCNT = 196608, WS_BAR = 65536, WS_XCNT = 131072, WS_XSLOT = 39 * MiB;
#define XB_TMO      128
#define XB_XCNT(j)  (256  + 64 * (j))
#define XB_XSUB(j)  (1280 + 64 * (j))
#define XB_XGEN(j)  (2304 + 64 * (j))
#define XB_TOP      3328
#define XB_TOPGEN   3392
#define XCD_BAR_WORDS 3456
#define XB_SPIN_CAP (1u << 22)
constexpr int LDS_BARST = LDS_BYTES - 16;
__device__ __forceinline__ unsigned xb_ld(unsigned* p)              { return __hip_atomic_load(p, __ATOMIC_RELAXED, __HIP_MEMORY_SCOPE_AGENT); }
__device__ __forceinline__ unsigned xb_add(unsigned* p, unsigned v) { return __hip_atomic_fetch_add(p, v, __ATOMIC_RELAXED, __HIP_MEMORY_SCOPE_AGENT); }
__device__ __forceinline__ unsigned xb_xcc_id() { return (unsigned)__builtin_amdgcn_s_getreg((3 << 11) | 20) & 0xFu; }
#define XB_SPIN(cond, bar) do { unsigned _sp = 0; while (cond) { __builtin_amdgcn_s_sleep(1); \
    if ((++_sp & 255u) == 0u) { if (xb_ld(&(bar)[XB_TMO])) break; if (_sp > XB_SPIN_CAP) { atomicAdd(&(bar)[XB_TMO], 1u); break; } } } } while (0)
__device__ __forceinline__ void xcd_barrier_post() {
    if (threadIdx.x == 0) { unsigned* bar = (unsigned*)(wsp() + WS_BAR); (void)xb_add(&bar[XB_XCNT(xb_xcc_id())], 1u); }
}
__device__ __forceinline__ void xcd_barrier_complete(unsigned* bar, unsigned x, unsigned& nloc, unsigned& nx) {
    const unsigned G = gridDim.x * gridDim.y * gridDim.z;
    unsigned sum, cnt, mine, sp = 0u;
    for (;;) {
        sum = 0u; cnt = 0u; mine = 0u;
#pragma unroll
        for (unsigned j = 0; j < 16; ++j) { const unsigned c = xb_ld(&bar[XB_XCNT(j)]); sum += c; cnt += (c > 0u) ? 1u : 0u; mine = (j == x) ? c : mine; }
        if (sum == G) break;
        __builtin_amdgcn_s_sleep(1);
        if ((++sp & 255u) == 0u) { if (xb_ld(&bar[XB_TMO])) break; if (sp > XB_SPIN_CAP) { atomicAdd(&bar[XB_TMO], 1u); break; } }
    }
    nloc = mine > 0u ? mine : 1u; nx = cnt > 0u ? cnt : 1u;
}
__device__ __forceinline__ void grid_bar() {
    asm volatile("s_waitcnt vmcnt(0)" ::: "memory");
    __syncthreads();
    if (threadIdx.x == 0) {
        unsigned* bar = (unsigned*)(wsp() + WS_BAR); const unsigned x = xb_xcc_id();
        volatile LAS unsigned* st = (volatile LAS unsigned*)(lds_base() + LDS_BARST);
        __builtin_amdgcn_s_waitcnt(0);
        unsigned nloc = st[0], nx = st[1];
        if (nloc == 0u) { xcd_barrier_complete(bar, x, nloc, nx); st[0] = nloc; st[1] = nx; }
        const unsigned old = xb_add(&bar[XB_XSUB(x)], 1u);
        const unsigned gen = old / nloc;
        if (old + 1u == (gen + 1u) * nloc) {
            __builtin_amdgcn_fence(__ATOMIC_RELEASE, "agent");
            asm volatile("s_waitcnt vmcnt(0)" ::: "memory");
            const unsigned og = xb_add(&bar[XB_TOP], 1u);
            const unsigned tg = og / nx;
            if (og + 1u == (tg + 1u) * nx) xb_add(&bar[XB_TOPGEN], 1u);
            else XB_SPIN(xb_ld(&bar[XB_TOPGEN]) == tg, bar);
            __builtin_amdgcn_fence(__ATOMIC_ACQUIRE, "agent");
            xb_add(&bar[XB_XGEN(x)], 1u);
            asm volatile("s_waitcnt vmcnt(0)" ::: "memory");
        } else {
            XB_SPIN(xb_ld(&bar[XB_XGEN(x)]) == gen, bar);
            __builtin_amdgcn_fence(__ATOMIC_ACQUIRE, "agent");
            asm volatile("s_waitcnt vmcnt(0)" ::: "memory");
        }
    }
    __syncthreads();
}

__device__ __forceinline__ void sub_bar(unsigned* cnt, unsigned n) {
    asm volatile("s_waitcnt vmcnt(0)" ::: "memory");
    __syncthreads();
    if (threadIdx.x == 0) {
        __builtin_amdgcn_fence(__ATOMIC_RELEASE, "agent");
        asm volatile("s_waitcnt vmcnt(0)" ::: "memory");
        xb_add(cnt, 1u);
        unsigned sp = 0; while (xb_ld(cnt) < n) { __builtin_amdgcn_s_sleep(1); if (++sp > XB_SPIN_CAP) break; }
        __builtin_amdgcn_fence(__ATOMIC_ACQUIRE, "agent");
        asm volatile("s_waitcnt vmcnt(0)" ::: "memory");
    }
    __syncthreads();
}
#define MFMA16(a, b, c) __builtin_amdgcn_mfma_f32_16x16x32_bf16(a, b, c, 0, 0, 0)
constexpr size_t WS_GL = 0, WS_W = 312 * MiB, WS_QD = 344 * MiB, WS_KDT = 376 * MiB, WS_UT = 408 * MiB, WS_AI = 440 * MiB;
typedef LAS unsigned short* lbf;
template <int PMODE>
__device__ __forceinline__ void dn_prep(Frame& F_, int l) {
    Frame F = mkframe();
    const bf16* PROJ = (const bf16*)(wsp() + WS_PROJ);
    lbf QS = (lbf)(F.lds), KS = (lbf)(F.lds + 17408), VT = (lbf)(F.lds + 34816), KGT = (lbf)(F.lds + 53248), KDT = (lbf)(F.lds + 71680), TB = (lbf)(F.lds + 107520);
    LAS float* LM = (LAS float*)(F.lds + 90112); LAS float* GC = (LAS float*)(F.lds + 116736); LAS float* BT = (LAS float*)(F.lds + 116992);
    const int lane = F.lane, wave = F.wave, fr = lane & 15, fq = lane >> 4;
    struct PrepIn { unsigned xr[3][11]; float cw[3][4][2]; bf16 a, b; };
#define PREP_LOAD(X, chx) do { const int ch_ = (chx), h_ = (ch_ >> 7) & 7, n_ = ch_ & 127, m0_ = (ch_ >> 10) * SEQ + n_ * 64; \
        X.a = PROJ[(size_t)(m0_ + lane) * DINP + C_DNA + h_]; X.b = PROJ[(size_t)(m0_ + lane) * DINP + C_DNB + h_]; \
        _Pragma("unroll") for (int ts = 0; ts < 3; ++ts) _Pragma("unroll") for (int j = 0; j < 11; ++j) { const int ii = 8 * wave - 3 + j; \
            X.xr[ts][j] = (n_ * 64 + ii >= 0) ? *(const unsigned*)(PROJ + (size_t)(m0_ + ii) * DINP + ts * 1024 + h_ * 128 + 2 * lane) : 0u; } \
        { const float* cwp = inp(4) + (size_t)l * 4 * 3072 + h_ * 128 + 2 * lane; \
          _Pragma("unroll") for (int ts = 0; ts < 3; ++ts) _Pragma("unroll") for (int j = 0; j < 4; ++j) { X.cw[ts][j][0] = cwp[j * 3072 + ts * 1024]; X.cw[ts][j][1] = cwp[j * 3072 + ts * 1024 + 1]; } } } while (0)
    PrepIn cur; unsigned eat = 0u;
    for (int ch = F.bid; ch < 2048; ch += F.G) {
        const int b = ch >> 10, h = (ch >> 7) & 7, n = ch & 127, m0 = b * SEQ + n * 64;
        PREP_LOAD(cur, ch);
        unsigned touch = 0u;
        if (ch + F.G < 2048 && F.tid < 402) { const int cn = ch + F.G, hn = (cn >> 7) & 7, nn = cn & 127, mn = (cn >> 10) * SEQ + nn * 64; const int rowt = F.tid / 6 - 3, ln = F.tid % 6;
            if (nn * 64 + rowt >= 0) touch = *(const unsigned*)(PROJ + (size_t)(mn + rowt) * DINP + (ln >> 1) * 1024 + hn * 128 + (ln & 1) * 64); }
        const float a_neg = -__expf(inp(5)[l * 8 + h]), dtb = inp(6)[l * 8 + h];
        float gc, beta, gl;
        { const float a_in = bf1(cur.a), b_in = bf1(cur.b);
          const float z = a_in + dtb; const float sp = (z > 20.f) ? z : log1pf(__expf(z)); gc = a_neg * sp;
#pragma unroll
          for (int o = 1; o < 64; o <<= 1) { const float t = __shfl_up(gc, o); if (lane >= o) gc += t; }
          beta = sigmoidf_(b_in); gl = __shfl(gc, 63);
          if (wave == 0) { GC[lane] = gc; BT[lane] = beta; } }
        float sv[8][3][2], pp[16];
#pragma unroll
        for (int rr = 0; rr < 8; ++rr) {
#pragma unroll
            for (int ts = 0; ts < 3; ++ts) { float y0 = 0.f, y1 = 0.f;
#pragma unroll
                for (int j = 0; j < 4; ++j) { const unsigned xw = cur.xr[ts][rr + j]; y0 += cur.cw[ts][j][0] * bflo(xw); y1 += cur.cw[ts][j][1] * bfhi(xw); }
                sv[rr][ts][0] = siluf_(y0); sv[rr][ts][1] = siluf_(y1); }
            pp[2 * rr] = sv[rr][0][0] * sv[rr][0][0] + sv[rr][0][1] * sv[rr][0][1]; pp[2 * rr + 1] = sv[rr][1][0] * sv[rr][1][0] + sv[rr][1][1] * sv[rr][1][1];
        }
        float tot;
        { const bool b5 = (lane & 32) != 0, b4 = (lane & 16) != 0, b3 = (lane & 8) != 0, b2 = (lane & 4) != 0;
          float p8[8], p4[4], p2[2];
#pragma unroll
          for (int k = 0; k < 8; ++k) p8[k] = (b5 ? pp[k + 8] : pp[k]) + __shfl_xor(b5 ? pp[k] : pp[k + 8], 32);
#pragma unroll
          for (int k = 0; k < 4; ++k) p4[k] = (b4 ? p8[k + 4] : p8[k]) + __shfl_xor(b4 ? p8[k] : p8[k + 4], 16);
#pragma unroll
          for (int k = 0; k < 2; ++k) p2[k] = (b3 ? p4[k + 2] : p4[k]) + __shfl_xor(b3 ? p4[k] : p4[k + 2], 8);
          tot = (b2 ? p2[1] : p2[0]) + __shfl_xor(b2 ? p2[0] : p2[1], 4);
          tot += __shfl_xor(tot, 2); tot += __shfl_xor(tot, 1); }
        unsigned kg[2][4], kd[2][4], vb[2][4];
#pragma unroll
        for (int rr = 0; rr < 8; ++rr) {
            const int i = 8 * wave + rr;
            const float gci = __int_as_float(__builtin_amdgcn_readlane(__float_as_int(gc), i)), bi = __int_as_float(__builtin_amdgcn_readlane(__float_as_int(beta), i));
            const float scq = rsqrtf(__int_as_float(__builtin_amdgcn_readlane(__float_as_int(tot), 8 * rr)) + EPS) * 0.08838834764831845f;
            const float sck = rsqrtf(__int_as_float(__builtin_amdgcn_readlane(__float_as_int(tot), 8 * rr + 4)) + EPS);
            const float q0 = sv[rr][0][0] * scq, q1 = sv[rr][0][1] * scq, k0 = sv[rr][1][0] * sck, k1 = sv[rr][1][1] * sck, v0 = sv[rr][2][0], v1 = sv[rr][2][1];
            const float eg = __expf(gci), egl = __expf(gl - gci);
            *(LAS unsigned*)(QS + i * 136 + 2 * lane) = pk2(q0, q1); *(LAS unsigned*)(KS + i * 136 + 2 * lane) = pk2(k0, k1);
            *(unsigned*)((bf16*)(wsp() + WS_QD) + (size_t)ch * 8192 + ((((i >> 4) * 4 + (lane >> 4)) * 64 + ((lane >> 2) & 3) * 16 + (i & 15)) * 8 + 2 * (lane & 3))) = pk2(q0 * eg, q1 * eg);
            const unsigned g0 = f2bf(k0 * bi * eg), g1 = f2bf(k1 * bi * eg), d0 = f2bf(k0 * egl), d1 = f2bf(k1 * egl), u0 = f2bf(v0 * bi), u1 = f2bf(v1 * bi);
            if (rr & 1) { kg[0][rr >> 1] |= g0 << 16; kg[1][rr >> 1] |= g1 << 16; kd[0][rr >> 1] |= d0 << 16; kd[1][rr >> 1] |= d1 << 16; vb[0][rr >> 1] |= u0 << 16; vb[1][rr >> 1] |= u1 << 16; }
            else { kg[0][rr >> 1] = g0; kg[1][rr >> 1] = g1; kd[0][rr >> 1] = d0; kd[1][rr >> 1] = d1; vb[0][rr >> 1] = u0; vb[1][rr >> 1] = u1; }
        }
#pragma unroll
        for (int c = 0; c < 2; ++c) {
            *(LAS v4u*)(KGT + (2 * lane + c) * 72 + 8 * wave) = (v4u){kg[c][0], kg[c][1], kg[c][2], kg[c][3]};
            *(LAS v4u*)(KDT + (2 * lane + c) * 72 + 8 * wave) = (v4u){kd[c][0], kd[c][1], kd[c][2], kd[c][3]};
            *(LAS v4u*)(VT + (2 * lane + c) * 72 + 8 * wave) = (v4u){vb[c][0], vb[c][1], vb[c][2], vb[c][3]};
        }
        __syncthreads();
        if (PMODE == 2) continue;
        { const int ti = wave >> 1;
          bf16x8 kfi[4], qfi[4];
#pragma unroll
          for (int ks = 0; ks < 4; ++ks) { kfi[ks] = *(const LAS bf16x8*)(KS + (16 * ti + fr) * 136 + 32 * ks + 8 * fq); qfi[ks] = *(const LAS bf16x8*)(QS + (16 * ti + fr) * 136 + 32 * ks + 8 * fq); }
#pragma unroll
          for (int tt = 0; tt < 2; ++tt) { const int tj = 2 * (wave & 1) + tt;
              f32x4 akk = {0.f, 0.f, 0.f, 0.f}, aqk = {0.f, 0.f, 0.f, 0.f};
#pragma unroll
              for (int ks = 0; ks < 4; ++ks) { const bf16x8 kfj = *(const LAS bf16x8*)(KS + (16 * tj + fr) * 136 + 32 * ks + 8 * fq); akk = MFMA16(kfi[ks], kfj, akk); aqk = MFMA16(kfj, qfi[ks], aqk); }
              { const int j = 16 * tj + fr; const float gcj = GC[j];
#pragma unroll
                for (int r = 0; r < 4; ++r) { const int i = 16 * ti + 4 * fq + r; LM[i * 68 + j] = (i > j) ? BT[i] * akk[r] * __expf(GC[i] - gcj) : 0.f; } }
              { const int i = 16 * ti + fr; const float gci = GC[i]; float v[4];
#pragma unroll
                for (int r = 0; r < 4; ++r) { const int j = 16 * tj + 4 * fq + r; v[r] = (i >= j) ? aqk[r] * __expf(gci - GC[j]) : 0.f; }
                v2u w; w.x = pk2(v[0], v[1]); w.y = pk2(v[2], v[3]);
                *(v2u*)((bf16*)(wsp() + WS_AI) + (size_t)ch * 4096 + (((ti * 2 + (tj >> 1)) * 64 + ((2 * tj + (fq >> 1)) & 3) * 16 + fr) * 8 + 4 * (fq & 1))) = w; } } }
        __syncthreads();
        {
            LAS float* T11f = (LAS float*)(F.lds + 117248); LAS float* T22f = T11f + 1056; LAS float* Mf = T22f + 1056;
            if (wave < 2 && PMODE != 1) {
                const int cl = lane & 31;
                float x[32]; float clf = (float)cl; asm volatile("" : "+v"(clf));
                LAS float* Lh = LM + (32 * wave) * 68 + 32 * wave; asm volatile("" : "+v"(Lh));
#pragma unroll
                for (int i = 0; i < 32; ++i) x[i] = 0.f;
#pragma unroll
                for (int i = 0; i < 32; ++i) {
                    float a0 = fmaxf(0.f, 1.f - fabsf(clf - (float)i)), a1 = 0.f, a2 = 0.f, a3 = 0.f;
#pragma unroll
                    for (int j4 = 0; j4 < (i + 3) / 4; ++j4) { const f32x4 Lv = *(const LAS f32x4*)(Lh + i * 68 + 4 * j4);
                        a0 -= Lv.x * x[4 * j4]; a1 -= Lv.y * x[4 * j4 + 1]; a2 -= Lv.z * x[4 * j4 + 2]; a3 -= Lv.w * x[4 * j4 + 3]; }
                    x[i] = (a0 + a1) + (a2 + a3);
                }
                if (lane < 32) {
                    LAS float* tf = (wave ? T22f : T11f) + cl; asm volatile("" : "+v"(tf));
                    lbf tb = TB + (32 * wave) * 72 + 32 * wave + cl; asm volatile("" : "+v"(tb));
#pragma unroll
                    for (int i = 0; i < 32; ++i) { tf[i * 33] = x[i]; tb[i * 72] = (bf16)f2bf(x[i]); }
                } else if (wave == 0) {
                    lbf tz = TB + 32 + cl; asm volatile("" : "+v"(tz));
#pragma unroll
                    for (int i = 0; i < 32; ++i) tz[i * 72] = 0;
                }
            }
            __syncthreads();
            const int ti2 = F.tid >> 5, c2 = F.tid & 31;
            if (PMODE != 1) {
                float m0 = 0.f, m1 = 0.f;
#pragma unroll 8
                for (int k = 0; k < 32; ++k) { const float t = T11f[k * 33 + c2]; m0 += LM[(32 + ti2) * 68 + k] * t; m1 += LM[(48 + ti2) * 68 + k] * t; }
                Mf[ti2 * 33 + c2] = m0; Mf[(ti2 + 16) * 33 + c2] = m1;
            }
            __syncthreads();
            if (PMODE != 1) {
                float t0 = 0.f, t1 = 0.f;
#pragma unroll 8
                for (int k = 0; k < 32; ++k) { const float mm = Mf[k * 33 + c2]; t0 -= T22f[ti2 * 33 + k] * mm; t1 -= T22f[(ti2 + 16) * 33 + k] * mm; }
                TB[(32 + ti2) * 72 + c2] = (bf16)f2bf(t0); TB[(48 + ti2) * 72 + c2] = (bf16)f2bf(t1);
            }
        }
        __syncthreads();
        eat ^= touch;
        { const int ti = wave & 3;
          bf16x8 tf[2];
#pragma unroll
          for (int ks = 0; ks < 2; ++ks) tf[ks] = *(const LAS bf16x8*)(TB + (16 * ti + fr) * 72 + 32 * ks + 8 * fq);
#pragma unroll
          for (int q4 = 0; q4 < 4; ++q4) { const int te = (wave >> 2) * 4 + q4;
              f32x4 au = {0.f, 0.f, 0.f, 0.f}, aw = {0.f, 0.f, 0.f, 0.f};
#pragma unroll
              for (int ks = 0; ks < 2; ++ks) { const bf16x8 vf = *(const LAS bf16x8*)(VT + (16 * te + fr) * 72 + 32 * ks + 8 * fq), gf = *(const LAS bf16x8*)(KGT + (16 * te + fr) * 72 + 32 * ks + 8 * fq);
                  au = MFMA16(tf[ks], vf, au); aw = MFMA16(gf, tf[ks], aw); }
              v2u w; w.x = pk2(au[0], au[1]); w.y = pk2(au[2], au[3]);
              *(v2u*)((bf16*)(wsp() + WS_UT) + (size_t)ch * 8192 + ((te * 4 + ti) * 64 + lane) * 4) = w;
              w.x = pk2(aw[0], aw[1]); w.y = pk2(aw[2], aw[3]);
              *(v2u*)((bf16*)(wsp() + WS_W) + (size_t)ch * 8192 + (((ti * 4 + (te >> 1)) * 64 + ((2 * te + (fq >> 1)) & 3) * 16 + fr) * 8 + 4 * (fq & 1))) = w; }
          { const int d = F.tid >> 2, part = F.tid & 3; const LAS v4u* src = (const LAS v4u*)((LAS unsigned char*)KDT + d * 144 + part * 32);
            bf16* dstb = (bf16*)(wsp() + WS_KDT) + (size_t)ch * 8192 + (((d >> 4) * 2 + (part >> 1)) * 64 + (2 * (part & 1)) * 16 + (d & 15)) * 8; *(v4u*)dstb = src[0]; *(v4u*)(dstb + 128) = src[1]; }
          if (F.tid == 0) ((float*)(wsp() + WS_GL))[ch] = gl; }
        __syncthreads();
    }
    if (eat == 0x12345u && fq == 77) GC[0] = 1.f;
}
#undef PREP_LOAD
struct DnSetC { bf16x8 wf[4], qf[4], af[2]; v2u ut[2]; };
struct DnSetS { bf16x8 kf[2][2]; float gl; unsigned pf; };
template <int MODE>
__device__ __forceinline__ void dn_scan(Frame& F_, int sid) {
    Frame F = mkframe();
    const int bh = sid >> 2, slice = sid & 3, b = bh >> 3, h = bh & 7;
    const int lane = F.lane, wave = F.wave, fr = lane & 15, fq = lane >> 4;
    lbf ST = (lbf)(F.lds); lbf VT2 = (lbf)(F.lds + 8704);
    for (int i = F.tid; i < (8704 + 4608) / 4; i += NTHR) ((LAS unsigned*)F.lds)[i] = 0u;
    const bf16* pW = (const bf16*)(wsp() + WS_W) + (size_t)bh * 128 * 8192; const bf16* pQ = (const bf16*)(wsp() + WS_QD) + (size_t)bh * 128 * 8192;
    const bf16* pA = (const bf16*)(wsp() + WS_AI) + (size_t)bh * 128 * 4096; const bf16* pK = (const bf16*)(wsp() + WS_KDT) + (size_t)bh * 128 * 8192;
    const bf16* pU = (const bf16*)(wsp() + WS_UT) + (size_t)bh * 128 * 8192; const float* pG = (const float*)(wsp() + WS_GL) + bh * 128;
    bf16* pO = (bf16*)(wsp() + WS_XN) + (size_t)b * SEQ * D + h * 128 + 32 * slice;
    short eat = 0;
    __syncthreads();
    if (wave < 4) {
        const int mi = wave;
        const unsigned oW = (mi * 4 * 64 + lane) * 8, oA = (mi * 2 * 64 + lane) * 8, oU = ((2 * slice) * 4 + mi) * 256 + lane * 4, oO = (16 * mi + fr) * D + 4 * fq;
#define DNC_LOAD(X, nn) do { const int c_ = (nn) < 128 ? (nn) : 127; \
            X.ut[0] = *(const v2u*)(pU + (size_t)c_ * 8192 + oU); X.ut[1] = *(const v2u*)(pU + (size_t)c_ * 8192 + oU + 1024); \
            _Pragma("unroll") for (int ks = 0; ks < 4; ++ks) { X.wf[ks] = *(const bf16x8*)(pW + (size_t)c_ * 8192 + (oW + 512 * ks)); X.qf[ks] = *(const bf16x8*)(pQ + (size_t)c_ * 8192 + (oW + 512 * ks)); } \
            _Pragma("unroll") for (int ks = 0; ks < 2; ++ks) X.af[ks] = *(const bf16x8*)(pA + (size_t)c_ * 4096 + (oA + 512 * ks)); } while (0)
#define DNC_STEP(X, nn) do { \
            f32x4 c1[2], c2[2]; \
            _Pragma("unroll") for (int ni = 0; ni < 2; ++ni) { c1[ni] = (f32x4){0.f, 0.f, 0.f, 0.f}; c2[ni] = (f32x4){0.f, 0.f, 0.f, 0.f}; \
                _Pragma("unroll") for (int ks = 0; ks < 4; ++ks) { const bf16x8 sf = *(const LAS bf16x8*)(ST + (16 * ni + fr) * 136 + 32 * ks + 8 * fq); c1[ni] = MFMA16(X.wf[ks], sf, c1[ni]); c2[ni] = MFMA16(sf, X.qf[ks], c2[ni]); } \
                v2u w_; w_.x = pk2(bflo(X.ut[ni].x) - c1[ni][0], bfhi(X.ut[ni].x) - c1[ni][1]); w_.y = pk2(bflo(X.ut[ni].y) - c1[ni][2], bfhi(X.ut[ni].y) - c1[ni][3]); \
                *(LAS v2u*)(VT2 + (16 * ni + fr) * 72 + 16 * mi + 4 * fq) = w_; } \
            __syncthreads(); \
            _Pragma("unroll") for (int ni = 0; ni < 2; ++ni) { \
                _Pragma("unroll") for (int ks = 0; ks < 2; ++ks) { const bf16x8 vf = *(const LAS bf16x8*)(VT2 + (16 * ni + fr) * 72 + 32 * ks + 8 * fq); c2[ni] = MFMA16(vf, X.af[ks], c2[ni]); } \
                v2u w_; w_.x = pk2(c2[ni][0], c2[ni][1]); w_.y = pk2(c2[ni][2], c2[ni][3]); if (MODE == 0) *(v2u*)(pO + (size_t)(nn) * 64 * D + oO + 16 * ni) = w_; } \
            __syncthreads(); } while (0)
        DnSetC SA, SB, SC;
        DNC_LOAD(SA, 0); DNC_LOAD(SB, 1);
        for (int n = 0; n < 126; n += 3) {
            DNC_LOAD(SC, n + 2); __builtin_amdgcn_sched_barrier(0); DNC_STEP(SA, n); __builtin_amdgcn_sched_barrier(0);
            DNC_LOAD(SA, n + 3); __builtin_amdgcn_sched_barrier(0); DNC_STEP(SB, n + 1); __builtin_amdgcn_sched_barrier(0);
            DNC_LOAD(SB, n + 4); __builtin_amdgcn_sched_barrier(0); DNC_STEP(SC, n + 2); __builtin_amdgcn_sched_barrier(0);
        }
        DNC_STEP(SA, 126); DNC_STEP(SB, 127);
#undef DNC_LOAD
#undef DNC_STEP
    } else {
        const int dq = wave - 4;
        f32x4 accS[2][2];
#pragma unroll
        for (int k = 0; k < 2; ++k)
#pragma unroll
            for (int ni = 0; ni < 2; ++ni) accS[k][ni] = (f32x4){0.f, 0.f, 0.f, 0.f};
        const int lt = F.tid - 256, li = slice * 112 + lt; const bool toucher = lt < 144;
        const bf16* pfBase = (lt >= 112) ? pU + 2048 * slice + (lt - 112) * 64 : (li < 128) ? pW + li * 64 : (li < 256) ? pQ + (li - 128) * 64 : (li < 384) ? pK + (li - 256) * 64 : pA + (li - 384) * 64;
        const unsigned pfStride = (lt >= 112 || li < 384) ? 8192u : 4096u;
        const unsigned oK = (2 * dq * 2 * 64 + lane) * 8;
#define DNS_LOAD(X, nn) do { const int c_ = (nn) < 128 ? (nn) : 127; eat ^= (short)X.pf; X.gl = pG[c_]; \
            _Pragma("unroll") for (int ks = 0; ks < 2; ++ks) { X.kf[0][ks] = *(const bf16x8*)(pK + (size_t)c_ * 8192 + (oK + 512 * ks)); X.kf[1][ks] = *(const bf16x8*)(pK + (size_t)c_ * 8192 + (oK + 1024 + 512 * ks)); } \
            { const int c2_ = (nn) + 2 < 128 ? (nn) + 2 : 127; X.pf = toucher ? *(const unsigned*)(pfBase + (size_t)c2_ * pfStride) : 0u; } } while (0)
#define DNS_STEP(X, nn) do { \
            const float egl = __expf(X.gl); \
            __syncthreads(); \
            _Pragma("unroll") for (int ni = 0; ni < 2; ++ni) { bf16x8 vf[2]; \
                _Pragma("unroll") for (int ks = 0; ks < 2; ++ks) vf[ks] = *(const LAS bf16x8*)(VT2 + (16 * ni + fr) * 72 + 32 * ks + 8 * fq); \
                _Pragma("unroll") for (int k = 0; k < 2; ++k) { accS[k][ni] = accS[k][ni] * egl; \
                    _Pragma("unroll") for (int ks = 0; ks < 2; ++ks) accS[k][ni] = MFMA16(X.kf[k][ks], vf[ks], accS[k][ni]); \
                    v2u w_; w_.x = pk2(accS[k][ni][0], accS[k][ni][1]); w_.y = pk2(accS[k][ni][2], accS[k][ni][3]); \
                    *(LAS v2u*)(ST + (16 * ni + fr) * 136 + 16 * (2 * dq + k) + 4 * fq) = w_; } } \
            __syncthreads(); } while (0)
        DnSetS SA, SB, SC; SA.pf = 0u; SB.pf = 0u; SC.pf = 0u;
        DNS_LOAD(SA, 0); DNS_LOAD(SB, 1);
        for (int n = 0; n < 126; n += 3) {
            DNS_LOAD(SC, n + 2); __builtin_amdgcn_sched_barrier(0); DNS_STEP(SA, n); __builtin_amdgcn_sched_barrier(0);
            DNS_LOAD(SA, n + 3); __builtin_amdgcn_sched_barrier(0); DNS_STEP(SB, n + 1); __builtin_amdgcn_sched_barrier(0);
            DNS_LOAD(SB, n + 4); __builtin_amdgcn_sched_barrier(0); DNS_STEP(SC, n + 2); __builtin_amdgcn_sched_barrier(0);
        }
        DNS_STEP(SA, 126); DNS_STEP(SB, 127);
#undef DNS_LOAD
#undef DNS_STEP
    }
    if (eat == 12345 && fq == 77) VT2[0] = (bf16)eat;
}
__device__ __forceinline__ void rope16(v4u& w0, v4u& w1, const float* rp) {
    float x[8], y[8];
#pragma unroll
    for (int j = 0; j < 4; ++j) { x[2 * j] = bflo(w0[j]); x[2 * j + 1] = bfhi(w0[j]); y[2 * j] = bflo(w1[j]); y[2 * j + 1] = bfhi(w1[j]); }
    const f32x4 c0 = *(const f32x4*)rp, c1 = *(const f32x4*)(rp + 4), s0 = *(const f32x4*)(rp + 8), s1 = *(const f32x4*)(rp + 12);
    float c[8] = {c0.x, c0.y, c0.z, c0.w, c1.x, c1.y, c1.z, c1.w}, s[8] = {s0.x, s0.y, s0.z, s0.w, s1.x, s1.y, s1.z, s1.w};
#pragma unroll
    for (int j = 0; j < 8; ++j) { const float a = x[j], bb = y[j]; x[j] = a * c[j] - bb * s[j]; y[j] = bb * c[j] + a * s[j]; }
#pragma unroll
    for (int j = 0; j < 4; ++j) { w0[j] = pk2(x[2 * j], x[2 * j + 1]); w1[j] = pk2(y[2 * j], y[2 * j + 1]); }
}
__device__ __forceinline__ void swa_mfma(Frame& F_, int l, int nskip) {
    Frame F = mkframe();
    bf16* PROJ = (bf16*)(wsp() + WS_PROJ); const float* ROPE = (const float*)(wsp() + WS_ROPE);
    lbf KL = (lbf)(F.lds), VTL = (lbf)(F.lds + 29952), QL = (lbf)(F.lds + 57600 + F.wave * 9216);
    const int tid = F.tid, lane = F.lane, wave = F.wave, fr = lane & 15, fq = lane >> 4;
    for (int unit = F.bid - nskip; unit < 512; unit += F.G - nskip) {
        const int b = unit >> 8, kvh = (unit >> 7) & 1, q0 = (unit & 127) * 64;
        for (int task = tid; task < 208 * 4; task += NTHR) { const int kl = task >> 2, seg = task & 3, tk = q0 - 128 + kl; v4u w0 = {0u, 0u, 0u, 0u}, w1 = {0u, 0u, 0u, 0u};
            if (kl < 192 && tk >= 0) { const int mk = b * SEQ + tk; const v4u* p = (const v4u*)(PROJ + (size_t)mk * DINP + C_SWK + kvh * 64 + 16 * seg); w0 = p[0]; w1 = p[1];
                if (seg == 0) rope16(w0, w1, ROPE + mk * 16); }
            *(LAS v4u*)(KL + kl * 72 + 16 * seg) = w0; *(LAS v4u*)(KL + kl * 72 + 16 * seg + 8) = w1; }
        for (int task = tid; task < 192 * 8; task += NTHR) { const int kl = task >> 3, seg = task & 7, tk = q0 - 128 + kl; v4u w = {0u, 0u, 0u, 0u};
            if (tk >= 0) w = *(const v4u*)(PROJ + (size_t)(b * SEQ + tk) * DINP + C_SWV + kvh * 64 + 8 * seg);
#pragma unroll
            for (int j = 0; j < 4; ++j) { VTL[(8 * seg + 2 * j) * 216 + kl] = (bf16)(w[j] & 0xffffu); VTL[(8 * seg + 2 * j + 1) * 216 + kl] = (bf16)(w[j] >> 16); } }
        for (int i = tid; i < 1024; i += NTHR) VTL[(i >> 4) * 216 + 192 + (i & 15)] = 0;
        { const int mq = b * SEQ + q0 + lane; const v4u* qp = (const v4u*)(PROJ + (size_t)mq * DINP + C_SWQ + (kvh * 8 + wave) * 64);
          v4u w[8];
#pragma unroll
          for (int i = 0; i < 8; ++i) w[i] = qp[i];
          rope16(w[0], w[1], ROPE + mq * 16);
#pragma unroll
          for (int i = 0; i < 8; ++i) { v4u o;
#pragma unroll
              for (int j = 0; j < 4; ++j) o[j] = pk2(bflo(w[i][j]) * 0.125f, bfhi(w[i][j]) * 0.125f);
              *(LAS v4u*)(QL + lane * 72 + 8 * i) = o; } }
        __syncthreads();
        const float sink = inp(8)[l * 16 + kvh * 8 + wave];
#pragma unroll 1
        for (int qt = 0; qt < 4; ++qt) {
            bf16x8 qf[2];
#pragma unroll
            for (int ks = 0; ks < 2; ++ks) qf[ks] = *(const LAS bf16x8*)(QL + (16 * qt + fr) * 72 + 32 * ks + 8 * fq);
            f32x4 st[10];
#pragma unroll
            for (int t = 0; t < 10; ++t) { st[t] = (f32x4){0.f, 0.f, 0.f, 0.f};
#pragma unroll
                for (int ks = 0; ks < 2; ++ks) { const bf16x8 kf = *(const LAS bf16x8*)(KL + (16 * (qt + t) + fr) * 72 + 32 * ks + 8 * fq); st[t] = MFMA16(kf, qf[ks], st[t]); } }
            const int qr = 16 * qt + fr; float mx = -1e30f;
#pragma unroll
            for (int t = 0; t < 10; ++t)
#pragma unroll
                for (int r = 0; r < 4; ++r) { const int kl = 16 * (qt + t) + 4 * fq + r; const bool ok = (kl > qr) && (kl <= qr + 128) && (q0 - 128 + kl >= 0);
                    st[t][r] = ok ? st[t][r] : -1e30f; mx = fmaxf(mx, st[t][r]); }
            mx = fmaxf(mx, __shfl_xor(mx, 16)); mx = fmaxf(mx, __shfl_xor(mx, 32)); mx = fmaxf(mx, sink);
            float sum = 0.f;
#pragma unroll
            for (int t = 0; t < 10; ++t)
#pragma unroll
                for (int r = 0; r < 4; ++r) { const float p = (st[t][r] > -1e29f) ? __expf(st[t][r] - mx) : 0.f; st[t][r] = p; sum += p; }
            sum += __shfl_xor(sum, 16); sum += __shfl_xor(sum, 32);
            const float inv = 1.f / (sum + __expf(sink - mx));
            bf16x8 pf[5];
#pragma unroll
            for (int pr = 0; pr < 5; ++pr) { v4u w; w.x = pk2(st[2 * pr][0] * inv, st[2 * pr][1] * inv); w.y = pk2(st[2 * pr][2] * inv, st[2 * pr][3] * inv);
                w.z = pk2(st[2 * pr + 1][0] * inv, st[2 * pr + 1][1] * inv); w.w = pk2(st[2 * pr + 1][2] * inv, st[2 * pr + 1][3] * inv); pf[pr] = __builtin_bit_cast(bf16x8, w); }
#pragma unroll
            for (int dt = 0; dt < 4; ++dt) { f32x4 acc = {0.f, 0.f, 0.f, 0.f};
#pragma unroll
                for (int pr = 0; pr < 5; ++pr) { const v2u a0 = *(const LAS v2u*)(VTL + (16 * dt + fr) * 216 + 16 * (qt + 2 * pr) + 4 * fq), a1 = *(const LAS v2u*)(VTL + (16 * dt + fr) * 216 + 16 * (qt + 2 * pr + 1) + 4 * fq);
                    v4u aw; aw.x = a0.x; aw.y = a0.y; aw.z = a1.x; aw.w = a1.y; acc = MFMA16(__builtin_bit_cast(bf16x8, aw), pf[pr], acc); }
                v2u w; w.x = pk2(acc[0], acc[1]); w.y = pk2(acc[2], acc[3]);
                *(v2u*)(PROJ + (size_t)(b * SEQ + q0 + 16 * qt + fr) * DINP + C_SWQ + (kvh * 8 + wave) * 64 + 16 * dt + 4 * fq) = w; }
        }
        __syncthreads();
    }
}
__device__ __forceinline__ void dn_naive(Frame& F_, int l) {
    Frame F = mkframe(); const int b = F.bid >> 3, h = F.bid & 7;
    const bf16* PROJ = (const bf16*)(wsp() + WS_PROJ); bf16* ORAW = (bf16*)(wsp() + WS_XN);
    LAS float* vals = (LAS float*)F.lds;
    LAS float* part = vals + 768;
    LAS float* bg = part + 16;
    LAS float* red = bg + 4;
    LAS float* red2 = red + 1024;
    const int tid = F.tid, lane = F.lane, wave = F.wave;
    const int e = tid & 127, r = tid >> 7;
    int col; float cw0 = 0.f, cw1 = 0.f, cw2 = 0.f, cw3 = 0.f;
    if (tid < 384) { const int chan = (tid >> 7) * 1024 + h * 128 + (tid & 127); col = chan; const float* cw = inp(4) + (size_t)l * 4 * 3072;
        cw0 = cw[chan]; cw1 = cw[3072 + chan]; cw2 = cw[2 * 3072 + chan]; cw3 = cw[3 * 3072 + chan]; }
    else if (tid == 384) col = C_DNB + h; else if (tid == 385) col = C_DNA + h; else col = 0;
    const float a_neg = -__expf(inp(5)[l * 8 + h]), dtb = inp(6)[l * 8 + h];
    float S[32];
#pragma unroll
    for (int i = 0; i < 32; ++i) S[i] = 0.f;
    float x0 = 0.f, x1 = 0.f, x2 = 0.f;
    const bf16* pcol = PROJ + (size_t)b * SEQ * DINP + col;
    float cur[16], nxt[16];
#pragma unroll
    for (int i = 0; i < 16; ++i) cur[i] = bf1(pcol[(size_t)i * DINP]);
    for (int tb = 0; tb < SEQ; tb += 16) {
        if (tb + 16 < SEQ) {
#pragma unroll
            for (int i = 0; i < 16; ++i) nxt[i] = bf1(pcol[(size_t)(tb + 16 + i) * DINP]);
        }
#pragma unroll
        for (int i = 0; i < 16; ++i) {
            const int t = tb + i, buf = i & 1;
            const float xin = cur[i];
            if (tid < 384) {
                const float y = cw0 * x0 + cw1 * x1 + cw2 * x2 + cw3 * xin; x0 = x1; x1 = x2; x2 = xin;
                const float s = siluf_(y); vals[buf * 384 + tid] = s;
                const float ss = wave_sum(s * s); if (lane == 0) part[buf * 8 + wave] = ss;
            } else if (tid == 384) { bg[buf * 2 + 0] = sigmoidf_(xin); }
            else if (tid == 385) { const float z = xin + dtb; const float sp = (z > 20.f) ? z : log1pf(__expf(z)); bg[buf * 2 + 1] = __expf(a_neg * sp); }
            __syncthreads();
            const float sq = rsqrtf(part[buf * 8 + 0] + part[buf * 8 + 1] + EPS) * 0.08838834764831845f;
            const float sk = rsqrtf(part[buf * 8 + 2] + part[buf * 8 + 3] + EPS);
            const float beta = bg[buf * 2 + 0], eg = bg[buf * 2 + 1];
            const LAS float* qv = vals + buf * 384 + 32 * r; const LAS float* kv = vals + buf * 384 + 128 + 32 * r;
            float pk = 0.f, pq = 0.f, pqk = 0.f;
#pragma unroll
            for (int dd = 0; dd < 32; ++dd) { const float kd = kv[dd], qd = qv[dd]; pk += kd * S[dd]; pq += qd * S[dd]; pqk += qd * kd; }
            red[(buf * 4 + r) * 128 + e] = pk * sk; red[((1 - buf) * 4 + r) * 128 + e] = pq * sq;
            if (e == 0) red2[r] = pqk;
            __syncthreads();
            float kS = 0.f, qS = 0.f;
#pragma unroll
            for (int rr = 0; rr < 4; ++rr) { kS += red[(buf * 4 + rr) * 128 + e]; qS += red[((1 - buf) * 4 + rr) * 128 + e]; }
            const float qk = (red2[0] + red2[1] + red2[2] + red2[3]) * sq * sk;
            const float ve = vals[buf * 384 + 256 + e];
            const float delta = beta * (ve - eg * kS);
            if (r == 0) ORAW[(size_t)(b * SEQ + t) * D + h * 128 + e] = (bf16)f2bf(eg * qS + qk * delta);
            const float kdl = sk * delta;
#pragma unroll
            for (int dd = 0; dd < 32; ++dd) S[dd] = eg * S[dd] + kv[dd] * kdl;
            __syncthreads();
        }
#pragma unroll
        for (int i = 0; i < 16; ++i) cur[i] = nxt[i];
    }
}
__device__ __forceinline__ void swa_naive(Frame& F_, int l, int nskip) {
    Frame F = mkframe(); const int w0 = (F.bid - nskip) * NWAVES + F.wave, nw = (F.G - nskip) * NWAVES;
    bf16* PROJ = (bf16*)(wsp() + WS_PROJ); const float* ROPE = (const float*)(wsp() + WS_ROPE);
    LAS float* qs = (LAS float*)(F.lds + F.wave * 8192);
    LAS float* ps = qs + 512;
    const int lane = F.lane;
    for (int task = w0; task < M * 2; task += nw) {
        const int m = task >> 1, kvh = task & 1, b = m / SEQ, t = m % SEQ;
        { const float c = ROPE[m * 16 + (lane & 7)], s = ROPE[m * 16 + 8 + (lane & 7)];
#pragma unroll
          for (int g = 0; g < 8; ++g) { const float x = bf1(PROJ[(size_t)m * DINP + C_SWQ + (kvh * 8 + g) * 64 + lane]); const float p = __shfl_xor(x, 8);
              const float y = (lane < 8) ? (x * c - p * s) : ((lane < 16) ? (x * c + p * s) : x); qs[g * 64 + lane] = y * 0.125f; } }
        asm volatile("s_waitcnt lgkmcnt(0)" ::: "memory");
#pragma unroll 1
        for (int kk = 0; kk < 2; ++kk) {
            const int tk = t - 127 + lane + 64 * kk; const bool valid = tk >= 0; const int mk = b * SEQ + (valid ? tk : 0);
            float kf[64];
            const v4u* kr = (const v4u*)(PROJ + (size_t)mk * DINP + C_SWK + kvh * 64);
#pragma unroll
            for (int i = 0; i < 8; ++i) { const v4u w = kr[i];
#pragma unroll
                for (int j = 0; j < 4; ++j) { kf[8 * i + 2 * j] = bflo(w[j]); kf[8 * i + 2 * j + 1] = bfhi(w[j]); } }
#pragma unroll
            for (int j = 0; j < 8; ++j) { const float c = ROPE[mk * 16 + j], s = ROPE[mk * 16 + 8 + j]; const float a = kf[j], bb = kf[j + 8]; kf[j] = a * c - bb * s; kf[j + 8] = bb * c + a * s; }
#pragma unroll
            for (int g = 0; g < 8; ++g) { float a = 0.f;
#pragma unroll
                for (int d4 = 0; d4 < 16; ++d4) { const f32x4 q = *(const LAS f32x4*)(qs + g * 64 + 4 * d4); a += q.x * kf[4 * d4] + q.y * kf[4 * d4 + 1] + q.z * kf[4 * d4 + 2] + q.w * kf[4 * d4 + 3]; }
                ps[(lane + 64 * kk) * 8 + g] = valid ? a : -1e30f; }
        }
        asm volatile("s_waitcnt lgkmcnt(0)" ::: "memory");
#pragma unroll
        for (int g = 0; g < 8; ++g) {
            const float sink = inp(8)[l * 16 + kvh * 8 + g];
            const float s0 = ps[lane * 8 + g], s1 = ps[(lane + 64) * 8 + g];
            const float mx = fmaxf(wave_max(fmaxf(s0, s1)), sink);
            const float p0 = (s0 > -1e29f) ? __expf(s0 - mx) : 0.f, p1 = (s1 > -1e29f) ? __expf(s1 - mx) : 0.f;
            const float den = wave_sum(p0 + p1) + __expf(sink - mx); const float inv = 1.f / den;
            ps[lane * 8 + g] = p0 * inv; ps[(lane + 64) * 8 + g] = p1 * inv;
        }
        asm volatile("s_waitcnt lgkmcnt(0)" ::: "memory");
        float o[8];
#pragma unroll
        for (int g = 0; g < 8; ++g) o[g] = 0.f;
        const int j0 = (t >= 127) ? 0 : (127 - t);
        for (int j = j0; j < 128; ++j) {
            const int mk = b * SEQ + t - 127 + j;
            const float v = bf1(PROJ[(size_t)mk * DINP + C_SWV + kvh * 64 + lane]);
            const f32x4 pa = *(const LAS f32x4*)(ps + j * 8), pb = *(const LAS f32x4*)(ps + j * 8 + 4);
            o[0] += pa.x * v; o[1] += pa.y * v; o[2] += pa.z * v; o[3] += pa.w * v; o[4] += pb.x * v; o[5] += pb.y * v; o[6] += pb.z * v; o[7] += pb.w * v;
        }
#pragma unroll
        for (int g = 0; g < 8; ++g) PROJ[(size_t)m * DINP + C_SWQ + (kvh * 8 + g) * 64 + lane] = (bf16)f2bf(o[g]);
        asm volatile("s_waitcnt lgkmcnt(0)" ::: "memory");
    }
}
__device__ __forceinline__ void phase_gnorm(Frame& F_, int l) {
    Frame F = mkframe();
    bf16* PROJ = (bf16*)(wsp() + WS_PROJ); const bf16* ORAW = (const bf16*)(wsp() + WS_XN);
    const int gw = F.bid * NWAVES + F.wave, NGW = F.G * NWAVES;
    const float g0 = inp(7)[l * 128 + 2 * F.lane], g1 = inp(7)[l * 128 + 2 * F.lane + 1];
    for (int m = gw; m < M; m += NGW) {
        unsigned ow[8], zw[8];
#pragma unroll
        for (int h = 0; h < 8; ++h) { ow[h] = *(const unsigned*)(ORAW + (size_t)m * D + h * 128 + 2 * F.lane); zw[h] = *(const unsigned*)(PROJ + (size_t)m * DINP + C_DNZ + h * 128 + 2 * F.lane); }
        float ss[8];
#pragma unroll
        for (int h = 0; h < 8; ++h) { const float o0 = bflo(ow[h]), o1 = bfhi(ow[h]); ss[h] = o0 * o0 + o1 * o1; }
#pragma unroll
        for (int o = 1; o < 64; o <<= 1) {
#pragma unroll
            for (int h = 0; h < 8; ++h) ss[h] += __shfl_xor(ss[h], o); }
#pragma unroll
        for (int h = 0; h < 8; ++h) { const float r = rsqrtf(ss[h] * (1.f / 128.f) + EPS);
            *(unsigned*)(PROJ + (size_t)m * DINP + C_DNQ + h * 128 + 2 * F.lane) = pk2(bflo(ow[h]) * r * g0 * siluf_(bflo(zw[h])), bfhi(ow[h]) * r * g1 * siluf_(bfhi(zw[h]))); }
    }
}

#ifndef PROBE_DUP
#define PROBE_DUP 0
#endif
#ifndef DN_NAIVE
#define DN_NAIVE 0
#endif
struct Args { const float* in[17]; float* out; unsigned char* ws; };
__global__ void __launch_bounds__(NTHR, 2) hybrid_fwd(Args args) {
    cg::grid_group grid = cg::this_grid();
    Frame F;
    F.lds = lds_base();
    F.tid = threadIdx.x; F.lane = F.tid & 63; F.wave = __builtin_amdgcn_readfirstlane(F.tid >> 6);
    F.G = gridDim.x; F.bid = blockIdx.x;
#define PROJ ((bf16*)(wsp() + WS_PROJ))
#define XN ((bf16*)(wsp() + WS_XN))
#define YF ((float*)(wsp() + WS_YF))
#define MIX ((bf16*)(wsp() + WS_MIX))
#define HB ((bf16*)(wsp() + WS_H))

    if (F.bid == 0) { for (int i = F.tid; i < XCD_BAR_WORDS; i += NTHR) ((unsigned*)(wsp() + WS_BAR))[i] = 0u; for (int i = F.tid; i < 16384; i += NTHR) ((unsigned*)(wsp() + WS_XCNT))[i] = 0u; if (F.tid < 256) ((unsigned*)(wsp() + WS_SUBCNT))[F.tid] = 0u; }
    if (F.tid < 4) ((LAS unsigned*)(lds_base() + LDS_BARST))[F.tid] = 0u;
    phase_rope(F);
    phase_norm(F, nullptr, nullptr, inp(0), outp(), inp(2), XN);
    phase_convert(F, -1, 0, 0);
    grid.sync();
    xcd_barrier_post();
    for (int l = 0; l < DEPTH; ++l) {
        {
            pg8::Gemm g{XN, (const bf16*)(wsp() + WS_WIN), nullptr, nullptr, M, DINP, D, D}; pg8::StaticOrder S; { Frame Fg = mkframe(); S.init(M, DINP, Fg.G, Fg.bid); }
            pg8::EpiBf16<0> E{PROJ, DINP};
            pg8::gemm_phase<pg8::EpiBf16<0>, pg8::StaticOrder, true, true>(F.lds, g, S, E);
#if PROBE_DUP == 5
            pg8::gemm_phase<pg8::EpiBf16<0>, pg8::StaticOrder, true, true>(F.lds, g, S, E);
#endif
        }
        grid_bar();
#if DN_NAIVE
        if (F.bid < 16) dn_naive(F, l);
        else swa_naive(F, l, 16);
#else
#if PROBE_DUP == 1
        dn_prep<0>(F, l);
#elif PROBE_DUP == 11
        dn_prep<1>(F, l);
#elif PROBE_DUP == 12
        dn_prep<2>(F, l);
#elif PROBE_DUP == 13
        dn_prep<3>(F, l);
#elif PROBE_DUP == 14
        dn_prep<4>(F, l);
#endif
        dn_prep<0>(F, l);
        grid_bar();
        { Frame Fg = mkframe(); if (Fg.bid < 64) { const int sid_ = (((Fg.bid & 7) * 2 + (Fg.bid >> 5)) << 2) | ((Fg.bid >> 3) & 3); dn_scan<0>(F, sid_);
#if PROBE_DUP == 2
            dn_scan<0>(F, sid_);
#elif PROBE_DUP == 3
            dn_scan<1>(F, sid_);
#elif PROBE_DUP == 4
            dn_scan<2>(F, sid_);
#endif
        }
        else {
            phase_convert(F, l, (l + 1 < DEPTH) ? l + 1 : -1, 64);
            __syncthreads();
            swa_mfma(F, l, 64);
            sub_bar((unsigned*)(wsp() + WS_SUBCNT) + 64 * l, (unsigned)(Fg.G - 64));
            pg8::Gemm g{PROJ + C_SWQ, (const bf16*)(wsp() + WS_WUPSW), nullptr, nullptr, M, D, D, DINP}; pg8::StaticOrder S; S.init(M, D, Fg.G - 64, Fg.bid - 64);
            pg8::EpiYb E{PROJ + C_DNK, DINP, PROJ + C_GB, DINP};
            pg8::gemm_phase<pg8::EpiYb, pg8::StaticOrder, true, true>(F.lds, g, S, E);
        } }
#endif
        grid_bar();
        phase_gnorm(F, l);
#if PROBE_DUP == 6
        phase_gnorm(F, l);
#endif
        grid_bar();
        {
            pg8::Gemm g{PROJ + C_DNQ, (const bf16*)(wsp() + WS_WUPDN), nullptr, nullptr, M, D, D, DINP}; pg8::StaticOrder S; { Frame Fg = mkframe(); S.init(M, D, Fg.G, Fg.bid); }
            pg8::EpiMerge2 E{MIX, D, PROJ + C_GA, PROJ + C_DNK, DINP};
            pg8::gemm_phase<pg8::EpiMerge2, pg8::StaticOrder, false, true>(F.lds, g, S, E);
        }
        grid_bar();
        {
            pg8::Gemm g{MIX, (const bf16*)(wsp() + WS_WO), nullptr, nullptr, M, D, D, D}; pg8::StaticOrder S; { Frame Fg = mkframe(); S.init(M, D, Fg.G, Fg.bid); }
            pg8::RmsExchange e1{(float*)(wsp() + WS_XSLOT), (unsigned*)(wsp() + WS_XCNT) + ((l * 4 + 0) * 64) * 16}, e2{(float*)(wsp() + WS_XSLOT + 262144), (unsigned*)(wsp() + WS_XCNT) + ((l * 4 + 1) * 64) * 16};
            pg8::EpiRmsRes E{outp(), inp(12) + l * D, inp(13) + l * D, XN, e1, e2};
            pg8::gemm_phase<pg8::EpiRmsRes, pg8::StaticOrder, false, true>(F.lds, g, S, E);
        }
        grid_bar();
        {
            pg8::Gemm g{XN, (const bf16*)(wsp() + WS_WFF1), nullptr, nullptr, M, FF, D, D}; pg8::StaticOrder S; { Frame Fg = mkframe(); S.init(M, FF, Fg.G, Fg.bid); }
            pg8::EpiBf16<2> E{HB, FF};
            pg8::gemm_phase<pg8::EpiBf16<2>, pg8::StaticOrder, true, true>(F.lds, g, S, E);
#if PROBE_DUP == 7
            pg8::gemm_phase<pg8::EpiBf16<2>, pg8::StaticOrder, true, true>(F.lds, g, S, E);
#endif
        }
        grid_bar();
        {
            pg8::Gemm g{HB, (const bf16*)(wsp() + WS_WFF2), nullptr, nullptr, M, D, FF, FF}; pg8::StaticOrder S; { Frame Fg = mkframe(); S.init(M, D, Fg.G, Fg.bid); }
            pg8::RmsExchange e1{(float*)(wsp() + WS_XSLOT), (unsigned*)(wsp() + WS_XCNT) + ((l * 4 + 2) * 64) * 16}, e2{(float*)(wsp() + WS_XSLOT + 262144), (unsigned*)(wsp() + WS_XCNT) + ((l * 4 + 3) * 64) * 16};
            pg8::EpiRmsRes E{outp(), inp(16) + l * D, (l + 1 < DEPTH) ? inp(2) + (l + 1) * D : nullptr, XN, e1, e2};
            pg8::gemm_phase<pg8::EpiRmsRes, pg8::StaticOrder, false, true>(F.lds, g, S, E);
        }
        if (l + 1 < DEPTH) grid_bar();
    }
#undef PROJ
#undef XN
#undef YF
#undef MIX
#undef HB
}

extern "C" void kernel_launch(void* const* d_in, const int* in_sizes, int n_in, void* d_out, int out_size, void* d_ws, size_t ws_size, hipStream_t stream) {
    static int init = 0;
    if (!init) {
        if (n_in != 17 || out_size != M * D || ws_size < WS_END) { fprintf(stderr, "kernel_launch: unexpected shapes (n_in %d out %d ws %zu)\n", n_in, out_size, ws_size); init = -1; return; }
        if (hipFuncSetAttribute((const void*)hybrid_fwd, hipFuncAttributeMaxDynamicSharedMemorySize, LDS_BYTES) != hipSuccess) { fprintf(stderr, "hipFuncSetAttribute failed\n"); init = -1; return; }
        init = 1;
    }
    if (init < 0) return;
    Args a{};
    for (int i = 0; i < 17; ++i) a.in[i] = (const float*)d_in[i];
    a.out = (float*)d_out; a.ws = (unsigned char*)d_ws;
    void* args[] = {&a};
    hipError_t e = hipLaunchCooperativeKernel((void*)hybrid_fwd, dim3(256), dim3(NTHR), args, LDS_BYTES, stream);
    if (e != hipSuccess) fprintf(stderr, "cooperative launch failed: %s\n", hipGetErrorString(e));
}
```

```cpp
#include <hip/hip_runtime.h>
#include <hip/hip_cooperative_groups.h>
#include <cstdio>
#include <cstdint>
namespace cg = cooperative_groups;

namespace pg8 {
#define PG8_LAS __attribute__((address_space(3)))
typedef unsigned short bf16_t;
typedef short bf16x8 __attribute__((ext_vector_type(8)));
typedef float f32x4 __attribute__((ext_vector_type(4)));
typedef unsigned u32x4 __attribute__((ext_vector_type(4)));
constexpr int BM = 256, BK = 64, HALF = 128, HTB = HALF * BK * 2, STAGE_BYTES = 8 * HTB, NXCD = 8, WGM = 8;

__host__ __device__ __forceinline__ int lds_byte(int r, int c) { const int st = (r >> 4) * 2 + (c >> 5), rr = r & 15, cc = c & 31, ob = rr * 64 + cc * 2; return st * 1024 + (ob ^ (((ob >> 9) & 1) << 5)); }
__host__ __device__ __forceinline__ void stage_rc(int b, int& R, int& C) { const int st = b / 1024, sb = b % 1024, swz = sb ^ (((sb >> 9) & 1) << 5); R = (st >> 1) * 16 + swz / 64; C = (st & 1) * 32 + (swz % 64) / 2; }
__host__ __device__ __forceinline__ int perm32(int rho) { const int n = rho >> 4, i = rho & 15; return 8 * (i >> 2) + 4 * n + (i & 3); }

struct Unit { int pm, pn, src; };
struct Gemm { const bf16_t* A; const bf16_t* Bt; const bf16_t* A2; const bf16_t* Bt2; int M, N, K, lda; };

struct StaticOrder {
    int nM, nN, nwg, G, c;
    __host__ __device__ void init(int M, int N, int G_, int c_) { nM = M / BM; nN = N / BM; nwg = nM * nN; G = G_; c = c_; }
    __host__ __device__ bool tile(long L, Unit& u) const {
        if (L >= nwg) return false;
        int wgid = (int)L; { const int q = nwg / NXCD, r = nwg % NXCD, xcd = wgid % NXCD, off = wgid / NXCD; wgid = (xcd < r ? xcd * (q + 1) : r * (q + 1) + (xcd - r) * q) + off; }
        const int nig = WGM * nN, gid = wgid / nig, fm = gid * WGM, gsz = (nM - fm) < WGM ? (nM - fm) : WGM;
        u.pm = fm + ((wgid % nig) % gsz); u.pn = (wgid % nig) / gsz; u.src = 0; return true;
    }
    __host__ __device__ bool next(int i, Unit& u) const { return tile((long)i * G + c, u); }
};
struct DualOrder {
    StaticOrder S;
    __host__ __device__ bool next(int i, Unit& u) const { const bool ok = S.tile((long)(i >> 1) * S.G + S.c, u); u.src = i & 1; return ok; }
};

typedef float f32x2c __attribute__((ext_vector_type(2)));
typedef __bf16 bf16x2c __attribute__((ext_vector_type(2)));
__device__ __forceinline__ unsigned cvt_pk_bf16(float lo, float hi) { const f32x2c v = {lo, hi}; return __builtin_bit_cast(unsigned, __builtin_convertvector(v, bf16x2c)); }
__device__ __forceinline__ float bf_lo(unsigned w) { return __uint_as_float(w << 16); }
__device__ __forceinline__ float bf_hi(unsigned w) { return __uint_as_float(w & 0xffff0000u); }

template <int ACT  > struct EpiBf16 {
    static constexpr bool PERM = true, DUAL = false, AFTER_DRAIN = false;
    bf16_t* O; int ldc;
    __device__ __forceinline__ void mid(f32x4 (&acc)[2][2][4][2], const Unit& u, int wr, int wc, int fr, int fq) const {}
    __device__ __forceinline__ void operator()(const f32x4 (&acc)[2][2][4][2], const Unit& u, int wr, int wc, int fr, int fq) const {
        const int row0 = u.pm * BM + wr * 64 + fr; const int col0 = u.pn * BM + wc * 32 + 8 * fq;
#pragma unroll
        for (int ai = 0; ai < 2; ++ai)
#pragma unroll
            for (int m = 0; m < 4; ++m) { bf16_t* rowp = O + (size_t)(row0 + ai * HALF + m * 16) * ldc + col0;
#pragma unroll
                for (int bj = 0; bj < 2; ++bj) { f32x4 v0 = acc[ai][bj][m][0], v1 = acc[ai][bj][m][1];
                    if (ACT == 2) {
#pragma unroll
                        for (int e = 0; e < 4; ++e) { const float a = fmaxf(v0[e], 0.f), b = fmaxf(v1[e], 0.f); v0[e] = a * a; v1[e] = b * b; } }
                    u32x4 w; w.x = cvt_pk_bf16(v0[0], v0[1]); w.y = cvt_pk_bf16(v0[2], v0[3]); w.z = cvt_pk_bf16(v1[0], v1[1]); w.w = cvt_pk_bf16(v1[2], v1[3]);
                    *(u32x4*)(rowp + bj * HALF) = w; } }
    }
};
struct EpiF32 {
    static constexpr bool PERM = false, DUAL = false, AFTER_DRAIN = false;
    float* O; int ldc;
    __device__ __forceinline__ void mid(f32x4 (&acc)[2][2][4][2], const Unit& u, int wr, int wc, int fr, int fq) const {}
    __device__ __forceinline__ void operator()(const f32x4 (&acc)[2][2][4][2], const Unit& u, int wr, int wc, int fr, int fq) const {
        float* rowp = O + (size_t)(u.pm * BM + wr * 64 + fr) * ldc + (u.pn * BM + wc * 32 + 4 * fq);
#pragma unroll
        for (int ai = 0; ai < 2; ++ai) {
#pragma unroll
            for (int m = 0; m < 4; ++m) {
#pragma unroll
                for (int bj = 0; bj < 2; ++bj)
#pragma unroll
                    for (int n = 0; n < 2; ++n) *(f32x4*)(rowp + bj * HALF + n * 16) = acc[ai][bj][m][n];
                rowp += (size_t)16 * ldc; asm volatile("" : "+v"(rowp) :: "memory"); }
            rowp += (size_t)64 * ldc; }
    }
};
struct EpiMerge {
    static constexpr bool PERM = true, DUAL = true, AFTER_DRAIN = false;
    bf16_t* O; int ldc; const bf16_t* GA; const bf16_t* GB; int ldg;
    __device__ __forceinline__ void mid(f32x4 (&acc)[2][2][4][2], const Unit& u, int wr, int wc, int fr, int fq) const {
        const int row0 = u.pm * BM + wr * 64 + fr; const int col0 = u.pn * BM + wc * 32 + 8 * fq;
#pragma unroll
        for (int ai = 0; ai < 2; ++ai)
#pragma unroll
            for (int m = 0; m < 4; ++m) { const size_t ro = (size_t)(row0 + ai * HALF + m * 16) * ldg + col0;
#pragma unroll
                for (int bj = 0; bj < 2; ++bj) { const u32x4 ga = *(const u32x4*)(GA + ro + bj * HALF), gb = *(const u32x4*)(GB + ro + bj * HALF);
#pragma unroll
                    for (int e = 0; e < 4; ++e) { const unsigned wa = ga[e], wb = gb[e];
                        const float r0 = (1.f + __expf(-bf_lo(wb))) / (1.f + __expf(-bf_lo(wa))), r1 = (1.f + __expf(-bf_hi(wb))) / (1.f + __expf(-bf_hi(wa)));
                        if (e < 2) { acc[ai][bj][m][0][2 * e] *= r0; acc[ai][bj][m][0][2 * e + 1] *= r1; } else { acc[ai][bj][m][1][2 * (e - 2)] *= r0; acc[ai][bj][m][1][2 * (e - 2) + 1] *= r1; } } } }
    }
    __device__ __forceinline__ void operator()(const f32x4 (&acc)[2][2][4][2], const Unit& u, int wr, int wc, int fr, int fq) const {
        const int row0 = u.pm * BM + wr * 64 + fr; const int col0 = u.pn * BM + wc * 32 + 8 * fq;
#pragma unroll
        for (int ai = 0; ai < 2; ++ai)
#pragma unroll
            for (int m = 0; m < 4; ++m) { const size_t ro = (size_t)(row0 + ai * HALF + m * 16) * ldg + col0; bf16_t* rowp = O + (size_t)(row0 + ai * HALF + m * 16) * ldc + col0;
#pragma unroll
                for (int bj = 0; bj < 2; ++bj) { const u32x4 gb = *(const u32x4*)(GB + ro + bj * HALF); f32x4 v0 = acc[ai][bj][m][0], v1 = acc[ai][bj][m][1];
                    float s[8];
#pragma unroll
                    for (int e = 0; e < 4; ++e) { s[2 * e] = 1.f / (1.f + __expf(-bf_lo(gb[e]))); s[2 * e + 1] = 1.f / (1.f + __expf(-bf_hi(gb[e]))); }
                    u32x4 w; w.x = cvt_pk_bf16(v0[0] * s[0], v0[1] * s[1]); w.y = cvt_pk_bf16(v0[2] * s[2], v0[3] * s[3]); w.z = cvt_pk_bf16(v1[0] * s[4], v1[1] * s[5]); w.w = cvt_pk_bf16(v1[2] * s[6], v1[3] * s[7]);
                    *(u32x4*)(rowp + bj * HALF) = w; } }
    }
};

struct EpiYb {
    static constexpr bool PERM = true, DUAL = false, AFTER_DRAIN = false;
    bf16_t* O; int ldc; const bf16_t* GB; int ldg;
    __device__ __forceinline__ void mid(f32x4 (&acc)[2][2][4][2], const Unit& u, int wr, int wc, int fr, int fq) const {}
    __device__ __forceinline__ void operator()(const f32x4 (&acc)[2][2][4][2], const Unit& u, int wr, int wc, int fr, int fq) const {
        const int row0 = u.pm * BM + wr * 64 + fr; const int col0 = u.pn * BM + wc * 32 + 8 * fq;
#pragma unroll
        for (int ai = 0; ai < 2; ++ai)
#pragma unroll
            for (int m = 0; m < 4; ++m) { const size_t ro = (size_t)(row0 + ai * HALF + m * 16) * ldg + col0; bf16_t* rowp = O + (size_t)(row0 + ai * HALF + m * 16) * ldc + col0;
#pragma unroll
                for (int bj = 0; bj < 2; ++bj) { const u32x4 gb = *(const u32x4*)(GB + ro + bj * HALF); const f32x4 v0 = acc[ai][bj][m][0], v1 = acc[ai][bj][m][1];
                    float s[8];
#pragma unroll
                    for (int e = 0; e < 4; ++e) { s[2 * e] = __builtin_amdgcn_rcpf(1.f + __expf(-bf_lo(gb[e]))); s[2 * e + 1] = __builtin_amdgcn_rcpf(1.f + __expf(-bf_hi(gb[e]))); }
                    u32x4 w; w.x = cvt_pk_bf16(v0[0] * s[0], v0[1] * s[1]); w.y = cvt_pk_bf16(v0[2] * s[2], v0[3] * s[3]); w.z = cvt_pk_bf16(v1[0] * s[4], v1[1] * s[5]); w.w = cvt_pk_bf16(v1[2] * s[6], v1[3] * s[7]);
                    *(u32x4*)(rowp + bj * HALF) = w; } }
    }
};
struct EpiMerge2 {
    static constexpr bool PERM = true, DUAL = false, AFTER_DRAIN = false;
    bf16_t* O; int ldc; const bf16_t* GA; const bf16_t* YB; int ldg;
    __device__ __forceinline__ void mid(f32x4 (&acc)[2][2][4][2], const Unit& u, int wr, int wc, int fr, int fq) const {}
    __device__ __forceinline__ void operator()(const f32x4 (&acc)[2][2][4][2], const Unit& u, int wr, int wc, int fr, int fq) const {
        const int row0 = u.pm * BM + wr * 64 + fr; const int col0 = u.pn * BM + wc * 32 + 8 * fq;
#pragma unroll
        for (int ai = 0; ai < 2; ++ai)
#pragma unroll
            for (int m = 0; m < 4; ++m) { const size_t ro = (size_t)(row0 + ai * HALF + m * 16) * ldg + col0; bf16_t* rowp = O + (size_t)(row0 + ai * HALF + m * 16) * ldc + col0;
#pragma unroll
                for (int bj = 0; bj < 2; ++bj) { const u32x4 ga = *(const u32x4*)(GA + ro + bj * HALF), yb = *(const u32x4*)(YB + ro + bj * HALF); const f32x4 v0 = acc[ai][bj][m][0], v1 = acc[ai][bj][m][1];
                    float o[8];
#pragma unroll
                    for (int e = 0; e < 4; ++e) { const float a0 = (e < 2) ? v0[2 * e] : v1[2 * (e - 2)], a1 = (e < 2) ? v0[2 * e + 1] : v1[2 * (e - 2) + 1];
                        o[2 * e] = a0 * __builtin_amdgcn_rcpf(1.f + __expf(-bf_lo(ga[e]))) + bf_lo(yb[e]); o[2 * e + 1] = a1 * __builtin_amdgcn_rcpf(1.f + __expf(-bf_hi(ga[e]))) + bf_hi(yb[e]); }
                    u32x4 w; w.x = cvt_pk_bf16(o[0], o[1]); w.y = cvt_pk_bf16(o[2], o[3]); w.z = cvt_pk_bf16(o[4], o[5]); w.w = cvt_pk_bf16(o[6], o[7]);
                    *(u32x4*)(rowp + bj * HALF) = w; } }
    }
};
struct RmsExchange {
    float* slots;
    unsigned* cnt;
    __device__ __forceinline__ void run(const f32x4 (&v)[2][2][4][2], const Unit& u, int wr, int wc, int fr, int fq, PG8_LAS unsigned char* lds, int wid, int lane) const {
        PG8_LAS float* P = (PG8_LAS float*)lds;
        PG8_LAS float* S = (PG8_LAS float*)(lds + 4096);
#pragma unroll
        for (int ai = 0; ai < 2; ++ai)
#pragma unroll
            for (int m = 0; m < 4; ++m) { float s = 0.f;
#pragma unroll
                for (int bj = 0; bj < 2; ++bj)
#pragma unroll
                    for (int n = 0; n < 2; ++n) { const f32x4 x = v[ai][bj][m][n]; s += (x[0] * x[0] + x[1] * x[1]) + (x[2] * x[2] + x[3] * x[3]); }
                s += __shfl_xor(s, 16); s += __shfl_xor(s, 32);
                if (fq == 0) P[(ai * HALF + wr * 64 + m * 16 + fr) * 4 + wc] = s; }
        asm volatile("s_waitcnt vmcnt(0) lgkmcnt(0)" ::: "memory"); __builtin_amdgcn_s_barrier(); asm volatile("" ::: "memory");
        const int row = wid * 64 + lane;
        if (wid < 4) {
            const f32x4 p = *(const PG8_LAS f32x4*)(P + row * 4);
            __hip_atomic_store(slots + ((size_t)(u.pm * BM + row) * 4 + u.pn), (p[0] + p[1]) + (p[2] + p[3]), __ATOMIC_RELAXED, __HIP_MEMORY_SCOPE_AGENT);
            asm volatile("s_waitcnt vmcnt(0)" ::: "memory");
            if (lane == 0) __hip_atomic_fetch_add(cnt + 16 * u.pm, 1u, __ATOMIC_RELAXED, __HIP_MEMORY_SCOPE_AGENT);
        }
        if (wid == 0) {
            unsigned sp = 0;
            while ((unsigned)__builtin_amdgcn_readfirstlane(__hip_atomic_load(cnt + 16 * u.pm, __ATOMIC_RELAXED, __HIP_MEMORY_SCOPE_AGENT)) < 16u) { __builtin_amdgcn_s_sleep(1); if (++sp > (1u << 22)) break; }
            __builtin_amdgcn_fence(__ATOMIC_ACQUIRE, "agent");
        }
        asm volatile("s_waitcnt vmcnt(0) lgkmcnt(0)" ::: "memory"); __builtin_amdgcn_s_barrier(); asm volatile("" ::: "memory");
        if (wid < 4) {
            const float* sl = slots + (size_t)(u.pm * BM + row) * 4; float t = 0.f;
#pragma unroll
            for (int k = 0; k < 4; ++k) t += __hip_atomic_load(sl + k, __ATOMIC_RELAXED, __HIP_MEMORY_SCOPE_AGENT);
            S[row] = rsqrtf(t * (1.0f / 1024.0f) + 1e-6f);
        }
        asm volatile("s_waitcnt vmcnt(0) lgkmcnt(0)" ::: "memory"); __builtin_amdgcn_s_barrier(); asm volatile("" ::: "memory");
    }
};
struct EpiRmsRes {
    static constexpr bool PERM = false, DUAL = false, AFTER_DRAIN = true;
    float* x; const float* gpost; const float* gnext; bf16_t* xn; RmsExchange e1, e2;
    __device__ __forceinline__ void mid(f32x4 (&acc)[2][2][4][2], const Unit& u, int wr, int wc, int fr, int fq) const {}
    __device__ __forceinline__ void operator()(const f32x4 (&acc)[2][2][4][2], const Unit& u, int wr, int wc, int fr, int fq) const {}
    __device__ __forceinline__ void fused(f32x4 (&acc)[2][2][4][2], const Unit& u, int wr, int wc, int fr, int fq, PG8_LAS unsigned char* lds, int wid, int lane) const {
        typedef unsigned u32x2v __attribute__((ext_vector_type(2)));
        const PG8_LAS float* S = (const PG8_LAS float*)(lds + 4096);
        const int col0 = u.pn * BM + wc * 32 + 4 * fq;
        bf16_t* xb = (bf16_t*)x;
        u32x2v pre[2][4][2][2];
#pragma unroll
        for (int ai = 0; ai < 2; ++ai)
#pragma unroll
            for (int m = 0; m < 4; ++m) { const bf16_t* xp = xb + (size_t)(u.pm * BM + ai * HALF + wr * 64 + m * 16 + fr) * 2048 + col0;
#pragma unroll
                for (int bj = 0; bj < 2; ++bj)
#pragma unroll
                    for (int n = 0; n < 2; ++n) pre[ai][m][bj][n] = *(const u32x2v*)(xp + bj * HALF + n * 16); }
        e1.run(acc, u, wr, wc, fr, fq, lds, wid, lane);
        f32x4 g[2][2];
#pragma unroll
        for (int bj = 0; bj < 2; ++bj)
#pragma unroll
            for (int n = 0; n < 2; ++n) g[bj][n] = *(const f32x4*)(gpost + col0 + bj * HALF + n * 16);
#pragma unroll
        for (int ai = 0; ai < 2; ++ai)
#pragma unroll
            for (int m = 0; m < 4; ++m) { const int r = ai * HALF + wr * 64 + m * 16 + fr; const float sr = S[r];
#pragma unroll
                for (int bj = 0; bj < 2; ++bj)
#pragma unroll
                    for (int n = 0; n < 2; ++n) { const u32x2v pw = pre[ai][m][bj][n]; const f32x4 xv = {bf_lo(pw.x), bf_hi(pw.x), bf_lo(pw.y), bf_hi(pw.y)};
                        const f32x4 o = xv + acc[ai][bj][m][n] * sr * g[bj][n]; acc[ai][bj][m][n] = o;
                        if (gnext) { u32x2v w; w.x = cvt_pk_bf16(o[0], o[1]); w.y = cvt_pk_bf16(o[2], o[3]); *(u32x2v*)(xb + (size_t)(u.pm * BM + r) * 2048 + col0 + bj * HALF + n * 16) = w; }
                        else *(f32x4*)(x + (size_t)(u.pm * BM + r) * 1024 + col0 + bj * HALF + n * 16) = o; } }
        if (gnext) {
            e2.run(acc, u, wr, wc, fr, fq, lds, wid, lane);
#pragma unroll
            for (int bj = 0; bj < 2; ++bj)
#pragma unroll
                for (int n = 0; n < 2; ++n) g[bj][n] = *(const f32x4*)(gnext + col0 + bj * HALF + n * 16);
#pragma unroll
            for (int ai = 0; ai < 2; ++ai)
#pragma unroll
                for (int m = 0; m < 4; ++m) { const int r = ai * HALF + wr * 64 + m * 16 + fr; const float sr = S[r]; bf16_t* op = xn + (size_t)(u.pm * BM + r) * 1024 + col0;
#pragma unroll
                    for (int bj = 0; bj < 2; ++bj)
#pragma unroll
                        for (int n = 0; n < 2; ++n) { const f32x4 o = acc[ai][bj][m][n] * sr * g[bj][n]; u32x2v w; w.x = cvt_pk_bf16(o[0], o[1]); w.y = cvt_pk_bf16(o[2], o[3]); *(u32x2v*)(op + bj * HALF + n * 16) = w; } }
        }
    }
};
template <class Epi, class Sched, bool ALIGN_EPI = false, bool SP2 = false>
__device__ __forceinline__ void gemm_phase(PG8_LAS unsigned char* lds, const Gemm g, const Sched& S, const Epi& E) {
    int tid_ = threadIdx.x; asm volatile("" : "+v"(tid_)); const int tid = tid_, wid = __builtin_amdgcn_readfirstlane(tid >> 6), lane = tid & 63, wr = wid >> 2, wc = wid & 3, fr = lane & 15, fq = lane >> 4;
    const int K = g.K, nt = K / BK, lda = g.lda;
    unsigned voffA[2], voffB[2];
#pragma unroll
    for (int i = 0; i < 2; ++i) { int R, C; stage_rc(tid * 16 + i * 8192, R, C); const int Rb = Epi::PERM ? ((R & ~31) + perm32(R & 31)) : R;
        voffA[i] = (unsigned)(R * lda + C) * 2u; voffB[i] = (unsigned)(Rb * K + C) * 2u; }
    const size_t kstep = (size_t)(BK * 2);
    const size_t hstepA = (size_t)HALF * lda * 2, hstepB = (size_t)HALF * K * 2;
    const size_t tstepA = 2 * hstepA, tstepB = 2 * hstepB;
    const unsigned ldsw = (unsigned)wid * 1024u;
    const int aoff = lds_byte(wr * 64 + fr, fq * 8), boff = lds_byte(wc * 32 + fr, fq * 8);
#define PG8_SA(b, h) (((b) * 2 + (h)) * HTB)
#define PG8_SB(b, h) ((4 + (b) * 2 + (h)) * HTB)
#define PG8_STAGE(bufoff, gbase, voff) do { _Pragma("unroll") for (int _i = 0; _i < 2; ++_i) \
        __builtin_amdgcn_global_load_lds((const unsigned*)((const char*)(gbase) + (voff)[_i]), (PG8_LAS unsigned*)(lds + (bufoff) + ldsw + _i * 8192), 16, 0, 0); } while (0)
#define PG8_LDA(dst, b, h) do { _Pragma("unroll") for (int m = 0; m < 4; ++m) _Pragma("unroll") for (int k = 0; k < 2; ++k) dst[m][k] = *(const PG8_LAS bf16x8*)(lds + PG8_SA(b, h) + aoff + m * 2048 + k * 1024); } while (0)
#define PG8_LDB(dst, b, h) do { _Pragma("unroll") for (int n = 0; n < 2; ++n) _Pragma("unroll") for (int k = 0; k < 2; ++k) dst[n][k] = *(const PG8_LAS bf16x8*)(lds + PG8_SB(b, h) + boff + n * 2048 + k * 1024); } while (0)
#define PG8_MMA(ai, bj, At, Bt) do { __builtin_amdgcn_s_setprio(1); _Pragma("unroll") for (int m = 0; m < 4; ++m) _Pragma("unroll") for (int n = 0; n < 2; ++n) _Pragma("unroll") for (int k = 0; k < 2; ++k) \
        acc[ai][bj][m][n] = __builtin_amdgcn_mfma_f32_16x16x32_bf16(Bt[n][k], At[m][k], acc[ai][bj][m][n], 0, 0, 0); __builtin_amdgcn_s_setprio(0); } while (0)
#define PG8_WAIT_V(n) asm volatile("s_waitcnt vmcnt(" #n ")" ::: "memory")
#define PG8_WAIT_L(n) asm volatile("s_waitcnt lgkmcnt(" #n ")" ::: "memory")
#define PG8_BAR __builtin_amdgcn_s_barrier()
#define PG8_SCHED __builtin_amdgcn_sched_barrier(0)
    Unit cur, nxt; int ui = 0;
    if (!S.next(0, cur)) return;
    f32x4 acc[2][2][4][2];
#pragma unroll
    for (int a = 0; a < 2; ++a)
#pragma unroll
        for (int b = 0; b < 2; ++b)
#pragma unroll
            for (int m = 0; m < 4; ++m)
#pragma unroll
                for (int n = 0; n < 2; ++n) acc[a][b][m][n] = (f32x4){0.f, 0.f, 0.f, 0.f};
    bf16x8 At[4][2], B0[2][2], B1[2][2];
    const char* cA = (const char*)(cur.src ? g.A2 : g.A) + (size_t)cur.pm * tstepA; const char* cB = (const char*)(cur.src ? g.Bt2 : g.Bt) + (size_t)cur.pn * tstepB;
    if constexpr (SP2) {
        PG8_STAGE(PG8_SB(0, 0), cB, voffB); PG8_STAGE(PG8_SB(0, 1), cB + hstepB, voffB); PG8_STAGE(PG8_SA(0, 0), cA, voffA); PG8_STAGE(PG8_SA(0, 1), cA + hstepA, voffA);
        if (wr == 1) PG8_BAR;
        PG8_WAIT_V(2); PG8_BAR;
        PG8_STAGE(PG8_SB(1, 0), cB + kstep, voffB); PG8_STAGE(PG8_SA(1, 0), cA + kstep, voffA); PG8_STAGE(PG8_SB(1, 1), cB + hstepB + kstep, voffB);
        PG8_WAIT_V(6); PG8_BAR;
    } else {
        PG8_STAGE(PG8_SB(0, 0), cB, voffB); PG8_STAGE(PG8_SA(0, 0), cA, voffA); PG8_STAGE(PG8_SB(0, 1), cB + hstepB, voffB); PG8_STAGE(PG8_SA(0, 1), cA + hstepA, voffA);
        if (wr == 1) PG8_BAR;
        PG8_WAIT_V(4); PG8_BAR;
        PG8_STAGE(PG8_SB(1, 0), cB + kstep, voffB); PG8_STAGE(PG8_SA(1, 0), cA + kstep, voffA); PG8_STAGE(PG8_SB(1, 1), cB + hstepB + kstep, voffB);
        PG8_WAIT_V(6); PG8_BAR;
    }
    for (;;) {
        const bool has_next = S.next(ui + 1, nxt);
        const char* nA = has_next ? (const char*)(nxt.src ? g.A2 : g.A) + (size_t)nxt.pm * tstepA : cA; const char* nB = has_next ? (const char*)(nxt.src ? g.Bt2 : g.Bt) + (size_t)nxt.pn * tstepB : cB;
        for (int t = 0; t < nt; t += 2) {
            const bool last = (t == nt - 2);
            const char* a1 = cA + (size_t)(t + 1) * kstep;
            const char* a2 = last ? nA : cA + (size_t)(t + 2) * kstep; const char* b2 = last ? nB : cB + (size_t)(t + 2) * kstep;
            const char* a3 = a2 + kstep; const char* b3 = b2 + kstep;
            if constexpr (SP2) {
            PG8_LDB(B0, 0, 0); PG8_LDB(B1, 0, 1); PG8_SCHED; PG8_LDA(At, 0, 0); PG8_STAGE(PG8_SA(1, 1), a1 + hstepA, voffA);
            PG8_WAIT_V(8); PG8_WAIT_L(0); PG8_BAR; PG8_MMA(0, 0, At, B0); PG8_MMA(0, 1, At, B1); PG8_BAR; PG8_SCHED;
            PG8_LDA(At, 0, 1); PG8_STAGE(PG8_SB(0, 0), b2, voffB); PG8_STAGE(PG8_SB(0, 1), b2 + hstepB, voffB); PG8_STAGE(PG8_SA(0, 0), a2, voffA);
            PG8_WAIT_V(8); PG8_WAIT_L(0); PG8_BAR; PG8_MMA(1, 0, At, B0); PG8_MMA(1, 1, At, B1); PG8_BAR; PG8_SCHED;
            PG8_LDB(B0, 1, 0); PG8_LDB(B1, 1, 1); PG8_SCHED; PG8_LDA(At, 1, 0); PG8_STAGE(PG8_SA(0, 1), a2 + hstepA, voffA);
            PG8_WAIT_V(8); PG8_WAIT_L(0); PG8_BAR; PG8_MMA(0, 0, At, B0); PG8_MMA(0, 1, At, B1); PG8_BAR; PG8_SCHED;
            PG8_LDA(At, 1, 1); PG8_STAGE(PG8_SB(1, 0), b3, voffB); PG8_STAGE(PG8_SB(1, 1), b3 + hstepB, voffB); PG8_STAGE(PG8_SA(1, 0), a3, voffA);
            PG8_WAIT_V(8); PG8_WAIT_L(0); PG8_BAR; PG8_MMA(1, 0, At, B0); PG8_MMA(1, 1, At, B1); PG8_BAR; PG8_SCHED;
            } else {
            PG8_LDB(B0, 0, 0); PG8_SCHED; PG8_LDA(At, 0, 0); PG8_STAGE(PG8_SA(1, 1), a1 + hstepA, voffA);
            PG8_WAIT_L(8); PG8_BAR; PG8_WAIT_L(0); PG8_MMA(0, 0, At, B0); PG8_BAR; PG8_SCHED;
            PG8_LDB(B1, 0, 1); PG8_STAGE(PG8_SB(0, 0), b2, voffB);
            PG8_BAR; PG8_WAIT_L(0); PG8_MMA(0, 1, At, B1); PG8_BAR;
            PG8_LDA(At, 0, 1); PG8_STAGE(PG8_SA(0, 0), a2, voffA);
            PG8_BAR; PG8_WAIT_L(0); PG8_MMA(1, 0, At, B0); PG8_BAR; PG8_SCHED;
            PG8_STAGE(PG8_SB(0, 1), b2 + hstepB, voffB);
            PG8_WAIT_V(6); PG8_BAR; PG8_MMA(1, 1, At, B1); PG8_BAR;
            PG8_LDB(B0, 1, 0); PG8_SCHED; PG8_LDA(At, 1, 0); PG8_STAGE(PG8_SA(0, 1), a2 + hstepA, voffA);
            PG8_WAIT_L(8); PG8_BAR; PG8_WAIT_L(0); PG8_MMA(0, 0, At, B0); PG8_BAR; PG8_SCHED;
            PG8_LDB(B1, 1, 1); PG8_STAGE(PG8_SB(1, 0), b3, voffB);
            PG8_BAR; PG8_WAIT_L(0); PG8_MMA(0, 1, At, B1); PG8_BAR;
            PG8_LDA(At, 1, 1); PG8_STAGE(PG8_SA(1, 0), a3, voffA);
            PG8_BAR; PG8_WAIT_L(0); PG8_MMA(1, 0, At, B0); PG8_BAR; PG8_SCHED;
            PG8_STAGE(PG8_SB(1, 1), b3 + hstepB, voffB);
            PG8_WAIT_V(6); PG8_BAR; PG8_MMA(1, 1, At, B1); PG8_BAR;
            }
        }
        if constexpr (ALIGN_EPI) { if (wr == 0) PG8_BAR; }
        const bool midu = Epi::DUAL && cur.src == 0;
        if constexpr (!Epi::AFTER_DRAIN) { if (midu) E.mid(acc, cur, wr, wc, fr, fq); else E(acc, cur, wr, wc, fr, fq); }
        if (!has_next) break;
        if (!midu) {
#pragma unroll
        for (int a = 0; a < 2; ++a)
#pragma unroll
            for (int b = 0; b < 2; ++b)
#pragma unroll
                for (int m = 0; m < 4; ++m)
#pragma unroll
                    for (int n = 0; n < 2; ++n) acc[a][b][m][n] = (f32x4){0.f, 0.f, 0.f, 0.f};
        }
        cur = nxt; cA = nA; cB = nB; ++ui;
        if constexpr (ALIGN_EPI) { if (wr == 1) PG8_BAR; }
    }
    PG8_WAIT_V(0);
    if constexpr (!ALIGN_EPI) { if (wr == 0) PG8_BAR; }
    PG8_BAR;
    if constexpr (Epi::AFTER_DRAIN) E.fused(acc, cur, wr, wc, fr, fq, lds, wid, lane);
#undef PG8_SA
#undef PG8_SB
#undef PG8_STAGE
#undef PG8_LDA
#undef PG8_LDB
#undef PG8_MMA
#undef PG8_WAIT_V
#undef PG8_WAIT_L
#undef PG8_BAR
#undef PG8_SCHED
}
}

#define GAS __attribute__((address_space(1)))
#define LAS __attribute__((address_space(3)))
typedef unsigned short bf16;
typedef unsigned v4u __attribute__((ext_vector_type(4)));
typedef unsigned v2u __attribute__((ext_vector_type(2)));
typedef float f32x4 __attribute__((ext_vector_type(4)));
typedef short bf16x8 __attribute__((ext_vector_type(8)));
constexpr int NWAVES = 8, NTHR = 512;
constexpr int BATCH = 2, SEQ = 8192, D = 1024, FF = 4096, DEPTH = 4, M = BATCH * SEQ;
constexpr int DIN = 7440, DINP = 7680;
constexpr int C_DNQ = 0, C_DNK = 1024, C_DNV = 2048, C_DNZ = 3072, C_SWQ = 4096, C_GA = 5120, C_GB = 6144, C_SWK = 7168, C_SWV = 7296, C_DNB = 7424, C_DNA = 7432;
constexpr float EPS = 1e-6f;
constexpr size_t MiB = 1u << 20;
constexpr size_t WS_WIN = 1 * MiB, WS_WUPDN = 16 * MiB, WS_WUPSW = 18 * MiB, WS_WO = 20 * MiB, WS_WFF1 = 22 * MiB, WS_WFF2 = 30 * MiB, WS_ROPE = 38 * MiB;
constexpr size_t WS_PROJ = 40 * MiB, WS_H = 40 * MiB, WS_XN = 280 * MiB, WS_YF = 312 * MiB, WS_MIX = 376 * MiB, WS_END = 456 * MiB;
constexpr int LDS_BYTES = 147456;

typedef float f32x2_t __attribute__((ext_vector_type(2)));
typedef __bf16 bf16x2_t __attribute__((ext_vector_type(2)));
__device__ __forceinline__ unsigned pk2(float lo, float hi) { const f32x2_t v = {lo, hi}; return __builtin_bit_cast(unsigned, __builtin_convertvector(v, bf16x2_t)); }
__device__ __forceinline__ unsigned f2bf(float f) { return pk2(f, 0.f) & 0xffffu; }
__device__ __forceinline__ float bflo(unsigned w) { return __uint_as_float(w << 16); }
__device__ __forceinline__ float bfhi(unsigned w) { return __uint_as_float(w & 0xffff0000u); }
__device__ __forceinline__ float bf1(bf16 h) { return __uint_as_float((unsigned)h << 16); }
__device__ __forceinline__ float wave_sum(float v) {
#pragma unroll
    for (int o = 1; o < 64; o <<= 1) v += __shfl_xor(v, o);
    return v;
}
__device__ __forceinline__ float wave_max(float v) {
#pragma unroll
    for (int o = 1; o < 64; o <<= 1) v = fmaxf(v, __shfl_xor(v, o));
    return v;
}
__device__ __forceinline__ float sigmoidf_(float x) { return __builtin_amdgcn_rcpf(1.f + __expf(-x)); }
__device__ __forceinline__ float siluf_(float x) { return x * __builtin_amdgcn_rcpf(1.f + __expf(-x)); }

struct Frame {
    LAS unsigned char* lds;
    int tid, lane, wave, G, bid;
};
__device__ __forceinline__ LAS unsigned char* lds_base() { extern __shared__ __attribute__((aligned(16))) unsigned char lds_dyn[]; return (LAS unsigned char*)lds_dyn; }
__device__ __forceinline__ Frame mkframe() {
    Frame F; F.lds = lds_base(); int tid = threadIdx.x; asm volatile("" : "+v"(tid)); int bid = blockIdx.x; asm volatile("" : "+s"(bid)); int G = gridDim.x; asm volatile("" : "+s"(G));
    F.tid = tid; F.lane = tid & 63; F.wave = __builtin_amdgcn_readfirstlane(tid >> 6); F.G = G; F.bid = bid; return F; }
typedef __attribute__((address_space(4))) const unsigned char* kargp_t;
__device__ __forceinline__ kargp_t kargs() { kargp_t p = (kargp_t)__builtin_amdgcn_kernarg_segment_ptr(); asm volatile("" : "+s"(p)); return p; }
__device__ __forceinline__ const float* inp(int k) { return *(const float* __attribute__((address_space(4))) const*)(kargs() + 8 * k); }
__device__ __forceinline__ float* outp() { return *(float* __attribute__((address_space(4))) const*)(kargs() + 8 * 17); }
__device__ __forceinline__ unsigned char* wsp() { return *(unsigned char* __attribute__((address_space(4))) const*)(kargs() + 8 * 18); }

__device__ __forceinline__ int orig_col(int nc) {
    if (nc < 4096) return nc;
    if (nc < 5120) return nc - 4096 + 4112;
    if (nc < 6144) return nc - 5120 + 5392;
    if (nc < 7168) return nc - 6144 + 6416;
    if (nc < 7296) return nc - 7168 + 5136;
    if (nc < 7424) return nc - 7296 + 5264;
    if (nc < 7440) return nc - 7424 + 4096;
    return -1;
}
template <bool PERMW>
__device__ __forceinline__ void transpose_item(const float* W, int K, int ldw, int nblk, bf16* WT, LAS float* scr, int item, int lane) {
    const int kb = item / nblk, nb = item % nblk, k0 = 64 * kb, n0 = 32 * nb;
    const int ncol = n0 + (lane & 31); const int oc = PERMW ? orig_col(ncol) : ncol;
#pragma unroll 8
    for (int i = 0; i < 32; ++i) { const int kk = 2 * i + (lane >> 5); scr[kk * 33 + (lane & 31)] = (oc >= 0) ? W[(size_t)(k0 + kk) * ldw + oc] : 0.f; }
    asm volatile("s_waitcnt lgkmcnt(0)" ::: "memory");
    const int c = lane & 7;
#pragma unroll
    for (int j = 0; j < 4; ++j) { const int n = (lane >> 3) + 8 * j; const LAS float* s = scr + (8 * c) * 33 + n;
        v4u o; o.x = pk2(s[0 * 33], s[1 * 33]); o.y = pk2(s[2 * 33], s[3 * 33]); o.z = pk2(s[4 * 33], s[5 * 33]); o.w = pk2(s[6 * 33], s[7 * 33]);
        *(v4u*)(WT + (size_t)(n0 + n) * K + k0 + 8 * c) = o; }
    asm volatile("s_waitcnt lgkmcnt(0)" ::: "memory");
}
__device__ __forceinline__ void phase_convert(Frame& F_, int lrest, int lin, int nskip) {
    Frame F = mkframe();
    LAS float* scr = (LAS float*)(F.lds + F.wave * 16384);
    const int gw = (F.bid - nskip) * NWAVES + F.wave, NGW = (F.G - nskip) * NWAVES;
    constexpr int I_IN = 16 * (DINP / 32), I_SQ = 16 * 32, I_F1 = 16 * (FF / 32), I_F2 = 64 * 32;
    const int n_in = (lin >= 0) ? I_IN : 0, n_rest = (lrest >= 0) ? 3 * I_SQ + I_F1 + I_F2 : 0;
    for (int it = gw; it < n_in + n_rest; it += NGW) {
        int r = it;
        if (r < n_in) { transpose_item<true>(inp(3) + (size_t)lin * D * DIN, D, DIN, DINP / 32, (bf16*)(wsp() + WS_WIN), scr, r, F.lane); continue; } r -= n_in;
        const int l = lrest;
        if (r < I_SQ) { transpose_item<false>(inp(9) + (size_t)l * D * D, D, D, 32, (bf16*)(wsp() + WS_WUPDN), scr, r, F.lane); continue; } r -= I_SQ;
        if (r < I_SQ) { transpose_item<false>(inp(10) + (size_t)l * D * D, D, D, 32, (bf16*)(wsp() + WS_WUPSW), scr, r, F.lane); continue; } r -= I_SQ;
        if (r < I_SQ) { transpose_item<false>(inp(11) + (size_t)l * D * D, D, D, 32, (bf16*)(wsp() + WS_WO), scr, r, F.lane); continue; } r -= I_SQ;
        if (r < I_F1) { transpose_item<false>(inp(14) + (size_t)l * D * FF, D, FF, FF / 32, (bf16*)(wsp() + WS_WFF1), scr, r, F.lane); continue; } r -= I_F1;
        transpose_item<false>(inp(15) + (size_t)l * FF * D, FF, D, 32, (bf16*)(wsp() + WS_WFF2), scr, r, F.lane);
    }
}
__device__ __forceinline__ void phase_rope(Frame& F_) {
    Frame F = mkframe();
    const int* pos = (const int*)inp(1); float* R = (float*)(wsp() + WS_ROPE);
    for (int i = F.bid * NTHR + F.tid; i < M * 8; i += F.G * NTHR) {
        const int m = i >> 3, j = i & 7;
        const float invf = exp2f(-(float)j * (0.125f * 18.931568569324174f));
        const float angf = (float)pos[m] * invf;
        const double a = (double)angf; const double n = rint(a * 0.15915494309189535);
        const float r = (float)(a - n * 6.283185307179586);
        R[m * 16 + j] = __cosf(r); R[m * 16 + 8 + j] = __sinf(r);
    }
}
__device__ __forceinline__ void phase_norm(Frame& F_, const float* y, const float* gpost, const float* xin, float* x, const float* gnext, bf16* XN) {
    Frame F = mkframe();
    const int gw = F.bid * NWAVES + F.wave, NGW = F.G * NWAVES;
    for (int m = gw; m < M; m += NGW) {
        f32x4 v[4];
        const f32x4* xr = (const f32x4*)(xin + (size_t)m * D) + F.lane;
#pragma unroll
        for (int j = 0; j < 4; ++j) v[j] = xr[64 * j];
        if (y) {
            const f32x4* yr = (const f32x4*)(y + (size_t)m * D) + F.lane; f32x4 w[4]; float s = 0.f;
#pragma unroll
            for (int j = 0; j < 4; ++j) { w[j] = yr[64 * j]; s += (w[j].x * w[j].x + w[j].y * w[j].y) + (w[j].z * w[j].z + w[j].w * w[j].w); }
            const float r = rsqrtf(wave_sum(s) * (1.f / D) + EPS);
#pragma unroll
            for (int j = 0; j < 4; ++j) { const f32x4 g = ((const f32x4*)gpost)[F.lane + 64 * j]; v[j] = v[j] + w[j] * r * g; }
        }
        v2u* xo = (v2u*)((bf16*)x + (size_t)m * 2048) + F.lane;
#pragma unroll
        for (int j = 0; j < 4; ++j) { v2u w; w.x = pk2(v[j].x, v[j].y); w.y = pk2(v[j].z, v[j].w); xo[64 * j] = w; }
        if (gnext) {
            float s = 0.f;
#pragma unroll
            for (int j = 0; j < 4; ++j) s += (v[j].x * v[j].x + v[j].y * v[j].y) + (v[j].z * v[j].z + v[j].w * v[j].w);
            const float r = rsqrtf(wave_sum(s) * (1.f / D) + EPS);
            v2u* o = (v2u*)(XN + (size_t)m * D) + F.lane;
#pragma unroll
            for (int j = 0; j < 4; ++j) { const f32x4 g = ((const f32x4*)gnext)[F.lane + 64 * j]; v2u w; w.x = pk2(v[j].x * r * g.x, v[j].y * r * g.y); w.y = pk2(v[j].z * r * g.z, v[j].w * r * g.w); o[64 * j] = w; }
        }
    }
}
constexpr size_t WS_SUBCNT = 196608, WS_BAR = 65536, WS_XCNT = 131072, WS_XSLOT = 39 * MiB;
#define XB_TMO      128
#define XB_XCNT(j)  (256  + 64 * (j))
#define XB_XSUB(j)  (1280 + 64 * (j))
#define XB_XGEN(j)  (2304 + 64 * (j))
#define XB_TOP      3328
#define XB_TOPGEN   3392
#define XCD_BAR_WORDS 3456
#define XB_SPIN_CAP (1u << 22)
constexpr int LDS_BARST = LDS_BYTES - 16;
__device__ __forceinline__ unsigned xb_ld(unsigned* p)              { return __hip_atomic_load(p, __ATOMIC_RELAXED, __HIP_MEMORY_SCOPE_AGENT); }
__device__ __forceinline__ unsigned xb_add(unsigned* p, unsigned v) { return __hip_atomic_fetch_add(p, v, __ATOMIC_RELAXED, __HIP_MEMORY_SCOPE_AGENT); }
__device__ __forceinline__ unsigned xb_xcc_id() { return (unsigned)__builtin_amdgcn_s_getreg((3 << 11) | 20) & 0xFu; }
#define XB_SPIN(cond, bar) do { unsigned _sp = 0; while (cond) { __builtin_amdgcn_s_sleep(1); \
    if ((++_sp & 255u) == 0u) { if (xb_ld(&(bar)[XB_TMO])) break; if (_sp > XB_SPIN_CAP) { atomicAdd(&(bar)[XB_TMO], 1u); break; } } } } while (0)
__device__ __forceinline__ void xcd_barrier_post() {
    if (threadIdx.x == 0) { unsigned* bar = (unsigned*)(wsp() + WS_BAR); (void)xb_add(&bar[XB_XCNT(xb_xcc_id())], 1u); }
}
__device__ __forceinline__ void xcd_barrier_complete(unsigned* bar, unsigned x, unsigned& nloc, unsigned& nx) {
    const unsigned G = gridDim.x * gridDim.y * gridDim.z;
    unsigned sum, cnt, mine, sp = 0u;
    for (;;) {
        sum = 0u; cnt = 0u; mine = 0u;
#pragma unroll
        for (unsigned j = 0; j < 16; ++j) { const unsigned c = xb_ld(&bar[XB_XCNT(j)]); sum += c; cnt += (c > 0u) ? 1u : 0u; mine = (j == x) ? c : mine; }
        if (sum == G) break;
        __builtin_amdgcn_s_sleep(1);
        if ((++sp & 255u) == 0u) { if (xb_ld(&bar[XB_TMO])) break; if (sp > XB_SPIN_CAP) { atomicAdd(&bar[XB_TMO], 1u); break; } }
    }
    nloc = mine > 0u ? mine : 1u; nx = cnt > 0u ? cnt : 1u;
}
__device__ __forceinline__ void grid_bar() {
    asm volatile("s_waitcnt vmcnt(0)" ::: "memory");
    __syncthreads();
    if (threadIdx.x == 0) {
        unsigned* bar = (unsigned*)(wsp() + WS_BAR); const unsigned x = xb_xcc_id();
        volatile LAS unsigned* st = (volatile LAS unsigned*)(lds_base() + LDS_BARST);
        __builtin_amdgcn_s_waitcnt(0);
        unsigned nloc = st[0], nx = st[1];
        if (nloc == 0u) { xcd_barrier_complete(bar, x, nloc, nx); st[0] = nloc; st[1] = nx; }
        const unsigned old = xb_add(&bar[XB_XSUB(x)], 1u);
        const unsigned gen = old / nloc;
        if (old + 1u == (gen + 1u) * nloc) {
            __builtin_amdgcn_fence(__ATOMIC_RELEASE, "agent");
            asm volatile("s_waitcnt vmcnt(0)" ::: "memory");
            const unsigned og = xb_add(&bar[XB_TOP], 1u);
            const unsigned tg = og / nx;
            if (og + 1u == (tg + 1u) * nx) xb_add(&bar[XB_TOPGEN], 1u);
            else XB_SPIN(xb_ld(&bar[XB_TOPGEN]) == tg, bar);
            __builtin_amdgcn_fence(__ATOMIC_ACQUIRE, "agent");
            xb_add(&bar[XB_XGEN(x)], 1u);
            asm volatile("s_waitcnt vmcnt(0)" ::: "memory");
        } else {
            XB_SPIN(xb_ld(&bar[XB_XGEN(x)]) == gen, bar);
            __builtin_amdgcn_fence(__ATOMIC_ACQUIRE, "agent");
            asm volatile("s_waitcnt vmcnt(0)" ::: "memory");
        }
    }
    __syncthreads();
}

__device__ __forceinline__ void sub_bar(unsigned* cnt, unsigned n) {
    asm volatile("s_waitcnt vmcnt(0)" ::: "memory");
    __syncthreads();
    if (threadIdx.x == 0) {
        __builtin_amdgcn_fence(__ATOMIC_RELEASE, "agent");
        asm volatile("s_waitcnt vmcnt(0)" ::: "memory");
        xb_add(cnt, 1u);
        unsigned sp = 0; while (xb_ld(cnt) < n) { __builtin_amdgcn_s_sleep(1); if (++sp > XB_SPIN_CAP) break; }
        __builtin_amdgcn_fence(__ATOMIC_ACQUIRE, "agent");
        asm volatile("s_waitcnt vmcnt(0)" ::: "memory");
    }
    __syncthreads();
}
#define MFMA16(a, b, c) __builtin_amdgcn_mfma_f32_16x16x32_bf16(a, b, c, 0, 0, 0)
constexpr size_t WS_GL = 0, WS_W = 312 * MiB, WS_QD = 344 * MiB, WS_KDT = 376 * MiB, WS_UT = 408 * MiB, WS_AI = 440 * MiB;
typedef LAS unsigned short* lbf;
template <int PMODE>
__device__ __forceinline__ void dn_prep(Frame& F_, int l) {
    Frame F = mkframe();
    const bf16* PROJ = (const bf16*)(wsp() + WS_PROJ);
    lbf QS = (lbf)(F.lds), KS = (lbf)(F.lds + 17408), VT = (lbf)(F.lds + 34816), KGT = (lbf)(F.lds + 53248), KDT = (lbf)(F.lds + 71680), TB = (lbf)(F.lds + 107520);
    LAS float* LM = (LAS float*)(F.lds + 90112); LAS float* GC = (LAS float*)(F.lds + 116736); LAS float* BT = (LAS float*)(F.lds + 116992);
    const int lane = F.lane, wave = F.wave, fr = lane & 15, fq = lane >> 4;
    struct PrepIn { unsigned xr[3][11]; float cw[3][4][2]; bf16 a, b; };
#define PREP_LOAD(X, chx) do { const int ch_ = (chx), h_ = (ch_ >> 7) & 7, n_ = ch_ & 127, m0_ = (ch_ >> 10) * SEQ + n_ * 64; \
        X.a = PROJ[(size_t)(m0_ + lane) * DINP + C_DNA + h_]; X.b = PROJ[(size_t)(m0_ + lane) * DINP + C_DNB + h_]; \
        _Pragma("unroll") for (int ts = 0; ts < 3; ++ts) _Pragma("unroll") for (int j = 0; j < 11; ++j) { const int ii = 8 * wave - 3 + j; \
            X.xr[ts][j] = (n_ * 64 + ii >= 0) ? *(const unsigned*)(PROJ + (size_t)(m0_ + ii) * DINP + ts * 1024 + h_ * 128 + 2 * lane) : 0u; } \
        { const float* cwp = inp(4) + (size_t)l * 4 * 3072 + h_ * 128 + 2 * lane; \
          _Pragma("unroll") for (int ts = 0; ts < 3; ++ts) _Pragma("unroll") for (int j = 0; j < 4; ++j) { X.cw[ts][j][0] = cwp[j * 3072 + ts * 1024]; X.cw[ts][j][1] = cwp[j * 3072 + ts * 1024 + 1]; } } } while (0)
    PrepIn cur; unsigned eat = 0u;
    for (int ch = F.bid; ch < 2048; ch += F.G) {
        const int b = ch >> 10, h = (ch >> 7) & 7, n = ch & 127, m0 = b * SEQ + n * 64;
        PREP_LOAD(cur, ch);
        unsigned touch = 0u;
        if (ch + F.G < 2048 && F.tid < 402) { const int cn = ch + F.G, hn = (cn >> 7) & 7, nn = cn & 127, mn = (cn >> 10) * SEQ + nn * 64; const int rowt = F.tid / 6 - 3, ln = F.tid % 6;
            if (nn * 64 + rowt >= 0) touch = *(const unsigned*)(PROJ + (size_t)(mn + rowt) * DINP + (ln >> 1) * 1024 + hn * 128 + (ln & 1) * 64); }
        const float a_neg = -__expf(inp(5)[l * 8 + h]), dtb = inp(6)[l * 8 + h];
        float gc, beta, gl;
        { const float a_in = bf1(cur.a), b_in = bf1(cur.b);
          const float z = a_in + dtb; const float sp = (z > 20.f) ? z : log1pf(__expf(z)); gc = a_neg * sp;
#pragma unroll
          for (int o = 1; o < 64; o <<= 1) { const float t = __shfl_up(gc, o); if (lane >= o) gc += t; }
          beta = sigmoidf_(b_in); gl = __shfl(gc, 63);
          if (wave == 0) { GC[lane] = gc; BT[lane] = beta; } }
        float sv[8][3][2], pp[16];
#pragma unroll
        for (int rr = 0; rr < 8; ++rr) {
#pragma unroll
            for (int ts = 0; ts < 3; ++ts) { float y0 = 0.f, y1 = 0.f;
#pragma unroll
                for (int j = 0; j < 4; ++j) { const unsigned xw = cur.xr[ts][rr + j]; y0 += cur.cw[ts][j][0] * bflo(xw); y1 += cur.cw[ts][j][1] * bfhi(xw); }
                sv[rr][ts][0] = siluf_(y0); sv[rr][ts][1] = siluf_(y1); }
            pp[2 * rr] = sv[rr][0][0] * sv[rr][0][0] + sv[rr][0][1] * sv[rr][0][1]; pp[2 * rr + 1] = sv[rr][1][0] * sv[rr][1][0] + sv[rr][1][1] * sv[rr][1][1];
        }
        float tot;
        { const bool b5 = (lane & 32) != 0, b4 = (lane & 16) != 0, b3 = (lane & 8) != 0, b2 = (lane & 4) != 0;
          float p8[8], p4[4], p2[2];
#pragma unroll
          for (int k = 0; k < 8; ++k) p8[k] = (b5 ? pp[k + 8] : pp[k]) + __shfl_xor(b5 ? pp[k] : pp[k + 8], 32);
#pragma unroll
          for (int k = 0; k < 4; ++k) p4[k] = (b4 ? p8[k + 4] : p8[k]) + __shfl_xor(b4 ? p8[k] : p8[k + 4], 16);
#pragma unroll
          for (int k = 0; k < 2; ++k) p2[k] = (b3 ? p4[k + 2] : p4[k]) + __shfl_xor(b3 ? p4[k] : p4[k + 2], 8);
          tot = (b2 ? p2[1] : p2[0]) + __shfl_xor(b2 ? p2[0] : p2[1], 4);
          tot += __shfl_xor(tot, 2); tot += __shfl_xor(tot, 1); }
        unsigned kg[2][4], kd[2][4], vb[2][4];
#pragma unroll
        for (int rr = 0; rr < 8; ++rr) {
            const int i = 8 * wave + rr;
            const float gci = __int_as_float(__builtin_amdgcn_readlane(__float_as_int(gc), i)), bi = __int_as_float(__builtin_amdgcn_readlane(__float_as_int(beta), i));
            const float scq = rsqrtf(__int_as_float(__builtin_amdgcn_readlane(__float_as_int(tot), 8 * rr)) + EPS) * 0.08838834764831845f;
            const float sck = rsqrtf(__int_as_float(__builtin_amdgcn_readlane(__float_as_int(tot), 8 * rr + 4)) + EPS);
            const float q0 = sv[rr][0][0] * scq, q1 = sv[rr][0][1] * scq, k0 = sv[rr][1][0] * sck, k1 = sv[rr][1][1] * sck, v0 = sv[rr][2][0], v1 = sv[rr][2][1];
            const float eg = __expf(gci), egl = __expf(gl - gci);
            *(LAS unsigned*)(QS + i * 136 + 2 * lane) = pk2(q0, q1); *(LAS unsigned*)(KS + i * 136 + 2 * lane) = pk2(k0, k1);
            *(unsigned*)((bf16*)(wsp() + WS_QD) + (size_t)ch * 8192 + ((((i >> 4) * 4 + (lane >> 4)) * 64 + ((lane >> 2) & 3) * 16 + (i & 15)) * 8 + 2 * (lane & 3))) = pk2(q0 * eg, q1 * eg);
            const unsigned g0 = f2bf(k0 * bi * eg), g1 = f2bf(k1 * bi * eg), d0 = f2bf(k0 * egl), d1 = f2bf(k1 * egl), u0 = f2bf(v0 * bi), u1 = f2bf(v1 * bi);
            if (rr & 1) { kg[0][rr >> 1] |= g0 << 16; kg[1][rr >> 1] |= g1 << 16; kd[0][rr >> 1] |= d0 << 16; kd[1][rr >> 1] |= d1 << 16; vb[0][rr >> 1] |= u0 << 16; vb[1][rr >> 1] |= u1 << 16; }
            else { kg[0][rr >> 1] = g0; kg[1][rr >> 1] = g1; kd[0][rr >> 1] = d0; kd[1][rr >> 1] = d1; vb[0][rr >> 1] = u0; vb[1][rr >> 1] = u1; }
        }
#pragma unroll
        for (int c = 0; c < 2; ++c) {
            *(LAS v4u*)(KGT + (2 * lane + c) * 72 + 8 * wave) = (v4u){kg[c][0], kg[c][1], kg[c][2], kg[c][3]};
            *(LAS v4u*)(KDT + (2 * lane + c) * 72 + 8 * wave) = (v4u){kd[c][0], kd[c][1], kd[c][2], kd[c][3]};
            *(LAS v4u*)(VT + (2 * lane + c) * 72 + 8 * wave) = (v4u){vb[c][0], vb[c][1], vb[c][2], vb[c][3]};
        }
        __syncthreads();
        if (PMODE == 2) continue;
        { const int ti = wave >> 1;
          bf16x8 kfi[4], qfi[4];
#pragma unroll
          for (int ks = 0; ks < 4; ++ks) { kfi[ks] = *(const LAS bf16x8*)(KS + (16 * ti + fr) * 136 + 32 * ks + 8 * fq); qfi[ks] = *(const LAS bf16x8*)(QS + (16 * ti + fr) * 136 + 32 * ks + 8 * fq); }
#pragma unroll
          for (int tt = 0; tt < 2; ++tt) { const int tj = 2 * (wave & 1) + tt;
              f32x4 akk = {0.f, 0.f, 0.f, 0.f}, aqk = {0.f, 0.f, 0.f, 0.f};
#pragma unroll
              for (int ks = 0; ks < 4; ++ks) { const bf16x8 kfj = *(const LAS bf16x8*)(KS + (16 * tj + fr) * 136 + 32 * ks + 8 * fq); akk = MFMA16(kfi[ks], kfj, akk); aqk = MFMA16(kfj, qfi[ks], aqk); }
              { const int j = 16 * tj + fr; const float gcj = GC[j];
#pragma unroll
                for (int r = 0; r < 4; ++r) { const int i = 16 * ti + 4 * fq + r; LM[i * 68 + j] = (i > j) ? BT[i] * akk[r] * __expf(GC[i] - gcj) : 0.f; } }
              { const int i = 16 * ti + fr; const float gci = GC[i]; float v[4];
#pragma unroll
                for (int r = 0; r < 4; ++r) { const int j = 16 * tj + 4 * fq + r; v[r] = (i >= j) ? aqk[r] * __expf(gci - GC[j]) : 0.f; }
                v2u w; w.x = pk2(v[0], v[1]); w.y = pk2(v[2], v[3]);
                *(v2u*)((bf16*)(wsp() + WS_AI) + (size_t)ch * 4096 + (((ti * 2 + (tj >> 1)) * 64 + ((2 * tj + (fq >> 1)) & 3) * 16 + fr) * 8 + 4 * (fq & 1))) = w; } } }
        __syncthreads();
        {
            LAS float* T11f = (LAS float*)(F.lds + 117248); LAS float* T22f = T11f + 1056; LAS float* Mf = T22f + 1056;
            if (wave < 2 && PMODE != 1) {
                const int cl = lane & 31;
                float x[32]; float clf = (float)cl; asm volatile("" : "+v"(clf));
                LAS float* Lh = LM + (32 * wave) * 68 + 32 * wave; asm volatile("" : "+v"(Lh));
#pragma unroll
                for (int i = 0; i < 32; ++i) x[i] = 0.f;
#pragma unroll
                for (int i = 0; i < 32; ++i) {
                    float a0 = fmaxf(0.f, 1.f - fabsf(clf - (float)i)), a1 = 0.f, a2 = 0.f, a3 = 0.f;
#pragma unroll
                    for (int j4 = 0; j4 < (i + 3) / 4; ++j4) { const f32x4 Lv = *(const LAS f32x4*)(Lh + i * 68 + 4 * j4);
                        a0 -= Lv.x * x[4 * j4]; a1 -= Lv.y * x[4 * j4 + 1]; a2 -= Lv.z * x[4 * j4 + 2]; a3 -= Lv.w * x[4 * j4 + 3]; }
                    x[i] = (a0 + a1) + (a2 + a3);
                }
                if (lane < 32) {
                    LAS float* tf = (wave ? T22f : T11f) + cl; asm volatile("" : "+v"(tf));
                    lbf tb = TB + (32 * wave) * 72 + 32 * wave + cl; asm volatile("" : "+v"(tb));
#pragma unroll
                    for (int i = 0; i < 32; ++i) { tf[i * 33] = x[i]; tb[i * 72] = (bf16)f2bf(x[i]); }
                } else if (wave == 0) {
                    lbf tz = TB + 32 + cl; asm volatile("" : "+v"(tz));
#pragma unroll
                    for (int i = 0; i < 32; ++i) tz[i * 72] = 0;
                }
            }
            __syncthreads();
            const int ti2 = F.tid >> 5, c2 = F.tid & 31;
            if (PMODE != 1) {
                float m0 = 0.f, m1 = 0.f;
#pragma unroll 8
                for (int k = 0; k < 32; ++k) { const float t = T11f[k * 33 + c2]; m0 += LM[(32 + ti2) * 68 + k] * t; m1 += LM[(48 + ti2) * 68 + k] * t; }
                Mf[ti2 * 33 + c2] = m0; Mf[(ti2 + 16) * 33 + c2] = m1;
            }
            __syncthreads();
            if (PMODE != 1) {
                float t0 = 0.f, t1 = 0.f;
#pragma unroll 8
                for (int k = 0; k < 32; ++k) { const float mm = Mf[k * 33 + c2]; t0 -= T22f[ti2 * 33 + k] * mm; t1 -= T22f[(ti2 + 16) * 33 + k] * mm; }
                TB[(32 + ti2) * 72 + c2] = (bf16)f2bf(t0); TB[(48 + ti2) * 72 + c2] = (bf16)f2bf(t1);
            }
        }
        __syncthreads();
        eat ^= touch;
        { const int ti = wave & 3;
          bf16x8 tf[2];
#pragma unroll
          for (int ks = 0; ks < 2; ++ks) tf[ks] = *(const LAS bf16x8*)(TB + (16 * ti + fr) * 72 + 32 * ks + 8 * fq);
#pragma unroll
          for (int q4 = 0; q4 < 4; ++q4) { const int te = (wave >> 2) * 4 + q4;
              f32x4 au = {0.f, 0.f, 0.f, 0.f}, aw = {0.f, 0.f, 0.f, 0.f};
#pragma unroll
              for (int ks = 0; ks < 2; ++ks) { const bf16x8 vf = *(const LAS bf16x8*)(VT + (16 * te + fr) * 72 + 32 * ks + 8 * fq), gf = *(const LAS bf16x8*)(KGT + (16 * te + fr) * 72 + 32 * ks + 8 * fq);
                  au = MFMA16(tf[ks], vf, au); aw = MFMA16(gf, tf[ks], aw); }
              v2u w; w.x = pk2(au[0], au[1]); w.y = pk2(au[2], au[3]);
              *(v2u*)((bf16*)(wsp() + WS_UT) + (size_t)ch * 8192 + ((te * 4 + ti) * 64 + lane) * 4) = w;
              w.x = pk2(aw[0], aw[1]); w.y = pk2(aw[2], aw[3]);
              *(v2u*)((bf16*)(wsp() + WS_W) + (size_t)ch * 8192 + (((ti * 4 + (te >> 1)) * 64 + ((2 * te + (fq >> 1)) & 3) * 16 + fr) * 8 + 4 * (fq & 1))) = w; }
          { const int d = F.tid >> 2, part = F.tid & 3; const LAS v4u* src = (const LAS v4u*)((LAS unsigned char*)KDT + d * 144 + part * 32);
            bf16* dstb = (bf16*)(wsp() + WS_KDT) + (size_t)ch * 8192 + (((d >> 4) * 2 + (part >> 1)) * 64 + (2 * (part & 1)) * 16 + (d & 15)) * 8; *(v4u*)dstb = src[0]; *(v4u*)(dstb + 128) = src[1]; }
          if (F.tid == 0) ((float*)(wsp() + WS_GL))[ch] = gl; }
        __syncthreads();
    }
    if (eat == 0x12345u && fq == 77) GC[0] = 1.f;
}
#undef PREP_LOAD
struct DnSetC { bf16x8 wf[4], qf[4], af[2]; v2u ut[2]; };
struct DnSetS { bf16x8 kf[2][2]; float gl; unsigned pf; };
template <int MODE>
__device__ __forceinline__ void dn_scan(Frame& F_, int sid) {
    Frame F = mkframe();
    const int bh = sid >> 2, slice = sid & 3, b = bh >> 3, h = bh & 7;
    const int lane = F.lane, wave = F.wave, fr = lane & 15, fq = lane >> 4;
    lbf ST = (lbf)(F.lds); lbf VT2 = (lbf)(F.lds + 8704);
    for (int i = F.tid; i < (8704 + 4608) / 4; i += NTHR) ((LAS unsigned*)F.lds)[i] = 0u;
    const bf16* pW = (const bf16*)(wsp() + WS_W) + (size_t)bh * 128 * 8192; const bf16* pQ = (const bf16*)(wsp() + WS_QD) + (size_t)bh * 128 * 8192;
    const bf16* pA = (const bf16*)(wsp() + WS_AI) + (size_t)bh * 128 * 4096; const bf16* pK = (const bf16*)(wsp() + WS_KDT) + (size_t)bh * 128 * 8192;
    const bf16* pU = (const bf16*)(wsp() + WS_UT) + (size_t)bh * 128 * 8192; const float* pG = (const float*)(wsp() + WS_GL) + bh * 128;
    bf16* pO = (bf16*)(wsp() + WS_XN) + (size_t)b * SEQ * D + h * 128 + 32 * slice;
    short eat = 0;
    __syncthreads();
    if (wave < 4) {
        const int mi = wave;
        const unsigned oW = (mi * 4 * 64 + lane) * 8, oA = (mi * 2 * 64 + lane) * 8, oU = ((2 * slice) * 4 + mi) * 256 + lane * 4, oO = (16 * mi + fr) * D + 4 * fq;
#define DNC_LOAD(X, nn) do { const int c_ = (nn) < 128 ? (nn) : 127; \
            X.ut[0] = *(const v2u*)(pU + (size_t)c_ * 8192 + oU); X.ut[1] = *(const v2u*)(pU + (size_t)c_ * 8192 + oU + 1024); \
            _Pragma("unroll") for (int ks = 0; ks < 4; ++ks) { X.wf[ks] = *(const bf16x8*)(pW + (size_t)c_ * 8192 + (oW + 512 * ks)); X.qf[ks] = *(const bf16x8*)(pQ + (size_t)c_ * 8192 + (oW + 512 * ks)); } \
            _Pragma("unroll") for (int ks = 0; ks < 2; ++ks) X.af[ks] = *(const bf16x8*)(pA + (size_t)c_ * 4096 + (oA + 512 * ks)); } while (0)
#define DNC_STEP(X, nn) do { \
            f32x4 c1[2], c2[2]; \
            _Pragma("unroll") for (int ni = 0; ni < 2; ++ni) { c1[ni] = (f32x4){0.f, 0.f, 0.f, 0.f}; c2[ni] = (f32x4){0.f, 0.f, 0.f, 0.f}; \
                _Pragma("unroll") for (int ks = 0; ks < 4; ++ks) { const bf16x8 sf = *(const LAS bf16x8*)(ST + (16 * ni + fr) * 136 + 32 * ks + 8 * fq); c1[ni] = MFMA16(X.wf[ks], sf, c1[ni]); c2[ni] = MFMA16(sf, X.qf[ks], c2[ni]); } \
                v2u w_; w_.x = pk2(bflo(X.ut[ni].x) - c1[ni][0], bfhi(X.ut[ni].x) - c1[ni][1]); w_.y = pk2(bflo(X.ut[ni].y) - c1[ni][2], bfhi(X.ut[ni].y) - c1[ni][3]); \
                *(LAS v2u*)(VT2 + (16 * ni + fr) * 72 + 16 * mi + 4 * fq) = w_; } \
            __syncthreads(); \
            _Pragma("unroll") for (int ni = 0; ni < 2; ++ni) { \
                _Pragma("unroll") for (int ks = 0; ks < 2; ++ks) { const bf16x8 vf = *(const LAS bf16x8*)(VT2 + (16 * ni + fr) * 72 + 32 * ks + 8 * fq); c2[ni] = MFMA16(vf, X.af[ks], c2[ni]); } \
                v2u w_; w_.x = pk2(c2[ni][0], c2[ni][1]); w_.y = pk2(c2[ni][2], c2[ni][3]); if (MODE == 0) *(v2u*)(pO + (size_t)(nn) * 64 * D + oO + 16 * ni) = w_; } \
            __syncthreads(); } while (0)
        DnSetC SA, SB, SC;
        DNC_LOAD(SA, 0); DNC_LOAD(SB, 1);
        for (int n = 0; n < 126; n += 3) {
            DNC_LOAD(SC, n + 2); __builtin_amdgcn_sched_barrier(0); DNC_STEP(SA, n); __builtin_amdgcn_sched_barrier(0);
            DNC_LOAD(SA, n + 3); __builtin_amdgcn_sched_barrier(0); DNC_STEP(SB, n + 1); __builtin_amdgcn_sched_barrier(0);
            DNC_LOAD(SB, n + 4); __builtin_amdgcn_sched_barrier(0); DNC_STEP(SC, n + 2); __builtin_amdgcn_sched_barrier(0);
        }
        DNC_STEP(SA, 126); DNC_STEP(SB, 127);
#undef DNC_LOAD
#undef DNC_STEP
    } else {
        const int dq = wave - 4;
        f32x4 accS[2][2];
#pragma unroll
        for (int k = 0; k < 2; ++k)
#pragma unroll
            for (int ni = 0; ni < 2; ++ni) accS[k][ni] = (f32x4){0.f, 0.f, 0.f, 0.f};
        const int lt = F.tid - 256, li = slice * 112 + lt; const bool toucher = lt < 144;
        const bf16* pfBase = (lt >= 112) ? pU + 2048 * slice + (lt - 112) * 64 : (li < 128) ? pW + li * 64 : (li < 256) ? pQ + (li - 128) * 64 : (li < 384) ? pK + (li - 256) * 64 : pA + (li - 384) * 64;
        const unsigned pfStride = (lt >= 112 || li < 384) ? 8192u : 4096u;
        const unsigned oK = (2 * dq * 2 * 64 + lane) * 8;
#define DNS_LOAD(X, nn) do { const int c_ = (nn) < 128 ? (nn) : 127; eat ^= (short)X.pf; X.gl = pG[c_]; \
            _Pragma("unroll") for (int ks = 0; ks < 2; ++ks) { X.kf[0][ks] = *(const bf16x8*)(pK + (size_t)c_ * 8192 + (oK + 512 * ks)); X.kf[1][ks] = *(const bf16x8*)(pK + (size_t)c_ * 8192 + (oK + 1024 + 512 * ks)); } \
            { const int c2_ = (nn) + 2 < 128 ? (nn) + 2 : 127; X.pf = toucher ? *(const unsigned*)(pfBase + (size_t)c2_ * pfStride) : 0u; } } while (0)
#define DNS_STEP(X, nn) do { \
            const float egl = __expf(X.gl); \
            __syncthreads(); \
            _Pragma("unroll") for (int ni = 0; ni < 2; ++ni) { bf16x8 vf[2]; \
                _Pragma("unroll") for (int ks = 0; ks < 2; ++ks) vf[ks] = *(const LAS bf16x8*)(VT2 + (16 * ni + fr) * 72 + 32 * ks + 8 * fq); \
                _Pragma("unroll") for (int k = 0; k < 2; ++k) { accS[k][ni] = accS[k][ni] * egl; \
                    _Pragma("unroll") for (int ks = 0; ks < 2; ++ks) accS[k][ni] = MFMA16(X.kf[k][ks], vf[ks], accS[k][ni]); \
                    v2u w_; w_.x = pk2(accS[k][ni][0], accS[k][ni][1]); w_.y = pk2(accS[k][ni][2], accS[k][ni][3]); \
                    *(LAS v2u*)(ST + (16 * ni + fr) * 136 + 16 * (2 * dq + k) + 4 * fq) = w_; } } \
            __syncthreads(); } while (0)
        DnSetS SA, SB, SC; SA.pf = 0u; SB.pf = 0u; SC.pf = 0u;
        DNS_LOAD(SA, 0); DNS_LOAD(SB, 1);
        for (int n = 0; n < 126; n += 3) {
            DNS_LOAD(SC, n + 2); __builtin_amdgcn_sched_barrier(0); DNS_STEP(SA, n); __builtin_amdgcn_sched_barrier(0);
            DNS_LOAD(SA, n + 3); __builtin_amdgcn_sched_barrier(0); DNS_STEP(SB, n + 1); __builtin_amdgcn_sched_barrier(0);
            DNS_LOAD(SB, n + 4); __builtin_amdgcn_sched_barrier(0); DNS_STEP(SC, n + 2); __builtin_amdgcn_sched_barrier(0);
        }
        DNS_STEP(SA, 126); DNS_STEP(SB, 127);
#undef DNS_LOAD
#undef DNS_STEP
    }
    if (eat == 12345 && fq == 77) VT2[0] = (bf16)eat;
}
__device__ __forceinline__ void rope16(v4u& w0, v4u& w1, const float* rp) {
    float x[8], y[8];
#pragma unroll
    for (int j = 0; j < 4; ++j) { x[2 * j] = bflo(w0[j]); x[2 * j + 1] = bfhi(w0[j]); y[2 * j] = bflo(w1[j]); y[2 * j + 1] = bfhi(w1[j]); }
    const f32x4 c0 = *(const f32x4*)rp, c1 = *(const f32x4*)(rp + 4), s0 = *(const f32x4*)(rp + 8), s1 = *(const f32x4*)(rp + 12);
    float c[8] = {c0.x, c0.y, c0.z, c0.w, c1.x, c1.y, c1.z, c1.w}, s[8] = {s0.x, s0.y, s0.z, s0.w, s1.x, s1.y, s1.z, s1.w};
#pragma unroll
    for (int j = 0; j < 8; ++j) { const float a = x[j], bb = y[j]; x[j] = a * c[j] - bb * s[j]; y[j] = bb * c[j] + a * s[j]; }
#pragma unroll
    for (int j = 0; j < 4; ++j) { w0[j] = pk2(x[2 * j], x[2 * j + 1]); w1[j] = pk2(y[2 * j], y[2 * j + 1]); }
}
__device__ __forceinline__ void swa_mfma(Frame& F_, int l, int nskip) {
    Frame F = mkframe();
    bf16* PROJ = (bf16*)(wsp() + WS_PROJ); const float* ROPE = (const float*)(wsp() + WS_ROPE);
    lbf KL = (lbf)(F.lds), VTL = (lbf)(F.lds + 29952), QL = (lbf)(F.lds + 57600 + F.wave * 9216);
    const int tid = F.tid, lane = F.lane, wave = F.wave, fr = lane & 15, fq = lane >> 4;
    for (int unit = F.bid - nskip; unit < 512; unit += F.G - nskip) {
        const int b = unit >> 8, kvh = (unit >> 7) & 1, q0 = (unit & 127) * 64;
        for (int task = tid; task < 208 * 4; task += NTHR) { const int kl = task >> 2, seg = task & 3, tk = q0 - 128 + kl; v4u w0 = {0u, 0u, 0u, 0u}, w1 = {0u, 0u, 0u, 0u};
            if (kl < 192 && tk >= 0) { const int mk = b * SEQ + tk; const v4u* p = (const v4u*)(PROJ + (size_t)mk * DINP + C_SWK + kvh * 64 + 16 * seg); w0 = p[0]; w1 = p[1];
                if (seg == 0) rope16(w0, w1, ROPE + mk * 16); }
            *(LAS v4u*)(KL + kl * 72 + 16 * seg) = w0; *(LAS v4u*)(KL + kl * 72 + 16 * seg + 8) = w1; }
        for (int task = tid; task < 192 * 8; task += NTHR) { const int kl = task >> 3, seg = task & 7, tk = q0 - 128 + kl; v4u w = {0u, 0u, 0u, 0u};
            if (tk >= 0) w = *(const v4u*)(PROJ + (size_t)(b * SEQ + tk) * DINP + C_SWV + kvh * 64 + 8 * seg);
#pragma unroll
            for (int j = 0; j < 4; ++j) { VTL[(8 * seg + 2 * j) * 216 + kl] = (bf16)(w[j] & 0xffffu); VTL[(8 * seg + 2 * j + 1) * 216 + kl] = (bf16)(w[j] >> 16); } }
        for (int i = tid; i < 1024; i += NTHR) VTL[(i >> 4) * 216 + 192 + (i & 15)] = 0;
        { const int mq = b * SEQ + q0 + lane; const v4u* qp = (const v4u*)(PROJ + (size_t)mq * DINP + C_SWQ + (kvh * 8 + wave) * 64);
          v4u w[8];
#pragma unroll
          for (int i = 0; i < 8; ++i) w[i] = qp[i];
          rope16(w[0], w[1], ROPE + mq * 16);
#pragma unroll
          for (int i = 0; i < 8; ++i) { v4u o;
#pragma unroll
              for (int j = 0; j < 4; ++j) o[j] = pk2(bflo(w[i][j]) * 0.125f, bfhi(w[i][j]) * 0.125f);
              *(LAS v4u*)(QL + lane * 72 + 8 * i) = o; } }
        __syncthreads();
        const float sink = inp(8)[l * 16 + kvh * 8 + wave];
#pragma unroll 1
        for (int qt = 0; qt < 4; ++qt) {
            bf16x8 qf[2];
#pragma unroll
            for (int ks = 0; ks < 2; ++ks) qf[ks] = *(const LAS bf16x8*)(QL + (16 * qt + fr) * 72 + 32 * ks + 8 * fq);
            f32x4 st[10];
#pragma unroll
            for (int t = 0; t < 10; ++t) { st[t] = (f32x4){0.f, 0.f, 0.f, 0.f};
#pragma unroll
                for (int ks = 0; ks < 2; ++ks) { const bf16x8 kf = *(const LAS bf16x8*)(KL + (16 * (qt + t) + fr) * 72 + 32 * ks + 8 * fq); st[t] = MFMA16(kf, qf[ks], st[t]); } }
            const int qr = 16 * qt + fr; float mx = -1e30f;
#pragma unroll
            for (int t = 0; t < 10; ++t)
#pragma unroll
                for (int r = 0; r < 4; ++r) { const int kl = 16 * (qt + t) + 4 * fq + r; const bool ok = (kl > qr) && (kl <= qr + 128) && (q0 - 128 + kl >= 0);
                    st[t][r] = ok ? st[t][r] : -1e30f; mx = fmaxf(mx, st[t][r]); }
            mx = fmaxf(mx, __shfl_xor(mx, 16)); mx = fmaxf(mx, __shfl_xor(mx, 32)); mx = fmaxf(mx, sink);
            float sum = 0.f;
#pragma unroll
            for (int t = 0; t < 10; ++t)
#pragma unroll
                for (int r = 0; r < 4; ++r) { const float p = (st[t][r] > -1e29f) ? __expf(st[t][r] - mx) : 0.f; st[t][r] = p; sum += p; }
            sum += __shfl_xor(sum, 16); sum += __shfl_xor(sum, 32);
            const float inv = 1.f / (sum + __expf(sink - mx));
            bf16x8 pf[5];
#pragma unroll
            for (int pr = 0; pr < 5; ++pr) { v4u w; w.x = pk2(st[2 * pr][0] * inv, st[2 * pr][1] * inv); w.y = pk2(st[2 * pr][2] * inv, st[2 * pr][3] * inv);
                w.z = pk2(st[2 * pr + 1][0] * inv, st[2 * pr + 1][1] * inv); w.w = pk2(st[2 * pr + 1][2] * inv, st[2 * pr + 1][3] * inv); pf[pr] = __builtin_bit_cast(bf16x8, w); }
#pragma unroll
            for (int dt = 0; dt < 4; ++dt) { f32x4 acc = {0.f, 0.f, 0.f, 0.f};
#pragma unroll
                for (int pr = 0; pr < 5; ++pr) { const v2u a0 = *(const LAS v2u*)(VTL + (16 * dt + fr) * 216 + 16 * (qt + 2 * pr) + 4 * fq), a1 = *(const LAS v2u*)(VTL + (16 * dt + fr) * 216 + 16 * (qt + 2 * pr + 1) + 4 * fq);
                    v4u aw; aw.x = a0.x; aw.y = a0.y; aw.z = a1.x; aw.w = a1.y; acc = MFMA16(__builtin_bit_cast(bf16x8, aw), pf[pr], acc); }
                v2u w; w.x = pk2(acc[0], acc[1]); w.y = pk2(acc[2], acc[3]);
                *(v2u*)(PROJ + (size_t)(b * SEQ + q0 + 16 * qt + fr) * DINP + C_SWQ + (kvh * 8 + wave) * 64 + 16 * dt + 4 * fq) = w; }
        }
        __syncthreads();
    }
}
__device__ __forceinline__ void dn_naive(Frame& F_, int l) {
    Frame F = mkframe(); const int b = F.bid >> 3, h = F.bid & 7;
    const bf16* PROJ = (const bf16*)(wsp() + WS_PROJ); bf16* ORAW = (bf16*)(wsp() + WS_XN);
    LAS float* vals = (LAS float*)F.lds;
    LAS float* part = vals + 768;
    LAS float* bg = part + 16;
    LAS float* red = bg + 4;
    LAS float* red2 = red + 1024;
    const int tid = F.tid, lane = F.lane, wave = F.wave;
    const int e = tid & 127, r = tid >> 7;
    int col; float cw0 = 0.f, cw1 = 0.f, cw2 = 0.f, cw3 = 0.f;
    if (tid < 384) { const int chan = (tid >> 7) * 1024 + h * 128 + (tid & 127); col = chan; const float* cw = inp(4) + (size_t)l * 4 * 3072;
        cw0 = cw[chan]; cw1 = cw[3072 + chan]; cw2 = cw[2 * 3072 + chan]; cw3 = cw[3 * 3072 + chan]; }
    else if (tid == 384) col = C_DNB + h; else if (tid == 385) col = C_DNA + h; else col = 0;
    const float a_neg = -__expf(inp(5)[l * 8 + h]), dtb = inp(6)[l * 8 + h];
    float S[32];
#pragma unroll
    for (int i = 0; i < 32; ++i) S[i] = 0.f;
    float x0 = 0.f, x1 = 0.f, x2 = 0.f;
    const bf16* pcol = PROJ + (size_t)b * SEQ * DINP + col;
    float cur[16], nxt[16];
#pragma unroll
    for (int i = 0; i < 16; ++i) cur[i] = bf1(pcol[(size_t)i * DINP]);
    for (int tb = 0; tb < SEQ; tb += 16) {
        if (tb + 16 < SEQ) {
#pragma unroll
            for (int i = 0; i < 16; ++i) nxt[i] = bf1(pcol[(size_t)(tb + 16 + i) * DINP]);
        }
#pragma unroll
        for (int i = 0; i < 16; ++i) {
            const int t = tb + i, buf = i & 1;
            const float xin = cur[i];
            if (tid < 384) {
                const float y = cw0 * x0 + cw1 * x1 + cw2 * x2 + cw3 * xin; x0 = x1; x1 = x2; x2 = xin;
                const float s = siluf_(y); vals[buf * 384 + tid] = s;
                const float ss = wave_sum(s * s); if (lane == 0) part[buf * 8 + wave] = ss;
            } else if (tid == 384) { bg[buf * 2 + 0] = sigmoidf_(xin); }
            else if (tid == 385) { const float z = xin + dtb; const float sp = (z > 20.f) ? z : log1pf(__expf(z)); bg[buf * 2 + 1] = __expf(a_neg * sp); }
            __syncthreads();
            const float sq = rsqrtf(part[buf * 8 + 0] + part[buf * 8 + 1] + EPS) * 0.08838834764831845f;
            const float sk = rsqrtf(part[buf * 8 + 2] + part[buf * 8 + 3] + EPS);
            const float beta = bg[buf * 2 + 0], eg = bg[buf * 2 + 1];
            const LAS float* qv = vals + buf * 384 + 32 * r; const LAS float* kv = vals + buf * 384 + 128 + 32 * r;
            float pk = 0.f, pq = 0.f, pqk = 0.f;
#pragma unroll
            for (int dd = 0; dd < 32; ++dd) { const float kd = kv[dd], qd = qv[dd]; pk += kd * S[dd]; pq += qd * S[dd]; pqk += qd * kd; }
            red[(buf * 4 + r) * 128 + e] = pk * sk; red[((1 - buf) * 4 + r) * 128 + e] = pq * sq;
            if (e == 0) red2[r] = pqk;
            __syncthreads();
            float kS = 0.f, qS = 0.f;
#pragma unroll
            for (int rr = 0; rr < 4; ++rr) { kS += red[(buf * 4 + rr) * 128 + e]; qS += red[((1 - buf) * 4 + rr) * 128 + e]; }
            const float qk = (red2[0] + red2[1] + red2[2] + red2[3]) * sq * sk;
            const float ve = vals[buf * 384 + 256 + e];
            const float delta = beta * (ve - eg * kS);
            if (r == 0) ORAW[(size_t)(b * SEQ + t) * D + h * 128 + e] = (bf16)f2bf(eg * qS + qk * delta);
            const float kdl = sk * delta;
#pragma unroll
            for (int dd = 0; dd < 32; ++dd) S[dd] = eg * S[dd] + kv[dd] * kdl;
            __syncthreads();
        }
#pragma unroll
        for (int i = 0; i < 16; ++i) cur[i] = nxt[i];
    }
}
__device__ __forceinline__ void swa_naive(Frame& F_, int l, int nskip) {
    Frame F = mkframe(); const int w0 = (F.bid - nskip) * NWAVES + F.wave, nw = (F.G - nskip) * NWAVES;
    bf16* PROJ = (bf16*)(wsp() + WS_PROJ); const float* ROPE = (const float*)(wsp() + WS_ROPE);
    LAS float* qs = (LAS float*)(F.lds + F.wave * 8192);
    LAS float* ps = qs + 512;
    const int lane = F.lane;
    for (int task = w0; task < M * 2; task += nw) {
        const int m = task >> 1, kvh = task & 1, b = m / SEQ, t = m % SEQ;
        { const float c = ROPE[m * 16 + (lane & 7)], s = ROPE[m * 16 + 8 + (lane & 7)];
#pragma unroll
          for (int g = 0; g < 8; ++g) { const float x = bf1(PROJ[(size_t)m * DINP + C_SWQ + (kvh * 8 + g) * 64 + lane]); const float p = __shfl_xor(x, 8);
              const float y = (lane < 8) ? (x * c - p * s) : ((lane < 16) ? (x * c + p * s) : x); qs[g * 64 + lane] = y * 0.125f; } }
        asm volatile("s_waitcnt lgkmcnt(0)" ::: "memory");
#pragma unroll 1
        for (int kk = 0; kk < 2; ++kk) {
            const int tk = t - 127 + lane + 64 * kk; const bool valid = tk >= 0; const int mk = b * SEQ + (valid ? tk : 0);
            float kf[64];
            const v4u* kr = (const v4u*)(PROJ + (size_t)mk * DINP + C_SWK + kvh * 64);
#pragma unroll
            for (int i = 0; i < 8; ++i) { const v4u w = kr[i];
#pragma unroll
                for (int j = 0; j < 4; ++j) { kf[8 * i + 2 * j] = bflo(w[j]); kf[8 * i + 2 * j + 1] = bfhi(w[j]); } }
#pragma unroll
            for (int j = 0; j < 8; ++j) { const float c = ROPE[mk * 16 + j], s = ROPE[mk * 16 + 8 + j]; const float a = kf[j], bb = kf[j + 8]; kf[j] = a * c - bb * s; kf[j + 8] = bb * c + a * s; }
#pragma unroll
            for (int g = 0; g < 8; ++g) { float a = 0.f;
#pragma unroll
                for (int d4 = 0; d4 < 16; ++d4) { const f32x4 q = *(const LAS f32x4*)(qs + g * 64 + 4 * d4); a += q.x * kf[4 * d4] + q.y * kf[4 * d4 + 1] + q.z * kf[4 * d4 + 2] + q.w * kf[4 * d4 + 3]; }
                ps[(lane + 64 * kk) * 8 + g] = valid ? a : -1e30f; }
        }
        asm volatile("s_waitcnt lgkmcnt(0)" ::: "memory");
#pragma unroll
        for (int g = 0; g < 8; ++g) {
            const float sink = inp(8)[l * 16 + kvh * 8 + g];
            const float s0 = ps[lane * 8 + g], s1 = ps[(lane + 64) * 8 + g];
            const float mx = fmaxf(wave_max(fmaxf(s0, s1)), sink);
            const float p0 = (s0 > -1e29f) ? __expf(s0 - mx) : 0.f, p1 = (s1 > -1e29f) ? __expf(s1 - mx) : 0.f;
            const float den = wave_sum(p0 + p1) + __expf(sink - mx); const float inv = 1.f / den;
            ps[lane * 8 + g] = p0 * inv; ps[(lane + 64) * 8 + g] = p1 * inv;
        }
        asm volatile("s_waitcnt lgkmcnt(0)" ::: "memory");
        float o[8];
#pragma unroll
        for (int g = 0; g < 8; ++g) o[g] = 0.f;
        const int j0 = (t >= 127) ? 0 : (127 - t);
        for (int j = j0; j < 128; ++j) {
            const int mk = b * SEQ + t - 127 + j;
            const float v = bf1(PROJ[(size_t)mk * DINP + C_SWV + kvh * 64 + lane]);
            const f32x4 pa = *(const LAS f32x4*)(ps + j * 8), pb = *(const LAS f32x4*)(ps + j * 8 + 4);
            o[0] += pa.x * v; o[1] += pa.y * v; o[2] += pa.z * v; o[3] += pa.w * v; o[4] += pb.x * v; o[5] += pb.y * v; o[6] += pb.z * v; o[7] += pb.w * v;
        }
#pragma unroll
        for (int g = 0; g < 8; ++g) PROJ[(size_t)m * DINP + C_SWQ + (kvh * 8 + g) * 64 + lane] = (bf16)f2bf(o[g]);
        asm volatile("s_waitcnt lgkmcnt(0)" ::: "memory");
    }
}
__device__ __forceinline__ void phase_gnorm(Frame& F_, int l) {
    Frame F = mkframe();
    bf16* PROJ = (bf16*)(wsp() + WS_PROJ); const bf16* ORAW = (const bf16*)(wsp() + WS_XN);
    const int gw = F.bid * NWAVES + F.wave, NGW = F.G * NWAVES;
    const float g0 = inp(7)[l * 128 + 2 * F.lane], g1 = inp(7)[l * 128 + 2 * F.lane + 1];
    for (int m = gw; m < M; m += NGW) {
        unsigned ow[8], zw[8];
#pragma unroll
        for (int h = 0; h < 8; ++h) { ow[h] = *(const unsigned*)(ORAW + (size_t)m * D + h * 128 + 2 * F.lane); zw[h] = *(const unsigned*)(PROJ + (size_t)m * DINP + C_DNZ + h * 128 + 2 * F.lane); }
        float ss[8];
#pragma unroll
        for (int h = 0; h < 8; ++h) { const float o0 = bflo(ow[h]), o1 = bfhi(ow[h]); ss[h] = o0 * o0 + o1 * o1; }
#pragma unroll
        for (int o = 1; o < 64; o <<= 1) {
#pragma unroll
            for (int h = 0; h < 8; ++h) ss[h] += __shfl_xor(ss[h], o); }
#pragma unroll
        for (int h = 0; h < 8; ++h) { const float r = rsqrtf(ss[h] * (1.f / 128.f) + EPS);
            *(unsigned*)(PROJ + (size_t)m * DINP + C_DNQ + h * 128 + 2 * F.lane) = pk2(bflo(ow[h]) * r * g0 * siluf_(bflo(zw[h])), bfhi(ow[h]) * r * g1 * siluf_(bfhi(zw[h]))); }
    }
}

#ifndef PROBE_ECHO
#define PROBE_ECHO 0
#endif
#define ECHO_BEGIN(k) do { if (PROBE_ECHO == (k)) echo_t0 = __builtin_amdgcn_s_memrealtime(); } while (0)
#define ECHO_END(k) do { if (PROBE_ECHO == (k)) { const unsigned long long t1_ = __builtin_amdgcn_s_memrealtime(), d_ = t1_ - echo_t0; while (__builtin_amdgcn_s_memrealtime() - t1_ < d_) __builtin_amdgcn_s_sleep(8); } } while (0)
#ifndef PROBE_DUP
#define PROBE_DUP 0
#endif
#ifndef DN_NAIVE
#define DN_NAIVE 0
#endif
struct Args { const float* in[17]; float* out; unsigned char* ws; };
__global__ void __launch_bounds__(NTHR, 2) hybrid_fwd(Args args) {
    cg::grid_group grid = cg::this_grid();
    Frame F;
    F.lds = lds_base();
    F.tid = threadIdx.x; F.lane = F.tid & 63; F.wave = __builtin_amdgcn_readfirstlane(F.tid >> 6);
    F.G = gridDim.x; F.bid = blockIdx.x;
#define PROJ ((bf16*)(wsp() + WS_PROJ))
#define XN ((bf16*)(wsp() + WS_XN))
#define YF ((float*)(wsp() + WS_YF))
#define MIX ((bf16*)(wsp() + WS_MIX))
#define HB ((bf16*)(wsp() + WS_H))

    unsigned long long echo_t0 = 0; (void)echo_t0;
    ECHO_BEGIN(9); ECHO_BEGIN(10); ECHO_BEGIN(11);
    if (F.bid == 0) { for (int i = F.tid; i < XCD_BAR_WORDS; i += NTHR) ((unsigned*)(wsp() + WS_BAR))[i] = 0u; for (int i = F.tid; i < 16384; i += NTHR) ((unsigned*)(wsp() + WS_XCNT))[i] = 0u; if (F.tid < 256) ((unsigned*)(wsp() + WS_SUBCNT))[F.tid] = 0u; }
    if (F.tid < 4) ((LAS unsigned*)(lds_base() + LDS_BARST))[F.tid] = 0u;
    grid.sync();
    ECHO_END(10);
    xcd_barrier_post();
    phase_rope(F);
    phase_norm(F, nullptr, nullptr, inp(0), outp(), inp(2), XN);
    phase_convert(F, -1, 0, 0);
    grid_bar();
    ECHO_END(9);
    for (int l = 0; l < DEPTH; ++l) {
        ECHO_BEGIN(1);
        {
            pg8::Gemm g{XN, (const bf16*)(wsp() + WS_WIN), nullptr, nullptr, M, DINP, D, D}; pg8::StaticOrder S; { Frame Fg = mkframe(); S.init(M, DINP, Fg.G, Fg.bid); }
            pg8::EpiBf16<0> E{PROJ, DINP};
            pg8::gemm_phase<pg8::EpiBf16<0>, pg8::StaticOrder, true, true>(F.lds, g, S, E);
#if PROBE_DUP == 5
            pg8::gemm_phase<pg8::EpiBf16<0>, pg8::StaticOrder, true, true>(F.lds, g, S, E);
#endif
        }
        grid_bar(); ECHO_END(1); ECHO_BEGIN(2);
#if DN_NAIVE
        if (F.bid < 16) dn_naive(F, l);
        else swa_naive(F, l, 16);
#else
#if PROBE_DUP == 1
        dn_prep<0>(F, l);
#elif PROBE_DUP == 11
        dn_prep<1>(F, l);
#elif PROBE_DUP == 12
        dn_prep<2>(F, l);
#elif PROBE_DUP == 13
        dn_prep<3>(F, l);
#elif PROBE_DUP == 14
        dn_prep<4>(F, l);
#endif
        dn_prep<0>(F, l);
        grid_bar(); ECHO_END(2); ECHO_BEGIN(3);
        { Frame Fg = mkframe(); if (Fg.bid < 64) { const int sid_ = (((Fg.bid & 7) * 2 + (Fg.bid >> 5)) << 2) | ((Fg.bid >> 3) & 3); dn_scan<0>(F, sid_);
#if PROBE_DUP == 2
            dn_scan<0>(F, sid_);
#elif PROBE_DUP == 3
            dn_scan<1>(F, sid_);
#elif PROBE_DUP == 4
            dn_scan<2>(F, sid_);
#endif
        }
        else {
            phase_convert(F, l, (l + 1 < DEPTH) ? l + 1 : -1, 64);
            __syncthreads();
            swa_mfma(F, l, 64);
            sub_bar((unsigned*)(wsp() + WS_SUBCNT) + 64 * l, (unsigned)(Fg.G - 64));
            pg8::Gemm g{PROJ + C_SWQ, (const bf16*)(wsp() + WS_WUPSW), nullptr, nullptr, M, D, D, DINP}; pg8::StaticOrder S; S.init(M, D, Fg.G - 64, Fg.bid - 64);
            pg8::EpiYb E{PROJ + C_DNK, DINP, PROJ + C_GB, DINP};
            pg8::gemm_phase<pg8::EpiYb, pg8::StaticOrder, true, true>(F.lds, g, S, E);
        } }
#endif
        grid_bar(); ECHO_END(3); ECHO_BEGIN(4);
        phase_gnorm(F, l);
#if PROBE_DUP == 6
        phase_gnorm(F, l);
#endif
        grid_bar(); ECHO_END(4); ECHO_BEGIN(5);
        {
            pg8::Gemm g{PROJ + C_DNQ, (const bf16*)(wsp() + WS_WUPDN), nullptr, nullptr, M, D, D, DINP}; pg8::StaticOrder S; { Frame Fg = mkframe(); S.init(M, D, Fg.G, Fg.bid); }
            pg8::EpiMerge2 E{MIX, D, PROJ + C_GA, PROJ + C_DNK, DINP};
            pg8::gemm_phase<pg8::EpiMerge2, pg8::StaticOrder, false, true>(F.lds, g, S, E);
        }
        grid_bar(); ECHO_END(5); ECHO_BEGIN(6);
        {
            pg8::Gemm g{MIX, (const bf16*)(wsp() + WS_WO), nullptr, nullptr, M, D, D, D}; pg8::StaticOrder S; { Frame Fg = mkframe(); S.init(M, D, Fg.G, Fg.bid); }
            pg8::RmsExchange e1{(float*)(wsp() + WS_XSLOT), (unsigned*)(wsp() + WS_XCNT) + ((l * 4 + 0) * 64) * 16}, e2{(float*)(wsp() + WS_XSLOT + 262144), (unsigned*)(wsp() + WS_XCNT) + ((l * 4 + 1) * 64) * 16};
            pg8::EpiRmsRes E{outp(), inp(12) + l * D, inp(13) + l * D, XN, e1, e2};
            pg8::gemm_phase<pg8::EpiRmsRes, pg8::StaticOrder, false, true>(F.lds, g, S, E);
        }
        grid_bar(); ECHO_END(6); ECHO_BEGIN(7);
        {
            pg8::Gemm g{XN, (const bf16*)(wsp() + WS_WFF1), nullptr, nullptr, M, FF, D, D}; pg8::StaticOrder S; { Frame Fg = mkframe(); S.init(M, FF, Fg.G, Fg.bid); }
            pg8::EpiBf16<2> E{HB, FF};
            pg8::gemm_phase<pg8::EpiBf16<2>, pg8::StaticOrder, true, true>(F.lds, g, S, E);
#if PROBE_DUP == 7
            pg8::gemm_phase<pg8::EpiBf16<2>, pg8::StaticOrder, true, true>(F.lds, g, S, E);
#endif
        }
        grid_bar(); ECHO_END(7); ECHO_BEGIN(8);
        {
            pg8::Gemm g{HB, (const bf16*)(wsp() + WS_WFF2), nullptr, nullptr, M, D, FF, FF}; pg8::StaticOrder S; { Frame Fg = mkframe(); S.init(M, D, Fg.G, Fg.bid); }
            pg8::RmsExchange e1{(float*)(wsp() + WS_XSLOT), (unsigned*)(wsp() + WS_XCNT) + ((l * 4 + 2) * 64) * 16}, e2{(float*)(wsp() + WS_XSLOT + 262144), (unsigned*)(wsp() + WS_XCNT) + ((l * 4 + 3) * 64) * 16};
            pg8::EpiRmsRes E{outp(), inp(16) + l * D, (l + 1 < DEPTH) ? inp(2) + (l + 1) * D : nullptr, XN, e1, e2};
            pg8::gemm_phase<pg8::EpiRmsRes, pg8::StaticOrder, false, true>(F.lds, g, S, E);
        }
        if (l + 1 < DEPTH) grid_bar();
        ECHO_END(8);
    }
    ECHO_END(11);
#undef PROJ
#undef XN
#undef YF
#undef MIX
#undef HB
}

extern "C" void kernel_launch(void* const* d_in, const int* in_sizes, int n_in, void* d_out, int out_size, void* d_ws, size_t ws_size, hipStream_t stream) {
    static int init = 0;
    if (!init) {
        if (n_in != 17 || out_size != M * D || ws_size < WS_END) { fprintf(stderr, "kernel_launch: unexpected shapes (n_in %d out %d ws %zu)\n", n_in, out_size, ws_size); init = -1; return; }
        if (hipFuncSetAttribute((const void*)hybrid_fwd, hipFuncAttributeMaxDynamicSharedMemorySize, LDS_BYTES) != hipSuccess) { fprintf(stderr, "hipFuncSetAttribute failed\n"); init = -1; return; }
        init = 1;
    }
    if (init < 0) return;
    Args a{};
    for (int i = 0; i < 17; ++i) a.in[i] = (const float*)d_in[i];
    a.out = (float*)d_out; a.ws = (unsigned char*)d_ws;
    void* args[] = {&a};
    hipError_t e = hipLaunchCooperativeKernel((void*)hybrid_fwd, dim3(256), dim3(NTHR), args, LDS_BYTES, stream);
    if (e != hipSuccess) fprintf(stderr, "cooperative launch failed: %s\n", hipGetErrorString(e));
}
```

```cpp
#include <hip/hip_runtime.h>
#include <hip/hip_cooperative_groups.h>
#include <cstdio>
#include <cstdint>
namespace cg = cooperative_groups;

namespace pg8 {
#define PG8_LAS __attribute__((address_space(3)))
typedef unsigned short bf16_t;
typedef short bf16x8 __attribute__((ext_vector_type(8)));
typedef float f32x4 __attribute__((ext_vector_type(4)));
typedef unsigned u32x4 __attribute__((ext_vector_type(4)));
constexpr int BM = 256, BK = 64, HALF = 128, HTB = HALF * BK * 2, STAGE_BYTES = 8 * HTB, NXCD = 8, WGM = 8;

__host__ __device__ __forceinline__ int lds_byte(int r, int c) { const int st = (r >> 4) * 2 + (c >> 5), rr = r & 15, cc = c & 31, ob = rr * 64 + cc * 2; return st * 1024 + (ob ^ (((ob >> 9) & 1) << 5)); }
__host__ __device__ __forceinline__ void stage_rc(int b, int& R, int& C) { const int st = b / 1024, sb = b % 1024, swz = sb ^ (((sb >> 9) & 1) << 5); R = (st >> 1) * 16 + swz / 64; C = (st & 1) * 32 + (swz % 64) / 2; }
__host__ __device__ __forceinline__ int perm32(int rho) { const int n = rho >> 4, i = rho & 15; return 8 * (i >> 2) + 4 * n + (i & 3); }

struct Unit { int pm, pn, src; };
struct Gemm { const bf16_t* A; const bf16_t* Bt; const bf16_t* A2; const bf16_t* Bt2; int M, N, K, lda; };

struct StaticOrder {
    int nM, nN, nwg, G, c;
    __host__ __device__ void init(int M, int N, int G_, int c_) { nM = M / BM; nN = N / BM; nwg = nM * nN; G = G_; c = c_; }
    __host__ __device__ bool tile(long L, Unit& u) const {
        if (L >= nwg) return false;
        int wgid = (int)L; { const int q = nwg / NXCD, r = nwg % NXCD, xcd = wgid % NXCD, off = wgid / NXCD; wgid = (xcd < r ? xcd * (q + 1) : r * (q + 1) + (xcd - r) * q) + off; }
        const int nig = WGM * nN, gid = wgid / nig, fm = gid * WGM, gsz = (nM - fm) < WGM ? (nM - fm) : WGM;
        u.pm = fm + ((wgid % nig) % gsz); u.pn = (wgid % nig) / gsz; u.src = 0; return true;
    }
    __host__ __device__ bool next(int i, Unit& u) const { return tile((long)i * G + c, u); }
};
struct DualOrder {
    StaticOrder S;
    __host__ __device__ bool next(int i, Unit& u) const { const bool ok = S.tile((long)(i >> 1) * S.G + S.c, u); u.src = i & 1; return ok; }
};

typedef float f32x2c __attribute__((ext_vector_type(2)));
typedef __bf16 bf16x2c __attribute__((ext_vector_type(2)));
__device__ __forceinline__ unsigned cvt_pk_bf16(float lo, float hi) { const f32x2c v = {lo, hi}; return __builtin_bit_cast(unsigned, __builtin_convertvector(v, bf16x2c)); }
__device__ __forceinline__ float bf_lo(unsigned w) { return __uint_as_float(w << 16); }
__device__ __forceinline__ float bf_hi(unsigned w) { return __uint_as_float(w & 0xffff0000u); }

template <int ACT  > struct EpiBf16 {
    static constexpr bool PERM = true, DUAL = false, AFTER_DRAIN = false;
    bf16_t* O; int ldc;
    __device__ __forceinline__ void mid(f32x4 (&acc)[2][2][4][2], const Unit& u, int wr, int wc, int fr, int fq) const {}
    __device__ __forceinline__ void operator()(const f32x4 (&acc)[2][2][4][2], const Unit& u, int wr, int wc, int fr, int fq) const {
        const int row0 = u.pm * BM + wr * 64 + fr; const int col0 = u.pn * BM + wc * 32 + 8 * fq;
#pragma unroll
        for (int ai = 0; ai < 2; ++ai)
#pragma unroll
            for (int m = 0; m < 4; ++m) { bf16_t* rowp = O + (size_t)(row0 + ai * HALF + m * 16) * ldc + col0;
#pragma unroll
                for (int bj = 0; bj < 2; ++bj) { f32x4 v0 = acc[ai][bj][m][0], v1 = acc[ai][bj][m][1];
                    if (ACT == 2) {
#pragma unroll
                        for (int e = 0; e < 4; ++e) { const float a = fmaxf(v0[e], 0.f), b = fmaxf(v1[e], 0.f); v0[e] = a * a; v1[e] = b * b; } }
                    u32x4 w; w.x = cvt_pk_bf16(v0[0], v0[1]); w.y = cvt_pk_bf16(v0[2], v0[3]); w.z = cvt_pk_bf16(v1[0], v1[1]); w.w = cvt_pk_bf16(v1[2], v1[3]);
                    *(u32x4*)(rowp + bj * HALF) = w; } }
    }
};
struct EpiF32 {
    static constexpr bool PERM = false, DUAL = false, AFTER_DRAIN = false;
    float* O; int ldc;
    __device__ __forceinline__ void mid(f32x4 (&acc)[2][2][4][2], const Unit& u, int wr, int wc, int fr, int fq) const {}
    __device__ __forceinline__ void operator()(const f32x4 (&acc)[2][2][4][2], const Unit& u, int wr, int wc, int fr, int fq) const {
        float* rowp = O + (size_t)(u.pm * BM + wr * 64 + fr) * ldc + (u.pn * BM + wc * 32 + 4 * fq);
#pragma unroll
        for (int ai = 0; ai < 2; ++ai) {
#pragma unroll
            for (int m = 0; m < 4; ++m) {
#pragma unroll
                for (int bj = 0; bj < 2; ++bj)
#pragma unroll
                    for (int n = 0; n < 2; ++n) *(f32x4*)(rowp + bj * HALF + n * 16) = acc[ai][bj][m][n];
                rowp += (size_t)16 * ldc; asm volatile("" : "+v"(rowp) :: "memory"); }
            rowp += (size_t)64 * ldc; }
    }
};
struct EpiMerge {
    static constexpr bool PERM = true, DUAL = true, AFTER_DRAIN = false;
    bf16_t* O; int ldc; const bf16_t* GA; const bf16_t* GB; int ldg;
    __device__ __forceinline__ void mid(f32x4 (&acc)[2][2][4][2], const Unit& u, int wr, int wc, int fr, int fq) const {
        const int row0 = u.pm * BM + wr * 64 + fr; const int col0 = u.pn * BM + wc * 32 + 8 * fq;
#pragma unroll
        for (int ai = 0; ai < 2; ++ai)
#pragma unroll
            for (int m = 0; m < 4; ++m) { const size_t ro = (size_t)(row0 + ai * HALF + m * 16) * ldg + col0;
#pragma unroll
                for (int bj = 0; bj < 2; ++bj) { const u32x4 ga = *(const u32x4*)(GA + ro + bj * HALF), gb = *(const u32x4*)(GB + ro + bj * HALF);
#pragma unroll
                    for (int e = 0; e < 4; ++e) { const unsigned wa = ga[e], wb = gb[e];
                        const float r0 = (1.f + __expf(-bf_lo(wb))) / (1.f + __expf(-bf_lo(wa))), r1 = (1.f + __expf(-bf_hi(wb))) / (1.f + __expf(-bf_hi(wa)));
                        if (e < 2) { acc[ai][bj][m][0][2 * e] *= r0; acc[ai][bj][m][0][2 * e + 1] *= r1; } else { acc[ai][bj][m][1][2 * (e - 2)] *= r0; acc[ai][bj][m][1][2 * (e - 2) + 1] *= r1; } } } }
    }
    __device__ __forceinline__ void operator()(const f32x4 (&acc)[2][2][4][2], const Unit& u, int wr, int wc, int fr, int fq) const {
        const int row0 = u.pm * BM + wr * 64 + fr; const int col0 = u.pn * BM + wc * 32 + 8 * fq;
#pragma unroll
        for (int ai = 0; ai < 2; ++ai)
#pragma unroll
            for (int m = 0; m < 4; ++m) { const size_t ro = (size_t)(row0 + ai * HALF + m * 16) * ldg + col0; bf16_t* rowp = O + (size_t)(row0 + ai * HALF + m * 16) * ldc + col0;
#pragma unroll
                for (int bj = 0; bj < 2; ++bj) { const u32x4 gb = *(const u32x4*)(GB + ro + bj * HALF); f32x4 v0 = acc[ai][bj][m][0], v1 = acc[ai][bj][m][1];
                    float s[8];
#pragma unroll
                    for (int e = 0; e < 4; ++e) { s[2 * e] = 1.f / (1.f + __expf(-bf_lo(gb[e]))); s[2 * e + 1] = 1.f / (1.f + __expf(-bf_hi(gb[e]))); }
                    u32x4 w; w.x = cvt_pk_bf16(v0[0] * s[0], v0[1] * s[1]); w.y = cvt_pk_bf16(v0[2] * s[2], v0[3] * s[3]); w.z = cvt_pk_bf16(v1[0] * s[4], v1[1] * s[5]); w.w = cvt_pk_bf16(v1[2] * s[6], v1[3] * s[7]);
                    *(u32x4*)(rowp + bj * HALF) = w; } }
    }
};

struct EpiYb {
    static constexpr bool PERM = true, DUAL = false, AFTER_DRAIN = false;
    bf16_t* O; int ldc; const bf16_t* GB; int ldg;
    __device__ __forceinline__ void mid(f32x4 (&acc)[2][2][4][2], const Unit& u, int wr, int wc, int fr, int fq) const {}
    __device__ __forceinline__ void operator()(const f32x4 (&acc)[2][2][4][2], const Unit& u, int wr, int wc, int fr, int fq) const {
        const int row0 = u.pm * BM + wr * 64 + fr; const int col0 = u.pn * BM + wc * 32 + 8 * fq;
#pragma unroll
        for (int ai = 0; ai < 2; ++ai)
#pragma unroll
            for (int m = 0; m < 4; ++m) { const size_t ro = (size_t)(row0 + ai * HALF + m * 16) * ldg + col0; bf16_t* rowp = O + (size_t)(row0 + ai * HALF + m * 16) * ldc + col0;
#pragma unroll
                for (int bj = 0; bj < 2; ++bj) { const u32x4 gb = *(const u32x4*)(GB + ro + bj * HALF); const f32x4 v0 = acc[ai][bj][m][0], v1 = acc[ai][bj][m][1];
                    float s[8];
#pragma unroll
                    for (int e = 0; e < 4; ++e) { s[2 * e] = __builtin_amdgcn_rcpf(1.f + __expf(-bf_lo(gb[e]))); s[2 * e + 1] = __builtin_amdgcn_rcpf(1.f + __expf(-bf_hi(gb[e]))); }
                    u32x4 w; w.x = cvt_pk_bf16(v0[0] * s[0], v0[1] * s[1]); w.y = cvt_pk_bf16(v0[2] * s[2], v0[3] * s[3]); w.z = cvt_pk_bf16(v1[0] * s[4], v1[1] * s[5]); w.w = cvt_pk_bf16(v1[2] * s[6], v1[3] * s[7]);
                    *(u32x4*)(rowp + bj * HALF) = w; } }
    }
};
struct EpiMerge2 {
    static constexpr bool PERM = true, DUAL = false, AFTER_DRAIN = false;
    bf16_t* O; int ldc; const bf16_t* GA; const bf16_t* YB; int ldg;
    __device__ __forceinline__ void mid(f32x4 (&acc)[2][2][4][2], const Unit& u, int wr, int wc, int fr, int fq) const {}
    __device__ __forceinline__ void operator()(const f32x4 (&acc)[2][2][4][2], const Unit& u, int wr, int wc, int fr, int fq) const {
        const int row0 = u.pm * BM + wr * 64 + fr; const int col0 = u.pn * BM + wc * 32 + 8 * fq;
#pragma unroll
        for (int ai = 0; ai < 2; ++ai)
#pragma unroll
            for (int m = 0; m < 4; ++m) { const size_t ro = (size_t)(row0 + ai * HALF + m * 16) * ldg + col0; bf16_t* rowp = O + (size_t)(row0 + ai * HALF + m * 16) * ldc + col0;
#pragma unroll
                for (int bj = 0; bj < 2; ++bj) { const u32x4 ga = *(const u32x4*)(GA + ro + bj * HALF), yb = *(const u32x4*)(YB + ro + bj * HALF); const f32x4 v0 = acc[ai][bj][m][0], v1 = acc[ai][bj][m][1];
                    float o[8];
#pragma unroll
                    for (int e = 0; e < 4; ++e) { const float a0 = (e < 2) ? v0[2 * e] : v1[2 * (e - 2)], a1 = (e < 2) ? v0[2 * e + 1] : v1[2 * (e - 2) + 1];
                        o[2 * e] = a0 * __builtin_amdgcn_rcpf(1.f + __expf(-bf_lo(ga[e]))) + bf_lo(yb[e]); o[2 * e + 1] = a1 * __builtin_amdgcn_rcpf(1.f + __expf(-bf_hi(ga[e]))) + bf_hi(yb[e]); }
                    u32x4 w; w.x = cvt_pk_bf16(o[0], o[1]); w.y = cvt_pk_bf16(o[2], o[3]); w.z = cvt_pk_bf16(o[4], o[5]); w.w = cvt_pk_bf16(o[6], o[7]);
                    *(u32x4*)(rowp + bj * HALF) = w; } }
    }
};
struct RmsExchange {
    float* slots;
    unsigned* cnt;
    __device__ __forceinline__ void run(const f32x4 (&v)[2][2][4][2], const Unit& u, int wr, int wc, int fr, int fq, PG8_LAS unsigned char* lds, int wid, int lane) const {
        PG8_LAS float* P = (PG8_LAS float*)lds;
        PG8_LAS float* S = (PG8_LAS float*)(lds + 4096);
#pragma unroll
        for (int ai = 0; ai < 2; ++ai)
#pragma unroll
            for (int m = 0; m < 4; ++m) { float s = 0.f;
#pragma unroll
                for (int bj = 0; bj < 2; ++bj)
#pragma unroll
                    for (int n = 0; n < 2; ++n) { const f32x4 x = v[ai][bj][m][n]; s += (x[0] * x[0] + x[1] * x[1]) + (x[2] * x[2] + x[3] * x[3]); }
                s += __shfl_xor(s, 16); s += __shfl_xor(s, 32);
                if (fq == 0) P[(ai * HALF + wr * 64 + m * 16 + fr) * 4 + wc] = s; }
        asm volatile("s_waitcnt vmcnt(0) lgkmcnt(0)" ::: "memory"); __builtin_amdgcn_s_barrier(); asm volatile("" ::: "memory");
        const int row = wid * 64 + lane;
        if (wid < 4) {
            const f32x4 p = *(const PG8_LAS f32x4*)(P + row * 4);
            __hip_atomic_store(slots + ((size_t)(u.pm * BM + row) * 4 + u.pn), (p[0] + p[1]) + (p[2] + p[3]), __ATOMIC_RELAXED, __HIP_MEMORY_SCOPE_AGENT);
            asm volatile("s_waitcnt vmcnt(0)" ::: "memory");
            if (lane == 0) __hip_atomic_fetch_add(cnt + 16 * u.pm, 1u, __ATOMIC_RELAXED, __HIP_MEMORY_SCOPE_AGENT);
        }
        if (wid == 0) {
            unsigned sp = 0;
            while ((unsigned)__builtin_amdgcn_readfirstlane(__hip_atomic_load(cnt + 16 * u.pm, __ATOMIC_RELAXED, __HIP_MEMORY_SCOPE_AGENT)) < 16u) { __builtin_amdgcn_s_sleep(1); if (++sp > (1u << 22)) break; }
            __builtin_amdgcn_fence(__ATOMIC_ACQUIRE, "agent");
        }
        asm volatile("s_waitcnt vmcnt(0) lgkmcnt(0)" ::: "memory"); __builtin_amdgcn_s_barrier(); asm volatile("" ::: "memory");
        if (wid < 4) {
            const float* sl = slots + (size_t)(u.pm * BM + row) * 4; float t = 0.f;
#pragma unroll
            for (int k = 0; k < 4; ++k) t += __hip_atomic_load(sl + k, __ATOMIC_RELAXED, __HIP_MEMORY_SCOPE_AGENT);
            S[row] = rsqrtf(t * (1.0f / 1024.0f) + 1e-6f);
        }
        asm volatile("s_waitcnt vmcnt(0) lgkmcnt(0)" ::: "memory"); __builtin_amdgcn_s_barrier(); asm volatile("" ::: "memory");
    }
};
struct EpiRmsRes {
    static constexpr bool PERM = false, DUAL = false, AFTER_DRAIN = true;
    float* x; const float* gpost; const float* gnext; bf16_t* xn; RmsExchange e1, e2;
    __device__ __forceinline__ void mid(f32x4 (&acc)[2][2][4][2], const Unit& u, int wr, int wc, int fr, int fq) const {}
    __device__ __forceinline__ void operator()(const f32x4 (&acc)[2][2][4][2], const Unit& u, int wr, int wc, int fr, int fq) const {}
    __device__ __forceinline__ void fused(f32x4 (&acc)[2][2][4][2], const Unit& u, int wr, int wc, int fr, int fq, PG8_LAS unsigned char* lds, int wid, int lane) const {
        typedef unsigned u32x2v __attribute__((ext_vector_type(2)));
        const PG8_LAS float* S = (const PG8_LAS float*)(lds + 4096);
        const int col0 = u.pn * BM + wc * 32 + 4 * fq;
        bf16_t* xb = (bf16_t*)x;
        u32x2v pre[2][4][2][2];
#pragma unroll
        for (int ai = 0; ai < 2; ++ai)
#pragma unroll
            for (int m = 0; m < 4; ++m) { const bf16_t* xp = xb + (size_t)(u.pm * BM + ai * HALF + wr * 64 + m * 16 + fr) * 2048 + col0;
#pragma unroll
                for (int bj = 0; bj < 2; ++bj)
#pragma unroll
                    for (int n = 0; n < 2; ++n) pre[ai][m][bj][n] = *(const u32x2v*)(xp + bj * HALF + n * 16); }
        e1.run(acc, u, wr, wc, fr, fq, lds, wid, lane);
        f32x4 g[2][2];
#pragma unroll
        for (int bj = 0; bj < 2; ++bj)
#pragma unroll
            for (int n = 0; n < 2; ++n) g[bj][n] = *(const f32x4*)(gpost + col0 + bj * HALF + n * 16);
#pragma unroll
        for (int ai = 0; ai < 2; ++ai)
#pragma unroll
            for (int m = 0; m < 4; ++m) { const int r = ai * HALF + wr * 64 + m * 16 + fr; const float sr = S[r];
#pragma unroll
                for (int bj = 0; bj < 2; ++bj)
#pragma unroll
                    for (int n = 0; n < 2; ++n) { const u32x2v pw = pre[ai][m][bj][n]; const f32x4 xv = {bf_lo(pw.x), bf_hi(pw.x), bf_lo(pw.y), bf_hi(pw.y)};
                        const f32x4 o = xv + acc[ai][bj][m][n] * sr * g[bj][n]; acc[ai][bj][m][n] = o;
                        if (gnext) { u32x2v w; w.x = cvt_pk_bf16(o[0], o[1]); w.y = cvt_pk_bf16(o[2], o[3]); *(u32x2v*)(xb + (size_t)(u.pm * BM + r) * 2048 + col0 + bj * HALF + n * 16) = w; }
                        else *(f32x4*)(x + (size_t)(u.pm * BM + r) * 1024 + col0 + bj * HALF + n * 16) = o; } }
        if (gnext) {
            e2.run(acc, u, wr, wc, fr, fq, lds, wid, lane);
#pragma unroll
            for (int bj = 0; bj < 2; ++bj)
#pragma unroll
                for (int n = 0; n < 2; ++n) g[bj][n] = *(const f32x4*)(gnext + col0 + bj * HALF + n * 16);
#pragma unroll
            for (int ai = 0; ai < 2; ++ai)
#pragma unroll
                for (int m = 0; m < 4; ++m) { const int r = ai * HALF + wr * 64 + m * 16 + fr; const float sr = S[r]; bf16_t* op = xn + (size_t)(u.pm * BM + r) * 1024 + col0;
#pragma unroll
                    for (int bj = 0; bj < 2; ++bj)
#pragma unroll
                        for (int n = 0; n < 2; ++n) { const f32x4 o = acc[ai][bj][m][n] * sr * g[bj][n]; u32x2v w; w.x = cvt_pk_bf16(o[0], o[1]); w.y = cvt_pk_bf16(o[2], o[3]); *(u32x2v*)(op + bj * HALF + n * 16) = w; } }
        }
    }
};
template <class Epi, class Sched, bool ALIGN_EPI = false, bool SP2 = false>
__device__ __forceinline__ void gemm_phase(PG8_LAS unsigned char* lds, const Gemm g, const Sched& S, const Epi& E) {
    int tid_ = threadIdx.x; asm volatile("" : "+v"(tid_)); const int tid = tid_, wid = __builtin_amdgcn_readfirstlane(tid >> 6), lane = tid & 63, wr = wid >> 2, wc = wid & 3, fr = lane & 15, fq = lane >> 4;
    const int K = g.K, nt = K / BK, lda = g.lda;
    unsigned voffA[2], voffB[2];
#pragma unroll
    for (int i = 0; i < 2; ++i) { int R, C; stage_rc(tid * 16 + i * 8192, R, C); const int Rb = Epi::PERM ? ((R & ~31) + perm32(R & 31)) : R;
        voffA[i] = (unsigned)(R * lda + C) * 2u; voffB[i] = (unsigned)(Rb * K + C) * 2u; }
    const size_t kstep = (size_t)(BK * 2);
    const size_t hstepA = (size_t)HALF * lda * 2, hstepB = (size_t)HALF * K * 2;
    const size_t tstepA = 2 * hstepA, tstepB = 2 * hstepB;
    const unsigned ldsw = (unsigned)wid * 1024u;
    const int aoff = lds_byte(wr * 64 + fr, fq * 8), boff = lds_byte(wc * 32 + fr, fq * 8);
#define PG8_SA(b, h) (((b) * 2 + (h)) * HTB)
#define PG8_SB(b, h) ((4 + (b) * 2 + (h)) * HTB)
#define PG8_STAGE(bufoff, gbase, voff) do { _Pragma("unroll") for (int _i = 0; _i < 2; ++_i) \
        __builtin_amdgcn_global_load_lds((const unsigned*)((const char*)(gbase) + (voff)[_i]), (PG8_LAS unsigned*)(lds + (bufoff) + ldsw + _i * 8192), 16, 0, 0); } while (0)
#define PG8_LDA(dst, b, h) do { _Pragma("unroll") for (int m = 0; m < 4; ++m) _Pragma("unroll") for (int k = 0; k < 2; ++k) dst[m][k] = *(const PG8_LAS bf16x8*)(lds + PG8_SA(b, h) + aoff + m * 2048 + k * 1024); } while (0)
#define PG8_LDB(dst, b, h) do { _Pragma("unroll") for (int n = 0; n < 2; ++n) _Pragma("unroll") for (int k = 0; k < 2; ++k) dst[n][k] = *(const PG8_LAS bf16x8*)(lds + PG8_SB(b, h) + boff + n * 2048 + k * 1024); } while (0)
#define PG8_MMA(ai, bj, At, Bt) do { __builtin_amdgcn_s_setprio(1); _Pragma("unroll") for (int m = 0; m < 4; ++m) _Pragma("unroll") for (int n = 0; n < 2; ++n) _Pragma("unroll") for (int k = 0; k < 2; ++k) \
        acc[ai][bj][m][n] = __builtin_amdgcn_mfma_f32_16x16x32_bf16(Bt[n][k], At[m][k], acc[ai][bj][m][n], 0, 0, 0); __builtin_amdgcn_s_setprio(0); } while (0)
#define PG8_WAIT_V(n) asm volatile("s_waitcnt vmcnt(" #n ")" ::: "memory")
#define PG8_WAIT_L(n) asm volatile("s_waitcnt lgkmcnt(" #n ")" ::: "memory")
#define PG8_BAR __builtin_amdgcn_s_barrier()
#define PG8_SCHED __builtin_amdgcn_sched_barrier(0)
    Unit cur, nxt; int ui = 0;
    if (!S.next(0, cur)) return;
    f32x4 acc[2][2][4][2];
#pragma unroll
    for (int a = 0; a < 2; ++a)
#pragma unroll
        for (int b = 0; b < 2; ++b)
#pragma unroll
            for (int m = 0; m < 4; ++m)
#pragma unroll
                for (int n = 0; n < 2; ++n) acc[a][b][m][n] = (f32x4){0.f, 0.f, 0.f, 0.f};
    bf16x8 At[4][2], B0[2][2], B1[2][2];
    const char* cA = (const char*)(cur.src ? g.A2 : g.A) + (size_t)cur.pm * tstepA; const char* cB = (const char*)(cur.src ? g.Bt2 : g.Bt) + (size_t)cur.pn * tstepB;
    if constexpr (SP2) {
        PG8_STAGE(PG8_SB(0, 0), cB, voffB); PG8_STAGE(PG8_SB(0, 1), cB + hstepB, voffB); PG8_STAGE(PG8_SA(0, 0), cA, voffA); PG8_STAGE(PG8_SA(0, 1), cA + hstepA, voffA);
        if (wr == 1) PG8_BAR;
        PG8_WAIT_V(2); PG8_BAR;
        PG8_STAGE(PG8_SB(1, 0), cB + kstep, voffB); PG8_STAGE(PG8_SA(1, 0), cA + kstep, voffA); PG8_STAGE(PG8_SB(1, 1), cB + hstepB + kstep, voffB);
        PG8_WAIT_V(6); PG8_BAR;
    } else {
        PG8_STAGE(PG8_SB(0, 0), cB, voffB); PG8_STAGE(PG8_SA(0, 0), cA, voffA); PG8_STAGE(PG8_SB(0, 1), cB + hstepB, voffB); PG8_STAGE(PG8_SA(0, 1), cA + hstepA, voffA);
        if (wr == 1) PG8_BAR;
        PG8_WAIT_V(4); PG8_BAR;
        PG8_STAGE(PG8_SB(1, 0), cB + kstep, voffB); PG8_STAGE(PG8_SA(1, 0), cA + kstep, voffA); PG8_STAGE(PG8_SB(1, 1), cB + hstepB + kstep, voffB);
        PG8_WAIT_V(6); PG8_BAR;
    }
    for (;;) {
        const bool has_next = S.next(ui + 1, nxt);
        const char* nA = has_next ? (const char*)(nxt.src ? g.A2 : g.A) + (size_t)nxt.pm * tstepA : cA; const char* nB = has_next ? (const char*)(nxt.src ? g.Bt2 : g.Bt) + (size_t)nxt.pn * tstepB : cB;
        for (int t = 0; t < nt; t += 2) {
            const bool last = (t == nt - 2);
            const char* a1 = cA + (size_t)(t + 1) * kstep;
            const char* a2 = last ? nA : cA + (size_t)(t + 2) * kstep; const char* b2 = last ? nB : cB + (size_t)(t + 2) * kstep;
            const char* a3 = a2 + kstep; const char* b3 = b2 + kstep;
            if constexpr (SP2) {
            PG8_LDB(B0, 0, 0); PG8_LDB(B1, 0, 1); PG8_SCHED; PG8_LDA(At, 0, 0); PG8_STAGE(PG8_SA(1, 1), a1 + hstepA, voffA);
            PG8_WAIT_V(8); PG8_WAIT_L(0); PG8_BAR; PG8_MMA(0, 0, At, B0); PG8_MMA(0, 1, At, B1); PG8_BAR; PG8_SCHED;
            PG8_LDA(At, 0, 1); PG8_STAGE(PG8_SB(0, 0), b2, voffB); PG8_STAGE(PG8_SB(0, 1), b2 + hstepB, voffB); PG8_STAGE(PG8_SA(0, 0), a2, voffA);
            PG8_WAIT_V(8); PG8_WAIT_L(0); PG8_BAR; PG8_MMA(1, 0, At, B0); PG8_MMA(1, 1, At, B1); PG8_BAR; PG8_SCHED;
            PG8_LDB(B0, 1, 0); PG8_LDB(B1, 1, 1); PG8_SCHED; PG8_LDA(At, 1, 0); PG8_STAGE(PG8_SA(0, 1), a2 + hstepA, voffA);
            PG8_WAIT_V(8); PG8_WAIT_L(0); PG8_BAR; PG8_MMA(0, 0, At, B0); PG8_MMA(0, 1, At, B1); PG8_BAR; PG8_SCHED;
            PG8_LDA(At, 1, 1); PG8_STAGE(PG8_SB(1, 0), b3, voffB); PG8_STAGE(PG8_SB(1, 1), b3 + hstepB, voffB); PG8_STAGE(PG8_SA(1, 0), a3, voffA);
            PG8_WAIT_V(8); PG8_WAIT_L(0); PG8_BAR; PG8_MMA(1, 0, At, B0); PG8_MMA(1, 1, At, B1); PG8_BAR; PG8_SCHED;
            } else {
            PG8_LDB(B0, 0, 0); PG8_SCHED; PG8_LDA(At, 0, 0); PG8_STAGE(PG8_SA(1, 1), a1 + hstepA, voffA);
            PG8_WAIT_L(8); PG8_BAR; PG8_WAIT_L(0); PG8_MMA(0, 0, At, B0); PG8_BAR; PG8_SCHED;
            PG8_LDB(B1, 0, 1); PG8_STAGE(PG8_SB(0, 0), b2, voffB);
            PG8_BAR; PG8_WAIT_L(0); PG8_MMA(0, 1, At, B1); PG8_BAR;
            PG8_LDA(At, 0, 1); PG8_STAGE(PG8_SA(0, 0), a2, voffA);
            PG8_BAR; PG8_WAIT_L(0); PG8_MMA(1, 0, At, B0); PG8_BAR; PG8_SCHED;
            PG8_STAGE(PG8_SB(0, 1), b2 + hstepB, voffB);
            PG8_WAIT_V(6); PG8_BAR; PG8_MMA(1, 1, At, B1); PG8_BAR;
            PG8_LDB(B0, 1, 0); PG8_SCHED; PG8_LDA(At, 1, 0); PG8_STAGE(PG8_SA(0, 1), a2 + hstepA, voffA);
            PG8_WAIT_L(8); PG8_BAR; PG8_WAIT_L(0); PG8_MMA(0, 0, At, B0); PG8_BAR; PG8_SCHED;
            PG8_LDB(B1, 1, 1); PG8_STAGE(PG8_SB(1, 0), b3, voffB);
            PG8_BAR; PG8_WAIT_L(0); PG8_MMA(0, 1, At, B1); PG8_BAR;
            PG8_LDA(At, 1, 1); PG8_STAGE(PG8_SA(1, 0), a3, voffA);
            PG8_BAR; PG8_WAIT_L(0); PG8_MMA(1, 0, At, B0); PG8_BAR; PG8_SCHED;
            PG8_STAGE(PG8_SB(1, 1), b3 + hstepB, voffB);
            PG8_WAIT_V(6); PG8_BAR; PG8_MMA(1, 1, At, B1); PG8_BAR;
            }
        }
        if constexpr (ALIGN_EPI) { if (wr == 0) PG8_BAR; }
        const bool midu = Epi::DUAL && cur.src == 0;
        if constexpr (!Epi::AFTER_DRAIN) { if (midu) E.mid(acc, cur, wr, wc, fr, fq); else E(acc, cur, wr, wc, fr, fq); }
        if (!has_next) break;
        if (!midu) {
#pragma unroll
        for (int a = 0; a < 2; ++a)
#pragma unroll
            for (int b = 0; b < 2; ++b)
#pragma unroll
                for (int m = 0; m < 4; ++m)
#pragma unroll
                    for (int n = 0; n < 2; ++n) acc[a][b][m][n] = (f32x4){0.f, 0.f, 0.f, 0.f};
        }
        cur = nxt; cA = nA; cB = nB; ++ui;
        if constexpr (ALIGN_EPI) { if (wr == 1) PG8_BAR; }
    }
    PG8_WAIT_V(0);
    if constexpr (!ALIGN_EPI) { if (wr == 0) PG8_BAR; }
    PG8_BAR;
    if constexpr (Epi::AFTER_DRAIN) E.fused(acc, cur, wr, wc, fr, fq, lds, wid, lane);
#undef PG8_SA
#undef PG8_SB
#undef PG8_STAGE
#undef PG8_LDA
#undef PG8_LDB
#undef PG8_MMA
#undef PG8_WAIT_V
#undef PG8_WAIT_L
#undef PG8_BAR
#undef PG8_SCHED
}
}

#define GAS __attribute__((address_space(1)))
#define LAS __attribute__((address_space(3)))
typedef unsigned short bf16;
typedef unsigned v4u __attribute__((ext_vector_type(4)));
typedef unsigned v2u __attribute__((ext_vector_type(2)));
typedef float f32x4 __attribute__((ext_vector_type(4)));
typedef short bf16x8 __attribute__((ext_vector_type(8)));
constexpr int NWAVES = 8, NTHR = 512;
constexpr int BATCH = 2, SEQ = 8192, D = 1024, FF = 4096, DEPTH = 4, M = BATCH * SEQ;
constexpr int DIN = 7440, DINP = 7680;
constexpr int C_DNQ = 0, C_DNK = 1024, C_DNV = 2048, C_DNZ = 3072, C_SWQ = 4096, C_GA = 5120, C_GB = 6144, C_SWK = 7168, C_SWV = 7296, C_DNB = 7424, C_DNA = 7432;
constexpr float EPS = 1e-6f;
constexpr size_t MiB = 1u << 20;
constexpr size_t WS_WIN = 1 * MiB, WS_WUPDN = 16 * MiB, WS_WUPSW = 18 * MiB, WS_WO = 20 * MiB, WS_WFF1 = 22 * MiB, WS_WFF2 = 30 * MiB, WS_ROPE = 38 * MiB;
constexpr size_t WS_PROJ = 40 * MiB, WS_H = 40 * MiB, WS_XN = 280 * MiB, WS_YF = 312 * MiB, WS_MIX = 376 * MiB, WS_END = 456 * MiB;
constexpr int LDS_BYTES = 147456;

typedef float f32x2_t __attribute__((ext_vector_type(2)));
typedef __bf16 bf16x2_t __attribute__((ext_vector_type(2)));
__device__ __forceinline__ unsigned pk2(float lo, float hi) { const f32x2_t v = {lo, hi}; return __builtin_bit_cast(unsigned, __builtin_convertvector(v, bf16x2_t)); }
__device__ __forceinline__ unsigned f2bf(float f) { return pk2(f, 0.f) & 0xffffu; }
__device__ __forceinline__ float bflo(unsigned w) { return __uint_as_float(w << 16); }
__device__ __forceinline__ float bfhi(unsigned w) { return __uint_as_float(w & 0xffff0000u); }
__device__ __forceinline__ float bf1(bf16 h) { return __uint_as_float((unsigned)h << 16); }
__device__ __forceinline__ float wave_sum(float v) {
#pragma unroll
    for (int o = 1; o < 64; o <<= 1) v += __shfl_xor(v, o);
    return v;
}
__device__ __forceinline__ float wave_max(float v) {
#pragma unroll
    for (int o = 1; o < 64; o <<= 1) v = fmaxf(v, __shfl_xor(v, o));
    return v;
}
__device__ __forceinline__ float sigmoidf_(float x) { return __builtin_amdgcn_rcpf(1.f + __expf(-x)); }
__device__ __forceinline__ float siluf_(float x) { return x * __builtin_amdgcn_rcpf(1.f + __expf(-x)); }

struct Frame {
    LAS unsigned char* lds;
    int tid, lane, wave, G, bid;
};
__device__ __forceinline__ LAS unsigned char* lds_base() { extern __shared__ __attribute__((aligned(16))) unsigned char lds_dyn[]; return (LAS unsigned char*)lds_dyn; }
__device__ __forceinline__ Frame mkframe() {
    Frame F; F.lds = lds_base(); int tid = threadIdx.x; asm volatile("" : "+v"(tid)); int bid = blockIdx.x; asm volatile("" : "+s"(bid)); int G = gridDim.x; asm volatile("" : "+s"(G));
    F.tid = tid; F.lane = tid & 63; F.wave = __builtin_amdgcn_readfirstlane(tid >> 6); F.G = G; F.bid = bid; return F; }
typedef __attribute__((address_space(4))) const unsigned char* kargp_t;
__device__ __forceinline__ kargp_t kargs() { kargp_t p = (kargp_t)__builtin_amdgcn_kernarg_segment_ptr(); asm volatile("" : "+s"(p)); return p; }
__device__ __forceinline__ const float* inp(int k) { return *(const float* __attribute__((address_space(4))) const*)(kargs() + 8 * k); }
__device__ __forceinline__ float* outp() { return *(float* __attribute__((address_space(4))) const*)(kargs() + 8 * 17); }
__device__ __forceinline__ unsigned char* wsp() { return *(unsigned char* __attribute__((address_space(4))) const*)(kargs() + 8 * 18); }

__device__ __forceinline__ int orig_col(int nc) {
    if (nc < 4096) return nc;
    if (nc < 5120) return nc - 4096 + 4112;
    if (nc < 6144) return nc - 5120 + 5392;
    if (nc < 7168) return nc - 6144 + 6416;
    if (nc < 7296) return nc - 7168 + 5136;
    if (nc < 7424) return nc - 7296 + 5264;
    if (nc < 7440) return nc - 7424 + 4096;
    return -1;
}
template <bool PERMW>
__device__ __forceinline__ void transpose_item(const float* W, int K, int ldw, int nblk, bf16* WT, LAS float* scr, int item, int lane) {
    const int kb = item / nblk, nb = item % nblk, k0 = 64 * kb, n0 = 32 * nb;
    const int ncol = n0 + (lane & 31); const int oc = PERMW ? orig_col(ncol) : ncol;
    float wv[32];
    { const float* wp = W + (size_t)(k0 + (lane >> 5)) * ldw + (oc >= 0 ? oc : 0);
#pragma unroll
      for (int i = 0; i < 32; ++i) wv[i] = wp[(size_t)(2 * i) * ldw]; }
#pragma unroll
    for (int i = 0; i < 32; ++i) scr[(2 * i + (lane >> 5)) * 33 + (lane & 31)] = (oc >= 0) ? wv[i] : 0.f;
    asm volatile("s_waitcnt lgkmcnt(0)" ::: "memory");
    const int c = lane & 7;
#pragma unroll
    for (int j = 0; j < 4; ++j) { const int n = (lane >> 3) + 8 * j; const LAS float* s = scr + (8 * c) * 33 + n;
        v4u o; o.x = pk2(s[0 * 33], s[1 * 33]); o.y = pk2(s[2 * 33], s[3 * 33]); o.z = pk2(s[4 * 33], s[5 * 33]); o.w = pk2(s[6 * 33], s[7 * 33]);
        *(v4u*)(WT + (size_t)(n0 + n) * K + k0 + 8 * c) = o; }
    asm volatile("s_waitcnt lgkmcnt(0)" ::: "memory");
}
__device__ __forceinline__ void phase_convert(Frame& F_, int lrest, int lin, int nskip) {
    Frame F = mkframe();
    LAS float* scr = (LAS float*)(F.lds + F.wave * 16384);
    const int gw = (F.bid - nskip) * NWAVES + F.wave, NGW = (F.G - nskip) * NWAVES;
    constexpr int I_IN = 16 * (DINP / 32), I_SQ = 16 * 32, I_F1 = 16 * (FF / 32), I_F2 = 64 * 32;
    const int n_in = (lin >= 0) ? I_IN : 0, n_rest = (lrest >= 0) ? 3 * I_SQ + I_F1 + I_F2 : 0;
    for (int it = gw; it < n_in + n_rest; it += NGW) {
        int r = it;
        if (r < n_in) { transpose_item<true>(inp(3) + (size_t)lin * D * DIN, D, DIN, DINP / 32, (bf16*)(wsp() + WS_WIN), scr, r, F.lane); continue; } r -= n_in;
        const int l = lrest;
        if (r < I_SQ) { transpose_item<false>(inp(9) + (size_t)l * D * D, D, D, 32, (bf16*)(wsp() + WS_WUPDN), scr, r, F.lane); continue; } r -= I_SQ;
        if (r < I_SQ) { transpose_item<false>(inp(10) + (size_t)l * D * D, D, D, 32, (bf16*)(wsp() + WS_WUPSW), scr, r, F.lane); continue; } r -= I_SQ;
        if (r < I_SQ) { transpose_item<false>(inp(11) + (size_t)l * D * D, D, D, 32, (bf16*)(wsp() + WS_WO), scr, r, F.lane); continue; } r -= I_SQ;
        if (r < I_F1) { transpose_item<false>(inp(14) + (size_t)l * D * FF, D, FF, FF / 32, (bf16*)(wsp() + WS_WFF1), scr, r, F.lane); continue; } r -= I_F1;
        transpose_item<false>(inp(15) + (size_t)l * FF * D, FF, D, 32, (bf16*)(wsp() + WS_WFF2), scr, r, F.lane);
    }
}
__device__ __forceinline__ void phase_rope(Frame& F_) {
    Frame F = mkframe();
    const int* pos = (const int*)inp(1); float* R = (float*)(wsp() + WS_ROPE);
    for (int i = F.bid * NTHR + F.tid; i < M * 8; i += F.G * NTHR) {
        const int m = i >> 3, j = i & 7;
        const float invf = exp2f(-(float)j * (0.125f * 18.931568569324174f));
        const float angf = (float)pos[m] * invf;
        const double a = (double)angf; const double n = rint(a * 0.15915494309189535);
        const float r = (float)(a - n * 6.283185307179586);
        R[m * 16 + j] = __cosf(r); R[m * 16 + 8 + j] = __sinf(r);
    }
}
__device__ __forceinline__ void phase_norm(Frame& F_, const float* y, const float* gpost, const float* xin, float* x, const float* gnext, bf16* XN) {
    Frame F = mkframe();
    const int gw = F.bid * NWAVES + F.wave, NGW = F.G * NWAVES;
    for (int m = gw; m < M; m += NGW) {
        f32x4 v[4];
        const f32x4* xr = (const f32x4*)(xin + (size_t)m * D) + F.lane;
#pragma unroll
        for (int j = 0; j < 4; ++j) v[j] = xr[64 * j];
        if (y) {
            const f32x4* yr = (const f32x4*)(y + (size_t)m * D) + F.lane; f32x4 w[4]; float s = 0.f;
#pragma unroll
            for (int j = 0; j < 4; ++j) { w[j] = yr[64 * j]; s += (w[j].x * w[j].x + w[j].y * w[j].y) + (w[j].z * w[j].z + w[j].w * w[j].w); }
            const float r = rsqrtf(wave_sum(s) * (1.f / D) + EPS);
#pragma unroll
            for (int j = 0; j < 4; ++j) { const f32x4 g = ((const f32x4*)gpost)[F.lane + 64 * j]; v[j] = v[j] + w[j] * r * g; }
        }
        v2u* xo = (v2u*)((bf16*)x + (size_t)m * 2048) + F.lane;
#pragma unroll
        for (int j = 0; j < 4; ++j) { v2u w; w.x = pk2(v[j].x, v[j].y); w.y = pk2(v[j].z, v[j].w); xo[64 * j] = w; }
        if (gnext) {
            float s = 0.f;
#pragma unroll
            for (int j = 0; j < 4; ++j) s += (v[j].x * v[j].x + v[j].y * v[j].y) + (v[j].z * v[j].z + v[j].w * v[j].w);
            const float r = rsqrtf(wave_sum(s) * (1.f / D) + EPS);
            v2u* o = (v2u*)(XN + (size_t)m * D) + F.lane;
#pragma unroll
            for (int j = 0; j < 4; ++j) { const f32x4 g = ((const f32x4*)gnext)[F.lane + 64 * j]; v2u w; w.x = pk2(v[j].x * r * g.x, v[j].y * r * g.y); w.y = pk2(v[j].z * r * g.z, v[j].w * r * g.w); o[64 * j] = w; }
        }
    }
}
constexpr size_t WS_SUBCNT = 196608, WS_BAR = 65536, WS_XCNT = 131072, WS_XSLOT = 39 * MiB;
#define XB_TMO      128
#define XB_XCNT(j)  (256  + 64 * (j))
#define XB_XSUB(j)  (1280 + 64 * (j))
#define XB_XGEN(j)  (2304 + 64 * (j))
#define XB_TOP      3328
#define XB_TOPGEN   3392
#define XCD_BAR_WORDS 3456
#define XB_SPIN_CAP (1u << 22)
constexpr int LDS_BARST = LDS_BYTES - 16;
__device__ __forceinline__ unsigned xb_ld(unsigned* p)              { return __hip_atomic_load(p, __ATOMIC_RELAXED, __HIP_MEMORY_SCOPE_AGENT); }
__device__ __forceinline__ unsigned xb_add(unsigned* p, unsigned v) { return __hip_atomic_fetch_add(p, v, __ATOMIC_RELAXED, __HIP_MEMORY_SCOPE_AGENT); }
__device__ __forceinline__ unsigned xb_xcc_id() { return (unsigned)__builtin_amdgcn_s_getreg((3 << 11) | 20) & 0xFu; }
#define XB_SPIN(cond, bar) do { unsigned _sp = 0; while (cond) { __builtin_amdgcn_s_sleep(1); \
    if ((++_sp & 255u) == 0u) { if (xb_ld(&(bar)[XB_TMO])) break; if (_sp > XB_SPIN_CAP) { atomicAdd(&(bar)[XB_TMO], 1u); break; } } } } while (0)
__device__ __forceinline__ void xcd_barrier_post() {
    if (threadIdx.x == 0) { unsigned* bar = (unsigned*)(wsp() + WS_BAR); (void)xb_add(&bar[XB_XCNT(xb_xcc_id())], 1u); }
}
__device__ __forceinline__ void xcd_barrier_complete(unsigned* bar, unsigned x, unsigned& nloc, unsigned& nx) {
    const unsigned G = gridDim.x * gridDim.y * gridDim.z;
    unsigned sum, cnt, mine, sp = 0u;
    for (;;) {
        sum = 0u; cnt = 0u; mine = 0u;
#pragma unroll
        for (unsigned j = 0; j < 16; ++j) { const unsigned c = xb_ld(&bar[XB_XCNT(j)]); sum += c; cnt += (c > 0u) ? 1u : 0u; mine = (j == x) ? c : mine; }
        if (sum == G) break;
        __builtin_amdgcn_s_sleep(1);
        if ((++sp & 255u) == 0u) { if (xb_ld(&bar[XB_TMO])) break; if (sp > XB_SPIN_CAP) { atomicAdd(&bar[XB_TMO], 1u); break; } }
    }
    nloc = mine > 0u ? mine : 1u; nx = cnt > 0u ? cnt : 1u;
}
__device__ __forceinline__ void grid_bar() {
    asm volatile("s_waitcnt vmcnt(0)" ::: "memory");
    __syncthreads();
    if (threadIdx.x == 0) {
        unsigned* bar = (unsigned*)(wsp() + WS_BAR); const unsigned x = xb_xcc_id();
        volatile LAS unsigned* st = (volatile LAS unsigned*)(lds_base() + LDS_BARST);
        __builtin_amdgcn_s_waitcnt(0);
        unsigned nloc = st[0], nx = st[1];
        if (nloc == 0u) { xcd_barrier_complete(bar, x, nloc, nx); st[0] = nloc; st[1] = nx; }
        const unsigned old = xb_add(&bar[XB_XSUB(x)], 1u);
        const unsigned gen = old / nloc;
        if (old + 1u == (gen + 1u) * nloc) {
            __builtin_amdgcn_fence(__ATOMIC_RELEASE, "agent");
            asm volatile("s_waitcnt vmcnt(0)" ::: "memory");
            const unsigned og = xb_add(&bar[XB_TOP], 1u);
            const unsigned tg = og / nx;
            if (og + 1u == (tg + 1u) * nx) xb_add(&bar[XB_TOPGEN], 1u);
            else XB_SPIN(xb_ld(&bar[XB_TOPGEN]) == tg, bar);
            __builtin_amdgcn_fence(__ATOMIC_ACQUIRE, "agent");
            xb_add(&bar[XB_XGEN(x)], 1u);
            asm volatile("s_waitcnt vmcnt(0)" ::: "memory");
        } else {
            XB_SPIN(xb_ld(&bar[XB_XGEN(x)]) == gen, bar);
            __builtin_amdgcn_fence(__ATOMIC_ACQUIRE, "agent");
            asm volatile("s_waitcnt vmcnt(0)" ::: "memory");
        }
    }
    __syncthreads();
}

__device__ __forceinline__ void sub_bar(unsigned* cnt, unsigned n) {
    asm volatile("s_waitcnt vmcnt(0)" ::: "memory");
    __syncthreads();
    if (threadIdx.x == 0) {
        __builtin_amdgcn_fence(__ATOMIC_RELEASE, "agent");
        asm volatile("s_waitcnt vmcnt(0)" ::: "memory");
        xb_add(cnt, 1u);
        unsigned sp = 0; while (xb_ld(cnt) < n) { __builtin_amdgcn_s_sleep(1); if (++sp > XB_SPIN_CAP) break; }
        __builtin_amdgcn_fence(__ATOMIC_ACQUIRE, "agent");
        asm volatile("s_waitcnt vmcnt(0)" ::: "memory");
    }
    __syncthreads();
}
#define MFMA16(a, b, c) __builtin_amdgcn_mfma_f32_16x16x32_bf16(a, b, c, 0, 0, 0)
constexpr size_t WS_GL = 0, WS_W = 312 * MiB, WS_QD = 344 * MiB, WS_KDT = 376 * MiB, WS_UT = 408 * MiB, WS_AI = 440 * MiB;
typedef LAS unsigned short* lbf;
template <int PMODE>
__device__ __forceinline__ void dn_prep(Frame& F_, int l) {
    Frame F = mkframe();
    const bf16* PROJ = (const bf16*)(wsp() + WS_PROJ);
    lbf QS = (lbf)(F.lds), KS = (lbf)(F.lds + 17408), VT = (lbf)(F.lds + 34816), KGT = (lbf)(F.lds + 53248), KDT = (lbf)(F.lds + 71680), TB = (lbf)(F.lds + 107520);
    LAS float* LM = (LAS float*)(F.lds + 90112); LAS float* GC = (LAS float*)(F.lds + 116736); LAS float* BT = (LAS float*)(F.lds + 116992);
    const int lane = F.lane, wave = F.wave, fr = lane & 15, fq = lane >> 4;
    struct PrepIn { unsigned xr[3][11]; float cw[3][4][2]; bf16 a, b; };
#define PREP_LOAD(X, chx) do { const int ch_ = (chx), h_ = (ch_ >> 7) & 7, n_ = ch_ & 127, m0_ = (ch_ >> 10) * SEQ + n_ * 64; \
        X.a = PROJ[(size_t)(m0_ + lane) * DINP + C_DNA + h_]; X.b = PROJ[(size_t)(m0_ + lane) * DINP + C_DNB + h_]; \
        _Pragma("unroll") for (int ts = 0; ts < 3; ++ts) _Pragma("unroll") for (int j = 0; j < 11; ++j) { const int ii = 8 * wave - 3 + j; \
            X.xr[ts][j] = (n_ * 64 + ii >= 0) ? *(const unsigned*)(PROJ + (size_t)(m0_ + ii) * DINP + ts * 1024 + h_ * 128 + 2 * lane) : 0u; } \
        { const float* cwp = inp(4) + (size_t)l * 4 * 3072 + h_ * 128 + 2 * lane; \
          _Pragma("unroll") for (int ts = 0; ts < 3; ++ts) _Pragma("unroll") for (int j = 0; j < 4; ++j) { X.cw[ts][j][0] = cwp[j * 3072 + ts * 1024]; X.cw[ts][j][1] = cwp[j * 3072 + ts * 1024 + 1]; } } } while (0)
    PrepIn cur; unsigned eat = 0u;
    for (int ch = F.bid; ch < 2048; ch += F.G) {
        const int b = ch >> 10, h = (ch >> 7) & 7, n = ch & 127, m0 = b * SEQ + n * 64;
        PREP_LOAD(cur, ch);
        unsigned touch = 0u;
        if (ch + F.G < 2048 && F.tid < 402) { const int cn = ch + F.G, hn = (cn >> 7) & 7, nn = cn & 127, mn = (cn >> 10) * SEQ + nn * 64; const int rowt = F.tid / 6 - 3, ln = F.tid % 6;
            if (nn * 64 + rowt >= 0) touch = *(const unsigned*)(PROJ + (size_t)(mn + rowt) * DINP + (ln >> 1) * 1024 + hn * 128 + (ln & 1) * 64); }
        const float a_neg = -__expf(inp(5)[l * 8 + h]), dtb = inp(6)[l * 8 + h];
        float gc, beta, gl;
        { const float a_in = bf1(cur.a), b_in = bf1(cur.b);
          const float z = a_in + dtb; const float sp = (z > 20.f) ? z : log1pf(__expf(z)); gc = a_neg * sp;
#pragma unroll
          for (int o = 1; o < 64; o <<= 1) { const float t = __shfl_up(gc, o); if (lane >= o) gc += t; }
          beta = sigmoidf_(b_in); gl = __shfl(gc, 63);
          if (wave == 0) { GC[lane] = gc; BT[lane] = beta; } }
        float sv[8][3][2], pp[16];
#pragma unroll
        for (int rr = 0; rr < 8; ++rr) {
#pragma unroll
            for (int ts = 0; ts < 3; ++ts) { float y0 = 0.f, y1 = 0.f;
#pragma unroll
                for (int j = 0; j < 4; ++j) { const unsigned xw = cur.xr[ts][rr + j]; y0 += cur.cw[ts][j][0] * bflo(xw); y1 += cur.cw[ts][j][1] * bfhi(xw); }
                sv[rr][ts][0] = siluf_(y0); sv[rr][ts][1] = siluf_(y1); }
            pp[2 * rr] = sv[rr][0][0] * sv[rr][0][0] + sv[rr][0][1] * sv[rr][0][1]; pp[2 * rr + 1] = sv[rr][1][0] * sv[rr][1][0] + sv[rr][1][1] * sv[rr][1][1];
        }
        float tot;
        { const bool b5 = (lane & 32) != 0, b4 = (lane & 16) != 0, b3 = (lane & 8) != 0, b2 = (lane & 4) != 0;
          float p8[8], p4[4], p2[2];
#pragma unroll
          for (int k = 0; k < 8; ++k) p8[k] = (b5 ? pp[k + 8] : pp[k]) + __shfl_xor(b5 ? pp[k] : pp[k + 8], 32);
#pragma unroll
          for (int k = 0; k < 4; ++k) p4[k] = (b4 ? p8[k + 4] : p8[k]) + __shfl_xor(b4 ? p8[k] : p8[k + 4], 16);
#pragma unroll
          for (int k = 0; k < 2; ++k) p2[k] = (b3 ? p4[k + 2] : p4[k]) + __shfl_xor(b3 ? p4[k] : p4[k + 2], 8);
          tot = (b2 ? p2[1] : p2[0]) + __shfl_xor(b2 ? p2[0] : p2[1], 4);
          tot += __shfl_xor(tot, 2); tot += __shfl_xor(tot, 1); }
        unsigned kg[2][4], kd[2][4], vb[2][4];
#pragma unroll
        for (int rr = 0; rr < 8; ++rr) {
            const int i = 8 * wave + rr;
            const float gci = __int_as_float(__builtin_amdgcn_readlane(__float_as_int(gc), i)), bi = __int_as_float(__builtin_amdgcn_readlane(__float_as_int(beta), i));
            const float scq = rsqrtf(__int_as_float(__builtin_amdgcn_readlane(__float_as_int(tot), 8 * rr)) + EPS) * 0.08838834764831845f;
            const float sck = rsqrtf(__int_as_float(__builtin_amdgcn_readlane(__float_as_int(tot), 8 * rr + 4)) + EPS);
            const float q0 = sv[rr][0][0] * scq, q1 = sv[rr][0][1] * scq, k0 = sv[rr][1][0] * sck, k1 = sv[rr][1][1] * sck, v0 = sv[rr][2][0], v1 = sv[rr][2][1];
            const float eg = __expf(gci), egl = __expf(gl - gci);
            *(LAS unsigned*)(QS + i * 136 + 2 * lane) = pk2(q0, q1); *(LAS unsigned*)(KS + i * 136 + 2 * lane) = pk2(k0, k1);
            *(unsigned*)((bf16*)(wsp() + WS_QD) + (size_t)ch * 8192 + ((((i >> 4) * 4 + (lane >> 4)) * 64 + ((lane >> 2) & 3) * 16 + (i & 15)) * 8 + 2 * (lane & 3))) = pk2(q0 * eg, q1 * eg);
            const unsigned g0 = f2bf(k0 * bi * eg), g1 = f2bf(k1 * bi * eg), d0 = f2bf(k0 * egl), d1 = f2bf(k1 * egl), u0 = f2bf(v0 * bi), u1 = f2bf(v1 * bi);
            if (rr & 1) { kg[0][rr >> 1] |= g0 << 16; kg[1][rr >> 1] |= g1 << 16; kd[0][rr >> 1] |= d0 << 16; kd[1][rr >> 1] |= d1 << 16; vb[0][rr >> 1] |= u0 << 16; vb[1][rr >> 1] |= u1 << 16; }
            else { kg[0][rr >> 1] = g0; kg[1][rr >> 1] = g1; kd[0][rr >> 1] = d0; kd[1][rr >> 1] = d1; vb[0][rr >> 1] = u0; vb[1][rr >> 1] = u1; }
        }
#pragma unroll
        for (int c = 0; c < 2; ++c) {
            *(LAS v4u*)(KGT + (2 * lane + c) * 72 + 8 * wave) = (v4u){kg[c][0], kg[c][1], kg[c][2], kg[c][3]};
            *(LAS v4u*)(KDT + (2 * lane + c) * 72 + 8 * wave) = (v4u){kd[c][0], kd[c][1], kd[c][2], kd[c][3]};
            *(LAS v4u*)(VT + (2 * lane + c) * 72 + 8 * wave) = (v4u){vb[c][0], vb[c][1], vb[c][2], vb[c][3]};
        }
        __syncthreads();
        if (PMODE == 2) continue;
        { const int ti = wave >> 1;
          bf16x8 kfi[4], qfi[4];
#pragma unroll
          for (int ks = 0; ks < 4; ++ks) { kfi[ks] = *(const LAS bf16x8*)(KS + (16 * ti + fr) * 136 + 32 * ks + 8 * fq); qfi[ks] = *(const LAS bf16x8*)(QS + (16 * ti + fr) * 136 + 32 * ks + 8 * fq); }
#pragma unroll
          for (int tt = 0; tt < 2; ++tt) { const int tj = 2 * (wave & 1) + tt;
              f32x4 akk = {0.f, 0.f, 0.f, 0.f}, aqk = {0.f, 0.f, 0.f, 0.f};
#pragma unroll
              for (int ks = 0; ks < 4; ++ks) { const bf16x8 kfj = *(const LAS bf16x8*)(KS + (16 * tj + fr) * 136 + 32 * ks + 8 * fq); akk = MFMA16(kfi[ks], kfj, akk); aqk = MFMA16(kfj, qfi[ks], aqk); }
              { const int j = 16 * tj + fr; const float gcj = GC[j];
#pragma unroll
                for (int r = 0; r < 4; ++r) { const int i = 16 * ti + 4 * fq + r; LM[i * 68 + j] = (i > j) ? BT[i] * akk[r] * __expf(GC[i] - gcj) : 0.f; } }
              { const int i = 16 * ti + fr; const float gci = GC[i]; float v[4];
#pragma unroll
                for (int r = 0; r < 4; ++r) { const int j = 16 * tj + 4 * fq + r; v[r] = (i >= j) ? aqk[r] * __expf(gci - GC[j]) : 0.f; }
                v2u w; w.x = pk2(v[0], v[1]); w.y = pk2(v[2], v[3]);
                *(v2u*)((bf16*)(wsp() + WS_AI) + (size_t)ch * 4096 + (((ti * 2 + (tj >> 1)) * 64 + ((2 * tj + (fq >> 1)) & 3) * 16 + fr) * 8 + 4 * (fq & 1))) = w; } } }
        __syncthreads();
        {
            LAS float* T11f = (LAS float*)(F.lds + 117248); LAS float* T22f = T11f + 1056; LAS float* Mf = T22f + 1056;
            if (wave < 2 && PMODE != 1) {
                const int cl = lane & 31;
                float x[32]; float clf = (float)cl; asm volatile("" : "+v"(clf));
                LAS float* Lh = LM + (32 * wave) * 68 + 32 * wave; asm volatile("" : "+v"(Lh));
#pragma unroll
                for (int i = 0; i < 32; ++i) x[i] = 0.f;
#pragma unroll
                for (int i = 0; i < 32; ++i) {
                    float a0 = fmaxf(0.f, 1.f - fabsf(clf - (float)i)), a1 = 0.f, a2 = 0.f, a3 = 0.f;
#pragma unroll
                    for (int j4 = 0; j4 < (i + 3) / 4; ++j4) { const f32x4 Lv = *(const LAS f32x4*)(Lh + i * 68 + 4 * j4);
                        a0 -= Lv.x * x[4 * j4]; a1 -= Lv.y * x[4 * j4 + 1]; a2 -= Lv.z * x[4 * j4 + 2]; a3 -= Lv.w * x[4 * j4 + 3]; }
                    x[i] = (a0 + a1) + (a2 + a3);
                }
                if (lane < 32) {
                    LAS float* tf = (wave ? T22f : T11f) + cl; asm volatile("" : "+v"(tf));
                    lbf tb = TB + (32 * wave) * 72 + 32 * wave + cl; asm volatile("" : "+v"(tb));
#pragma unroll
                    for (int i = 0; i < 32; ++i) { tf[i * 33] = x[i]; tb[i * 72] = (bf16)f2bf(x[i]); }
                } else if (wave == 0) {
                    lbf tz = TB + 32 + cl; asm volatile("" : "+v"(tz));
#pragma unroll
                    for (int i = 0; i < 32; ++i) tz[i * 72] = 0;
                }
            }
            __syncthreads();
            const int ti2 = F.tid >> 5, c2 = F.tid & 31;
            if (PMODE != 1) {
                float m0 = 0.f, m1 = 0.f;
#pragma unroll 8
                for (int k = 0; k < 32; ++k) { const float t = T11f[k * 33 + c2]; m0 += LM[(32 + ti2) * 68 + k] * t; m1 += LM[(48 + ti2) * 68 + k] * t; }
                Mf[ti2 * 33 + c2] = m0; Mf[(ti2 + 16) * 33 + c2] = m1;
            }
            __syncthreads();
            if (PMODE != 1) {
                float t0 = 0.f, t1 = 0.f;
#pragma unroll 8
                for (int k = 0; k < 32; ++k) { const float mm = Mf[k * 33 + c2]; t0 -= T22f[ti2 * 33 + k] * mm; t1 -= T22f[(ti2 + 16) * 33 + k] * mm; }
                TB[(32 + ti2) * 72 + c2] = (bf16)f2bf(t0); TB[(48 + ti2) * 72 + c2] = (bf16)f2bf(t1);
            }
        }
        __syncthreads();
        eat ^= touch;
        { const int ti = wave & 3;
          bf16x8 tf[2];
#pragma unroll
          for (int ks = 0; ks < 2; ++ks) tf[ks] = *(const LAS bf16x8*)(TB + (16 * ti + fr) * 72 + 32 * ks + 8 * fq);
#pragma unroll
          for (int q4 = 0; q4 < 4; ++q4) { const int te = (wave >> 2) * 4 + q4;
              f32x4 au = {0.f, 0.f, 0.f, 0.f}, aw = {0.f, 0.f, 0.f, 0.f};
#pragma unroll
              for (int ks = 0; ks < 2; ++ks) { const bf16x8 vf = *(const LAS bf16x8*)(VT + (16 * te + fr) * 72 + 32 * ks + 8 * fq), gf = *(const LAS bf16x8*)(KGT + (16 * te + fr) * 72 + 32 * ks + 8 * fq);
                  au = MFMA16(tf[ks], vf, au); aw = MFMA16(gf, tf[ks], aw); }
              v2u w; w.x = pk2(au[0], au[1]); w.y = pk2(au[2], au[3]);
              *(v2u*)((bf16*)(wsp() + WS_UT) + (size_t)ch * 8192 + ((te * 4 + ti) * 64 + lane) * 4) = w;
              w.x = pk2(aw[0], aw[1]); w.y = pk2(aw[2], aw[3]);
              *(v2u*)((bf16*)(wsp() + WS_W) + (size_t)ch * 8192 + (((ti * 4 + (te >> 1)) * 64 + ((2 * te + (fq >> 1)) & 3) * 16 + fr) * 8 + 4 * (fq & 1))) = w; }
          { const int d = F.tid >> 2, part = F.tid & 3; const LAS v4u* src = (const LAS v4u*)((LAS unsigned char*)KDT + d * 144 + part * 32);
            bf16* dstb = (bf16*)(wsp() + WS_KDT) + (size_t)ch * 8192 + (((d >> 4) * 2 + (part >> 1)) * 64 + (2 * (part & 1)) * 16 + (d & 15)) * 8; *(v4u*)dstb = src[0]; *(v4u*)(dstb + 128) = src[1]; }
          if (F.tid == 0) ((float*)(wsp() + WS_GL))[ch] = gl; }
        __syncthreads();
    }
    if (eat == 0x12345u && fq == 77) GC[0] = 1.f;
}
#undef PREP_LOAD
struct DnSetC { bf16x8 wf[4], qf[4], af[2]; v2u ut[2]; };
struct DnSetS { bf16x8 kf[2][2]; float gl; unsigned pf; };
template <int MODE>
__device__ __forceinline__ void dn_scan(Frame& F_, int sid) {
    Frame F = mkframe();
    const int bh = sid >> 2, slice = sid & 3, b = bh >> 3, h = bh & 7;
    const int lane = F.lane, wave = F.wave, fr = lane & 15, fq = lane >> 4;
    lbf ST = (lbf)(F.lds); lbf VT2 = (lbf)(F.lds + 8704);
    for (int i = F.tid; i < (8704 + 4608) / 4; i += NTHR) ((LAS unsigned*)F.lds)[i] = 0u;
    const bf16* pW = (const bf16*)(wsp() + WS_W) + (size_t)bh * 128 * 8192; const bf16* pQ = (const bf16*)(wsp() + WS_QD) + (size_t)bh * 128 * 8192;
    const bf16* pA = (const bf16*)(wsp() + WS_AI) + (size_t)bh * 128 * 4096; const bf16* pK = (const bf16*)(wsp() + WS_KDT) + (size_t)bh * 128 * 8192;
    const bf16* pU = (const bf16*)(wsp() + WS_UT) + (size_t)bh * 128 * 8192; const float* pG = (const float*)(wsp() + WS_GL) + bh * 128;
    bf16* pO = (bf16*)(wsp() + WS_XN) + (size_t)b * SEQ * D + h * 128 + 32 * slice;
    short eat = 0;
    __syncthreads();
    if (wave < 4) {
        const int mi = wave;
        const unsigned oW = (mi * 4 * 64 + lane) * 8, oA = (mi * 2 * 64 + lane) * 8, oU = ((2 * slice) * 4 + mi) * 256 + lane * 4, oO = (16 * mi + fr) * D + 4 * fq;
#define DNC_LOAD(X, nn) do { const int c_ = (nn) < 128 ? (nn) : 127; \
            X.ut[0] = *(const v2u*)(pU + (size_t)c_ * 8192 + oU); X.ut[1] = *(const v2u*)(pU + (size_t)c_ * 8192 + oU + 1024); \
            _Pragma("unroll") for (int ks = 0; ks < 4; ++ks) { X.wf[ks] = *(const bf16x8*)(pW + (size_t)c_ * 8192 + (oW + 512 * ks)); X.qf[ks] = *(const bf16x8*)(pQ + (size_t)c_ * 8192 + (oW + 512 * ks)); } \
            _Pragma("unroll") for (int ks = 0; ks < 2; ++ks) X.af[ks] = *(const bf16x8*)(pA + (size_t)c_ * 4096 + (oA + 512 * ks)); } while (0)
#define DNC_STEP(X, nn) do { \
            f32x4 c1[2], c2[2]; \
            _Pragma("unroll") for (int ni = 0; ni < 2; ++ni) { c1[ni] = (f32x4){0.f, 0.f, 0.f, 0.f}; c2[ni] = (f32x4){0.f, 0.f, 0.f, 0.f}; \
                _Pragma("unroll") for (int ks = 0; ks < 4; ++ks) { const bf16x8 sf = *(const LAS bf16x8*)(ST + (16 * ni + fr) * 136 + 32 * ks + 8 * fq); c1[ni] = MFMA16(X.wf[ks], sf, c1[ni]); c2[ni] = MFMA16(sf, X.qf[ks], c2[ni]); } \
                v2u w_; w_.x = pk2(bflo(X.ut[ni].x) - c1[ni][0], bfhi(X.ut[ni].x) - c1[ni][1]); w_.y = pk2(bflo(X.ut[ni].y) - c1[ni][2], bfhi(X.ut[ni].y) - c1[ni][3]); \
                *(LAS v2u*)(VT2 + (16 * ni + fr) * 72 + 16 * mi + 4 * fq) = w_; } \
            __syncthreads(); \
            _Pragma("unroll") for (int ni = 0; ni < 2; ++ni) { \
                _Pragma("unroll") for (int ks = 0; ks < 2; ++ks) { const bf16x8 vf = *(const LAS bf16x8*)(VT2 + (16 * ni + fr) * 72 + 32 * ks + 8 * fq); c2[ni] = MFMA16(vf, X.af[ks], c2[ni]); } \
                v2u w_; w_.x = pk2(c2[ni][0], c2[ni][1]); w_.y = pk2(c2[ni][2], c2[ni][3]); if (MODE == 0) *(v2u*)(pO + (size_t)(nn) * 64 * D + oO + 16 * ni) = w_; } \
            __syncthreads(); } while (0)
        DnSetC SA, SB, SC;
        DNC_LOAD(SA, 0); DNC_LOAD(SB, 1);
        for (int n = 0; n < 126; n += 3) {
            DNC_LOAD(SC, n + 2); __builtin_amdgcn_sched_barrier(0); DNC_STEP(SA, n); __builtin_amdgcn_sched_barrier(0);
            DNC_LOAD(SA, n + 3); __builtin_amdgcn_sched_barrier(0); DNC_STEP(SB, n + 1); __builtin_amdgcn_sched_barrier(0);
            DNC_LOAD(SB, n + 4); __builtin_amdgcn_sched_barrier(0); DNC_STEP(SC, n + 2); __builtin_amdgcn_sched_barrier(0);
        }
        DNC_STEP(SA, 126); DNC_STEP(SB, 127);
#undef DNC_LOAD
#undef DNC_STEP
    } else {
        const int dq = wave - 4;
        f32x4 accS[2][2];
#pragma unroll
        for (int k = 0; k < 2; ++k)
#pragma unroll
            for (int ni = 0; ni < 2; ++ni) accS[k][ni] = (f32x4){0.f, 0.f, 0.f, 0.f};
        const int lt = F.tid - 256, li = slice * 112 + lt; const bool toucher = lt < 144;
        const bf16* pfBase = (lt >= 112) ? pU + 2048 * slice + (lt - 112) * 64 : (li < 128) ? pW + li * 64 : (li < 256) ? pQ + (li - 128) * 64 : (li < 384) ? pK + (li - 256) * 64 : pA + (li - 384) * 64;
        const unsigned pfStride = (lt >= 112 || li < 384) ? 8192u : 4096u;
        const unsigned oK = (2 * dq * 2 * 64 + lane) * 8;
#define DNS_LOAD(X, nn) do { const int c_ = (nn) < 128 ? (nn) : 127; eat ^= (short)X.pf; X.gl = pG[c_]; \
            _Pragma("unroll") for (int ks = 0; ks < 2; ++ks) { X.kf[0][ks] = *(const bf16x8*)(pK + (size_t)c_ * 8192 + (oK + 512 * ks)); X.kf[1][ks] = *(const bf16x8*)(pK + (size_t)c_ * 8192 + (oK + 1024 + 512 * ks)); } \
            { const int c2_ = (nn) + 2 < 128 ? (nn) + 2 : 127; X.pf = toucher ? *(const unsigned*)(pfBase + (size_t)c2_ * pfStride) : 0u; } } while (0)
#define DNS_STEP(X, nn) do { \
            const float egl = __expf(X.gl); \
            __syncthreads(); \
            _Pragma("unroll") for (int ni = 0; ni < 2; ++ni) { bf16x8 vf[2]; \
                _Pragma("unroll") for (int ks = 0; ks < 2; ++ks) vf[ks] = *(const LAS bf16x8*)(VT2 + (16 * ni + fr) * 72 + 32 * ks + 8 * fq); \
                _Pragma("unroll") for (int k = 0; k < 2; ++k) { accS[k][ni] = accS[k][ni] * egl; \
                    _Pragma("unroll") for (int ks = 0; ks < 2; ++ks) accS[k][ni] = MFMA16(X.kf[k][ks], vf[ks], accS[k][ni]); \
                    v2u w_; w_.x = pk2(accS[k][ni][0], accS[k][ni][1]); w_.y = pk2(accS[k][ni][2], accS[k][ni][3]); \
                    *(LAS v2u*)(ST + (16 * ni + fr) * 136 + 16 * (2 * dq + k) + 4 * fq) = w_; } } \
            __syncthreads(); } while (0)
        DnSetS SA, SB, SC; SA.pf = 0u; SB.pf = 0u; SC.pf = 0u;
        DNS_LOAD(SA, 0); DNS_LOAD(SB, 1);
        for (int n = 0; n < 126; n += 3) {
            DNS_LOAD(SC, n + 2); __builtin_amdgcn_sched_barrier(0); DNS_STEP(SA, n); __builtin_amdgcn_sched_barrier(0);
            DNS_LOAD(SA, n + 3); __builtin_amdgcn_sched_barrier(0); DNS_STEP(SB, n + 1); __builtin_amdgcn_sched_barrier(0);
            DNS_LOAD(SB, n + 4); __builtin_amdgcn_sched_barrier(0); DNS_STEP(SC, n + 2); __builtin_amdgcn_sched_barrier(0);
        }
        DNS_STEP(SA, 126); DNS_STEP(SB, 127);
#undef DNS_LOAD
#undef DNS_STEP
    }
    if (eat == 12345 && fq == 77) VT2[0] = (bf16)eat;
}
__device__ __forceinline__ void rope16(v4u& w0, v4u& w1, const float* rp) {
    float x[8], y[8];
#pragma unroll
    for (int j = 0; j < 4; ++j) { x[2 * j] = bflo(w0[j]); x[2 * j + 1] = bfhi(w0[j]); y[2 * j] = bflo(w1[j]); y[2 * j + 1] = bfhi(w1[j]); }
    const f32x4 c0 = *(const f32x4*)rp, c1 = *(const f32x4*)(rp + 4), s0 = *(const f32x4*)(rp + 8), s1 = *(const f32x4*)(rp + 12);
    float c[8] = {c0.x, c0.y, c0.z, c0.w, c1.x, c1.y, c1.z, c1.w}, s[8] = {s0.x, s0.y, s0.z, s0.w, s1.x, s1.y, s1.z, s1.w};
#pragma unroll
    for (int j = 0; j < 8; ++j) { const float a = x[j], bb = y[j]; x[j] = a * c[j] - bb * s[j]; y[j] = bb * c[j] + a * s[j]; }
#pragma unroll
    for (int j = 0; j < 4; ++j) { w0[j] = pk2(x[2 * j], x[2 * j + 1]); w1[j] = pk2(y[2 * j], y[2 * j + 1]); }
}
__device__ __forceinline__ void swa_mfma(Frame& F_, int l, int nskip) {
    Frame F = mkframe();
    bf16* PROJ = (bf16*)(wsp() + WS_PROJ); const float* ROPE = (const float*)(wsp() + WS_ROPE);
    lbf KL = (lbf)(F.lds), VTL = (lbf)(F.lds + 29952), QL = (lbf)(F.lds + 57600 + F.wave * 9216);
    const int tid = F.tid, lane = F.lane, wave = F.wave, fr = lane & 15, fq = lane >> 4;
    for (int unit = F.bid - nskip; unit < 512; unit += F.G - nskip) {
        const int b = unit >> 8, kvh = (unit >> 7) & 1, q0 = (unit & 127) * 64;
        for (int task = tid; task < 208 * 4; task += NTHR) { const int kl = task >> 2, seg = task & 3, tk = q0 - 128 + kl; v4u w0 = {0u, 0u, 0u, 0u}, w1 = {0u, 0u, 0u, 0u};
            if (kl < 192 && tk >= 0) { const int mk = b * SEQ + tk; const v4u* p = (const v4u*)(PROJ + (size_t)mk * DINP + C_SWK + kvh * 64 + 16 * seg); w0 = p[0]; w1 = p[1];
                if (seg == 0) rope16(w0, w1, ROPE + mk * 16); }
            *(LAS v4u*)(KL + kl * 72 + 16 * seg) = w0; *(LAS v4u*)(KL + kl * 72 + 16 * seg + 8) = w1; }
        for (int task = tid; task < 192 * 8; task += NTHR) { const int kl = task >> 3, seg = task & 7, tk = q0 - 128 + kl; v4u w = {0u, 0u, 0u, 0u};
            if (tk >= 0) w = *(const v4u*)(PROJ + (size_t)(b * SEQ + tk) * DINP + C_SWV + kvh * 64 + 8 * seg);
#pragma unroll
            for (int j = 0; j < 4; ++j) { VTL[(8 * seg + 2 * j) * 216 + kl] = (bf16)(w[j] & 0xffffu); VTL[(8 * seg + 2 * j + 1) * 216 + kl] = (bf16)(w[j] >> 16); } }
        for (int i = tid; i < 1024; i += NTHR) VTL[(i >> 4) * 216 + 192 + (i & 15)] = 0;
        { const int mq = b * SEQ + q0 + lane; const v4u* qp = (const v4u*)(PROJ + (size_t)mq * DINP + C_SWQ + (kvh * 8 + wave) * 64);
          v4u w[8];
#pragma unroll
          for (int i = 0; i < 8; ++i) w[i] = qp[i];
          rope16(w[0], w[1], ROPE + mq * 16);
#pragma unroll
          for (int i = 0; i < 8; ++i) { v4u o;
#pragma unroll
              for (int j = 0; j < 4; ++j) o[j] = pk2(bflo(w[i][j]) * 0.125f, bfhi(w[i][j]) * 0.125f);
              *(LAS v4u*)(QL + lane * 72 + 8 * i) = o; } }
        __syncthreads();
        const float sink = inp(8)[l * 16 + kvh * 8 + wave];
#pragma unroll 1
        for (int qt = 0; qt < 4; ++qt) {
            bf16x8 qf[2];
#pragma unroll
            for (int ks = 0; ks < 2; ++ks) qf[ks] = *(const LAS bf16x8*)(QL + (16 * qt + fr) * 72 + 32 * ks + 8 * fq);
            f32x4 st[10];
#pragma unroll
            for (int t = 0; t < 10; ++t) { st[t] = (f32x4){0.f, 0.f, 0.f, 0.f};
#pragma unroll
                for (int ks = 0; ks < 2; ++ks) { const bf16x8 kf = *(const LAS bf16x8*)(KL + (16 * (qt + t) + fr) * 72 + 32 * ks + 8 * fq); st[t] = MFMA16(kf, qf[ks], st[t]); } }
            const int qr = 16 * qt + fr; float mx = -1e30f;
#pragma unroll
            for (int t = 0; t < 10; ++t)
#pragma unroll
                for (int r = 0; r < 4; ++r) { const int kl = 16 * (qt + t) + 4 * fq + r; const bool ok = (kl > qr) && (kl <= qr + 128) && (q0 - 128 + kl >= 0);
                    st[t][r] = ok ? st[t][r] : -1e30f; mx = fmaxf(mx, st[t][r]); }
            mx = fmaxf(mx, __shfl_xor(mx, 16)); mx = fmaxf(mx, __shfl_xor(mx, 32)); mx = fmaxf(mx, sink);
            float sum = 0.f;
#pragma unroll
            for (int t = 0; t < 10; ++t)
#pragma unroll
                for (int r = 0; r < 4; ++r) { const float p = (st[t][r] > -1e29f) ? __expf(st[t][r] - mx) : 0.f; st[t][r] = p; sum += p; }
            sum += __shfl_xor(sum, 16); sum += __shfl_xor(sum, 32);
            const float inv = 1.f / (sum + __expf(sink - mx));
            bf16x8 pf[5];
#pragma unroll
            for (int pr = 0; pr < 5; ++pr) { v4u w; w.x = pk2(st[2 * pr][0] * inv, st[2 * pr][1] * inv); w.y = pk2(st[2 * pr][2] * inv, st[2 * pr][3] * inv);
                w.z = pk2(st[2 * pr + 1][0] * inv, st[2 * pr + 1][1] * inv); w.w = pk2(st[2 * pr + 1][2] * inv, st[2 * pr + 1][3] * inv); pf[pr] = __builtin_bit_cast(bf16x8, w); }
#pragma unroll
            for (int dt = 0; dt < 4; ++dt) { f32x4 acc = {0.f, 0.f, 0.f, 0.f};
#pragma unroll
                for (int pr = 0; pr < 5; ++pr) { const v2u a0 = *(const LAS v2u*)(VTL + (16 * dt + fr) * 216 + 16 * (qt + 2 * pr) + 4 * fq), a1 = *(const LAS v2u*)(VTL + (16 * dt + fr) * 216 + 16 * (qt + 2 * pr + 1) + 4 * fq);
                    v4u aw; aw.x = a0.x; aw.y = a0.y; aw.z = a1.x; aw.w = a1.y; acc = MFMA16(__builtin_bit_cast(bf16x8, aw), pf[pr], acc); }
                v2u w; w.x = pk2(acc[0], acc[1]); w.y = pk2(acc[2], acc[3]);
                *(v2u*)(PROJ + (size_t)(b * SEQ + q0 + 16 * qt + fr) * DINP + C_SWQ + (kvh * 8 + wave) * 64 + 16 * dt + 4 * fq) = w; }
        }
        __syncthreads();
    }
}
__device__ __forceinline__ void dn_naive(Frame& F_, int l) {
    Frame F = mkframe(); const int b = F.bid >> 3, h = F.bid & 7;
    const bf16* PROJ = (const bf16*)(wsp() + WS_PROJ); bf16* ORAW = (bf16*)(wsp() + WS_XN);
    LAS float* vals = (LAS float*)F.lds;
    LAS float* part = vals + 768;
    LAS float* bg = part + 16;
    LAS float* red = bg + 4;
    LAS float* red2 = red + 1024;
    const int tid = F.tid, lane = F.lane, wave = F.wave;
    const int e = tid & 127, r = tid >> 7;
    int col; float cw0 = 0.f, cw1 = 0.f, cw2 = 0.f, cw3 = 0.f;
    if (tid < 384) { const int chan = (tid >> 7) * 1024 + h * 128 + (tid & 127); col = chan; const float* cw = inp(4) + (size_t)l * 4 * 3072;
        cw0 = cw[chan]; cw1 = cw[3072 + chan]; cw2 = cw[2 * 3072 + chan]; cw3 = cw[3 * 3072 + chan]; }
    else if (tid == 384) col = C_DNB + h; else if (tid == 385) col = C_DNA + h; else col = 0;
    const float a_neg = -__expf(inp(5)[l * 8 + h]), dtb = inp(6)[l * 8 + h];
    float S[32];
#pragma unroll
    for (int i = 0; i < 32; ++i) S[i] = 0.f;
    float x0 = 0.f, x1 = 0.f, x2 = 0.f;
    const bf16* pcol = PROJ + (size_t)b * SEQ * DINP + col;
    float cur[16], nxt[16];
#pragma unroll
    for (int i = 0; i < 16; ++i) cur[i] = bf1(pcol[(size_t)i * DINP]);
    for (int tb = 0; tb < SEQ; tb += 16) {
        if (tb + 16 < SEQ) {
#pragma unroll
            for (int i = 0; i < 16; ++i) nxt[i] = bf1(pcol[(size_t)(tb + 16 + i) * DINP]);
        }
#pragma unroll
        for (int i = 0; i < 16; ++i) {
            const int t = tb + i, buf = i & 1;
            const float xin = cur[i];
            if (tid < 384) {
                const float y = cw0 * x0 + cw1 * x1 + cw2 * x2 + cw3 * xin; x0 = x1; x1 = x2; x2 = xin;
                const float s = siluf_(y); vals[buf * 384 + tid] = s;
                const float ss = wave_sum(s * s); if (lane == 0) part[buf * 8 + wave] = ss;
            } else if (tid == 384) { bg[buf * 2 + 0] = sigmoidf_(xin); }
            else if (tid == 385) { const float z = xin + dtb; const float sp = (z > 20.f) ? z : log1pf(__expf(z)); bg[buf * 2 + 1] = __expf(a_neg * sp); }
            __syncthreads();
            const float sq = rsqrtf(part[buf * 8 + 0] + part[buf * 8 + 1] + EPS) * 0.08838834764831845f;
            const float sk = rsqrtf(part[buf * 8 + 2] + part[buf * 8 + 3] + EPS);
            const float beta = bg[buf * 2 + 0], eg = bg[buf * 2 + 1];
            const LAS float* qv = vals + buf * 384 + 32 * r; const LAS float* kv = vals + buf * 384 + 128 + 32 * r;
            float pk = 0.f, pq = 0.f, pqk = 0.f;
#pragma unroll
            for (int dd = 0; dd < 32; ++dd) { const float kd = kv[dd], qd = qv[dd]; pk += kd * S[dd]; pq += qd * S[dd]; pqk += qd * kd; }
            red[(buf * 4 + r) * 128 + e] = pk * sk; red[((1 - buf) * 4 + r) * 128 + e] = pq * sq;
            if (e == 0) red2[r] = pqk;
            __syncthreads();
            float kS = 0.f, qS = 0.f;
#pragma unroll
            for (int rr = 0; rr < 4; ++rr) { kS += red[(buf * 4 + rr) * 128 + e]; qS += red[((1 - buf) * 4 + rr) * 128 + e]; }
            const float qk = (red2[0] + red2[1] + red2[2] + red2[3]) * sq * sk;
            const float ve = vals[buf * 384 + 256 + e];
            const float delta = beta * (ve - eg * kS);
            if (r == 0) ORAW[(size_t)(b * SEQ + t) * D + h * 128 + e] = (bf16)f2bf(eg * qS + qk * delta);
            const float kdl = sk * delta;
#pragma unroll
            for (int dd = 0; dd < 32; ++dd) S[dd] = eg * S[dd] + kv[dd] * kdl;
            __syncthreads();
        }
#pragma unroll
        for (int i = 0; i < 16; ++i) cur[i] = nxt[i];
    }
}
__device__ __forceinline__ void swa_naive(Frame& F_, int l, int nskip) {
    Frame F = mkframe(); const int w0 = (F.bid - nskip) * NWAVES + F.wave, nw = (F.G - nskip) * NWAVES;
    bf16* PROJ = (bf16*)(wsp() + WS_PROJ); const float* ROPE = (const float*)(wsp() + WS_ROPE);
    LAS float* qs = (LAS float*)(F.lds + F.wave * 8192);
    LAS float* ps = qs + 512;
    const int lane = F.lane;
    for (int task = w0; task < M * 2; task += nw) {
        const int m = task >> 1, kvh = task & 1, b = m / SEQ, t = m % SEQ;
        { const float c = ROPE[m * 16 + (lane & 7)], s = ROPE[m * 16 + 8 + (lane & 7)];
#pragma unroll
          for (int g = 0; g < 8; ++g) { const float x = bf1(PROJ[(size_t)m * DINP + C_SWQ + (kvh * 8 + g) * 64 + lane]); const float p = __shfl_xor(x, 8);
              const float y = (lane < 8) ? (x * c - p * s) : ((lane < 16) ? (x * c + p * s) : x); qs[g * 64 + lane] = y * 0.125f; } }
        asm volatile("s_waitcnt lgkmcnt(0)" ::: "memory");
#pragma unroll 1
        for (int kk = 0; kk < 2; ++kk) {
            const int tk = t - 127 + lane + 64 * kk; const bool valid = tk >= 0; const int mk = b * SEQ + (valid ? tk : 0);
            float kf[64];
            const v4u* kr = (const v4u*)(PROJ + (size_t)mk * DINP + C_SWK + kvh * 64);
#pragma unroll
            for (int i = 0; i < 8; ++i) { const v4u w = kr[i];
#pragma unroll
                for (int j = 0; j < 4; ++j) { kf[8 * i + 2 * j] = bflo(w[j]); kf[8 * i + 2 * j + 1] = bfhi(w[j]); } }
#pragma unroll
            for (int j = 0; j < 8; ++j) { const float c = ROPE[mk * 16 + j], s = ROPE[mk * 16 + 8 + j]; const float a = kf[j], bb = kf[j + 8]; kf[j] = a * c - bb * s; kf[j + 8] = bb * c + a * s; }
#pragma unroll
            for (int g = 0; g < 8; ++g) { float a = 0.f;
#pragma unroll
                for (int d4 = 0; d4 < 16; ++d4) { const f32x4 q = *(const LAS f32x4*)(qs + g * 64 + 4 * d4); a += q.x * kf[4 * d4] + q.y * kf[4 * d4 + 1] + q.z * kf[4 * d4 + 2] + q.w * kf[4 * d4 + 3]; }
                ps[(lane + 64 * kk) * 8 + g] = valid ? a : -1e30f; }
        }
        asm volatile("s_waitcnt lgkmcnt(0)" ::: "memory");
#pragma unroll
        for (int g = 0; g < 8; ++g) {
            const float sink = inp(8)[l * 16 + kvh * 8 + g];
            const float s0 = ps[lane * 8 + g], s1 = ps[(lane + 64) * 8 + g];
            const float mx = fmaxf(wave_max(fmaxf(s0, s1)), sink);
            const float p0 = (s0 > -1e29f) ? __expf(s0 - mx) : 0.f, p1 = (s1 > -1e29f) ? __expf(s1 - mx) : 0.f;
            const float den = wave_sum(p0 + p1) + __expf(sink - mx); const float inv = 1.f / den;
            ps[lane * 8 + g] = p0 * inv; ps[(lane + 64) * 8 + g] = p1 * inv;
        }
        asm volatile("s_waitcnt lgkmcnt(0)" ::: "memory");
        float o[8];
#pragma unroll
        for (int g = 0; g < 8; ++g) o[g] = 0.f;
        const int j0 = (t >= 127) ? 0 : (127 - t);
        for (int j = j0; j < 128; ++j) {
            const int mk = b * SEQ + t - 127 + j;
            const float v = bf1(PROJ[(size_t)mk * DINP + C_SWV + kvh * 64 + lane]);
            const f32x4 pa = *(const LAS f32x4*)(ps + j * 8), pb = *(const LAS f32x4*)(ps + j * 8 + 4);
            o[0] += pa.x * v; o[1] += pa.y * v; o[2] += pa.z * v; o[3] += pa.w * v; o[4] += pb.x * v; o[5] += pb.y * v; o[6] += pb.z * v; o[7] += pb.w * v;
        }
#pragma unroll
        for (int g = 0; g < 8; ++g) PROJ[(size_t)m * DINP + C_SWQ + (kvh * 8 + g) * 64 + lane] = (bf16)f2bf(o[g]);
        asm volatile("s_waitcnt lgkmcnt(0)" ::: "memory");
    }
}
__device__ __forceinline__ void phase_gnorm(Frame& F_, int l) {
    Frame F = mkframe();
    bf16* PROJ = (bf16*)(wsp() + WS_PROJ); const bf16* ORAW = (const bf16*)(wsp() + WS_XN);
    const int gw = F.bid * NWAVES + F.wave, NGW = F.G * NWAVES;
    const float g0 = inp(7)[l * 128 + 2 * F.lane], g1 = inp(7)[l * 128 + 2 * F.lane + 1];
    for (int m = gw; m < M; m += NGW) {
        unsigned ow[8], zw[8];
#pragma unroll
        for (int h = 0; h < 8; ++h) { ow[h] = *(const unsigned*)(ORAW + (size_t)m * D + h * 128 + 2 * F.lane); zw[h] = *(const unsigned*)(PROJ + (size_t)m * DINP + C_DNZ + h * 128 + 2 * F.lane); }
        float ss[8];
#pragma unroll
        for (int h = 0; h < 8; ++h) { const float o0 = bflo(ow[h]), o1 = bfhi(ow[h]); ss[h] = o0 * o0 + o1 * o1; }
#pragma unroll
        for (int o = 1; o < 64; o <<= 1) {
#pragma unroll
            for (int h = 0; h < 8; ++h) ss[h] += __shfl_xor(ss[h], o); }
#pragma unroll
        for (int h = 0; h < 8; ++h) { const float r = rsqrtf(ss[h] * (1.f / 128.f) + EPS);
            *(unsigned*)(PROJ + (size_t)m * DINP + C_DNQ + h * 128 + 2 * F.lane) = pk2(bflo(ow[h]) * r * g0 * siluf_(bflo(zw[h])), bfhi(ow[h]) * r * g1 * siluf_(bfhi(zw[h]))); }
    }
}

#ifndef PROBE_ECHO
#define PROBE_ECHO 0
#endif
#define ECHO_BEGIN(k) do { if (PROBE_ECHO == (k)) echo_t0 = __builtin_amdgcn_s_memrealtime(); } while (0)
#define ECHO_END(k) do { if (PROBE_ECHO == (k)) { const unsigned long long t1_ = __builtin_amdgcn_s_memrealtime(), d_ = t1_ - echo_t0; while (__builtin_amdgcn_s_memrealtime() - t1_ < d_) __builtin_amdgcn_s_sleep(8); } } while (0)
#ifndef PROBE_DUP
#define PROBE_DUP 0
#endif
#ifndef DN_NAIVE
#define DN_NAIVE 0
#endif
struct Args { const float* in[17]; float* out; unsigned char* ws; };
__global__ void __launch_bounds__(NTHR, 2) hybrid_fwd(Args args) {
    cg::grid_group grid = cg::this_grid();
    Frame F;
    F.lds = lds_base();
    F.tid = threadIdx.x; F.lane = F.tid & 63; F.wave = __builtin_amdgcn_readfirstlane(F.tid >> 6);
    F.G = gridDim.x; F.bid = blockIdx.x;
#define PROJ ((bf16*)(wsp() + WS_PROJ))
#define XN ((bf16*)(wsp() + WS_XN))
#define YF ((float*)(wsp() + WS_YF))
#define MIX ((bf16*)(wsp() + WS_MIX))
#define HB ((bf16*)(wsp() + WS_H))

    unsigned long long echo_t0 = 0; (void)echo_t0;
    ECHO_BEGIN(9); ECHO_BEGIN(10); ECHO_BEGIN(11);
    if (F.bid == 0) { for (int i = F.tid; i < XCD_BAR_WORDS; i += NTHR) ((unsigned*)(wsp() + WS_BAR))[i] = 0u; for (int i = F.tid; i < 16384; i += NTHR) ((unsigned*)(wsp() + WS_XCNT))[i] = 0u; if (F.tid < 256) ((unsigned*)(wsp() + WS_SUBCNT))[F.tid] = 0u; }
    if (F.tid < 4) ((LAS unsigned*)(lds_base() + LDS_BARST))[F.tid] = 0u;
    grid.sync();
    ECHO_END(10);
    xcd_barrier_post();
    phase_rope(F);
    phase_norm(F, nullptr, nullptr, inp(0), outp(), inp(2), XN);
    phase_convert(F, -1, 0, 0);
    grid_bar();
    ECHO_END(9);
    for (int l = 0; l < DEPTH; ++l) {
        ECHO_BEGIN(1);
        {
            pg8::Gemm g{XN, (const bf16*)(wsp() + WS_WIN), nullptr, nullptr, M, DINP, D, D}; pg8::StaticOrder S; { Frame Fg = mkframe(); S.init(M, DINP, Fg.G, Fg.bid); }
            pg8::EpiBf16<0> E{PROJ, DINP};
            pg8::gemm_phase<pg8::EpiBf16<0>, pg8::StaticOrder, true, true>(F.lds, g, S, E);
#if PROBE_DUP == 5
            pg8::gemm_phase<pg8::EpiBf16<0>, pg8::StaticOrder, true, true>(F.lds, g, S, E);
#endif
        }
        grid_bar(); ECHO_END(1); ECHO_BEGIN(2);
#if DN_NAIVE
        if (F.bid < 16) dn_naive(F, l);
        else swa_naive(F, l, 16);
#else
#if PROBE_DUP == 1
        dn_prep<0>(F, l);
#elif PROBE_DUP == 11
        dn_prep<1>(F, l);
#elif PROBE_DUP == 12
        dn_prep<2>(F, l);
#elif PROBE_DUP == 13
        dn_prep<3>(F, l);
#elif PROBE_DUP == 14
        dn_prep<4>(F, l);
#endif
        dn_prep<0>(F, l);
        grid_bar(); ECHO_END(2); ECHO_BEGIN(3);
        { Frame Fg = mkframe(); if (Fg.bid < 64) { const int sid_ = (((Fg.bid & 7) * 2 + (Fg.bid >> 5)) << 2) | ((Fg.bid >> 3) & 3); dn_scan<0>(F, sid_);
#if PROBE_DUP == 2
            dn_scan<0>(F, sid_);
#elif PROBE_DUP == 3
            dn_scan<1>(F, sid_);
#elif PROBE_DUP == 4
            dn_scan<2>(F, sid_);
#endif
        }
        else {
            phase_convert(F, l, (l + 1 < DEPTH) ? l + 1 : -1, 64);
            __syncthreads();
            swa_mfma(F, l, 64);
            sub_bar((unsigned*)(wsp() + WS_SUBCNT) + 64 * l, (unsigned)(Fg.G - 64));
            pg8::Gemm g{PROJ + C_SWQ, (const bf16*)(wsp() + WS_WUPSW), nullptr, nullptr, M, D, D, DINP}; pg8::StaticOrder S; S.init(M, D, Fg.G - 64, Fg.bid - 64);
            pg8::EpiYb E{PROJ + C_DNK, DINP, PROJ + C_GB, DINP};
            pg8::gemm_phase<pg8::EpiYb, pg8::StaticOrder, true, true>(F.lds, g, S, E);
        } }
#endif
        grid_bar(); ECHO_END(3); ECHO_BEGIN(4);
        phase_gnorm(F, l);
#if PROBE_DUP == 6
        phase_gnorm(F, l);
#endif
        grid_bar(); ECHO_END(4); ECHO_BEGIN(5);
        {
            pg8::Gemm g{PROJ + C_DNQ, (const bf16*)(wsp() + WS_WUPDN), nullptr, nullptr, M, D, D, DINP}; pg8::StaticOrder S; { Frame Fg = mkframe(); S.init(M, D, Fg.G, Fg.bid); }
            pg8::EpiMerge2 E{MIX, D, PROJ + C_GA, PROJ + C_DNK, DINP};
            pg8::gemm_phase<pg8::EpiMerge2, pg8::StaticOrder, false, true>(F.lds, g, S, E);
        }
        grid_bar(); ECHO_END(5); ECHO_BEGIN(6);
        {
            pg8::Gemm g{MIX, (const bf16*)(wsp() + WS_WO), nullptr, nullptr, M, D, D, D}; pg8::StaticOrder S; { Frame Fg = mkframe(); S.init(M, D, Fg.G, Fg.bid); }
            pg8::RmsExchange e1{(float*)(wsp() + WS_XSLOT), (unsigned*)(wsp() + WS_XCNT) + ((l * 4 + 0) * 64) * 16}, e2{(float*)(wsp() + WS_XSLOT + 262144), (unsigned*)(wsp() + WS_XCNT) + ((l * 4 + 1) * 64) * 16};
            pg8::EpiRmsRes E{outp(), inp(12) + l * D, inp(13) + l * D, XN, e1, e2};
            pg8::gemm_phase<pg8::EpiRmsRes, pg8::StaticOrder, false, true>(F.lds, g, S, E);
        }
        grid_bar(); ECHO_END(6); ECHO_BEGIN(7);
        {
            pg8::Gemm g{XN, (const bf16*)(wsp() + WS_WFF1), nullptr, nullptr, M, FF, D, D}; pg8::StaticOrder S; { Frame Fg = mkframe(); S.init(M, FF, Fg.G, Fg.bid); }
            pg8::EpiBf16<2> E{HB, FF};
            pg8::gemm_phase<pg8::EpiBf16<2>, pg8::StaticOrder, true, true>(F.lds, g, S, E);
#if PROBE_DUP == 7
            pg8::gemm_phase<pg8::EpiBf16<2>, pg8::StaticOrder, true, true>(F.lds, g, S, E);
#endif
        }
        grid_bar(); ECHO_END(7); ECHO_BEGIN(8);
        {
            pg8::Gemm g{HB, (const bf16*)(wsp() + WS_WFF2), nullptr, nullptr, M, D, FF, FF}; pg8::StaticOrder S; { Frame Fg = mkframe(); S.init(M, D, Fg.G, Fg.bid); }
            pg8::RmsExchange e1{(float*)(wsp() + WS_XSLOT), (unsigned*)(wsp() + WS_XCNT) + ((l * 4 + 2) * 64) * 16}, e2{(float*)(wsp() + WS_XSLOT + 262144), (unsigned*)(wsp() + WS_XCNT) + ((l * 4 + 3) * 64) * 16};
            pg8::EpiRmsRes E{outp(), inp(16) + l * D, (l + 1 < DEPTH) ? inp(2) + (l + 1) * D : nullptr, XN, e1, e2};
            pg8::gemm_phase<pg8::EpiRmsRes, pg8::StaticOrder, false, true>(F.lds, g, S, E);
        }
        if (l + 1 < DEPTH) grid_bar();
        ECHO_END(8);
    }
    ECHO_END(11);
#undef PROJ
#undef XN
#undef YF
#undef MIX
#undef HB
}

extern "C" void kernel_launch(void* const* d_in, const int* in_sizes, int n_in, void* d_out, int out_size, void* d_ws, size_t ws_size, hipStream_t stream) {
    static int init = 0;
    if (!init) {
        if (n_in != 17 || out_size != M * D || ws_size < WS_END) { fprintf(stderr, "kernel_launch: unexpected shapes (n_in %d out %d ws %zu)\n", n_in, out_size, ws_size); init = -1; return; }
        if (hipFuncSetAttribute((const void*)hybrid_fwd, hipFuncAttributeMaxDynamicSharedMemorySize, LDS_BYTES) != hipSuccess) { fprintf(stderr, "hipFuncSetAttribute failed\n"); init = -1; return; }
        init = 1;
    }
    if (init < 0) return;
    Args a{};
    for (int i = 0; i < 17; ++i) a.in[i] = (const float*)d_in[i];
    a.out = (float*)d_out; a.ws = (unsigned char*)d_ws;
    void* args[] = {&a};
    hipError_t e = hipLaunchCooperativeKernel((void*)hybrid_fwd, dim3(256), dim3(NTHR), args, LDS_BYTES, stream);
    if (e != hipSuccess) fprintf(stderr, "cooperative launch failed: %s\n", hipGetErrorString(e));
}
```

```cpp
#include <hip/hip_runtime.h>
#include <hip/hip_cooperative_groups.h>
#include <cstdio>
#include <cstdint>
namespace cg = cooperative_groups;

namespace pg8 {
#define PG8_LAS __attribute__((address_space(3)))
typedef unsigned short bf16_t;
typedef short bf16x8 __attribute__((ext_vector_type(8)));
typedef float f32x4 __attribute__((ext_vector_type(4)));
typedef unsigned u32x4 __attribute__((ext_vector_type(4)));
constexpr int BM = 256, BK = 64, HALF = 128, HTB = HALF * BK * 2, STAGE_BYTES = 8 * HTB, NXCD = 8, WGM = 8;

__host__ __device__ __forceinline__ int lds_byte(int r, int c) { const int st = (r >> 4) * 2 + (c >> 5), rr = r & 15, cc = c & 31, ob = rr * 64 + cc * 2; return st * 1024 + (ob ^ (((ob >> 9) & 1) << 5)); }
__host__ __device__ __forceinline__ void stage_rc(int b, int& R, int& C) { const int st = b / 1024, sb = b % 1024, swz = sb ^ (((sb >> 9) & 1) << 5); R = (st >> 1) * 16 + swz / 64; C = (st & 1) * 32 + (swz % 64) / 2; }
__host__ __device__ __forceinline__ int perm32(int rho) { const int n = rho >> 4, i = rho & 15; return 8 * (i >> 2) + 4 * n + (i & 3); }

struct Unit { int pm, pn, src; };
struct Gemm { const bf16_t* A; const bf16_t* Bt; const bf16_t* A2; const bf16_t* Bt2; int M, N, K, lda; };

struct StaticOrder {
    int nM, nN, nwg, G, c;
    __host__ __device__ void init(int M, int N, int G_, int c_) { nM = M / BM; nN = N / BM; nwg = nM * nN; G = G_; c = c_; }
    __host__ __device__ bool tile(long L, Unit& u) const {
        if (L >= nwg) return false;
        int wgid = (int)L; { const int q = nwg / NXCD, r = nwg % NXCD, xcd = wgid % NXCD, off = wgid / NXCD; wgid = (xcd < r ? xcd * (q + 1) : r * (q + 1) + (xcd - r) * q) + off; }
        const int nig = WGM * nN, gid = wgid / nig, fm = gid * WGM, gsz = (nM - fm) < WGM ? (nM - fm) : WGM;
        u.pm = fm + ((wgid % nig) % gsz); u.pn = (wgid % nig) / gsz; u.src = 0; return true;
    }
    __host__ __device__ bool next(int i, Unit& u) const { return tile((long)i * G + c, u); }
};
struct DualOrder {
    StaticOrder S;
    __host__ __device__ bool next(int i, Unit& u) const { const bool ok = S.tile((long)(i >> 1) * S.G + S.c, u); u.src = i & 1; return ok; }
};

typedef float f32x2c __attribute__((ext_vector_type(2)));
typedef __bf16 bf16x2c __attribute__((ext_vector_type(2)));
__device__ __forceinline__ unsigned cvt_pk_bf16(float lo, float hi) { const f32x2c v = {lo, hi}; return __builtin_bit_cast(unsigned, __builtin_convertvector(v, bf16x2c)); }
__device__ __forceinline__ float bf_lo(unsigned w) { return __uint_as_float(w << 16); }
__device__ __forceinline__ float bf_hi(unsigned w) { return __uint_as_float(w & 0xffff0000u); }

template <int ACT  > struct EpiBf16 {
    static constexpr bool PERM = true, DUAL = false, AFTER_DRAIN = false;
    bf16_t* O; int ldc;
    __device__ __forceinline__ void mid(f32x4 (&acc)[2][2][4][2], const Unit& u, int wr, int wc, int fr, int fq) const {}
    __device__ __forceinline__ void operator()(const f32x4 (&acc)[2][2][4][2], const Unit& u, int wr, int wc, int fr, int fq) const {
        const int row0 = u.pm * BM + wr * 64 + fr; const int col0 = u.pn * BM + wc * 32 + 8 * fq;
#pragma unroll
        for (int ai = 0; ai < 2; ++ai)
#pragma unroll
            for (int m = 0; m < 4; ++m) { bf16_t* rowp = O + (size_t)(row0 + ai * HALF + m * 16) * ldc + col0;
#pragma unroll
                for (int bj = 0; bj < 2; ++bj) { f32x4 v0 = acc[ai][bj][m][0], v1 = acc[ai][bj][m][1];
                    if (ACT == 2) {
#pragma unroll
                        for (int e = 0; e < 4; ++e) { const float a = fmaxf(v0[e], 0.f), b = fmaxf(v1[e], 0.f); v0[e] = a * a; v1[e] = b * b; } }
                    u32x4 w; w.x = cvt_pk_bf16(v0[0], v0[1]); w.y = cvt_pk_bf16(v0[2], v0[3]); w.z = cvt_pk_bf16(v1[0], v1[1]); w.w = cvt_pk_bf16(v1[2], v1[3]);
                    *(u32x4*)(rowp + bj * HALF) = w; } }
    }
};
struct EpiF32 {
    static constexpr bool PERM = false, DUAL = false, AFTER_DRAIN = false;
    float* O; int ldc;
    __device__ __forceinline__ void mid(f32x4 (&acc)[2][2][4][2], const Unit& u, int wr, int wc, int fr, int fq) const {}
    __device__ __forceinline__ void operator()(const f32x4 (&acc)[2][2][4][2], const Unit& u, int wr, int wc, int fr, int fq) const {
        float* rowp = O + (size_t)(u.pm * BM + wr * 64 + fr) * ldc + (u.pn * BM + wc * 32 + 4 * fq);
#pragma unroll
        for (int ai = 0; ai < 2; ++ai) {
#pragma unroll
            for (int m = 0; m < 4; ++m) {
#pragma unroll
                for (int bj = 0; bj < 2; ++bj)
#pragma unroll
                    for (int n = 0; n < 2; ++n) *(f32x4*)(rowp + bj * HALF + n * 16) = acc[ai][bj][m][n];
                rowp += (size_t)16 * ldc; asm volatile("" : "+v"(rowp) :: "memory"); }
            rowp += (size_t)64 * ldc; }
    }
};
struct EpiMerge {
    static constexpr bool PERM = true, DUAL = true, AFTER_DRAIN = false;
    bf16_t* O; int ldc; const bf16_t* GA; const bf16_t* GB; int ldg;
    __device__ __forceinline__ void mid(f32x4 (&acc)[2][2][4][2], const Unit& u, int wr, int wc, int fr, int fq) const {
        const int row0 = u.pm * BM + wr * 64 + fr; const int col0 = u.pn * BM + wc * 32 + 8 * fq;
#pragma unroll
        for (int ai = 0; ai < 2; ++ai)
#pragma unroll
            for (int m = 0; m < 4; ++m) { const size_t ro = (size_t)(row0 + ai * HALF + m * 16) * ldg + col0;
#pragma unroll
                for (int bj = 0; bj < 2; ++bj) { const u32x4 ga = *(const u32x4*)(GA + ro + bj * HALF), gb = *(const u32x4*)(GB + ro + bj * HALF);
#pragma unroll
                    for (int e = 0; e < 4; ++e) { const unsigned wa = ga[e], wb = gb[e];
                        const float r0 = (1.f + __expf(-bf_lo(wb))) / (1.f + __expf(-bf_lo(wa))), r1 = (1.f + __expf(-bf_hi(wb))) / (1.f + __expf(-bf_hi(wa)));
                        if (e < 2) { acc[ai][bj][m][0][2 * e] *= r0; acc[ai][bj][m][0][2 * e + 1] *= r1; } else { acc[ai][bj][m][1][2 * (e - 2)] *= r0; acc[ai][bj][m][1][2 * (e - 2) + 1] *= r1; } } } }
    }
    __device__ __forceinline__ void operator()(const f32x4 (&acc)[2][2][4][2], const Unit& u, int wr, int wc, int fr, int fq) const {
        const int row0 = u.pm * BM + wr * 64 + fr; const int col0 = u.pn * BM + wc * 32 + 8 * fq;
#pragma unroll
        for (int ai = 0; ai < 2; ++ai)
#pragma unroll
            for (int m = 0; m < 4; ++m) { const size_t ro = (size_t)(row0 + ai * HALF + m * 16) * ldg + col0; bf16_t* rowp = O + (size_t)(row0 + ai * HALF + m * 16) * ldc + col0;
#pragma unroll
                for (int bj = 0; bj < 2; ++bj) { const u32x4 gb = *(const u32x4*)(GB + ro + bj * HALF); f32x4 v0 = acc[ai][bj][m][0], v1 = acc[ai][bj][m][1];
                    float s[8];
#pragma unroll
                    for (int e = 0; e < 4; ++e) { s[2 * e] = 1.f / (1.f + __expf(-bf_lo(gb[e]))); s[2 * e + 1] = 1.f / (1.f + __expf(-bf_hi(gb[e]))); }
                    u32x4 w; w.x = cvt_pk_bf16(v0[0] * s[0], v0[1] * s[1]); w.y = cvt_pk_bf16(v0[2] * s[2], v0[3] * s[3]); w.z = cvt_pk_bf16(v1[0] * s[4], v1[1] * s[5]); w.w = cvt_pk_bf16(v1[2] * s[6], v1[3] * s[7]);
                    *(u32x4*)(rowp + bj * HALF) = w; } }
    }
};

struct EpiYb {
    static constexpr bool PERM = true, DUAL = false, AFTER_DRAIN = false;
    bf16_t* O; int ldc; const bf16_t* GB; int ldg;
    __device__ __forceinline__ void mid(f32x4 (&acc)[2][2][4][2], const Unit& u, int wr, int wc, int fr, int fq) const {}
    __device__ __forceinline__ void operator()(const f32x4 (&acc)[2][2][4][2], const Unit& u, int wr, int wc, int fr, int fq) const {
        const int row0 = u.pm * BM + wr * 64 + fr; const int col0 = u.pn * BM + wc * 32 + 8 * fq;
        u32x4 cgb[2], ngb[2];
        { const size_t ro = (size_t)row0 * ldg + col0;
#pragma unroll
          for (int bj = 0; bj < 2; ++bj) cgb[bj] = *(const u32x4*)(GB + ro + bj * HALF); }
#pragma unroll
        for (int g = 0; g < 8; ++g) { const int ai = g >> 2, m = g & 3;
            if (g < 7) { const size_t ro = (size_t)(row0 + ((g + 1) >> 2) * HALF + ((g + 1) & 3) * 16) * ldg + col0;
#pragma unroll
                for (int bj = 0; bj < 2; ++bj) ngb[bj] = *(const u32x4*)(GB + ro + bj * HALF); }
            bf16_t* rowp = O + (size_t)(row0 + ai * HALF + m * 16) * ldc + col0;
#pragma unroll
            for (int bj = 0; bj < 2; ++bj) { const u32x4 gb = cgb[bj]; const f32x4 v0 = acc[ai][bj][m][0], v1 = acc[ai][bj][m][1];
                float s[8];
#pragma unroll
                for (int e = 0; e < 4; ++e) { s[2 * e] = __builtin_amdgcn_rcpf(1.f + __expf(-bf_lo(gb[e]))); s[2 * e + 1] = __builtin_amdgcn_rcpf(1.f + __expf(-bf_hi(gb[e]))); }
                u32x4 w; w.x = cvt_pk_bf16(v0[0] * s[0], v0[1] * s[1]); w.y = cvt_pk_bf16(v0[2] * s[2], v0[3] * s[3]); w.z = cvt_pk_bf16(v1[0] * s[4], v1[1] * s[5]); w.w = cvt_pk_bf16(v1[2] * s[6], v1[3] * s[7]);
                *(u32x4*)(rowp + bj * HALF) = w; }
#pragma unroll
            for (int bj = 0; bj < 2; ++bj) cgb[bj] = ngb[bj];
        }
    }
};
struct EpiMerge2 {
    static constexpr bool PERM = true, DUAL = false, AFTER_DRAIN = false;
    bf16_t* O; int ldc; const bf16_t* GA; const bf16_t* YB; int ldg;
    __device__ __forceinline__ void mid(f32x4 (&acc)[2][2][4][2], const Unit& u, int wr, int wc, int fr, int fq) const {}
    __device__ __forceinline__ void operator()(const f32x4 (&acc)[2][2][4][2], const Unit& u, int wr, int wc, int fr, int fq) const {
        const int row0 = u.pm * BM + wr * 64 + fr; const int col0 = u.pn * BM + wc * 32 + 8 * fq;
        u32x4 cga[2], cyb[2], nga[2], nyb[2];
        { const size_t ro = (size_t)row0 * ldg + col0;
#pragma unroll
          for (int bj = 0; bj < 2; ++bj) { cga[bj] = *(const u32x4*)(GA + ro + bj * HALF); cyb[bj] = *(const u32x4*)(YB + ro + bj * HALF); } }
#pragma unroll
        for (int g = 0; g < 8; ++g) { const int ai = g >> 2, m = g & 3;
            if (g < 7) { const size_t ro = (size_t)(row0 + ((g + 1) >> 2) * HALF + ((g + 1) & 3) * 16) * ldg + col0;
#pragma unroll
                for (int bj = 0; bj < 2; ++bj) { nga[bj] = *(const u32x4*)(GA + ro + bj * HALF); nyb[bj] = *(const u32x4*)(YB + ro + bj * HALF); } }
            bf16_t* rowp = O + (size_t)(row0 + ai * HALF + m * 16) * ldc + col0;
#pragma unroll
            for (int bj = 0; bj < 2; ++bj) { const u32x4 ga = cga[bj], yb = cyb[bj]; const f32x4 v0 = acc[ai][bj][m][0], v1 = acc[ai][bj][m][1];
                float o[8];
#pragma unroll
                for (int e = 0; e < 4; ++e) { const float a0 = (e < 2) ? v0[2 * e] : v1[2 * (e - 2)], a1 = (e < 2) ? v0[2 * e + 1] : v1[2 * (e - 2) + 1];
                    o[2 * e] = a0 * __builtin_amdgcn_rcpf(1.f + __expf(-bf_lo(ga[e]))) + bf_lo(yb[e]); o[2 * e + 1] = a1 * __builtin_amdgcn_rcpf(1.f + __expf(-bf_hi(ga[e]))) + bf_hi(yb[e]); }
                u32x4 w; w.x = cvt_pk_bf16(o[0], o[1]); w.y = cvt_pk_bf16(o[2], o[3]); w.z = cvt_pk_bf16(o[4], o[5]); w.w = cvt_pk_bf16(o[6], o[7]);
                *(u32x4*)(rowp + bj * HALF) = w; }
#pragma unroll
            for (int bj = 0; bj < 2; ++bj) { cga[bj] = nga[bj]; cyb[bj] = nyb[bj]; }
        }
    }
};
struct RmsExchange {
    float* slots;
    unsigned* cnt;
    __device__ __forceinline__ void run(const f32x4 (&v)[2][2][4][2], const Unit& u, int wr, int wc, int fr, int fq, PG8_LAS unsigned char* lds, int wid, int lane) const {
        PG8_LAS float* P = (PG8_LAS float*)lds;
        PG8_LAS float* S = (PG8_LAS float*)(lds + 4096);
#pragma unroll
        for (int ai = 0; ai < 2; ++ai)
#pragma unroll
            for (int m = 0; m < 4; ++m) { float s = 0.f;
#pragma unroll
                for (int bj = 0; bj < 2; ++bj)
#pragma unroll
                    for (int n = 0; n < 2; ++n) { const f32x4 x = v[ai][bj][m][n]; s += (x[0] * x[0] + x[1] * x[1]) + (x[2] * x[2] + x[3] * x[3]); }
                s += __shfl_xor(s, 16); s += __shfl_xor(s, 32);
                if (fq == 0) P[(ai * HALF + wr * 64 + m * 16 + fr) * 4 + wc] = s; }
        asm volatile("s_waitcnt vmcnt(0) lgkmcnt(0)" ::: "memory"); __builtin_amdgcn_s_barrier(); asm volatile("" ::: "memory");
        const int row = wid * 64 + lane;
        if (wid < 4) {
            const f32x4 p = *(const PG8_LAS f32x4*)(P + row * 4);
            __hip_atomic_store(slots + ((size_t)(u.pm * BM + row) * 4 + u.pn), (p[0] + p[1]) + (p[2] + p[3]), __ATOMIC_RELAXED, __HIP_MEMORY_SCOPE_AGENT);
            asm volatile("s_waitcnt vmcnt(0)" ::: "memory");
            if (lane == 0) __hip_atomic_fetch_add(cnt + 16 * u.pm, 1u, __ATOMIC_RELAXED, __HIP_MEMORY_SCOPE_AGENT);
        }
        if (wid == 0) {
            unsigned sp = 0;
            while ((unsigned)__builtin_amdgcn_readfirstlane(__hip_atomic_load(cnt + 16 * u.pm, __ATOMIC_RELAXED, __HIP_MEMORY_SCOPE_AGENT)) < 16u) { __builtin_amdgcn_s_sleep(1); if (++sp > (1u << 22)) break; }
            __builtin_amdgcn_fence(__ATOMIC_ACQUIRE, "agent");
        }
        asm volatile("s_waitcnt vmcnt(0) lgkmcnt(0)" ::: "memory"); __builtin_amdgcn_s_barrier(); asm volatile("" ::: "memory");
        if (wid < 4) {
            const float* sl = slots + (size_t)(u.pm * BM + row) * 4; float t = 0.f;
#pragma unroll
            for (int k = 0; k < 4; ++k) t += __hip_atomic_load(sl + k, __ATOMIC_RELAXED, __HIP_MEMORY_SCOPE_AGENT);
            S[row] = rsqrtf(t * (1.0f / 1024.0f) + 1e-6f);
        }
        asm volatile("s_waitcnt vmcnt(0) lgkmcnt(0)" ::: "memory"); __builtin_amdgcn_s_barrier(); asm volatile("" ::: "memory");
    }
};
struct EpiRmsRes {
    static constexpr bool PERM = false, DUAL = false, AFTER_DRAIN = true;
    float* x; const float* gpost; const float* gnext; bf16_t* xn; RmsExchange e1, e2;
    __device__ __forceinline__ void mid(f32x4 (&acc)[2][2][4][2], const Unit& u, int wr, int wc, int fr, int fq) const {}
    __device__ __forceinline__ void operator()(const f32x4 (&acc)[2][2][4][2], const Unit& u, int wr, int wc, int fr, int fq) const {}
    __device__ __forceinline__ void fused(f32x4 (&acc)[2][2][4][2], const Unit& u, int wr, int wc, int fr, int fq, PG8_LAS unsigned char* lds, int wid, int lane) const {
        typedef unsigned u32x2v __attribute__((ext_vector_type(2)));
        const PG8_LAS float* S = (const PG8_LAS float*)(lds + 4096);
        const int col0 = u.pn * BM + wc * 32 + 4 * fq;
        bf16_t* xb = (bf16_t*)x;
        u32x2v pre[2][4][2][2];
#pragma unroll
        for (int ai = 0; ai < 2; ++ai)
#pragma unroll
            for (int m = 0; m < 4; ++m) { const bf16_t* xp = xb + (size_t)(u.pm * BM + ai * HALF + wr * 64 + m * 16 + fr) * 2048 + col0;
#pragma unroll
                for (int bj = 0; bj < 2; ++bj)
#pragma unroll
                    for (int n = 0; n < 2; ++n) pre[ai][m][bj][n] = *(const u32x2v*)(xp + bj * HALF + n * 16); }
        e1.run(acc, u, wr, wc, fr, fq, lds, wid, lane);
        f32x4 g[2][2];
#pragma unroll
        for (int bj = 0; bj < 2; ++bj)
#pragma unroll
            for (int n = 0; n < 2; ++n) g[bj][n] = *(const f32x4*)(gpost + col0 + bj * HALF + n * 16);
#pragma unroll
        for (int ai = 0; ai < 2; ++ai)
#pragma unroll
            for (int m = 0; m < 4; ++m) { const int r = ai * HALF + wr * 64 + m * 16 + fr; const float sr = S[r];
#pragma unroll
                for (int bj = 0; bj < 2; ++bj)
#pragma unroll
                    for (int n = 0; n < 2; ++n) { const u32x2v pw = pre[ai][m][bj][n]; const f32x4 xv = {bf_lo(pw.x), bf_hi(pw.x), bf_lo(pw.y), bf_hi(pw.y)};
                        const f32x4 o = xv + acc[ai][bj][m][n] * sr * g[bj][n]; acc[ai][bj][m][n] = o;
                        if (gnext) { u32x2v w; w.x = cvt_pk_bf16(o[0], o[1]); w.y = cvt_pk_bf16(o[2], o[3]); *(u32x2v*)(xb + (size_t)(u.pm * BM + r) * 2048 + col0 + bj * HALF + n * 16) = w; }
                        else *(f32x4*)(x + (size_t)(u.pm * BM + r) * 1024 + col0 + bj * HALF + n * 16) = o; } }
        if (gnext) {
            e2.run(acc, u, wr, wc, fr, fq, lds, wid, lane);
#pragma unroll
            for (int bj = 0; bj < 2; ++bj)
#pragma unroll
                for (int n = 0; n < 2; ++n) g[bj][n] = *(const f32x4*)(gnext + col0 + bj * HALF + n * 16);
#pragma unroll
            for (int ai = 0; ai < 2; ++ai)
#pragma unroll
                for (int m = 0; m < 4; ++m) { const int r = ai * HALF + wr * 64 + m * 16 + fr; const float sr = S[r]; bf16_t* op = xn + (size_t)(u.pm * BM + r) * 1024 + col0;
#pragma unroll
                    for (int bj = 0; bj < 2; ++bj)
#pragma unroll
                        for (int n = 0; n < 2; ++n) { const f32x4 o = acc[ai][bj][m][n] * sr * g[bj][n]; u32x2v w; w.x = cvt_pk_bf16(o[0], o[1]); w.y = cvt_pk_bf16(o[2], o[3]); *(u32x2v*)(op + bj * HALF + n * 16) = w; } }
        }
    }
};
template <class Epi, class Sched, bool ALIGN_EPI = false, bool SP2 = false>
__device__ __forceinline__ void gemm_phase(PG8_LAS unsigned char* lds, const Gemm g, const Sched& S, const Epi& E) {
    int tid_ = threadIdx.x; asm volatile("" : "+v"(tid_)); const int tid = tid_, wid = __builtin_amdgcn_readfirstlane(tid >> 6), lane = tid & 63, wr = wid >> 2, wc = wid & 3, fr = lane & 15, fq = lane >> 4;
    const int K = g.K, nt = K / BK, lda = g.lda;
    unsigned voffA[2], voffB[2];
#pragma unroll
    for (int i = 0; i < 2; ++i) { int R, C; stage_rc(tid * 16 + i * 8192, R, C); const int Rb = Epi::PERM ? ((R & ~31) + perm32(R & 31)) : R;
        voffA[i] = (unsigned)(R * lda + C) * 2u; voffB[i] = (unsigned)(Rb * K + C) * 2u; }
    const size_t kstep = (size_t)(BK * 2);
    const size_t hstepA = (size_t)HALF * lda * 2, hstepB = (size_t)HALF * K * 2;
    const size_t tstepA = 2 * hstepA, tstepB = 2 * hstepB;
    const unsigned ldsw = (unsigned)wid * 1024u;
    const int aoff = lds_byte(wr * 64 + fr, fq * 8), boff = lds_byte(wc * 32 + fr, fq * 8);
#define PG8_SA(b, h) (((b) * 2 + (h)) * HTB)
#define PG8_SB(b, h) ((4 + (b) * 2 + (h)) * HTB)
#define PG8_STAGE(bufoff, gbase, voff) do { _Pragma("unroll") for (int _i = 0; _i < 2; ++_i) \
        __builtin_amdgcn_global_load_lds((const unsigned*)((const char*)(gbase) + (voff)[_i]), (PG8_LAS unsigned*)(lds + (bufoff) + ldsw + _i * 8192), 16, 0, 0); } while (0)
#define PG8_LDA(dst, b, h) do { _Pragma("unroll") for (int m = 0; m < 4; ++m) _Pragma("unroll") for (int k = 0; k < 2; ++k) dst[m][k] = *(const PG8_LAS bf16x8*)(lds + PG8_SA(b, h) + aoff + m * 2048 + k * 1024); } while (0)
#define PG8_LDB(dst, b, h) do { _Pragma("unroll") for (int n = 0; n < 2; ++n) _Pragma("unroll") for (int k = 0; k < 2; ++k) dst[n][k] = *(const PG8_LAS bf16x8*)(lds + PG8_SB(b, h) + boff + n * 2048 + k * 1024); } while (0)
#define PG8_MMA(ai, bj, At, Bt) do { __builtin_amdgcn_s_setprio(1); _Pragma("unroll") for (int m = 0; m < 4; ++m) _Pragma("unroll") for (int n = 0; n < 2; ++n) _Pragma("unroll") for (int k = 0; k < 2; ++k) \
        acc[ai][bj][m][n] = __builtin_amdgcn_mfma_f32_16x16x32_bf16(Bt[n][k], At[m][k], acc[ai][bj][m][n], 0, 0, 0); __builtin_amdgcn_s_setprio(0); } while (0)
#define PG8_WAIT_V(n) asm volatile("s_waitcnt vmcnt(" #n ")" ::: "memory")
#define PG8_WAIT_L(n) asm volatile("s_waitcnt lgkmcnt(" #n ")" ::: "memory")
#define PG8_BAR __builtin_amdgcn_s_barrier()
#define PG8_SCHED __builtin_amdgcn_sched_barrier(0)
    Unit cur, nxt; int ui = 0;
    if (!S.next(0, cur)) return;
    f32x4 acc[2][2][4][2];
#pragma unroll
    for (int a = 0; a < 2; ++a)
#pragma unroll
        for (int b = 0; b < 2; ++b)
#pragma unroll
            for (int m = 0; m < 4; ++m)
#pragma unroll
                for (int n = 0; n < 2; ++n) acc[a][b][m][n] = (f32x4){0.f, 0.f, 0.f, 0.f};
    bf16x8 At[4][2], B0[2][2], B1[2][2];
    const char* cA = (const char*)(cur.src ? g.A2 : g.A) + (size_t)cur.pm * tstepA; const char* cB = (const char*)(cur.src ? g.Bt2 : g.Bt) + (size_t)cur.pn * tstepB;
    if constexpr (SP2) {
        PG8_STAGE(PG8_SB(0, 0), cB, voffB); PG8_STAGE(PG8_SB(0, 1), cB + hstepB, voffB); PG8_STAGE(PG8_SA(0, 0), cA, voffA); PG8_STAGE(PG8_SA(0, 1), cA + hstepA, voffA);
        if (wr == 1) PG8_BAR;
        PG8_WAIT_V(2); PG8_BAR;
        PG8_STAGE(PG8_SB(1, 0), cB + kstep, voffB); PG8_STAGE(PG8_SA(1, 0), cA + kstep, voffA); PG8_STAGE(PG8_SB(1, 1), cB + hstepB + kstep, voffB);
        PG8_WAIT_V(6); PG8_BAR;
    } else {
        PG8_STAGE(PG8_SB(0, 0), cB, voffB); PG8_STAGE(PG8_SA(0, 0), cA, voffA); PG8_STAGE(PG8_SB(0, 1), cB + hstepB, voffB); PG8_STAGE(PG8_SA(0, 1), cA + hstepA, voffA);
        if (wr == 1) PG8_BAR;
        PG8_WAIT_V(4); PG8_BAR;
        PG8_STAGE(PG8_SB(1, 0), cB + kstep, voffB); PG8_STAGE(PG8_SA(1, 0), cA + kstep, voffA); PG8_STAGE(PG8_SB(1, 1), cB + hstepB + kstep, voffB);
        PG8_WAIT_V(6); PG8_BAR;
    }
    for (;;) {
        const bool has_next = S.next(ui + 1, nxt);
        const char* nA = has_next ? (const char*)(nxt.src ? g.A2 : g.A) + (size_t)nxt.pm * tstepA : cA; const char* nB = has_next ? (const char*)(nxt.src ? g.Bt2 : g.Bt) + (size_t)nxt.pn * tstepB : cB;
        for (int t = 0; t < nt; t += 2) {
            const bool last = (t == nt - 2);
            const char* a1 = cA + (size_t)(t + 1) * kstep;
            const char* a2 = last ? nA : cA + (size_t)(t + 2) * kstep; const char* b2 = last ? nB : cB + (size_t)(t + 2) * kstep;
            const char* a3 = a2 + kstep; const char* b3 = b2 + kstep;
            if constexpr (SP2) {
            PG8_LDB(B0, 0, 0); PG8_LDB(B1, 0, 1); PG8_SCHED; PG8_LDA(At, 0, 0); PG8_STAGE(PG8_SA(1, 1), a1 + hstepA, voffA);
            PG8_WAIT_V(8); PG8_WAIT_L(0); PG8_BAR; PG8_MMA(0, 0, At, B0); PG8_MMA(0, 1, At, B1); PG8_BAR; PG8_SCHED;
            PG8_LDA(At, 0, 1); PG8_STAGE(PG8_SB(0, 0), b2, voffB); PG8_STAGE(PG8_SB(0, 1), b2 + hstepB, voffB); PG8_STAGE(PG8_SA(0, 0), a2, voffA);
            PG8_WAIT_V(8); PG8_WAIT_L(0); PG8_BAR; PG8_MMA(1, 0, At, B0); PG8_MMA(1, 1, At, B1); PG8_BAR; PG8_SCHED;
            PG8_LDB(B0, 1, 0); PG8_LDB(B1, 1, 1); PG8_SCHED; PG8_LDA(At, 1, 0); PG8_STAGE(PG8_SA(0, 1), a2 + hstepA, voffA);
            PG8_WAIT_V(8); PG8_WAIT_L(0); PG8_BAR; PG8_MMA(0, 0, At, B0); PG8_MMA(0, 1, At, B1); PG8_BAR; PG8_SCHED;
            PG8_LDA(At, 1, 1); PG8_STAGE(PG8_SB(1, 0), b3, voffB); PG8_STAGE(PG8_SB(1, 1), b3 + hstepB, voffB); PG8_STAGE(PG8_SA(1, 0), a3, voffA);
            PG8_WAIT_V(8); PG8_WAIT_L(0); PG8_BAR; PG8_MMA(1, 0, At, B0); PG8_MMA(1, 1, At, B1); PG8_BAR; PG8_SCHED;
            } else {
            PG8_LDB(B0, 0, 0); PG8_SCHED; PG8_LDA(At, 0, 0); PG8_STAGE(PG8_SA(1, 1), a1 + hstepA, voffA);
            PG8_WAIT_L(8); PG8_BAR; PG8_WAIT_L(0); PG8_MMA(0, 0, At, B0); PG8_BAR; PG8_SCHED;
            PG8_LDB(B1, 0, 1); PG8_STAGE(PG8_SB(0, 0), b2, voffB);
            PG8_BAR; PG8_WAIT_L(0); PG8_MMA(0, 1, At, B1); PG8_BAR;
            PG8_LDA(At, 0, 1); PG8_STAGE(PG8_SA(0, 0), a2, voffA);
            PG8_BAR; PG8_WAIT_L(0); PG8_MMA(1, 0, At, B0); PG8_BAR; PG8_SCHED;
            PG8_STAGE(PG8_SB(0, 1), b2 + hstepB, voffB);
            PG8_WAIT_V(6); PG8_BAR; PG8_MMA(1, 1, At, B1); PG8_BAR;
            PG8_LDB(B0, 1, 0); PG8_SCHED; PG8_LDA(At, 1, 0); PG8_STAGE(PG8_SA(0, 1), a2 + hstepA, voffA);
            PG8_WAIT_L(8); PG8_BAR; PG8_WAIT_L(0); PG8_MMA(0, 0, At, B0); PG8_BAR; PG8_SCHED;
            PG8_LDB(B1, 1, 1); PG8_STAGE(PG8_SB(1, 0), b3, voffB);
            PG8_BAR; PG8_WAIT_L(0); PG8_MMA(0, 1, At, B1); PG8_BAR;
            PG8_LDA(At, 1, 1); PG8_STAGE(PG8_SA(1, 0), a3, voffA);
            PG8_BAR; PG8_WAIT_L(0); PG8_MMA(1, 0, At, B0); PG8_BAR; PG8_SCHED;
            PG8_STAGE(PG8_SB(1, 1), b3 + hstepB, voffB);
            PG8_WAIT_V(6); PG8_BAR; PG8_MMA(1, 1, At, B1); PG8_BAR;
            }
        }
        if constexpr (ALIGN_EPI) { if (wr == 0) PG8_BAR; }
        const bool midu = Epi::DUAL && cur.src == 0;
        if constexpr (!Epi::AFTER_DRAIN) { if (midu) E.mid(acc, cur, wr, wc, fr, fq); else E(acc, cur, wr, wc, fr, fq); }
        if (!has_next) break;
        if (!midu) {
#pragma unroll
        for (int a = 0; a < 2; ++a)
#pragma unroll
            for (int b = 0; b < 2; ++b)
#pragma unroll
                for (int m = 0; m < 4; ++m)
#pragma unroll
                    for (int n = 0; n < 2; ++n) acc[a][b][m][n] = (f32x4){0.f, 0.f, 0.f, 0.f};
        }
        cur = nxt; cA = nA; cB = nB; ++ui;
        if constexpr (ALIGN_EPI) { if (wr == 1) PG8_BAR; }
    }
    PG8_WAIT_V(0);
    if constexpr (!ALIGN_EPI) { if (wr == 0) PG8_BAR; }
    PG8_BAR;
    if constexpr (Epi::AFTER_DRAIN) E.fused(acc, cur, wr, wc, fr, fq, lds, wid, lane);
#undef PG8_SA
#undef PG8_SB
#undef PG8_STAGE
#undef PG8_LDA
#undef PG8_LDB
#undef PG8_MMA
#undef PG8_WAIT_V
#undef PG8_WAIT_L
#undef PG8_BAR
#undef PG8_SCHED
}
}

#define GAS __attribute__((address_space(1)))
#define LAS __attribute__((address_space(3)))
typedef unsigned short bf16;
typedef unsigned v4u __attribute__((ext_vector_type(4)));
typedef unsigned v2u __attribute__((ext_vector_type(2)));
typedef float f32x4 __attribute__((ext_vector_type(4)));
typedef short bf16x8 __attribute__((ext_vector_type(8)));
constexpr int NWAVES = 8, NTHR = 512;
constexpr int BATCH = 2, SEQ = 8192, D = 1024, FF = 4096, DEPTH = 4, M = BATCH * SEQ;
constexpr int DIN = 7440, DINP = 7680;
constexpr int C_DNQ = 0, C_DNK = 1024, C_DNV = 2048, C_DNZ = 3072, C_SWQ = 4096, C_GA = 5120, C_GB = 6144, C_SWK = 7168, C_SWV = 7296, C_DNB = 7424, C_DNA = 7432;
constexpr float EPS = 1e-6f;
constexpr size_t MiB = 1u << 20;
constexpr size_t WS_WIN = 1 * MiB, WS_WUPDN = 16 * MiB, WS_WUPSW = 18 * MiB, WS_WO = 20 * MiB, WS_WFF1 = 22 * MiB, WS_WFF2 = 30 * MiB, WS_ROPE = 38 * MiB;
constexpr size_t WS_PROJ = 40 * MiB, WS_H = 40 * MiB, WS_XN = 280 * MiB, WS_YF = 312 * MiB, WS_MIX = 376 * MiB, WS_END = 456 * MiB;
constexpr int LDS_BYTES = 147456;

typedef float f32x2_t __attribute__((ext_vector_type(2)));
typedef __bf16 bf16x2_t __attribute__((ext_vector_type(2)));
__device__ __forceinline__ unsigned pk2(float lo, float hi) { const f32x2_t v = {lo, hi}; return __builtin_bit_cast(unsigned, __builtin_convertvector(v, bf16x2_t)); }
__device__ __forceinline__ unsigned f2bf(float f) { return pk2(f, 0.f) & 0xffffu; }
__device__ __forceinline__ float bflo(unsigned w) { return __uint_as_float(w << 16); }
__device__ __forceinline__ float bfhi(unsigned w) { return __uint_as_float(w & 0xffff0000u); }
__device__ __forceinline__ float bf1(bf16 h) { return __uint_as_float((unsigned)h << 16); }
__device__ __forceinline__ float wave_sum(float v) {
#pragma unroll
    for (int o = 1; o < 64; o <<= 1) v += __shfl_xor(v, o);
    return v;
}
__device__ __forceinline__ float wave_max(float v) {
#pragma unroll
    for (int o = 1; o < 64; o <<= 1) v = fmaxf(v, __shfl_xor(v, o));
    return v;
}
__device__ __forceinline__ float sigmoidf_(float x) { return __builtin_amdgcn_rcpf(1.f + __expf(-x)); }
__device__ __forceinline__ float siluf_(float x) { return x * __builtin_amdgcn_rcpf(1.f + __expf(-x)); }

struct Frame {
    LAS unsigned char* lds;
    int tid, lane, wave, G, bid;
};
__device__ __forceinline__ LAS unsigned char* lds_base() { extern __shared__ __attribute__((aligned(16))) unsigned char lds_dyn[]; return (LAS unsigned char*)lds_dyn; }
__device__ __forceinline__ Frame mkframe() {
    Frame F; F.lds = lds_base(); int tid = threadIdx.x; asm volatile("" : "+v"(tid)); int bid = blockIdx.x; asm volatile("" : "+s"(bid)); int G = gridDim.x; asm volatile("" : "+s"(G));
    F.tid = tid; F.lane = tid & 63; F.wave = __builtin_amdgcn_readfirstlane(tid >> 6); F.G = G; F.bid = bid; return F; }
typedef __attribute__((address_space(4))) const unsigned char* kargp_t;
__device__ __forceinline__ kargp_t kargs() { kargp_t p = (kargp_t)__builtin_amdgcn_kernarg_segment_ptr(); asm volatile("" : "+s"(p)); return p; }
__device__ __forceinline__ const float* inp(int k) { return *(const float* __attribute__((address_space(4))) const*)(kargs() + 8 * k); }
__device__ __forceinline__ float* outp() { return *(float* __attribute__((address_space(4))) const*)(kargs() + 8 * 17); }
__device__ __forceinline__ unsigned char* wsp() { return *(unsigned char* __attribute__((address_space(4))) const*)(kargs() + 8 * 18); }

__device__ __forceinline__ int orig_col(int nc) {
    if (nc < 4096) return nc;
    if (nc < 5120) return nc - 4096 + 4112;
    if (nc < 6144) return nc - 5120 + 5392;
    if (nc < 7168) return nc - 6144 + 6416;
    if (nc < 7296) return nc - 7168 + 5136;
    if (nc < 7424) return nc - 7296 + 5264;
    if (nc < 7440) return nc - 7424 + 4096;
    return -1;
}
template <bool PERMW>
__device__ __forceinline__ void transpose_item(const float* W, int K, int ldw, int nblk, bf16* WT, LAS float* scr, int item, int lane) {
    const int kb = item / nblk, nb = item % nblk, k0 = 64 * kb, n0 = 32 * nb;
    const int ncol = n0 + (lane & 31); const int oc = PERMW ? orig_col(ncol) : ncol;
    float wv[32];
    { const float* wp = W + (size_t)(k0 + (lane >> 5)) * ldw + (oc >= 0 ? oc : 0);
#pragma unroll
      for (int i = 0; i < 32; ++i) wv[i] = wp[(size_t)(2 * i) * ldw]; }
#pragma unroll
    for (int i = 0; i < 32; ++i) scr[(2 * i + (lane >> 5)) * 33 + (lane & 31)] = (oc >= 0) ? wv[i] : 0.f;
    asm volatile("s_waitcnt lgkmcnt(0)" ::: "memory");
    const int c = lane & 7;
#pragma unroll
    for (int j = 0; j < 4; ++j) { const int n = (lane >> 3) + 8 * j; const LAS float* s = scr + (8 * c) * 33 + n;
        v4u o; o.x = pk2(s[0 * 33], s[1 * 33]); o.y = pk2(s[2 * 33], s[3 * 33]); o.z = pk2(s[4 * 33], s[5 * 33]); o.w = pk2(s[6 * 33], s[7 * 33]);
        *(v4u*)(WT + (size_t)(n0 + n) * K + k0 + 8 * c) = o; }
    asm volatile("s_waitcnt lgkmcnt(0)" ::: "memory");
}
__device__ __forceinline__ void phase_convert(Frame& F_, int lrest, int lin, int nskip) {
    Frame F = mkframe();
    LAS float* scr = (LAS float*)(F.lds + F.wave * 16384);
    const int gw = (F.bid - nskip) * NWAVES + F.wave, NGW = (F.G - nskip) * NWAVES;
    constexpr int I_IN = 16 * (DINP / 32), I_SQ = 16 * 32, I_F1 = 16 * (FF / 32), I_F2 = 64 * 32;
    const int n_in = (lin >= 0) ? I_IN : 0, n_rest = (lrest >= 0) ? 3 * I_SQ + I_F1 + I_F2 : 0;
    for (int it = gw; it < n_in + n_rest; it += NGW) {
        int r = it;
        if (r < n_in) { transpose_item<true>(inp(3) + (size_t)lin * D * DIN, D, DIN, DINP / 32, (bf16*)(wsp() + WS_WIN), scr, r, F.lane); continue; } r -= n_in;
        const int l = lrest;
        if (r < I_SQ) { transpose_item<false>(inp(9) + (size_t)l * D * D, D, D, 32, (bf16*)(wsp() + WS_WUPDN), scr, r, F.lane); continue; } r -= I_SQ;
        if (r < I_SQ) { transpose_item<false>(inp(10) + (size_t)l * D * D, D, D, 32, (bf16*)(wsp() + WS_WUPSW), scr, r, F.lane); continue; } r -= I_SQ;
        if (r < I_SQ) { transpose_item<false>(inp(11) + (size_t)l * D * D, D, D, 32, (bf16*)(wsp() + WS_WO), scr, r, F.lane); continue; } r -= I_SQ;
        if (r < I_F1) { transpose_item<false>(inp(14) + (size_t)l * D * FF, D, FF, FF / 32, (bf16*)(wsp() + WS_WFF1), scr, r, F.lane); continue; } r -= I_F1;
        transpose_item<false>(inp(15) + (size_t)l * FF * D, FF, D, 32, (bf16*)(wsp() + WS_WFF2), scr, r, F.lane);
    }
}
__device__ __forceinline__ void phase_rope(Frame& F_) {
    Frame F = mkframe();
    const int* pos = (const int*)inp(1); float* R = (float*)(wsp() + WS_ROPE);
    for (int i = F.bid * NTHR + F.tid; i < M * 8; i += F.G * NTHR) {
        const int m = i >> 3, j = i & 7;
        const float invf = exp2f(-(float)j * (0.125f * 18.931568569324174f));
        const float angf = (float)pos[m] * invf;
        const double a = (double)angf; const double n = rint(a * 0.15915494309189535);
        const float r = (float)(a - n * 6.283185307179586);
        R[m * 16 + j] = __cosf(r); R[m * 16 + 8 + j] = __sinf(r);
    }
}
__device__ __forceinline__ void phase_norm(Frame& F_, const float* y, const float* gpost, const float* xin, float* x, const float* gnext, bf16* XN) {
    Frame F = mkframe();
    const int gw = F.bid * NWAVES + F.wave, NGW = F.G * NWAVES;
    for (int m = gw; m < M; m += NGW) {
        f32x4 v[4];
        const f32x4* xr = (const f32x4*)(xin + (size_t)m * D) + F.lane;
#pragma unroll
        for (int j = 0; j < 4; ++j) v[j] = xr[64 * j];
        if (y) {
            const f32x4* yr = (const f32x4*)(y + (size_t)m * D) + F.lane; f32x4 w[4]; float s = 0.f;
#pragma unroll
            for (int j = 0; j < 4; ++j) { w[j] = yr[64 * j]; s += (w[j].x * w[j].x + w[j].y * w[j].y) + (w[j].z * w[j].z + w[j].w * w[j].w); }
            const float r = rsqrtf(wave_sum(s) * (1.f / D) + EPS);
#pragma unroll
            for (int j = 0; j < 4; ++j) { const f32x4 g = ((const f32x4*)gpost)[F.lane + 64 * j]; v[j] = v[j] + w[j] * r * g; }
        }
        v2u* xo = (v2u*)((bf16*)x + (size_t)m * 2048) + F.lane;
#pragma unroll
        for (int j = 0; j < 4; ++j) { v2u w; w.x = pk2(v[j].x, v[j].y); w.y = pk2(v[j].z, v[j].w); xo[64 * j] = w; }
        if (gnext) {
            float s = 0.f;
#pragma unroll
            for (int j = 0; j < 4; ++j) s += (v[j].x * v[j].x + v[j].y * v[j].y) + (v[j].z * v[j].z + v[j].w * v[j].w);
            const float r = rsqrtf(wave_sum(s) * (1.f / D) + EPS);
            v2u* o = (v2u*)(XN + (size_t)m * D) + F.lane;
#pragma unroll
            for (int j = 0; j < 4; ++j) { const f32x4 g = ((const f32x4*)gnext)[F.lane + 64 * j]; v2u w; w.x = pk2(v[j].x * r * g.x, v[j].y * r * g.y); w.y = pk2(v[j].z * r * g.z, v[j].w * r * g.w); o[64 * j] = w; }
        }
    }
}
constexpr size_t WS_SUBCNT = 196608, WS_BAR = 65536, WS_XCNT = 131072, WS_XSLOT = 39 * MiB;
#define XB_TMO      128
#define XB_XCNT(j)  (256  + 64 * (j))
#define XB_XSUB(j)  (1280 + 64 * (j))
#define XB_XGEN(j)  (2304 + 64 * (j))
#define XB_TOP      3328
#define XB_TOPGEN   3392
#define XCD_BAR_WORDS 3456
#define XB_SPIN_CAP (1u << 22)
constexpr int LDS_BARST = LDS_BYTES - 16;
__device__ __forceinline__ unsigned xb_ld(unsigned* p)              { return __hip_atomic_load(p, __ATOMIC_RELAXED, __HIP_MEMORY_SCOPE_AGENT); }
__device__ __forceinline__ unsigned xb_add(unsigned* p, unsigned v) { return __hip_atomic_fetch_add(p, v, __ATOMIC_RELAXED, __HIP_MEMORY_SCOPE_AGENT); }
__device__ __forceinline__ unsigned xb_xcc_id() { return (unsigned)__builtin_amdgcn_s_getreg((3 << 11) | 20) & 0xFu; }
#define XB_SPIN(cond, bar) do { unsigned _sp = 0; while (cond) { __builtin_amdgcn_s_sleep(1); \
    if ((++_sp & 255u) == 0u) { if (xb_ld(&(bar)[XB_TMO])) break; if (_sp > XB_SPIN_CAP) { atomicAdd(&(bar)[XB_TMO], 1u); break; } } } } while (0)
__device__ __forceinline__ void xcd_barrier_post() {
    if (threadIdx.x == 0) { unsigned* bar = (unsigned*)(wsp() + WS_BAR); (void)xb_add(&bar[XB_XCNT(xb_xcc_id())], 1u); }
}
__device__ __forceinline__ void xcd_barrier_complete(unsigned* bar, unsigned x, unsigned& nloc, unsigned& nx) {
    const unsigned G = gridDim.x * gridDim.y * gridDim.z;
    unsigned sum, cnt, mine, sp = 0u;
    for (;;) {
        sum = 0u; cnt = 0u; mine = 0u;
#pragma unroll
        for (unsigned j = 0; j < 16; ++j) { const unsigned c = xb_ld(&bar[XB_XCNT(j)]); sum += c; cnt += (c > 0u) ? 1u : 0u; mine = (j == x) ? c : mine; }
        if (sum == G) break;
        __builtin_amdgcn_s_sleep(1);
        if ((++sp & 255u) == 0u) { if (xb_ld(&bar[XB_TMO])) break; if (sp > XB_SPIN_CAP) { atomicAdd(&bar[XB_TMO], 1u); break; } }
    }
    nloc = mine > 0u ? mine : 1u; nx = cnt > 0u ? cnt : 1u;
}
__device__ __forceinline__ void grid_bar() {
    asm volatile("s_waitcnt vmcnt(0)" ::: "memory");
    __syncthreads();
    if (threadIdx.x == 0) {
        unsigned* bar = (unsigned*)(wsp() + WS_BAR); const unsigned x = xb_xcc_id();
        volatile LAS unsigned* st = (volatile LAS unsigned*)(lds_base() + LDS_BARST);
        __builtin_amdgcn_s_waitcnt(0);
        unsigned nloc = st[0], nx = st[1];
        if (nloc == 0u) { xcd_barrier_complete(bar, x, nloc, nx); st[0] = nloc; st[1] = nx; }
        const unsigned old = xb_add(&bar[XB_XSUB(x)], 1u);
        const unsigned gen = old / nloc;
        if (old + 1u == (gen + 1u) * nloc) {
            __builtin_amdgcn_fence(__ATOMIC_RELEASE, "agent");
            asm volatile("s_waitcnt vmcnt(0)" ::: "memory");
            const unsigned og = xb_add(&bar[XB_TOP], 1u);
            const unsigned tg = og / nx;
            if (og + 1u == (tg + 1u) * nx) xb_add(&bar[XB_TOPGEN], 1u);
            else XB_SPIN(xb_ld(&bar[XB_TOPGEN]) == tg, bar);
            __builtin_amdgcn_fence(__ATOMIC_ACQUIRE, "agent");
            xb_add(&bar[XB_XGEN(x)], 1u);
            asm volatile("s_waitcnt vmcnt(0)" ::: "memory");
        } else {
            XB_SPIN(xb_ld(&bar[XB_XGEN(x)]) == gen, bar);
            __builtin_amdgcn_fence(__ATOMIC_ACQUIRE, "agent");
            asm volatile("s_waitcnt vmcnt(0)" ::: "memory");
        }
    }
    __syncthreads();
}

__device__ __forceinline__ void sub_bar(unsigned* cnt, unsigned n) {
    asm volatile("s_waitcnt vmcnt(0)" ::: "memory");
    __syncthreads();
    if (threadIdx.x == 0) {
        __builtin_amdgcn_fence(__ATOMIC_RELEASE, "agent");
        asm volatile("s_waitcnt vmcnt(0)" ::: "memory");
        xb_add(cnt, 1u);
        unsigned sp = 0; while (xb_ld(cnt) < n) { __builtin_amdgcn_s_sleep(1); if (++sp > XB_SPIN_CAP) break; }
        __builtin_amdgcn_fence(__ATOMIC_ACQUIRE, "agent");
        asm volatile("s_waitcnt vmcnt(0)" ::: "memory");
    }
    __syncthreads();
}
#define MFMA16(a, b, c) __builtin_amdgcn_mfma_f32_16x16x32_bf16(a, b, c, 0, 0, 0)
constexpr size_t WS_GL = 0, WS_W = 312 * MiB, WS_QD = 344 * MiB, WS_KDT = 376 * MiB, WS_UT = 408 * MiB, WS_AI = 440 * MiB;
typedef LAS unsigned short* lbf;
template <int PMODE>
__device__ __forceinline__ void dn_prep(Frame& F_, int l) {
    Frame F = mkframe();
    const bf16* PROJ = (const bf16*)(wsp() + WS_PROJ);
    lbf QS = (lbf)(F.lds), KS = (lbf)(F.lds + 17408), VT = (lbf)(F.lds + 34816), KGT = (lbf)(F.lds + 53248), KDT = (lbf)(F.lds + 71680), TB = (lbf)(F.lds + 107520);
    LAS float* LM = (LAS float*)(F.lds + 90112); LAS float* GC = (LAS float*)(F.lds + 116736); LAS float* BT = (LAS float*)(F.lds + 116992);
    const int lane = F.lane, wave = F.wave, fr = lane & 15, fq = lane >> 4;
    struct PrepIn { unsigned xr[3][11]; float cw[3][4][2]; bf16 a, b; };
#define PREP_LOAD(X, chx) do { const int ch_ = (chx), h_ = (ch_ >> 7) & 7, n_ = ch_ & 127, m0_ = (ch_ >> 10) * SEQ + n_ * 64; \
        X.a = PROJ[(size_t)(m0_ + lane) * DINP + C_DNA + h_]; X.b = PROJ[(size_t)(m0_ + lane) * DINP + C_DNB + h_]; \
        _Pragma("unroll") for (int ts = 0; ts < 3; ++ts) _Pragma("unroll") for (int j = 0; j < 11; ++j) { const int ii = 8 * wave - 3 + j; \
            X.xr[ts][j] = (n_ * 64 + ii >= 0) ? *(const unsigned*)(PROJ + (size_t)(m0_ + ii) * DINP + ts * 1024 + h_ * 128 + 2 * lane) : 0u; } \
        { const float* cwp = inp(4) + (size_t)l * 4 * 3072 + h_ * 128 + 2 * lane; \
          _Pragma("unroll") for (int ts = 0; ts < 3; ++ts) _Pragma("unroll") for (int j = 0; j < 4; ++j) { X.cw[ts][j][0] = cwp[j * 3072 + ts * 1024]; X.cw[ts][j][1] = cwp[j * 3072 + ts * 1024 + 1]; } } } while (0)
    PrepIn cur; unsigned eat = 0u;
    for (int ch = F.bid; ch < 2048; ch += F.G) {
        const int b = ch >> 10, h = (ch >> 7) & 7, n = ch & 127, m0 = b * SEQ + n * 64;
        PREP_LOAD(cur, ch);
        unsigned touch = 0u;
        if (ch + F.G < 2048 && F.tid < 402) { const int cn = ch + F.G, hn = (cn >> 7) & 7, nn = cn & 127, mn = (cn >> 10) * SEQ + nn * 64; const int rowt = F.tid / 6 - 3, ln = F.tid % 6;
            if (nn * 64 + rowt >= 0) touch = *(const unsigned*)(PROJ + (size_t)(mn + rowt) * DINP + (ln >> 1) * 1024 + hn * 128 + (ln & 1) * 64); }
        const float a_neg = -__expf(inp(5)[l * 8 + h]), dtb = inp(6)[l * 8 + h];
        float gc, beta, gl;
        { const float a_in = bf1(cur.a), b_in = bf1(cur.b);
          const float z = a_in + dtb; const float sp = (z > 20.f) ? z : log1pf(__expf(z)); gc = a_neg * sp;
#pragma unroll
          for (int o = 1; o < 64; o <<= 1) { const float t = __shfl_up(gc, o); if (lane >= o) gc += t; }
          beta = sigmoidf_(b_in); gl = __shfl(gc, 63);
          if (wave == 0) { GC[lane] = gc; BT[lane] = beta; } }
        float sv[8][3][2], pp[16];
#pragma unroll
        for (int rr = 0; rr < 8; ++rr) {
#pragma unroll
            for (int ts = 0; ts < 3; ++ts) { float y0 = 0.f, y1 = 0.f;
#pragma unroll
                for (int j = 0; j < 4; ++j) { const unsigned xw = cur.xr[ts][rr + j]; y0 += cur.cw[ts][j][0] * bflo(xw); y1 += cur.cw[ts][j][1] * bfhi(xw); }
                sv[rr][ts][0] = siluf_(y0); sv[rr][ts][1] = siluf_(y1); }
            pp[2 * rr] = sv[rr][0][0] * sv[rr][0][0] + sv[rr][0][1] * sv[rr][0][1]; pp[2 * rr + 1] = sv[rr][1][0] * sv[rr][1][0] + sv[rr][1][1] * sv[rr][1][1];
        }
        float tot;
        { const bool b5 = (lane & 32) != 0, b4 = (lane & 16) != 0, b3 = (lane & 8) != 0, b2 = (lane & 4) != 0;
          float p8[8], p4[4], p2[2];
#pragma unroll
          for (int k = 0; k < 8; ++k) p8[k] = (b5 ? pp[k + 8] : pp[k]) + __shfl_xor(b5 ? pp[k] : pp[k + 8], 32);
#pragma unroll
          for (int k = 0; k < 4; ++k) p4[k] = (b4 ? p8[k + 4] : p8[k]) + __shfl_xor(b4 ? p8[k] : p8[k + 4], 16);
#pragma unroll
          for (int k = 0; k < 2; ++k) p2[k] = (b3 ? p4[k + 2] : p4[k]) + __shfl_xor(b3 ? p4[k] : p4[k + 2], 8);
          tot = (b2 ? p2[1] : p2[0]) + __shfl_xor(b2 ? p2[0] : p2[1], 4);
          tot += __shfl_xor(tot, 2); tot += __shfl_xor(tot, 1); }
        unsigned kg[2][4], kd[2][4], vb[2][4];
#pragma unroll
        for (int rr = 0; rr < 8; ++rr) {
            const int i = 8 * wave + rr;
            const float gci = __int_as_float(__builtin_amdgcn_readlane(__float_as_int(gc), i)), bi = __int_as_float(__builtin_amdgcn_readlane(__float_as_int(beta), i));
            const float scq = rsqrtf(__int_as_float(__builtin_amdgcn_readlane(__float_as_int(tot), 8 * rr)) + EPS) * 0.08838834764831845f;
            const float sck = rsqrtf(__int_as_float(__builtin_amdgcn_readlane(__float_as_int(tot), 8 * rr + 4)) + EPS);
            const float q0 = sv[rr][0][0] * scq, q1 = sv[rr][0][1] * scq, k0 = sv[rr][1][0] * sck, k1 = sv[rr][1][1] * sck, v0 = sv[rr][2][0], v1 = sv[rr][2][1];
            const float eg = __expf(gci), egl = __expf(gl - gci);
            *(LAS unsigned*)(QS + i * 136 + 2 * lane) = pk2(q0, q1); *(LAS unsigned*)(KS + i * 136 + 2 * lane) = pk2(k0, k1);
            *(unsigned*)((bf16*)(wsp() + WS_QD) + (size_t)ch * 8192 + ((((i >> 4) * 4 + (lane >> 4)) * 64 + ((lane >> 2) & 3) * 16 + (i & 15)) * 8 + 2 * (lane & 3))) = pk2(q0 * eg, q1 * eg);
            const unsigned g0 = f2bf(k0 * bi * eg), g1 = f2bf(k1 * bi * eg), d0 = f2bf(k0 * egl), d1 = f2bf(k1 * egl), u0 = f2bf(v0 * bi), u1 = f2bf(v1 * bi);
            if (rr & 1) { kg[0][rr >> 1] |= g0 << 16; kg[1][rr >> 1] |= g1 << 16; kd[0][rr >> 1] |= d0 << 16; kd[1][rr >> 1] |= d1 << 16; vb[0][rr >> 1] |= u0 << 16; vb[1][rr >> 1] |= u1 << 16; }
            else { kg[0][rr >> 1] = g0; kg[1][rr >> 1] = g1; kd[0][rr >> 1] = d0; kd[1][rr >> 1] = d1; vb[0][rr >> 1] = u0; vb[1][rr >> 1] = u1; }
        }
#pragma unroll
        for (int c = 0; c < 2; ++c) {
            *(LAS v4u*)(KGT + (2 * lane + c) * 72 + 8 * wave) = (v4u){kg[c][0], kg[c][1], kg[c][2], kg[c][3]};
            *(LAS v4u*)(KDT + (2 * lane + c) * 72 + 8 * wave) = (v4u){kd[c][0], kd[c][1], kd[c][2], kd[c][3]};
            *(LAS v4u*)(VT + (2 * lane + c) * 72 + 8 * wave) = (v4u){vb[c][0], vb[c][1], vb[c][2], vb[c][3]};
        }
        __syncthreads();
        if (PMODE == 2) continue;
        { const int ti = wave >> 1;
          bf16x8 kfi[4], qfi[4];
#pragma unroll
          for (int ks = 0; ks < 4; ++ks) { kfi[ks] = *(const LAS bf16x8*)(KS + (16 * ti + fr) * 136 + 32 * ks + 8 * fq); qfi[ks] = *(const LAS bf16x8*)(QS + (16 * ti + fr) * 136 + 32 * ks + 8 * fq); }
#pragma unroll
          for (int tt = 0; tt < 2; ++tt) { const int tj = 2 * (wave & 1) + tt;
              f32x4 akk = {0.f, 0.f, 0.f, 0.f}, aqk = {0.f, 0.f, 0.f, 0.f};
#pragma unroll
              for (int ks = 0; ks < 4; ++ks) { const bf16x8 kfj = *(const LAS bf16x8*)(KS + (16 * tj + fr) * 136 + 32 * ks + 8 * fq); akk = MFMA16(kfi[ks], kfj, akk); aqk = MFMA16(kfj, qfi[ks], aqk); }
              { const int j = 16 * tj + fr; const float gcj = GC[j];
#pragma unroll
                for (int r = 0; r < 4; ++r) { const int i = 16 * ti + 4 * fq + r; LM[i * 68 + j] = (i > j) ? BT[i] * akk[r] * __expf(GC[i] - gcj) : 0.f; } }
              { const int i = 16 * ti + fr; const float gci = GC[i]; float v[4];
#pragma unroll
                for (int r = 0; r < 4; ++r) { const int j = 16 * tj + 4 * fq + r; v[r] = (i >= j) ? aqk[r] * __expf(gci - GC[j]) : 0.f; }
                v2u w; w.x = pk2(v[0], v[1]); w.y = pk2(v[2], v[3]);
                *(v2u*)((bf16*)(wsp() + WS_AI) + (size_t)ch * 4096 + (((ti * 2 + (tj >> 1)) * 64 + ((2 * tj + (fq >> 1)) & 3) * 16 + fr) * 8 + 4 * (fq & 1))) = w; } } }
        __syncthreads();
        {
            LAS float* T11f = (LAS float*)(F.lds + 117248); LAS float* T22f = T11f + 1056; LAS float* Mf = T22f + 1056;
            if (wave < 2 && PMODE != 1) {
                const int cl = lane & 31;
                float x[32]; float clf = (float)cl; asm volatile("" : "+v"(clf));
                LAS float* Lh = LM + (32 * wave) * 68 + 32 * wave; asm volatile("" : "+v"(Lh));
#pragma unroll
                for (int i = 0; i < 32; ++i) x[i] = 0.f;
#pragma unroll
                for (int i = 0; i < 32; ++i) {
                    float a0 = fmaxf(0.f, 1.f - fabsf(clf - (float)i)), a1 = 0.f, a2 = 0.f, a3 = 0.f;
#pragma unroll
                    for (int j4 = 0; j4 < (i + 3) / 4; ++j4) { const f32x4 Lv = *(const LAS f32x4*)(Lh + i * 68 + 4 * j4);
                        a0 -= Lv.x * x[4 * j4]; a1 -= Lv.y * x[4 * j4 + 1]; a2 -= Lv.z * x[4 * j4 + 2]; a3 -= Lv.w * x[4 * j4 + 3]; }
                    x[i] = (a0 + a1) + (a2 + a3);
                }
                if (lane < 32) {
                    LAS float* tf = (wave ? T22f : T11f) + cl; asm volatile("" : "+v"(tf));
                    lbf tb = TB + (32 * wave) * 72 + 32 * wave + cl; asm volatile("" : "+v"(tb));
#pragma unroll
                    for (int i = 0; i < 32; ++i) { tf[i * 33] = x[i]; tb[i * 72] = (bf16)f2bf(x[i]); }
                } else if (wave == 0) {
                    lbf tz = TB + 32 + cl; asm volatile("" : "+v"(tz));
#pragma unroll
                    for (int i = 0; i < 32; ++i) tz[i * 72] = 0;
                }
            }
            __syncthreads();
            const int ti2 = F.tid >> 5, c2 = F.tid & 31;
            if (PMODE != 1) {
                float m0 = 0.f, m1 = 0.f;
#pragma unroll 8
                for (int k = 0; k < 32; ++k) { const float t = T11f[k * 33 + c2]; m0 += LM[(32 + ti2) * 68 + k] * t; m1 += LM[(48 + ti2) * 68 + k] * t; }
                Mf[ti2 * 33 + c2] = m0; Mf[(ti2 + 16) * 33 + c2] = m1;
            }
            __syncthreads();
            if (PMODE != 1) {
                float t0 = 0.f, t1 = 0.f;
#pragma unroll 8
                for (int k = 0; k < 32; ++k) { const float mm = Mf[k * 33 + c2]; t0 -= T22f[ti2 * 33 + k] * mm; t1 -= T22f[(ti2 + 16) * 33 + k] * mm; }
                TB[(32 + ti2) * 72 + c2] = (bf16)f2bf(t0); TB[(48 + ti2) * 72 + c2] = (bf16)f2bf(t1);
            }
        }
        __syncthreads();
        eat ^= touch;
        { const int ti = wave & 3;
          bf16x8 tf[2];
#pragma unroll
          for (int ks = 0; ks < 2; ++ks) tf[ks] = *(const LAS bf16x8*)(TB + (16 * ti + fr) * 72 + 32 * ks + 8 * fq);
#pragma unroll
          for (int q4 = 0; q4 < 4; ++q4) { const int te = (wave >> 2) * 4 + q4;
              f32x4 au = {0.f, 0.f, 0.f, 0.f}, aw = {0.f, 0.f, 0.f, 0.f};
#pragma unroll
              for (int ks = 0; ks < 2; ++ks) { const bf16x8 vf = *(const LAS bf16x8*)(VT + (16 * te + fr) * 72 + 32 * ks + 8 * fq), gf = *(const LAS bf16x8*)(KGT + (16 * te + fr) * 72 + 32 * ks + 8 * fq);
                  au = MFMA16(tf[ks], vf, au); aw = MFMA16(gf, tf[ks], aw); }
              v2u w; w.x = pk2(au[0], au[1]); w.y = pk2(au[2], au[3]);
              *(v2u*)((bf16*)(wsp() + WS_UT) + (size_t)ch * 8192 + ((te * 4 + ti) * 64 + lane) * 4) = w;
              w.x = pk2(aw[0], aw[1]); w.y = pk2(aw[2], aw[3]);
              *(v2u*)((bf16*)(wsp() + WS_W) + (size_t)ch * 8192 + (((ti * 4 + (te >> 1)) * 64 + ((2 * te + (fq >> 1)) & 3) * 16 + fr) * 8 + 4 * (fq & 1))) = w; }
          { const int d = F.tid >> 2, part = F.tid & 3; const LAS v4u* src = (const LAS v4u*)((LAS unsigned char*)KDT + d * 144 + part * 32);
            bf16* dstb = (bf16*)(wsp() + WS_KDT) + (size_t)ch * 8192 + (((d >> 4) * 2 + (part >> 1)) * 64 + (2 * (part & 1)) * 16 + (d & 15)) * 8; *(v4u*)dstb = src[0]; *(v4u*)(dstb + 128) = src[1]; }
          if (F.tid == 0) ((float*)(wsp() + WS_GL))[ch] = gl; }
        __syncthreads();
    }
    if (eat == 0x12345u && fq == 77) GC[0] = 1.f;
}
#undef PREP_LOAD
struct DnSetC { bf16x8 wf[4], qf[4], af[2]; v2u ut[2]; };
struct DnSetS { bf16x8 kf[2][2]; float gl; unsigned pf; };
template <int MODE>
__device__ __forceinline__ void dn_scan(Frame& F_, int sid) {
    Frame F = mkframe();
    const int bh = sid >> 2, slice = sid & 3, b = bh >> 3, h = bh & 7;
    const int lane = F.lane, wave = F.wave, fr = lane & 15, fq = lane >> 4;
    lbf ST = (lbf)(F.lds); lbf VT2 = (lbf)(F.lds + 8704);
    for (int i = F.tid; i < (8704 + 4608) / 4; i += NTHR) ((LAS unsigned*)F.lds)[i] = 0u;
    const bf16* pW = (const bf16*)(wsp() + WS_W) + (size_t)bh * 128 * 8192; const bf16* pQ = (const bf16*)(wsp() + WS_QD) + (size_t)bh * 128 * 8192;
    const bf16* pA = (const bf16*)(wsp() + WS_AI) + (size_t)bh * 128 * 4096; const bf16* pK = (const bf16*)(wsp() + WS_KDT) + (size_t)bh * 128 * 8192;
    const bf16* pU = (const bf16*)(wsp() + WS_UT) + (size_t)bh * 128 * 8192; const float* pG = (const float*)(wsp() + WS_GL) + bh * 128;
    bf16* pO = (bf16*)(wsp() + WS_XN) + (size_t)b * SEQ * D + h * 128 + 32 * slice;
    short eat = 0;
    __syncthreads();
    if (wave < 4) {
        const int mi = wave;
        const unsigned oW = (mi * 4 * 64 + lane) * 8, oA = (mi * 2 * 64 + lane) * 8, oU = ((2 * slice) * 4 + mi) * 256 + lane * 4, oO = (16 * mi + fr) * D + 4 * fq;
#define DNC_LOAD(X, nn) do { const int c_ = (nn) < 128 ? (nn) : 127; \
            X.ut[0] = *(const v2u*)(pU + (size_t)c_ * 8192 + oU); X.ut[1] = *(const v2u*)(pU + (size_t)c_ * 8192 + oU + 1024); \
            _Pragma("unroll") for (int ks = 0; ks < 4; ++ks) { X.wf[ks] = *(const bf16x8*)(pW + (size_t)c_ * 8192 + (oW + 512 * ks)); X.qf[ks] = *(const bf16x8*)(pQ + (size_t)c_ * 8192 + (oW + 512 * ks)); } \
            _Pragma("unroll") for (int ks = 0; ks < 2; ++ks) X.af[ks] = *(const bf16x8*)(pA + (size_t)c_ * 4096 + (oA + 512 * ks)); } while (0)
#define DNC_STEP(X, nn) do { \
            f32x4 c1[2], c2[2]; \
            _Pragma("unroll") for (int ni = 0; ni < 2; ++ni) { c1[ni] = (f32x4){0.f, 0.f, 0.f, 0.f}; c2[ni] = (f32x4){0.f, 0.f, 0.f, 0.f}; \
                _Pragma("unroll") for (int ks = 0; ks < 4; ++ks) { const bf16x8 sf = *(const LAS bf16x8*)(ST + (16 * ni + fr) * 136 + 32 * ks + 8 * fq); c1[ni] = MFMA16(X.wf[ks], sf, c1[ni]); c2[ni] = MFMA16(sf, X.qf[ks], c2[ni]); } \
                v2u w_; w_.x = pk2(bflo(X.ut[ni].x) - c1[ni][0], bfhi(X.ut[ni].x) - c1[ni][1]); w_.y = pk2(bflo(X.ut[ni].y) - c1[ni][2], bfhi(X.ut[ni].y) - c1[ni][3]); \
                *(LAS v2u*)(VT2 + (16 * ni + fr) * 72 + 16 * mi + 4 * fq) = w_; } \
            __syncthreads(); \
            _Pragma("unroll") for (int ni = 0; ni < 2; ++ni) { \
                _Pragma("unroll") for (int ks = 0; ks < 2; ++ks) { const bf16x8 vf = *(const LAS bf16x8*)(VT2 + (16 * ni + fr) * 72 + 32 * ks + 8 * fq); c2[ni] = MFMA16(vf, X.af[ks], c2[ni]); } \
                v2u w_; w_.x = pk2(c2[ni][0], c2[ni][1]); w_.y = pk2(c2[ni][2], c2[ni][3]); if (MODE == 0) *(v2u*)(pO + (size_t)(nn) * 64 * D + oO + 16 * ni) = w_; } \
            __syncthreads(); } while (0)
        DnSetC SA, SB, SC;
        DNC_LOAD(SA, 0); DNC_LOAD(SB, 1);
        for (int n = 0; n < 126; n += 3) {
            DNC_LOAD(SC, n + 2); __builtin_amdgcn_sched_barrier(0); DNC_STEP(SA, n); __builtin_amdgcn_sched_barrier(0);
            DNC_LOAD(SA, n + 3); __builtin_amdgcn_sched_barrier(0); DNC_STEP(SB, n + 1); __builtin_amdgcn_sched_barrier(0);
            DNC_LOAD(SB, n + 4); __builtin_amdgcn_sched_barrier(0); DNC_STEP(SC, n + 2); __builtin_amdgcn_sched_barrier(0);
        }
        DNC_STEP(SA, 126); DNC_STEP(SB, 127);
#undef DNC_LOAD
#undef DNC_STEP
    } else {
        const int dq = wave - 4;
        f32x4 accS[2][2];
#pragma unroll
        for (int k = 0; k < 2; ++k)
#pragma unroll
            for (int ni = 0; ni < 2; ++ni) accS[k][ni] = (f32x4){0.f, 0.f, 0.f, 0.f};
        const int lt = F.tid - 256, li = slice * 112 + lt; const bool toucher = lt < 144;
        const bf16* pfBase = (lt >= 112) ? pU + 2048 * slice + (lt - 112) * 64 : (li < 128) ? pW + li * 64 : (li < 256) ? pQ + (li - 128) * 64 : (li < 384) ? pK + (li - 256) * 64 : pA + (li - 384) * 64;
        const unsigned pfStride = (lt >= 112 || li < 384) ? 8192u : 4096u;
        const unsigned oK = (2 * dq * 2 * 64 + lane) * 8;
#define DNS_LOAD(X, nn) do { const int c_ = (nn) < 128 ? (nn) : 127; eat ^= (short)X.pf; X.gl = pG[c_]; \
            _Pragma("unroll") for (int ks = 0; ks < 2; ++ks) { X.kf[0][ks] = *(const bf16x8*)(pK + (size_t)c_ * 8192 + (oK + 512 * ks)); X.kf[1][ks] = *(const bf16x8*)(pK + (size_t)c_ * 8192 + (oK + 1024 + 512 * ks)); } \
            { const int c2_ = (nn) + 2 < 128 ? (nn) + 2 : 127; X.pf = toucher ? *(const unsigned*)(pfBase + (size_t)c2_ * pfStride) : 0u; } } while (0)
#define DNS_STEP(X, nn) do { \
            const float egl = __expf(X.gl); \
            __syncthreads(); \
            _Pragma("unroll") for (int ni = 0; ni < 2; ++ni) { bf16x8 vf[2]; \
                _Pragma("unroll") for (int ks = 0; ks < 2; ++ks) vf[ks] = *(const LAS bf16x8*)(VT2 + (16 * ni + fr) * 72 + 32 * ks + 8 * fq); \
                _Pragma("unroll") for (int k = 0; k < 2; ++k) { accS[k][ni] = accS[k][ni] * egl; \
                    _Pragma("unroll") for (int ks = 0; ks < 2; ++ks) accS[k][ni] = MFMA16(X.kf[k][ks], vf[ks], accS[k][ni]); \
                    v2u w_; w_.x = pk2(accS[k][ni][0], accS[k][ni][1]); w_.y = pk2(accS[k][ni][2], accS[k][ni][3]); \
                    *(LAS v2u*)(ST + (16 * ni + fr) * 136 + 16 * (2 * dq + k) + 4 * fq) = w_; } } \
            __syncthreads(); } while (0)
        DnSetS SA, SB, SC; SA.pf = 0u; SB.pf = 0u; SC.pf = 0u;
        DNS_LOAD(SA, 0); DNS_LOAD(SB, 1);
        for (int n = 0; n < 126; n += 3) {
            DNS_LOAD(SC, n + 2); __builtin_amdgcn_sched_barrier(0); DNS_STEP(SA, n); __builtin_amdgcn_sched_barrier(0);
            DNS_LOAD(SA, n + 3); __builtin_amdgcn_sched_barrier(0); DNS_STEP(SB, n + 1); __builtin_amdgcn_sched_barrier(0);
            DNS_LOAD(SB, n + 4); __builtin_amdgcn_sched_barrier(0); DNS_STEP(SC, n + 2); __builtin_amdgcn_sched_barrier(0);
        }
        DNS_STEP(SA, 126); DNS_STEP(SB, 127);
#undef DNS_LOAD
#undef DNS_STEP
    }
    if (eat == 12345 && fq == 77) VT2[0] = (bf16)eat;
}
__device__ __forceinline__ void rope16(v4u& w0, v4u& w1, const float* rp) {
    float x[8], y[8];
#pragma unroll
    for (int j = 0; j < 4; ++j) { x[2 * j] = bflo(w0[j]); x[2 * j + 1] = bfhi(w0[j]); y[2 * j] = bflo(w1[j]); y[2 * j + 1] = bfhi(w1[j]); }
    const f32x4 c0 = *(const f32x4*)rp, c1 = *(const f32x4*)(rp + 4), s0 = *(const f32x4*)(rp + 8), s1 = *(const f32x4*)(rp + 12);
    float c[8] = {c0.x, c0.y, c0.z, c0.w, c1.x, c1.y, c1.z, c1.w}, s[8] = {s0.x, s0.y, s0.z, s0.w, s1.x, s1.y, s1.z, s1.w};
#pragma unroll
    for (int j = 0; j < 8; ++j) { const float a = x[j], bb = y[j]; x[j] = a * c[j] - bb * s[j]; y[j] = bb * c[j] + a * s[j]; }
#pragma unroll
    for (int j = 0; j < 4; ++j) { w0[j] = pk2(x[2 * j], x[2 * j + 1]); w1[j] = pk2(y[2 * j], y[2 * j + 1]); }
}
__device__ __forceinline__ void swa_mfma(Frame& F_, int l, int nskip) {
    Frame F = mkframe();
    bf16* PROJ = (bf16*)(wsp() + WS_PROJ); const float* ROPE = (const float*)(wsp() + WS_ROPE);
    lbf KL = (lbf)(F.lds), VTL = (lbf)(F.lds + 29952), QL = (lbf)(F.lds + 57600 + F.wave * 9216);
    const int tid = F.tid, lane = F.lane, wave = F.wave, fr = lane & 15, fq = lane >> 4;
    for (int unit = F.bid - nskip; unit < 512; unit += F.G - nskip) {
        const int b = unit >> 8, kvh = (unit >> 7) & 1, q0 = (unit & 127) * 64;
        for (int task = tid; task < 208 * 4; task += NTHR) { const int kl = task >> 2, seg = task & 3, tk = q0 - 128 + kl; v4u w0 = {0u, 0u, 0u, 0u}, w1 = {0u, 0u, 0u, 0u};
            if (kl < 192 && tk >= 0) { const int mk = b * SEQ + tk; const v4u* p = (const v4u*)(PROJ + (size_t)mk * DINP + C_SWK + kvh * 64 + 16 * seg); w0 = p[0]; w1 = p[1];
                if (seg == 0) rope16(w0, w1, ROPE + mk * 16); }
            *(LAS v4u*)(KL + kl * 72 + 16 * seg) = w0; *(LAS v4u*)(KL + kl * 72 + 16 * seg + 8) = w1; }
        for (int task = tid; task < 192 * 8; task += NTHR) { const int kl = task >> 3, seg = task & 7, tk = q0 - 128 + kl; v4u w = {0u, 0u, 0u, 0u};
            if (tk >= 0) w = *(const v4u*)(PROJ + (size_t)(b * SEQ + tk) * DINP + C_SWV + kvh * 64 + 8 * seg);
#pragma unroll
            for (int j = 0; j < 4; ++j) { VTL[(8 * seg + 2 * j) * 216 + kl] = (bf16)(w[j] & 0xffffu); VTL[(8 * seg + 2 * j + 1) * 216 + kl] = (bf16)(w[j] >> 16); } }
        for (int i = tid; i < 1024; i += NTHR) VTL[(i >> 4) * 216 + 192 + (i & 15)] = 0;
        { const int mq = b * SEQ + q0 + lane; const v4u* qp = (const v4u*)(PROJ + (size_t)mq * DINP + C_SWQ + (kvh * 8 + wave) * 64);
          v4u w[8];
#pragma unroll
          for (int i = 0; i < 8; ++i) w[i] = qp[i];
          rope16(w[0], w[1], ROPE + mq * 16);
#pragma unroll
          for (int i = 0; i < 8; ++i) { v4u o;
#pragma unroll
              for (int j = 0; j < 4; ++j) o[j] = pk2(bflo(w[i][j]) * 0.125f, bfhi(w[i][j]) * 0.125f);
              *(LAS v4u*)(QL + lane * 72 + 8 * i) = o; } }
        __syncthreads();
        const float sink = inp(8)[l * 16 + kvh * 8 + wave];
#pragma unroll 1
        for (int qt = 0; qt < 4; ++qt) {
            bf16x8 qf[2];
#pragma unroll
            for (int ks = 0; ks < 2; ++ks) qf[ks] = *(const LAS bf16x8*)(QL + (16 * qt + fr) * 72 + 32 * ks + 8 * fq);
            f32x4 st[10];
#pragma unroll
            for (int t = 0; t < 10; ++t) { st[t] = (f32x4){0.f, 0.f, 0.f, 0.f};
#pragma unroll
                for (int ks = 0; ks < 2; ++ks) { const bf16x8 kf = *(const LAS bf16x8*)(KL + (16 * (qt + t) + fr) * 72 + 32 * ks + 8 * fq); st[t] = MFMA16(kf, qf[ks], st[t]); } }
            const int qr = 16 * qt + fr; float mx = -1e30f;
#pragma unroll
            for (int t = 0; t < 10; ++t)
#pragma unroll
                for (int r = 0; r < 4; ++r) { const int kl = 16 * (qt + t) + 4 * fq + r; const bool ok = (kl > qr) && (kl <= qr + 128) && (q0 - 128 + kl >= 0);
                    st[t][r] = ok ? st[t][r] : -1e30f; mx = fmaxf(mx, st[t][r]); }
            mx = fmaxf(mx, __shfl_xor(mx, 16)); mx = fmaxf(mx, __shfl_xor(mx, 32)); mx = fmaxf(mx, sink);
            float sum = 0.f;
#pragma unroll
            for (int t = 0; t < 10; ++t)
#pragma unroll
                for (int r = 0; r < 4; ++r) { const float p = (st[t][r] > -1e29f) ? __expf(st[t][r] - mx) : 0.f; st[t][r] = p; sum += p; }
            sum += __shfl_xor(sum, 16); sum += __shfl_xor(sum, 32);
            const float inv = 1.f / (sum + __expf(sink - mx));
            bf16x8 pf[5];
#pragma unroll
            for (int pr = 0; pr < 5; ++pr) { v4u w; w.x = pk2(st[2 * pr][0] * inv, st[2 * pr][1] * inv); w.y = pk2(st[2 * pr][2] * inv, st[2 * pr][3] * inv);
                w.z = pk2(st[2 * pr + 1][0] * inv, st[2 * pr + 1][1] * inv); w.w = pk2(st[2 * pr + 1][2] * inv, st[2 * pr + 1][3] * inv); pf[pr] = __builtin_bit_cast(bf16x8, w); }
#pragma unroll
            for (int dt = 0; dt < 4; ++dt) { f32x4 acc = {0.f, 0.f, 0.f, 0.f};
#pragma unroll
                for (int pr = 0; pr < 5; ++pr) { const v2u a0 = *(const LAS v2u*)(VTL + (16 * dt + fr) * 216 + 16 * (qt + 2 * pr) + 4 * fq), a1 = *(const LAS v2u*)(VTL + (16 * dt + fr) * 216 + 16 * (qt + 2 * pr + 1) + 4 * fq);
                    v4u aw; aw.x = a0.x; aw.y = a0.y; aw.z = a1.x; aw.w = a1.y; acc = MFMA16(__builtin_bit_cast(bf16x8, aw), pf[pr], acc); }
                v2u w; w.x = pk2(acc[0], acc[1]); w.y = pk2(acc[2], acc[3]);
                *(v2u*)(PROJ + (size_t)(b * SEQ + q0 + 16 * qt + fr) * DINP + C_SWQ + (kvh * 8 + wave) * 64 + 16 * dt + 4 * fq) = w; }
        }
        __syncthreads();
    }
}
__device__ __forceinline__ void dn_naive(Frame& F_, int l) {
    Frame F = mkframe(); const int b = F.bid >> 3, h = F.bid & 7;
    const bf16* PROJ = (const bf16*)(wsp() + WS_PROJ); bf16* ORAW = (bf16*)(wsp() + WS_XN);
    LAS float* vals = (LAS float*)F.lds;
    LAS float* part = vals + 768;
    LAS float* bg = part + 16;
    LAS float* red = bg + 4;
    LAS float* red2 = red + 1024;
    const int tid = F.tid, lane = F.lane, wave = F.wave;
    const int e = tid & 127, r = tid >> 7;
    int col; float cw0 = 0.f, cw1 = 0.f, cw2 = 0.f, cw3 = 0.f;
    if (tid < 384) { const int chan = (tid >> 7) * 1024 + h * 128 + (tid & 127); col = chan; const float* cw = inp(4) + (size_t)l * 4 * 3072;
        cw0 = cw[chan]; cw1 = cw[3072 + chan]; cw2 = cw[2 * 3072 + chan]; cw3 = cw[3 * 3072 + chan]; }
    else if (tid == 384) col = C_DNB + h; else if (tid == 385) col = C_DNA + h; else col = 0;
    const float a_neg = -__expf(inp(5)[l * 8 + h]), dtb = inp(6)[l * 8 + h];
    float S[32];
#pragma unroll
    for (int i = 0; i < 32; ++i) S[i] = 0.f;
    float x0 = 0.f, x1 = 0.f, x2 = 0.f;
    const bf16* pcol = PROJ + (size_t)b * SEQ * DINP + col;
    float cur[16], nxt[16];
#pragma unroll
    for (int i = 0; i < 16; ++i) cur[i] = bf1(pcol[(size_t)i * DINP]);
    for (int tb = 0; tb < SEQ; tb += 16) {
        if (tb + 16 < SEQ) {
#pragma unroll
            for (int i = 0; i < 16; ++i) nxt[i] = bf1(pcol[(size_t)(tb + 16 + i) * DINP]);
        }
#pragma unroll
        for (int i = 0; i < 16; ++i) {
            const int t = tb + i, buf = i & 1;
            const float xin = cur[i];
            if (tid < 384) {
                const float y = cw0 * x0 + cw1 * x1 + cw2 * x2 + cw3 * xin; x0 = x1; x1 = x2; x2 = xin;
                const float s = siluf_(y); vals[buf * 384 + tid] = s;
                const float ss = wave_sum(s * s); if (lane == 0) part[buf * 8 + wave] = ss;
            } else if (tid == 384) { bg[buf * 2 + 0] = sigmoidf_(xin); }
            else if (tid == 385) { const float z = xin + dtb; const float sp = (z > 20.f) ? z : log1pf(__expf(z)); bg[buf * 2 + 1] = __expf(a_neg * sp); }
            __syncthreads();
            const float sq = rsqrtf(part[buf * 8 + 0] + part[buf * 8 + 1] + EPS) * 0.08838834764831845f;
            const float sk = rsqrtf(part[buf * 8 + 2] + part[buf * 8 + 3] + EPS);
            const float beta = bg[buf * 2 + 0], eg = bg[buf * 2 + 1];
            const LAS float* qv = vals + buf * 384 + 32 * r; const LAS float* kv = vals + buf * 384 + 128 + 32 * r;
            float pk = 0.f, pq = 0.f, pqk = 0.f;
#pragma unroll
            for (int dd = 0; dd < 32; ++dd) { const float kd = kv[dd], qd = qv[dd]; pk += kd * S[dd]; pq += qd * S[dd]; pqk += qd * kd; }
            red[(buf * 4 + r) * 128 + e] = pk * sk; red[((1 - buf) * 4 + r) * 128 + e] = pq * sq;
            if (e == 0) red2[r] = pqk;
            __syncthreads();
            float kS = 0.f, qS = 0.f;
#pragma unroll
            for (int rr = 0; rr < 4; ++rr) { kS += red[(buf * 4 + rr) * 128 + e]; qS += red[((1 - buf) * 4 + rr) * 128 + e]; }
            const float qk = (red2[0] + red2[1] + red2[2] + red2[3]) * sq * sk;
            const float ve = vals[buf * 384 + 256 + e];
            const float delta = beta * (ve - eg * kS);
            if (r == 0) ORAW[(size_t)(b * SEQ + t) * D + h * 128 + e] = (bf16)f2bf(eg * qS + qk * delta);
            const float kdl = sk * delta;
#pragma unroll
            for (int dd = 0; dd < 32; ++dd) S[dd] = eg * S[dd] + kv[dd] * kdl;
            __syncthreads();
        }
#pragma unroll
        for (int i = 0; i < 16; ++i) cur[i] = nxt[i];
    }
}
__device__ __forceinline__ void swa_naive(Frame& F_, int l, int nskip) {
    Frame F = mkframe(); const int w0 = (F.bid - nskip) * NWAVES + F.wave, nw = (F.G - nskip) * NWAVES;
    bf16* PROJ = (bf16*)(wsp() + WS_PROJ); const float* ROPE = (const float*)(wsp() + WS_ROPE);
    LAS float* qs = (LAS float*)(F.lds + F.wave * 8192);
    LAS float* ps = qs + 512;
    const int lane = F.lane;
    for (int task = w0; task < M * 2; task += nw) {
        const int m = task >> 1, kvh = task & 1, b = m / SEQ, t = m % SEQ;
        { const float c = ROPE[m * 16 + (lane & 7)], s = ROPE[m * 16 + 8 + (lane & 7)];
#pragma unroll
          for (int g = 0; g < 8; ++g) { const float x = bf1(PROJ[(size_t)m * DINP + C_SWQ + (kvh * 8 + g) * 64 + lane]); const float p = __shfl_xor(x, 8);
              const float y = (lane < 8) ? (x * c - p * s) : ((lane < 16) ? (x * c + p * s) : x); qs[g * 64 + lane] = y * 0.125f; } }
        asm volatile("s_waitcnt lgkmcnt(0)" ::: "memory");
#pragma unroll 1
        for (int kk = 0; kk < 2; ++kk) {
            const int tk = t - 127 + lane + 64 * kk; const bool valid = tk >= 0; const int mk = b * SEQ + (valid ? tk : 0);
            float kf[64];
            const v4u* kr = (const v4u*)(PROJ + (size_t)mk * DINP + C_SWK + kvh * 64);
#pragma unroll
            for (int i = 0; i < 8; ++i) { const v4u w = kr[i];
#pragma unroll
                for (int j = 0; j < 4; ++j) { kf[8 * i + 2 * j] = bflo(w[j]); kf[8 * i + 2 * j + 1] = bfhi(w[j]); } }
#pragma unroll
            for (int j = 0; j < 8; ++j) { const float c = ROPE[mk * 16 + j], s = ROPE[mk * 16 + 8 + j]; const float a = kf[j], bb = kf[j + 8]; kf[j] = a * c - bb * s; kf[j + 8] = bb * c + a * s; }
#pragma unroll
            for (int g = 0; g < 8; ++g) { float a = 0.f;
#pragma unroll
                for (int d4 = 0; d4 < 16; ++d4) { const f32x4 q = *(const LAS f32x4*)(qs + g * 64 + 4 * d4); a += q.x * kf[4 * d4] + q.y * kf[4 * d4 + 1] + q.z * kf[4 * d4 + 2] + q.w * kf[4 * d4 + 3]; }
                ps[(lane + 64 * kk) * 8 + g] = valid ? a : -1e30f; }
        }
        asm volatile("s_waitcnt lgkmcnt(0)" ::: "memory");
#pragma unroll
        for (int g = 0; g < 8; ++g) {
            const float sink = inp(8)[l * 16 + kvh * 8 + g];
            const float s0 = ps[lane * 8 + g], s1 = ps[(lane + 64) * 8 + g];
            const float mx = fmaxf(wave_max(fmaxf(s0, s1)), sink);
            const float p0 = (s0 > -1e29f) ? __expf(s0 - mx) : 0.f, p1 = (s1 > -1e29f) ? __expf(s1 - mx) : 0.f;
            const float den = wave_sum(p0 + p1) + __expf(sink - mx); const float inv = 1.f / den;
            ps[lane * 8 + g] = p0 * inv; ps[(lane + 64) * 8 + g] = p1 * inv;
        }
        asm volatile("s_waitcnt lgkmcnt(0)" ::: "memory");
        float o[8];
#pragma unroll
        for (int g = 0; g < 8; ++g) o[g] = 0.f;
        const int j0 = (t >= 127) ? 0 : (127 - t);
        for (int j = j0; j < 128; ++j) {
            const int mk = b * SEQ + t - 127 + j;
            const float v = bf1(PROJ[(size_t)mk * DINP + C_SWV + kvh * 64 + lane]);
            const f32x4 pa = *(const LAS f32x4*)(ps + j * 8), pb = *(const LAS f32x4*)(ps + j * 8 + 4);
            o[0] += pa.x * v; o[1] += pa.y * v; o[2] += pa.z * v; o[3] += pa.w * v; o[4] += pb.x * v; o[5] += pb.y * v; o[6] += pb.z * v; o[7] += pb.w * v;
        }
#pragma unroll
        for (int g = 0; g < 8; ++g) PROJ[(size_t)m * DINP + C_SWQ + (kvh * 8 + g) * 64 + lane] = (bf16)f2bf(o[g]);
        asm volatile("s_waitcnt lgkmcnt(0)" ::: "memory");
    }
}
__device__ __forceinline__ void phase_gnorm(Frame& F_, int l) {
    Frame F = mkframe();
    bf16* PROJ = (bf16*)(wsp() + WS_PROJ); const bf16* ORAW = (const bf16*)(wsp() + WS_XN);
    const int gw = F.bid * NWAVES + F.wave, NGW = F.G * NWAVES;
    const float g0 = inp(7)[l * 128 + 2 * F.lane], g1 = inp(7)[l * 128 + 2 * F.lane + 1];
    for (int m = gw; m < M; m += NGW) {
        unsigned ow[8], zw[8];
#pragma unroll
        for (int h = 0; h < 8; ++h) { ow[h] = *(const unsigned*)(ORAW + (size_t)m * D + h * 128 + 2 * F.lane); zw[h] = *(const unsigned*)(PROJ + (size_t)m * DINP + C_DNZ + h * 128 + 2 * F.lane); }
        float ss[8];
#pragma unroll
        for (int h = 0; h < 8; ++h) { const float o0 = bflo(ow[h]), o1 = bfhi(ow[h]); ss[h] = o0 * o0 + o1 * o1; }
#pragma unroll
        for (int o = 1; o < 64; o <<= 1) {
#pragma unroll
            for (int h = 0; h < 8; ++h) ss[h] += __shfl_xor(ss[h], o); }
#pragma unroll
        for (int h = 0; h < 8; ++h) { const float r = rsqrtf(ss[h] * (1.f / 128.f) + EPS);
            *(unsigned*)(PROJ + (size_t)m * DINP + C_DNQ + h * 128 + 2 * F.lane) = pk2(bflo(ow[h]) * r * g0 * siluf_(bflo(zw[h])), bfhi(ow[h]) * r * g1 * siluf_(bfhi(zw[h]))); }
    }
}

#ifndef PROBE_ECHO
#define PROBE_ECHO 0
#endif
#define ECHO_BEGIN(k) do { if (PROBE_ECHO == (k)) echo_t0 = __builtin_amdgcn_s_memrealtime(); } while (0)
#define ECHO_END(k) do { if (PROBE_ECHO == (k)) { const unsigned long long t1_ = __builtin_amdgcn_s_memrealtime(), d_ = t1_ - echo_t0; while (__builtin_amdgcn_s_memrealtime() - t1_ < d_) __builtin_amdgcn_s_sleep(8); } } while (0)
#ifndef PROBE_DUP
#define PROBE_DUP 0
#endif
#ifndef DN_NAIVE
#define DN_NAIVE 0
#endif
struct Args { const float* in[17]; float* out; unsigned char* ws; };
__global__ void __launch_bounds__(NTHR, 2) hybrid_fwd(Args args) {
    cg::grid_group grid = cg::this_grid();
    Frame F;
    F.lds = lds_base();
    F.tid = threadIdx.x; F.lane = F.tid & 63; F.wave = __builtin_amdgcn_readfirstlane(F.tid >> 6);
    F.G = gridDim.x; F.bid = blockIdx.x;
#define PROJ ((bf16*)(wsp() + WS_PROJ))
#define XN ((bf16*)(wsp() + WS_XN))
#define YF ((float*)(wsp() + WS_YF))
#define MIX ((bf16*)(wsp() + WS_MIX))
#define HB ((bf16*)(wsp() + WS_H))

    unsigned long long echo_t0 = 0; (void)echo_t0;
    ECHO_BEGIN(9); ECHO_BEGIN(10); ECHO_BEGIN(11);
    if (F.bid == 0) { for (int i = F.tid; i < XCD_BAR_WORDS; i += NTHR) ((unsigned*)(wsp() + WS_BAR))[i] = 0u; for (int i = F.tid; i < 16384; i += NTHR) ((unsigned*)(wsp() + WS_XCNT))[i] = 0u; if (F.tid < 256) ((unsigned*)(wsp() + WS_SUBCNT))[F.tid] = 0u; }
    if (F.tid < 4) ((LAS unsigned*)(lds_base() + LDS_BARST))[F.tid] = 0u;
    grid.sync();
    ECHO_END(10);
    xcd_barrier_post();
    phase_rope(F);
    phase_norm(F, nullptr, nullptr, inp(0), outp(), inp(2), XN);
    phase_convert(F, -1, 0, 0);
    grid_bar();
    ECHO_END(9);
    for (int l = 0; l < DEPTH; ++l) {
        ECHO_BEGIN(1);
        {
            pg8::Gemm g{XN, (const bf16*)(wsp() + WS_WIN), nullptr, nullptr, M, DINP, D, D}; pg8::StaticOrder S; { Frame Fg = mkframe(); S.init(M, DINP, Fg.G, Fg.bid); }
            pg8::EpiBf16<0> E{PROJ, DINP};
            pg8::gemm_phase<pg8::EpiBf16<0>, pg8::StaticOrder, true, true>(F.lds, g, S, E);
#if PROBE_DUP == 5
            pg8::gemm_phase<pg8::EpiBf16<0>, pg8::StaticOrder, true, true>(F.lds, g, S, E);
#endif
        }
        grid_bar(); ECHO_END(1); ECHO_BEGIN(2);
#if DN_NAIVE
        if (F.bid < 16) dn_naive(F, l);
        else swa_naive(F, l, 16);
#else
#if PROBE_DUP == 1
        dn_prep<0>(F, l);
#elif PROBE_DUP == 11
        dn_prep<1>(F, l);
#elif PROBE_DUP == 12
        dn_prep<2>(F, l);
#elif PROBE_DUP == 13
        dn_prep<3>(F, l);
#elif PROBE_DUP == 14
        dn_prep<4>(F, l);
#endif
        dn_prep<0>(F, l);
        grid_bar(); ECHO_END(2); ECHO_BEGIN(3);
        { Frame Fg = mkframe(); if (Fg.bid < 64) { const int sid_ = (((Fg.bid & 7) * 2 + (Fg.bid >> 5)) << 2) | ((Fg.bid >> 3) & 3); dn_scan<0>(F, sid_);
#if PROBE_DUP == 2
            dn_scan<0>(F, sid_);
#elif PROBE_DUP == 3
            dn_scan<1>(F, sid_);
#elif PROBE_DUP == 4
            dn_scan<2>(F, sid_);
#endif
        }
        else {
            phase_convert(F, l, (l + 1 < DEPTH) ? l + 1 : -1, 64);
            __syncthreads();
            swa_mfma(F, l, 64);
            sub_bar((unsigned*)(wsp() + WS_SUBCNT) + 64 * l, (unsigned)(Fg.G - 64));
            pg8::Gemm g{PROJ + C_SWQ, (const bf16*)(wsp() + WS_WUPSW), nullptr, nullptr, M, D, D, DINP}; pg8::StaticOrder S; S.init(M, D, Fg.G - 64, Fg.bid - 64);
            pg8::EpiYb E{PROJ + C_DNK, DINP, PROJ + C_GB, DINP};
            pg8::gemm_phase<pg8::EpiYb, pg8::StaticOrder, true, true>(F.lds, g, S, E);
        } }
#endif
        grid_bar(); ECHO_END(3); ECHO_BEGIN(4);
        phase_gnorm(F, l);
#if PROBE_DUP == 6
        phase_gnorm(F, l);
#endif
        grid_bar(); ECHO_END(4); ECHO_BEGIN(5);
        {
            pg8::Gemm g{PROJ + C_DNQ, (const bf16*)(wsp() + WS_WUPDN), nullptr, nullptr, M, D, D, DINP}; pg8::StaticOrder S; { Frame Fg = mkframe(); S.init(M, D, Fg.G, Fg.bid); }
            pg8::EpiMerge2 E{MIX, D, PROJ + C_GA, PROJ + C_DNK, DINP};
            pg8::gemm_phase<pg8::EpiMerge2, pg8::StaticOrder, false, true>(F.lds, g, S, E);
        }
        grid_bar(); ECHO_END(5); ECHO_BEGIN(6);
        {
            pg8::Gemm g{MIX, (const bf16*)(wsp() + WS_WO), nullptr, nullptr, M, D, D, D}; pg8::StaticOrder S; { Frame Fg = mkframe(); S.init(M, D, Fg.G, Fg.bid); }
            pg8::RmsExchange e1{(float*)(wsp() + WS_XSLOT), (unsigned*)(wsp() + WS_XCNT) + ((l * 4 + 0) * 64) * 16}, e2{(float*)(wsp() + WS_XSLOT + 262144), (unsigned*)(wsp() + WS_XCNT) + ((l * 4 + 1) * 64) * 16};
            pg8::EpiRmsRes E{outp(), inp(12) + l * D, inp(13) + l * D, XN, e1, e2};
            pg8::gemm_phase<pg8::EpiRmsRes, pg8::StaticOrder, false, true>(F.lds, g, S, E);
        }
        grid_bar(); ECHO_END(6); ECHO_BEGIN(7);
        {
            pg8::Gemm g{XN, (const bf16*)(wsp() + WS_WFF1), nullptr, nullptr, M, FF, D, D}; pg8::StaticOrder S; { Frame Fg = mkframe(); S.init(M, FF, Fg.G, Fg.bid); }
            pg8::EpiBf16<2> E{HB, FF};
            pg8::gemm_phase<pg8::EpiBf16<2>, pg8::StaticOrder, true, true>(F.lds, g, S, E);
#if PROBE_DUP == 7
            pg8::gemm_phase<pg8::EpiBf16<2>, pg8::StaticOrder, true, true>(F.lds, g, S, E);
#endif
        }
        grid_bar(); ECHO_END(7); ECHO_BEGIN(8);
        {
            pg8::Gemm g{HB, (const bf16*)(wsp() + WS_WFF2), nullptr, nullptr, M, D, FF, FF}; pg8::StaticOrder S; { Frame Fg = mkframe(); S.init(M, D, Fg.G, Fg.bid); }
            pg8::RmsExchange e1{(float*)(wsp() + WS_XSLOT), (unsigned*)(wsp() + WS_XCNT) + ((l * 4 + 2) * 64) * 16}, e2{(float*)(wsp() + WS_XSLOT + 262144), (unsigned*)(wsp() + WS_XCNT) + ((l * 4 + 3) * 64) * 16};
            pg8::EpiRmsRes E{outp(), inp(16) + l * D, (l + 1 < DEPTH) ? inp(2) + (l + 1) * D : nullptr, XN, e1, e2};
            pg8::gemm_phase<pg8::EpiRmsRes, pg8::StaticOrder, false, true>(F.lds, g, S, E);
        }
        if (l + 1 < DEPTH) grid_bar();
        ECHO_END(8);
    }
    ECHO_END(11);
#undef PROJ
#undef XN
#undef YF
#undef MIX
#undef HB
}

extern "C" void kernel_launch(void* const* d_in, const int* in_sizes, int n_in, void* d_out, int out_size, void* d_ws, size_t ws_size, hipStream_t stream) {
    static int init = 0;
    if (!init) {
        if (n_in != 17 || out_size != M * D || ws_size < WS_END) { fprintf(stderr, "kernel_launch: unexpected shapes (n_in %d out %d ws %zu)\n", n_in, out_size, ws_size); init = -1; return; }
        if (hipFuncSetAttribute((const void*)hybrid_fwd, hipFuncAttributeMaxDynamicSharedMemorySize, LDS_BYTES) != hipSuccess) { fprintf(stderr, "hipFuncSetAttribute failed\n"); init = -1; return; }
        init = 1;
    }
    if (init < 0) return;
    Args a{};
    for (int i = 0; i < 17; ++i) a.in[i] = (const float*)d_in[i];
    a.out = (float*)d_out; a.ws = (unsigned char*)d_ws;
    void* args[] = {&a};
    hipError_t e = hipLaunchCooperativeKernel((void*)hybrid_fwd, dim3(256), dim3(NTHR), args, LDS_BYTES, stream);
    if (e != hipSuccess) fprintf(stderr, "cooperative launch failed: %s\n", hipGetErrorString(e));
}
```

```cpp
#include <hip/hip_runtime.h>
#include <hip/hip_cooperative_groups.h>
#include <cstdio>
#include <cstdint>
namespace cg = cooperative_groups;

namespace pg8 {
#define PG8_LAS __attribute__((address_space(3)))
typedef unsigned short bf16_t;
typedef short bf16x8 __attribute__((ext_vector_type(8)));
typedef float f32x4 __attribute__((ext_vector_type(4)));
typedef unsigned u32x4 __attribute__((ext_vector_type(4)));
constexpr int BM = 256, BK = 64, HALF = 128, HTB = HALF * BK * 2, STAGE_BYTES = 8 * HTB, NXCD = 8, WGM = 8;

__host__ __device__ __forceinline__ int lds_byte(int r, int c) { const int st = (r >> 4) * 2 + (c >> 5), rr = r & 15, cc = c & 31, ob = rr * 64 + cc * 2; return st * 1024 + (ob ^ (((ob >> 9) & 1) << 5)); }
__host__ __device__ __forceinline__ void stage_rc(int b, int& R, int& C) { const int st = b / 1024, sb = b % 1024, swz = sb ^ (((sb >> 9) & 1) << 5); R = (st >> 1) * 16 + swz / 64; C = (st & 1) * 32 + (swz % 64) / 2; }
__host__ __device__ __forceinline__ int perm32(int rho) { const int n = rho >> 4, i = rho & 15; return 8 * (i >> 2) + 4 * n + (i & 3); }

struct Unit { int pm, pn, src; };
struct Gemm { const bf16_t* A; const bf16_t* Bt; const bf16_t* A2; const bf16_t* Bt2; int M, N, K, lda; };

struct StaticOrder {
    int nM, nN, nwg, G, c;
    __host__ __device__ void init(int M, int N, int G_, int c_) { nM = M / BM; nN = N / BM; nwg = nM * nN; G = G_; c = c_; }
    __host__ __device__ bool tile(long L, Unit& u) const {
        if (L >= nwg) return false;
        int wgid = (int)L; { const int q = nwg / NXCD, r = nwg % NXCD, xcd = wgid % NXCD, off = wgid / NXCD; wgid = (xcd < r ? xcd * (q + 1) : r * (q + 1) + (xcd - r) * q) + off; }
        const int nig = WGM * nN, gid = wgid / nig, fm = gid * WGM, gsz = (nM - fm) < WGM ? (nM - fm) : WGM;
        u.pm = fm + ((wgid % nig) % gsz); u.pn = (wgid % nig) / gsz; u.src = 0; return true;
    }
    __host__ __device__ bool next(int i, Unit& u) const { return tile((long)i * G + c, u); }
};
struct DualOrder {
    StaticOrder S;
    __host__ __device__ bool next(int i, Unit& u) const { const bool ok = S.tile((long)(i >> 1) * S.G + S.c, u); u.src = i & 1; return ok; }
};

typedef float f32x2c __attribute__((ext_vector_type(2)));
typedef __bf16 bf16x2c __attribute__((ext_vector_type(2)));
__device__ __forceinline__ unsigned cvt_pk_bf16(float lo, float hi) { const f32x2c v = {lo, hi}; return __builtin_bit_cast(unsigned, __builtin_convertvector(v, bf16x2c)); }
__device__ __forceinline__ float bf_lo(unsigned w) { return __uint_as_float(w << 16); }
__device__ __forceinline__ float bf_hi(unsigned w) { return __uint_as_float(w & 0xffff0000u); }

template <int ACT  > struct EpiBf16 {
    static constexpr bool PERM = true, DUAL = false, AFTER_DRAIN = false;
    bf16_t* O; int ldc;
    __device__ __forceinline__ void mid(f32x4 (&acc)[2][2][4][2], const Unit& u, int wr, int wc, int fr, int fq) const {}
    __device__ __forceinline__ void operator()(const f32x4 (&acc)[2][2][4][2], const Unit& u, int wr, int wc, int fr, int fq) const {
        const int row0 = u.pm * BM + wr * 64 + fr; const int col0 = u.pn * BM + wc * 32 + 8 * fq;
#pragma unroll
        for (int ai = 0; ai < 2; ++ai)
#pragma unroll
            for (int m = 0; m < 4; ++m) { bf16_t* rowp = O + (size_t)(row0 + ai * HALF + m * 16) * ldc + col0;
#pragma unroll
                for (int bj = 0; bj < 2; ++bj) { f32x4 v0 = acc[ai][bj][m][0], v1 = acc[ai][bj][m][1];
                    if (ACT == 2) {
#pragma unroll
                        for (int e = 0; e < 4; ++e) { const float a = fmaxf(v0[e], 0.f), b = fmaxf(v1[e], 0.f); v0[e] = a * a; v1[e] = b * b; } }
                    u32x4 w; w.x = cvt_pk_bf16(v0[0], v0[1]); w.y = cvt_pk_bf16(v0[2], v0[3]); w.z = cvt_pk_bf16(v1[0], v1[1]); w.w = cvt_pk_bf16(v1[2], v1[3]);
                    *(u32x4*)(rowp + bj * HALF) = w; } }
    }
};
struct EpiF32 {
    static constexpr bool PERM = false, DUAL = false, AFTER_DRAIN = false;
    float* O; int ldc;
    __device__ __forceinline__ void mid(f32x4 (&acc)[2][2][4][2], const Unit& u, int wr, int wc, int fr, int fq) const {}
    __device__ __forceinline__ void operator()(const f32x4 (&acc)[2][2][4][2], const Unit& u, int wr, int wc, int fr, int fq) const {
        float* rowp = O + (size_t)(u.pm * BM + wr * 64 + fr) * ldc + (u.pn * BM + wc * 32 + 4 * fq);
#pragma unroll
        for (int ai = 0; ai < 2; ++ai) {
#pragma unroll
            for (int m = 0; m < 4; ++m) {
#pragma unroll
                for (int bj = 0; bj < 2; ++bj)
#pragma unroll
                    for (int n = 0; n < 2; ++n) *(f32x4*)(rowp + bj * HALF + n * 16) = acc[ai][bj][m][n];
                rowp += (size_t)16 * ldc; asm volatile("" : "+v"(rowp) :: "memory"); }
            rowp += (size_t)64 * ldc; }
    }
};
struct EpiMerge {
    static constexpr bool PERM = true, DUAL = true, AFTER_DRAIN = false;
    bf16_t* O; int ldc; const bf16_t* GA; const bf16_t* GB; int ldg;
    __device__ __forceinline__ void mid(f32x4 (&acc)[2][2][4][2], const Unit& u, int wr, int wc, int fr, int fq) const {
        const int row0 = u.pm * BM + wr * 64 + fr; const int col0 = u.pn * BM + wc * 32 + 8 * fq;
#pragma unroll
        for (int ai = 0; ai < 2; ++ai)
#pragma unroll
            for (int m = 0; m < 4; ++m) { const size_t ro = (size_t)(row0 + ai * HALF + m * 16) * ldg + col0;
#pragma unroll
                for (int bj = 0; bj < 2; ++bj) { const u32x4 ga = *(const u32x4*)(GA + ro + bj * HALF), gb = *(const u32x4*)(GB + ro + bj * HALF);
#pragma unroll
                    for (int e = 0; e < 4; ++e) { const unsigned wa = ga[e], wb = gb[e];
                        const float r0 = (1.f + __expf(-bf_lo(wb))) / (1.f + __expf(-bf_lo(wa))), r1 = (1.f + __expf(-bf_hi(wb))) / (1.f + __expf(-bf_hi(wa)));
                        if (e < 2) { acc[ai][bj][m][0][2 * e] *= r0; acc[ai][bj][m][0][2 * e + 1] *= r1; } else { acc[ai][bj][m][1][2 * (e - 2)] *= r0; acc[ai][bj][m][1][2 * (e - 2) + 1] *= r1; } } } }
    }
    __device__ __forceinline__ void operator()(const f32x4 (&acc)[2][2][4][2], const Unit& u, int wr, int wc, int fr, int fq) const {
        const int row0 = u.pm * BM + wr * 64 + fr; const int col0 = u.pn * BM + wc * 32 + 8 * fq;
#pragma unroll
        for (int ai = 0; ai < 2; ++ai)
#pragma unroll
            for (int m = 0; m < 4; ++m) { const size_t ro = (size_t)(row0 + ai * HALF + m * 16) * ldg + col0; bf16_t* rowp = O + (size_t)(row0 + ai * HALF + m * 16) * ldc + col0;
#pragma unroll
                for (int bj = 0; bj < 2; ++bj) { const u32x4 gb = *(const u32x4*)(GB + ro + bj * HALF); f32x4 v0 = acc[ai][bj][m][0], v1 = acc[ai][bj][m][1];
                    float s[8];
#pragma unroll
                    for (int e = 0; e < 4; ++e) { s[2 * e] = 1.f / (1.f + __expf(-bf_lo(gb[e]))); s[2 * e + 1] = 1.f / (1.f + __expf(-bf_hi(gb[e]))); }
                    u32x4 w; w.x = cvt_pk_bf16(v0[0] * s[0], v0[1] * s[1]); w.y = cvt_pk_bf16(v0[2] * s[2], v0[3] * s[3]); w.z = cvt_pk_bf16(v1[0] * s[4], v1[1] * s[5]); w.w = cvt_pk_bf16(v1[2] * s[6], v1[3] * s[7]);
                    *(u32x4*)(rowp + bj * HALF) = w; } }
    }
};

struct EpiYb {
    static constexpr bool PERM = true, DUAL = false, AFTER_DRAIN = false;
    bf16_t* O; int ldc; const bf16_t* GB; int ldg;
    __device__ __forceinline__ void mid(f32x4 (&acc)[2][2][4][2], const Unit& u, int wr, int wc, int fr, int fq) const {}
    __device__ __forceinline__ void operator()(const f32x4 (&acc)[2][2][4][2], const Unit& u, int wr, int wc, int fr, int fq) const {
        const int row0 = u.pm * BM + wr * 64 + fr; const int col0 = u.pn * BM + wc * 32 + 8 * fq;
        u32x4 cgb[2], ngb[2];
        { const size_t ro = (size_t)row0 * ldg + col0;
#pragma unroll
          for (int bj = 0; bj < 2; ++bj) cgb[bj] = *(const u32x4*)(GB + ro + bj * HALF); }
#pragma unroll
        for (int g = 0; g < 8; ++g) { const int ai = g >> 2, m = g & 3;
            if (g < 7) { const size_t ro = (size_t)(row0 + ((g + 1) >> 2) * HALF + ((g + 1) & 3) * 16) * ldg + col0;
#pragma unroll
                for (int bj = 0; bj < 2; ++bj) ngb[bj] = *(const u32x4*)(GB + ro + bj * HALF); }
            bf16_t* rowp = O + (size_t)(row0 + ai * HALF + m * 16) * ldc + col0;
#pragma unroll
            for (int bj = 0; bj < 2; ++bj) { const u32x4 gb = cgb[bj]; const f32x4 v0 = acc[ai][bj][m][0], v1 = acc[ai][bj][m][1];
                float s[8];
#pragma unroll
                for (int e = 0; e < 4; ++e) { s[2 * e] = __builtin_amdgcn_rcpf(1.f + __expf(-bf_lo(gb[e]))); s[2 * e + 1] = __builtin_amdgcn_rcpf(1.f + __expf(-bf_hi(gb[e]))); }
                u32x4 w; w.x = cvt_pk_bf16(v0[0] * s[0], v0[1] * s[1]); w.y = cvt_pk_bf16(v0[2] * s[2], v0[3] * s[3]); w.z = cvt_pk_bf16(v1[0] * s[4], v1[1] * s[5]); w.w = cvt_pk_bf16(v1[2] * s[6], v1[3] * s[7]);
                *(u32x4*)(rowp + bj * HALF) = w; }
#pragma unroll
            for (int bj = 0; bj < 2; ++bj) cgb[bj] = ngb[bj];
        }
    }
};
struct EpiMerge2 {
    static constexpr bool PERM = true, DUAL = false, AFTER_DRAIN = false;
    bf16_t* O; int ldc; const bf16_t* GA; const bf16_t* YB; int ldg;
    __device__ __forceinline__ void mid(f32x4 (&acc)[2][2][4][2], const Unit& u, int wr, int wc, int fr, int fq) const {}
    __device__ __forceinline__ void operator()(const f32x4 (&acc)[2][2][4][2], const Unit& u, int wr, int wc, int fr, int fq) const {
        const int row0 = u.pm * BM + wr * 64 + fr; const int col0 = u.pn * BM + wc * 32 + 8 * fq;
        u32x4 cga[2], cyb[2], nga[2], nyb[2];
        { const size_t ro = (size_t)row0 * ldg + col0;
#pragma unroll
          for (int bj = 0; bj < 2; ++bj) { cga[bj] = *(const u32x4*)(GA + ro + bj * HALF); cyb[bj] = *(const u32x4*)(YB + ro + bj * HALF); } }
#pragma unroll
        for (int g = 0; g < 8; ++g) { const int ai = g >> 2, m = g & 3;
            if (g < 7) { const size_t ro = (size_t)(row0 + ((g + 1) >> 2) * HALF + ((g + 1) & 3) * 16) * ldg + col0;
#pragma unroll
                for (int bj = 0; bj < 2; ++bj) { nga[bj] = *(const u32x4*)(GA + ro + bj * HALF); nyb[bj] = *(const u32x4*)(YB + ro + bj * HALF); } }
            bf16_t* rowp = O + (size_t)(row0 + ai * HALF + m * 16) * ldc + col0;
#pragma unroll
            for (int bj = 0; bj < 2; ++bj) { const u32x4 ga = cga[bj], yb = cyb[bj]; const f32x4 v0 = acc[ai][bj][m][0], v1 = acc[ai][bj][m][1];
                float o[8];
#pragma unroll
                for (int e = 0; e < 4; ++e) { const float a0 = (e < 2) ? v0[2 * e] : v1[2 * (e - 2)], a1 = (e < 2) ? v0[2 * e + 1] : v1[2 * (e - 2) + 1];
                    o[2 * e] = a0 * __builtin_amdgcn_rcpf(1.f + __expf(-bf_lo(ga[e]))) + bf_lo(yb[e]); o[2 * e + 1] = a1 * __builtin_amdgcn_rcpf(1.f + __expf(-bf_hi(ga[e]))) + bf_hi(yb[e]); }
                u32x4 w; w.x = cvt_pk_bf16(o[0], o[1]); w.y = cvt_pk_bf16(o[2], o[3]); w.z = cvt_pk_bf16(o[4], o[5]); w.w = cvt_pk_bf16(o[6], o[7]);
                *(u32x4*)(rowp + bj * HALF) = w; }
#pragma unroll
            for (int bj = 0; bj < 2; ++bj) { cga[bj] = nga[bj]; cyb[bj] = nyb[bj]; }
        }
    }
};
struct RmsExchange {
    float* slots;
    unsigned* cnt;
    __device__ __forceinline__ void run(const f32x4 (&v)[2][2][4][2], const Unit& u, int wr, int wc, int fr, int fq, PG8_LAS unsigned char* lds, int wid, int lane) const {
        PG8_LAS float* P = (PG8_LAS float*)lds;
        PG8_LAS float* S = (PG8_LAS float*)(lds + 4096);
#pragma unroll
        for (int ai = 0; ai < 2; ++ai)
#pragma unroll
            for (int m = 0; m < 4; ++m) { float s = 0.f;
#pragma unroll
                for (int bj = 0; bj < 2; ++bj)
#pragma unroll
                    for (int n = 0; n < 2; ++n) { const f32x4 x = v[ai][bj][m][n]; s += (x[0] * x[0] + x[1] * x[1]) + (x[2] * x[2] + x[3] * x[3]); }
                s += __shfl_xor(s, 16); s += __shfl_xor(s, 32);
                if (fq == 0) P[(ai * HALF + wr * 64 + m * 16 + fr) * 4 + wc] = s; }
        asm volatile("s_waitcnt vmcnt(0) lgkmcnt(0)" ::: "memory"); __builtin_amdgcn_s_barrier(); asm volatile("" ::: "memory");
        const int row = wid * 64 + lane;
        if (wid < 4) {
            const f32x4 p = *(const PG8_LAS f32x4*)(P + row * 4);
            __hip_atomic_store(slots + ((size_t)(u.pm * BM + row) * 4 + u.pn), (p[0] + p[1]) + (p[2] + p[3]), __ATOMIC_RELAXED, __HIP_MEMORY_SCOPE_AGENT);
            asm volatile("s_waitcnt vmcnt(0)" ::: "memory");
            if (lane == 0) __hip_atomic_fetch_add(cnt + 16 * u.pm, 1u, __ATOMIC_RELAXED, __HIP_MEMORY_SCOPE_AGENT);
        }
        if (wid == 0) {
            unsigned sp = 0;
            while ((unsigned)__builtin_amdgcn_readfirstlane(__hip_atomic_load(cnt + 16 * u.pm, __ATOMIC_RELAXED, __HIP_MEMORY_SCOPE_AGENT)) < 16u) { __builtin_amdgcn_s_sleep(1); if (++sp > (1u << 22)) break; }
            __builtin_amdgcn_fence(__ATOMIC_ACQUIRE, "agent");
        }
        asm volatile("s_waitcnt vmcnt(0) lgkmcnt(0)" ::: "memory"); __builtin_amdgcn_s_barrier(); asm volatile("" ::: "memory");
        if (wid < 4) {
            const float* sl = slots + (size_t)(u.pm * BM + row) * 4; float t = 0.f;
#pragma unroll
            for (int k = 0; k < 4; ++k) t += __hip_atomic_load(sl + k, __ATOMIC_RELAXED, __HIP_MEMORY_SCOPE_AGENT);
            S[row] = rsqrtf(t * (1.0f / 1024.0f) + 1e-6f);
        }
        asm volatile("s_waitcnt vmcnt(0) lgkmcnt(0)" ::: "memory"); __builtin_amdgcn_s_barrier(); asm volatile("" ::: "memory");
    }
};
struct EpiRmsRes {
    static constexpr bool PERM = true, DUAL = false, AFTER_DRAIN = true;
    float* x; const float* gpost; const float* gnext; bf16_t* xn; RmsExchange e1, e2;
    __device__ __forceinline__ void mid(f32x4 (&acc)[2][2][4][2], const Unit& u, int wr, int wc, int fr, int fq) const {}
    __device__ __forceinline__ void operator()(const f32x4 (&acc)[2][2][4][2], const Unit& u, int wr, int wc, int fr, int fq) const {}
    __device__ __forceinline__ void fused(f32x4 (&acc)[2][2][4][2], const Unit& u, int wr, int wc, int fr, int fq, PG8_LAS unsigned char* lds, int wid, int lane) const {
        const PG8_LAS float* S = (const PG8_LAS float*)(lds + 4096);
        const int col0 = u.pn * BM + wc * 32 + 8 * fq;
        bf16_t* xb = (bf16_t*)x;
        u32x4 pre[2][4][2];
#pragma unroll
        for (int ai = 0; ai < 2; ++ai)
#pragma unroll
            for (int m = 0; m < 4; ++m) { const bf16_t* xp = xb + (size_t)(u.pm * BM + ai * HALF + wr * 64 + m * 16 + fr) * 2048 + col0;
#pragma unroll
                for (int bj = 0; bj < 2; ++bj) pre[ai][m][bj] = *(const u32x4*)(xp + bj * HALF); }
        e1.run(acc, u, wr, wc, fr, fq, lds, wid, lane);
        f32x4 g[2][2];
#pragma unroll
        for (int bj = 0; bj < 2; ++bj)
#pragma unroll
            for (int n = 0; n < 2; ++n) g[bj][n] = *(const f32x4*)(gpost + col0 + bj * HALF + n * 4);
#pragma unroll
        for (int ai = 0; ai < 2; ++ai)
#pragma unroll
            for (int m = 0; m < 4; ++m) { const int r = ai * HALF + wr * 64 + m * 16 + fr; const float sr = S[r];
#pragma unroll
                for (int bj = 0; bj < 2; ++bj) { const u32x4 pw = pre[ai][m][bj];
                    const f32x4 x0 = {bf_lo(pw.x), bf_hi(pw.x), bf_lo(pw.y), bf_hi(pw.y)}, x1 = {bf_lo(pw.z), bf_hi(pw.z), bf_lo(pw.w), bf_hi(pw.w)};
                    const f32x4 o0 = x0 + acc[ai][bj][m][0] * sr * g[bj][0], o1 = x1 + acc[ai][bj][m][1] * sr * g[bj][1]; acc[ai][bj][m][0] = o0; acc[ai][bj][m][1] = o1;
                    if (gnext) { u32x4 w; w.x = cvt_pk_bf16(o0[0], o0[1]); w.y = cvt_pk_bf16(o0[2], o0[3]); w.z = cvt_pk_bf16(o1[0], o1[1]); w.w = cvt_pk_bf16(o1[2], o1[3]);
                        *(u32x4*)(xb + (size_t)(u.pm * BM + r) * 2048 + col0 + bj * HALF) = w; }
                    else { float* op = x + (size_t)(u.pm * BM + r) * 1024 + col0 + bj * HALF; *(f32x4*)op = o0; *(f32x4*)(op + 4) = o1; } } }
        if (gnext) {
            e2.run(acc, u, wr, wc, fr, fq, lds, wid, lane);
#pragma unroll
            for (int bj = 0; bj < 2; ++bj)
#pragma unroll
                for (int n = 0; n < 2; ++n) g[bj][n] = *(const f32x4*)(gnext + col0 + bj * HALF + n * 4);
#pragma unroll
            for (int ai = 0; ai < 2; ++ai)
#pragma unroll
                for (int m = 0; m < 4; ++m) { const int r = ai * HALF + wr * 64 + m * 16 + fr; const float sr = S[r]; bf16_t* op = xn + (size_t)(u.pm * BM + r) * 1024 + col0;
#pragma unroll
                    for (int bj = 0; bj < 2; ++bj) { const f32x4 o0 = acc[ai][bj][m][0] * sr * g[bj][0], o1 = acc[ai][bj][m][1] * sr * g[bj][1];
                        u32x4 w; w.x = cvt_pk_bf16(o0[0], o0[1]); w.y = cvt_pk_bf16(o0[2], o0[3]); w.z = cvt_pk_bf16(o1[0], o1[1]); w.w = cvt_pk_bf16(o1[2], o1[3]);
                        *(u32x4*)(op + bj * HALF) = w; } }
        }
    }
};
template <class Epi, class Sched, bool ALIGN_EPI = false, bool SP2 = false>
__device__ __forceinline__ void gemm_phase(PG8_LAS unsigned char* lds, const Gemm g, const Sched& S, const Epi& E) {
    int tid_ = threadIdx.x; asm volatile("" : "+v"(tid_)); const int tid = tid_, wid = __builtin_amdgcn_readfirstlane(tid >> 6), lane = tid & 63, wr = wid >> 2, wc = wid & 3, fr = lane & 15, fq = lane >> 4;
    const int K = g.K, nt = K / BK, lda = g.lda;
    unsigned voffA[2], voffB[2];
#pragma unroll
    for (int i = 0; i < 2; ++i) { int R, C; stage_rc(tid * 16 + i * 8192, R, C); const int Rb = Epi::PERM ? ((R & ~31) + perm32(R & 31)) : R;
        voffA[i] = (unsigned)(R * lda + C) * 2u; voffB[i] = (unsigned)(Rb * K + C) * 2u; }
    const size_t kstep = (size_t)(BK * 2);
    const size_t hstepA = (size_t)HALF * lda * 2, hstepB = (size_t)HALF * K * 2;
    const size_t tstepA = 2 * hstepA, tstepB = 2 * hstepB;
    const unsigned ldsw = (unsigned)wid * 1024u;
    const int aoff = lds_byte(wr * 64 + fr, fq * 8), boff = lds_byte(wc * 32 + fr, fq * 8);
#define PG8_SA(b, h) (((b) * 2 + (h)) * HTB)
#define PG8_SB(b, h) ((4 + (b) * 2 + (h)) * HTB)
#define PG8_STAGE(bufoff, gbase, voff) do { _Pragma("unroll") for (int _i = 0; _i < 2; ++_i) \
        __builtin_amdgcn_global_load_lds((const unsigned*)((const char*)(gbase) + (voff)[_i]), (PG8_LAS unsigned*)(lds + (bufoff) + ldsw + _i * 8192), 16, 0, 0); } while (0)
#define PG8_LDA(dst, b, h) do { _Pragma("unroll") for (int m = 0; m < 4; ++m) _Pragma("unroll") for (int k = 0; k < 2; ++k) dst[m][k] = *(const PG8_LAS bf16x8*)(lds + PG8_SA(b, h) + aoff + m * 2048 + k * 1024); } while (0)
#define PG8_LDB(dst, b, h) do { _Pragma("unroll") for (int n = 0; n < 2; ++n) _Pragma("unroll") for (int k = 0; k < 2; ++k) dst[n][k] = *(const PG8_LAS bf16x8*)(lds + PG8_SB(b, h) + boff + n * 2048 + k * 1024); } while (0)
#define PG8_MMA(ai, bj, At, Bt) do { __builtin_amdgcn_s_setprio(1); _Pragma("unroll") for (int m = 0; m < 4; ++m) _Pragma("unroll") for (int n = 0; n < 2; ++n) _Pragma("unroll") for (int k = 0; k < 2; ++k) \
        acc[ai][bj][m][n] = __builtin_amdgcn_mfma_f32_16x16x32_bf16(Bt[n][k], At[m][k], acc[ai][bj][m][n], 0, 0, 0); __builtin_amdgcn_s_setprio(0); } while (0)
#define PG8_WAIT_V(n) asm volatile("s_waitcnt vmcnt(" #n ")" ::: "memory")
#define PG8_WAIT_L(n) asm volatile("s_waitcnt lgkmcnt(" #n ")" ::: "memory")
#define PG8_BAR __builtin_amdgcn_s_barrier()
#define PG8_SCHED __builtin_amdgcn_sched_barrier(0)
    Unit cur, nxt; int ui = 0;
    if (!S.next(0, cur)) return;
    f32x4 acc[2][2][4][2];
#pragma unroll
    for (int a = 0; a < 2; ++a)
#pragma unroll
        for (int b = 0; b < 2; ++b)
#pragma unroll
            for (int m = 0; m < 4; ++m)
#pragma unroll
                for (int n = 0; n < 2; ++n) acc[a][b][m][n] = (f32x4){0.f, 0.f, 0.f, 0.f};
    bf16x8 At[4][2], B0[2][2], B1[2][2];
    const char* cA = (const char*)(cur.src ? g.A2 : g.A) + (size_t)cur.pm * tstepA; const char* cB = (const char*)(cur.src ? g.Bt2 : g.Bt) + (size_t)cur.pn * tstepB;
    if constexpr (SP2) {
        PG8_STAGE(PG8_SB(0, 0), cB, voffB); PG8_STAGE(PG8_SB(0, 1), cB + hstepB, voffB); PG8_STAGE(PG8_SA(0, 0), cA, voffA); PG8_STAGE(PG8_SA(0, 1), cA + hstepA, voffA);
        if (wr == 1) PG8_BAR;
        PG8_WAIT_V(2); PG8_BAR;
        PG8_STAGE(PG8_SB(1, 0), cB + kstep, voffB); PG8_STAGE(PG8_SA(1, 0), cA + kstep, voffA); PG8_STAGE(PG8_SB(1, 1), cB + hstepB + kstep, voffB);
        PG8_WAIT_V(6); PG8_BAR;
    } else {
        PG8_STAGE(PG8_SB(0, 0), cB, voffB); PG8_STAGE(PG8_SA(0, 0), cA, voffA); PG8_STAGE(PG8_SB(0, 1), cB + hstepB, voffB); PG8_STAGE(PG8_SA(0, 1), cA + hstepA, voffA);
        if (wr == 1) PG8_BAR;
        PG8_WAIT_V(4); PG8_BAR;
        PG8_STAGE(PG8_SB(1, 0), cB + kstep, voffB); PG8_STAGE(PG8_SA(1, 0), cA + kstep, voffA); PG8_STAGE(PG8_SB(1, 1), cB + hstepB + kstep, voffB);
        PG8_WAIT_V(6); PG8_BAR;
    }
    for (;;) {
        const bool has_next = S.next(ui + 1, nxt);
        const char* nA = has_next ? (const char*)(nxt.src ? g.A2 : g.A) + (size_t)nxt.pm * tstepA : cA; const char* nB = has_next ? (const char*)(nxt.src ? g.Bt2 : g.Bt) + (size_t)nxt.pn * tstepB : cB;
        for (int t = 0; t < nt; t += 2) {
            const bool last = (t == nt - 2);
            const char* a1 = cA + (size_t)(t + 1) * kstep;
            const char* a2 = last ? nA : cA + (size_t)(t + 2) * kstep; const char* b2 = last ? nB : cB + (size_t)(t + 2) * kstep;
            const char* a3 = a2 + kstep; const char* b3 = b2 + kstep;
            if constexpr (SP2) {
            PG8_LDB(B0, 0, 0); PG8_LDB(B1, 0, 1); PG8_SCHED; PG8_LDA(At, 0, 0); PG8_STAGE(PG8_SA(1, 1), a1 + hstepA, voffA);
            PG8_WAIT_V(8); PG8_WAIT_L(0); PG8_BAR; PG8_MMA(0, 0, At, B0); PG8_MMA(0, 1, At, B1); PG8_BAR; PG8_SCHED;
            PG8_LDA(At, 0, 1); PG8_STAGE(PG8_SB(0, 0), b2, voffB); PG8_STAGE(PG8_SB(0, 1), b2 + hstepB, voffB); PG8_STAGE(PG8_SA(0, 0), a2, voffA);
            PG8_WAIT_V(8); PG8_WAIT_L(0); PG8_BAR; PG8_MMA(1, 0, At, B0); PG8_MMA(1, 1, At, B1); PG8_BAR; PG8_SCHED;
            PG8_LDB(B0, 1, 0); PG8_LDB(B1, 1, 1); PG8_SCHED; PG8_LDA(At, 1, 0); PG8_STAGE(PG8_SA(0, 1), a2 + hstepA, voffA);
            PG8_WAIT_V(8); PG8_WAIT_L(0); PG8_BAR; PG8_MMA(0, 0, At, B0); PG8_MMA(0, 1, At, B1); PG8_BAR; PG8_SCHED;
            PG8_LDA(At, 1, 1); PG8_STAGE(PG8_SB(1, 0), b3, voffB); PG8_STAGE(PG8_SB(1, 1), b3 + hstepB, voffB); PG8_STAGE(PG8_SA(1, 0), a3, voffA);
            PG8_WAIT_V(8); PG8_WAIT_L(0); PG8_BAR; PG8_MMA(1, 0, At, B0); PG8_MMA(1, 1, At, B1); PG8_BAR; PG8_SCHED;
            } else {
            PG8_LDB(B0, 0, 0); PG8_SCHED; PG8_LDA(At, 0, 0); PG8_STAGE(PG8_SA(1, 1), a1 + hstepA, voffA);
            PG8_WAIT_L(8); PG8_BAR; PG8_WAIT_L(0); PG8_MMA(0, 0, At, B0); PG8_BAR; PG8_SCHED;
            PG8_LDB(B1, 0, 1); PG8_STAGE(PG8_SB(0, 0), b2, voffB);
            PG8_BAR; PG8_WAIT_L(0); PG8_MMA(0, 1, At, B1); PG8_BAR;
            PG8_LDA(At, 0, 1); PG8_STAGE(PG8_SA(0, 0), a2, voffA);
            PG8_BAR; PG8_WAIT_L(0); PG8_MMA(1, 0, At, B0); PG8_BAR; PG8_SCHED;
            PG8_STAGE(PG8_SB(0, 1), b2 + hstepB, voffB);
            PG8_WAIT_V(6); PG8_BAR; PG8_MMA(1, 1, At, B1); PG8_BAR;
            PG8_LDB(B0, 1, 0); PG8_SCHED; PG8_LDA(At, 1, 0); PG8_STAGE(PG8_SA(0, 1), a2 + hstepA, voffA);
            PG8_WAIT_L(8); PG8_BAR; PG8_WAIT_L(0); PG8_MMA(0, 0, At, B0); PG8_BAR; PG8_SCHED;
            PG8_LDB(B1, 1, 1); PG8_STAGE(PG8_SB(1, 0), b3, voffB);
            PG8_BAR; PG8_WAIT_L(0); PG8_MMA(0, 1, At, B1); PG8_BAR;
            PG8_LDA(At, 1, 1); PG8_STAGE(PG8_SA(1, 0), a3, voffA);
            PG8_BAR; PG8_WAIT_L(0); PG8_MMA(1, 0, At, B0); PG8_BAR; PG8_SCHED;
            PG8_STAGE(PG8_SB(1, 1), b3 + hstepB, voffB);
            PG8_WAIT_V(6); PG8_BAR; PG8_MMA(1, 1, At, B1); PG8_BAR;
            }
        }
        if constexpr (ALIGN_EPI) { if (wr == 0) PG8_BAR; }
        const bool midu = Epi::DUAL && cur.src == 0;
        if constexpr (!Epi::AFTER_DRAIN) { if (midu) E.mid(acc, cur, wr, wc, fr, fq); else E(acc, cur, wr, wc, fr, fq); }
        if (!has_next) break;
        if (!midu) {
#pragma unroll
        for (int a = 0; a < 2; ++a)
#pragma unroll
            for (int b = 0; b < 2; ++b)
#pragma unroll
                for (int m = 0; m < 4; ++m)
#pragma unroll
                    for (int n = 0; n < 2; ++n) acc[a][b][m][n] = (f32x4){0.f, 0.f, 0.f, 0.f};
        }
        cur = nxt; cA = nA; cB = nB; ++ui;
        if constexpr (ALIGN_EPI) { if (wr == 1) PG8_BAR; }
    }
    PG8_WAIT_V(0);
    if constexpr (!ALIGN_EPI) { if (wr == 0) PG8_BAR; }
    PG8_BAR;
    if constexpr (Epi::AFTER_DRAIN) E.fused(acc, cur, wr, wc, fr, fq, lds, wid, lane);
#undef PG8_SA
#undef PG8_SB
#undef PG8_STAGE
#undef PG8_LDA
#undef PG8_LDB
#undef PG8_MMA
#undef PG8_WAIT_V
#undef PG8_WAIT_L
#undef PG8_BAR
#undef PG8_SCHED
}
}

#define GAS __attribute__((address_space(1)))
#define LAS __attribute__((address_space(3)))
typedef unsigned short bf16;
typedef unsigned v4u __attribute__((ext_vector_type(4)));
typedef unsigned v2u __attribute__((ext_vector_type(2)));
typedef float f32x4 __attribute__((ext_vector_type(4)));
typedef short bf16x8 __attribute__((ext_vector_type(8)));
constexpr int NWAVES = 8, NTHR = 512;
constexpr int BATCH = 2, SEQ = 8192, D = 1024, FF = 4096, DEPTH = 4, M = BATCH * SEQ;
constexpr int DIN = 7440, DINP = 7680;
constexpr int C_DNQ = 0, C_DNK = 1024, C_DNV = 2048, C_DNZ = 3072, C_SWQ = 4096, C_GA = 5120, C_GB = 6144, C_SWK = 7168, C_SWV = 7296, C_DNB = 7424, C_DNA = 7432;
constexpr float EPS = 1e-6f;
constexpr size_t MiB = 1u << 20;
constexpr size_t WS_WIN = 1 * MiB, WS_WUPDN = 16 * MiB, WS_WUPSW = 18 * MiB, WS_WO = 20 * MiB, WS_WFF1 = 22 * MiB, WS_WFF2 = 30 * MiB, WS_ROPE = 38 * MiB;
constexpr size_t WS_PROJ = 40 * MiB, WS_H = 40 * MiB, WS_XN = 280 * MiB, WS_YF = 312 * MiB, WS_MIX = 376 * MiB, WS_END = 456 * MiB;
constexpr int LDS_BYTES = 147456;

typedef float f32x2_t __attribute__((ext_vector_type(2)));
typedef __bf16 bf16x2_t __attribute__((ext_vector_type(2)));
__device__ __forceinline__ unsigned pk2(float lo, float hi) { const f32x2_t v = {lo, hi}; return __builtin_bit_cast(unsigned, __builtin_convertvector(v, bf16x2_t)); }
__device__ __forceinline__ unsigned f2bf(float f) { return pk2(f, 0.f) & 0xffffu; }
__device__ __forceinline__ float bflo(unsigned w) { return __uint_as_float(w << 16); }
__device__ __forceinline__ float bfhi(unsigned w) { return __uint_as_float(w & 0xffff0000u); }
__device__ __forceinline__ float bf1(bf16 h) { return __uint_as_float((unsigned)h << 16); }
__device__ __forceinline__ float wave_sum(float v) {
#pragma unroll
    for (int o = 1; o < 64; o <<= 1) v += __shfl_xor(v, o);
    return v;
}
__device__ __forceinline__ float wave_max(float v) {
#pragma unroll
    for (int o = 1; o < 64; o <<= 1) v = fmaxf(v, __shfl_xor(v, o));
    return v;
}
__device__ __forceinline__ float sigmoidf_(float x) { return __builtin_amdgcn_rcpf(1.f + __expf(-x)); }
__device__ __forceinline__ float siluf_(float x) { return x * __builtin_amdgcn_rcpf(1.f + __expf(-x)); }

struct Frame {
    LAS unsigned char* lds;
    int tid, lane, wave, G, bid;
};
__device__ __forceinline__ LAS unsigned char* lds_base() { extern __shared__ __attribute__((aligned(16))) unsigned char lds_dyn[]; return (LAS unsigned char*)lds_dyn; }
__device__ __forceinline__ Frame mkframe() {
    Frame F; F.lds = lds_base(); int tid = threadIdx.x; asm volatile("" : "+v"(tid)); int bid = blockIdx.x; asm volatile("" : "+s"(bid)); int G = gridDim.x; asm volatile("" : "+s"(G));
    F.tid = tid; F.lane = tid & 63; F.wave = __builtin_amdgcn_readfirstlane(tid >> 6); F.G = G; F.bid = bid; return F; }
typedef __attribute__((address_space(4))) const unsigned char* kargp_t;
__device__ __forceinline__ kargp_t kargs() { kargp_t p = (kargp_t)__builtin_amdgcn_kernarg_segment_ptr(); asm volatile("" : "+s"(p)); return p; }
__device__ __forceinline__ const float* inp(int k) { return *(const float* __attribute__((address_space(4))) const*)(kargs() + 8 * k); }
__device__ __forceinline__ float* outp() { return *(float* __attribute__((address_space(4))) const*)(kargs() + 8 * 17); }
__device__ __forceinline__ unsigned char* wsp() { return *(unsigned char* __attribute__((address_space(4))) const*)(kargs() + 8 * 18); }

__device__ __forceinline__ int orig_col(int nc) {
    if (nc < 4096) return nc;
    if (nc < 5120) return nc - 4096 + 4112;
    if (nc < 6144) return nc - 5120 + 5392;
    if (nc < 7168) return nc - 6144 + 6416;
    if (nc < 7296) return nc - 7168 + 5136;
    if (nc < 7424) return nc - 7296 + 5264;
    if (nc < 7440) return nc - 7424 + 4096;
    return -1;
}
template <bool PERMW>
__device__ __forceinline__ void transpose_item(const float* W, int K, int ldw, int nblk, bf16* WT, LAS float* scr, int item, int lane) {
    const int kb = item / nblk, nb = item % nblk, k0 = 64 * kb, n0 = 32 * nb;
    const int ncol = n0 + (lane & 31); const int oc = PERMW ? orig_col(ncol) : ncol;
    float wv[32];
    { const float* wp = W + (size_t)(k0 + (lane >> 5)) * ldw + (oc >= 0 ? oc : 0);
#pragma unroll
      for (int i = 0; i < 32; ++i) wv[i] = wp[(size_t)(2 * i) * ldw]; }
#pragma unroll
    for (int i = 0; i < 32; ++i) scr[(2 * i + (lane >> 5)) * 33 + (lane & 31)] = (oc >= 0) ? wv[i] : 0.f;
    asm volatile("s_waitcnt lgkmcnt(0)" ::: "memory");
    const int c = lane & 7;
#pragma unroll
    for (int j = 0; j < 4; ++j) { const int n = (lane >> 3) + 8 * j; const LAS float* s = scr + (8 * c) * 33 + n;
        v4u o; o.x = pk2(s[0 * 33], s[1 * 33]); o.y = pk2(s[2 * 33], s[3 * 33]); o.z = pk2(s[4 * 33], s[5 * 33]); o.w = pk2(s[6 * 33], s[7 * 33]);
        *(v4u*)(WT + (size_t)(n0 + n) * K + k0 + 8 * c) = o; }
    asm volatile("s_waitcnt lgkmcnt(0)" ::: "memory");
}
__device__ __forceinline__ void phase_convert(Frame& F_, int lrest, int lin, int nskip) {
    Frame F = mkframe();
    LAS float* scr = (LAS float*)(F.lds + F.wave * 16384);
    const int gw = (F.bid - nskip) * NWAVES + F.wave, NGW = (F.G - nskip) * NWAVES;
    constexpr int I_IN = 16 * (DINP / 32), I_SQ = 16 * 32, I_F1 = 16 * (FF / 32), I_F2 = 64 * 32;
    const int n_in = (lin >= 0) ? I_IN : 0, n_rest = (lrest >= 0) ? 3 * I_SQ + I_F1 + I_F2 : 0;
    for (int it = gw; it < n_in + n_rest; it += NGW) {
        int r = it;
        if (r < n_in) { transpose_item<true>(inp(3) + (size_t)lin * D * DIN, D, DIN, DINP / 32, (bf16*)(wsp() + WS_WIN), scr, r, F.lane); continue; } r -= n_in;
        const int l = lrest;
        if (r < I_SQ) { transpose_item<false>(inp(9) + (size_t)l * D * D, D, D, 32, (bf16*)(wsp() + WS_WUPDN), scr, r, F.lane); continue; } r -= I_SQ;
        if (r < I_SQ) { transpose_item<false>(inp(10) + (size_t)l * D * D, D, D, 32, (bf16*)(wsp() + WS_WUPSW), scr, r, F.lane); continue; } r -= I_SQ;
        if (r < I_SQ) { transpose_item<false>(inp(11) + (size_t)l * D * D, D, D, 32, (bf16*)(wsp() + WS_WO), scr, r, F.lane); continue; } r -= I_SQ;
        if (r < I_F1) { transpose_item<false>(inp(14) + (size_t)l * D * FF, D, FF, FF / 32, (bf16*)(wsp() + WS_WFF1), scr, r, F.lane); continue; } r -= I_F1;
        transpose_item<false>(inp(15) + (size_t)l * FF * D, FF, D, 32, (bf16*)(wsp() + WS_WFF2), scr, r, F.lane);
    }
}
__device__ __forceinline__ void phase_rope(Frame& F_) {
    Frame F = mkframe();
    const int* pos = (const int*)inp(1); float* R = (float*)(wsp() + WS_ROPE);
    for (int i = F.bid * NTHR + F.tid; i < M * 8; i += F.G * NTHR) {
        const int m = i >> 3, j = i & 7;
        const float invf = exp2f(-(float)j * (0.125f * 18.931568569324174f));
        const float angf = (float)pos[m] * invf;
        const double a = (double)angf; const double n = rint(a * 0.15915494309189535);
        const float r = (float)(a - n * 6.283185307179586);
        R[m * 16 + j] = __cosf(r); R[m * 16 + 8 + j] = __sinf(r);
    }
}
__device__ __forceinline__ void phase_norm(Frame& F_, const float* y, const float* gpost, const float* xin, float* x, const float* gnext, bf16* XN) {
    Frame F = mkframe();
    const int gw = F.bid * NWAVES + F.wave, NGW = F.G * NWAVES;
    for (int m = gw; m < M; m += NGW) {
        f32x4 v[4];
        const f32x4* xr = (const f32x4*)(xin + (size_t)m * D) + F.lane;
#pragma unroll
        for (int j = 0; j < 4; ++j) v[j] = xr[64 * j];
        if (y) {
            const f32x4* yr = (const f32x4*)(y + (size_t)m * D) + F.lane; f32x4 w[4]; float s = 0.f;
#pragma unroll
            for (int j = 0; j < 4; ++j) { w[j] = yr[64 * j]; s += (w[j].x * w[j].x + w[j].y * w[j].y) + (w[j].z * w[j].z + w[j].w * w[j].w); }
            const float r = rsqrtf(wave_sum(s) * (1.f / D) + EPS);
#pragma unroll
            for (int j = 0; j < 4; ++j) { const f32x4 g = ((const f32x4*)gpost)[F.lane + 64 * j]; v[j] = v[j] + w[j] * r * g; }
        }
        v2u* xo = (v2u*)((bf16*)x + (size_t)m * 2048) + F.lane;
#pragma unroll
        for (int j = 0; j < 4; ++j) { v2u w; w.x = pk2(v[j].x, v[j].y); w.y = pk2(v[j].z, v[j].w); xo[64 * j] = w; }
        if (gnext) {
            float s = 0.f;
#pragma unroll
            for (int j = 0; j < 4; ++j) s += (v[j].x * v[j].x + v[j].y * v[j].y) + (v[j].z * v[j].z + v[j].w * v[j].w);
            const float r = rsqrtf(wave_sum(s) * (1.f / D) + EPS);
            v2u* o = (v2u*)(XN + (size_t)m * D) + F.lane;
#pragma unroll
            for (int j = 0; j < 4; ++j) { const f32x4 g = ((const f32x4*)gnext)[F.lane + 64 * j]; v2u w; w.x = pk2(v[j].x * r * g.x, v[j].y * r * g.y); w.y = pk2(v[j].z * r * g.z, v[j].w * r * g.w); o[64 * j] = w; }
        }
    }
}
constexpr size_t WS_SUBCNT = 196608, WS_BAR = 65536, WS_XCNT = 131072, WS_XSLOT = 39 * MiB;
#define XB_TMO      128
#define XB_XCNT(j)  (256  + 64 * (j))
#define XB_XSUB(j)  (1280 + 64 * (j))
#define XB_XGEN(j)  (2304 + 64 * (j))
#define XB_TOP      3328
#define XB_TOPGEN   3392
#define XCD_BAR_WORDS 3456
#define XB_SPIN_CAP (1u << 22)
constexpr int LDS_BARST = LDS_BYTES - 16;
__device__ __forceinline__ unsigned xb_ld(unsigned* p)              { return __hip_atomic_load(p, __ATOMIC_RELAXED, __HIP_MEMORY_SCOPE_AGENT); }
__device__ __forceinline__ unsigned xb_add(unsigned* p, unsigned v) { return __hip_atomic_fetch_add(p, v, __ATOMIC_RELAXED, __HIP_MEMORY_SCOPE_AGENT); }
__device__ __forceinline__ unsigned xb_xcc_id() { return (unsigned)__builtin_amdgcn_s_getreg((3 << 11) | 20) & 0xFu; }
#define XB_SPIN(cond, bar) do { unsigned _sp = 0; while (cond) { __builtin_amdgcn_s_sleep(1); \
    if ((++_sp & 255u) == 0u) { if (xb_ld(&(bar)[XB_TMO])) break; if (_sp > XB_SPIN_CAP) { atomicAdd(&(bar)[XB_TMO], 1u); break; } } } } while (0)
__device__ __forceinline__ void xcd_barrier_post() {
    if (threadIdx.x == 0) { unsigned* bar = (unsigned*)(wsp() + WS_BAR); (void)xb_add(&bar[XB_XCNT(xb_xcc_id())], 1u); }
}
__device__ __forceinline__ void xcd_barrier_complete(unsigned* bar, unsigned x, unsigned& nloc, unsigned& nx) {
    const unsigned G = gridDim.x * gridDim.y * gridDim.z;
    unsigned sum, cnt, mine, sp = 0u;
    for (;;) {
        sum = 0u; cnt = 0u; mine = 0u;
#pragma unroll
        for (unsigned j = 0; j < 16; ++j) { const unsigned c = xb_ld(&bar[XB_XCNT(j)]); sum += c; cnt += (c > 0u) ? 1u : 0u; mine = (j == x) ? c : mine; }
        if (sum == G) break;
        __builtin_amdgcn_s_sleep(1);
        if ((++sp & 255u) == 0u) { if (xb_ld(&bar[XB_TMO])) break; if (sp > XB_SPIN_CAP) { atomicAdd(&bar[XB_TMO], 1u); break; } }
    }
    nloc = mine > 0u ? mine : 1u; nx = cnt > 0u ? cnt : 1u;
}
__device__ __forceinline__ void grid_bar() {
    asm volatile("s_waitcnt vmcnt(0)" ::: "memory");
    __syncthreads();
    if (threadIdx.x == 0) {
        unsigned* bar = (unsigned*)(wsp() + WS_BAR); const unsigned x = xb_xcc_id();
        volatile LAS unsigned* st = (volatile LAS unsigned*)(lds_base() + LDS_BARST);
        __builtin_amdgcn_s_waitcnt(0);
        unsigned nloc = st[0], nx = st[1];
        if (nloc == 0u) { xcd_barrier_complete(bar, x, nloc, nx); st[0] = nloc; st[1] = nx; }
        const unsigned old = xb_add(&bar[XB_XSUB(x)], 1u);
        const unsigned gen = old / nloc;
        if (old + 1u == (gen + 1u) * nloc) {
            __builtin_amdgcn_fence(__ATOMIC_RELEASE, "agent");
            asm volatile("s_waitcnt vmcnt(0)" ::: "memory");
            const unsigned og = xb_add(&bar[XB_TOP], 1u);
            const unsigned tg = og / nx;
            if (og + 1u == (tg + 1u) * nx) xb_add(&bar[XB_TOPGEN], 1u);
            else XB_SPIN(xb_ld(&bar[XB_TOPGEN]) == tg, bar);
            __builtin_amdgcn_fence(__ATOMIC_ACQUIRE, "agent");
            xb_add(&bar[XB_XGEN(x)], 1u);
            asm volatile("s_waitcnt vmcnt(0)" ::: "memory");
        } else {
            XB_SPIN(xb_ld(&bar[XB_XGEN(x)]) == gen, bar);
            __builtin_amdgcn_fence(__ATOMIC_ACQUIRE, "agent");
            asm volatile("s_waitcnt vmcnt(0)" ::: "memory");
        }
    }
    __syncthreads();
}

__device__ __forceinline__ void sub_bar(unsigned* cnt, unsigned n) {
    asm volatile("s_waitcnt vmcnt(0)" ::: "memory");
    __syncthreads();
    if (threadIdx.x == 0) {
        __builtin_amdgcn_fence(__ATOMIC_RELEASE, "agent");
        asm volatile("s_waitcnt vmcnt(0)" ::: "memory");
        xb_add(cnt, 1u);
        unsigned sp = 0; while (xb_ld(cnt) < n) { __builtin_amdgcn_s_sleep(1); if (++sp > XB_SPIN_CAP) break; }
        __builtin_amdgcn_fence(__ATOMIC_ACQUIRE, "agent");
        asm volatile("s_waitcnt vmcnt(0)" ::: "memory");
    }
    __syncthreads();
}
#define MFMA16(a, b, c) __builtin_amdgcn_mfma_f32_16x16x32_bf16(a, b, c, 0, 0, 0)
constexpr size_t WS_GL = 0, WS_W = 312 * MiB, WS_QD = 344 * MiB, WS_KDT = 376 * MiB, WS_UT = 408 * MiB, WS_AI = 440 * MiB;
typedef LAS unsigned short* lbf;
template <int PMODE>
__device__ __forceinline__ void dn_prep(Frame& F_, int l) {
    Frame F = mkframe();
    const bf16* PROJ = (const bf16*)(wsp() + WS_PROJ);
    lbf QS = (lbf)(F.lds), KS = (lbf)(F.lds + 17408), VT = (lbf)(F.lds + 34816), KGT = (lbf)(F.lds + 53248), KDT = (lbf)(F.lds + 71680), TB = (lbf)(F.lds + 107520);
    LAS float* LM = (LAS float*)(F.lds + 90112); LAS float* GC = (LAS float*)(F.lds + 116736); LAS float* BT = (LAS float*)(F.lds + 116992);
    const int lane = F.lane, wave = F.wave, fr = lane & 15, fq = lane >> 4;
    struct PrepIn { unsigned xr[3][11]; float cw[3][4][2]; bf16 a, b; };
#define PREP_LOAD(X, chx) do { const int ch_ = (chx), h_ = (ch_ >> 7) & 7, n_ = ch_ & 127, m0_ = (ch_ >> 10) * SEQ + n_ * 64; \
        X.a = PROJ[(size_t)(m0_ + lane) * DINP + C_DNA + h_]; X.b = PROJ[(size_t)(m0_ + lane) * DINP + C_DNB + h_]; \
        _Pragma("unroll") for (int ts = 0; ts < 3; ++ts) _Pragma("unroll") for (int j = 0; j < 11; ++j) { const int ii = 8 * wave - 3 + j; \
            X.xr[ts][j] = (n_ * 64 + ii >= 0) ? *(const unsigned*)(PROJ + (size_t)(m0_ + ii) * DINP + ts * 1024 + h_ * 128 + 2 * lane) : 0u; } \
        { const float* cwp = inp(4) + (size_t)l * 4 * 3072 + h_ * 128 + 2 * lane; \
          _Pragma("unroll") for (int ts = 0; ts < 3; ++ts) _Pragma("unroll") for (int j = 0; j < 4; ++j) { X.cw[ts][j][0] = cwp[j * 3072 + ts * 1024]; X.cw[ts][j][1] = cwp[j * 3072 + ts * 1024 + 1]; } } } while (0)
    PrepIn cur; unsigned eat = 0u;
    for (int ch = F.bid; ch < 2048; ch += F.G) {
        const int b = ch >> 10, h = (ch >> 7) & 7, n = ch & 127, m0 = b * SEQ + n * 64;
        PREP_LOAD(cur, ch);
        unsigned touch = 0u;
        if (ch + F.G < 2048 && F.tid < 402) { const int cn = ch + F.G, hn = (cn >> 7) & 7, nn = cn & 127, mn = (cn >> 10) * SEQ + nn * 64; const int rowt = F.tid / 6 - 3, ln = F.tid % 6;
            if (nn * 64 + rowt >= 0) touch = *(const unsigned*)(PROJ + (size_t)(mn + rowt) * DINP + (ln >> 1) * 1024 + hn * 128 + (ln & 1) * 64); }
        const float a_neg = -__expf(inp(5)[l * 8 + h]), dtb = inp(6)[l * 8 + h];
        float gc, beta, gl;
        { const float a_in = bf1(cur.a), b_in = bf1(cur.b);
          const float z = a_in + dtb; const float sp = (z > 20.f) ? z : log1pf(__expf(z)); gc = a_neg * sp;
#pragma unroll
          for (int o = 1; o < 64; o <<= 1) { const float t = __shfl_up(gc, o); if (lane >= o) gc += t; }
          beta = sigmoidf_(b_in); gl = __shfl(gc, 63);
          if (wave == 0) { GC[lane] = gc; BT[lane] = beta; } }
        float sv[8][3][2], pp[16];
#pragma unroll
        for (int rr = 0; rr < 8; ++rr) {
#pragma unroll
            for (int ts = 0; ts < 3; ++ts) { float y0 = 0.f, y1 = 0.f;
#pragma unroll
                for (int j = 0; j < 4; ++j) { const unsigned xw = cur.xr[ts][rr + j]; y0 += cur.cw[ts][j][0] * bflo(xw); y1 += cur.cw[ts][j][1] * bfhi(xw); }
                sv[rr][ts][0] = siluf_(y0); sv[rr][ts][1] = siluf_(y1); }
            pp[2 * rr] = sv[rr][0][0] * sv[rr][0][0] + sv[rr][0][1] * sv[rr][0][1]; pp[2 * rr + 1] = sv[rr][1][0] * sv[rr][1][0] + sv[rr][1][1] * sv[rr][1][1];
        }
        float tot;
        { const bool b5 = (lane & 32) != 0, b4 = (lane & 16) != 0, b3 = (lane & 8) != 0, b2 = (lane & 4) != 0;
          float p8[8], p4[4], p2[2];
#pragma unroll
          for (int k = 0; k < 8; ++k) p8[k] = (b5 ? pp[k + 8] : pp[k]) + __shfl_xor(b5 ? pp[k] : pp[k + 8], 32);
#pragma unroll
          for (int k = 0; k < 4; ++k) p4[k] = (b4 ? p8[k + 4] : p8[k]) + __shfl_xor(b4 ? p8[k] : p8[k + 4], 16);
#pragma unroll
          for (int k = 0; k < 2; ++k) p2[k] = (b3 ? p4[k + 2] : p4[k]) + __shfl_xor(b3 ? p4[k] : p4[k + 2], 8);
          tot = (b2 ? p2[1] : p2[0]) + __shfl_xor(b2 ? p2[0] : p2[1], 4);
          tot += __shfl_xor(tot, 2); tot += __shfl_xor(tot, 1); }
        unsigned kg[2][4], kd[2][4], vb[2][4];
#pragma unroll
        for (int rr = 0; rr < 8; ++rr) {
            const int i = 8 * wave + rr;
            const float gci = __int_as_float(__builtin_amdgcn_readlane(__float_as_int(gc), i)), bi = __int_as_float(__builtin_amdgcn_readlane(__float_as_int(beta), i));
            const float scq = rsqrtf(__int_as_float(__builtin_amdgcn_readlane(__float_as_int(tot), 8 * rr)) + EPS) * 0.08838834764831845f;
            const float sck = rsqrtf(__int_as_float(__builtin_amdgcn_readlane(__float_as_int(tot), 8 * rr + 4)) + EPS);
            const float q0 = sv[rr][0][0] * scq, q1 = sv[rr][0][1] * scq, k0 = sv[rr][1][0] * sck, k1 = sv[rr][1][1] * sck, v0 = sv[rr][2][0], v1 = sv[rr][2][1];
            const float eg = __expf(gci), egl = __expf(gl - gci);
            *(LAS unsigned*)(QS + i * 136 + 2 * lane) = pk2(q0, q1); *(LAS unsigned*)(KS + i * 136 + 2 * lane) = pk2(k0, k1);
            *(unsigned*)((bf16*)(wsp() + WS_QD) + (size_t)ch * 8192 + ((((i >> 4) * 4 + (lane >> 4)) * 64 + ((lane >> 2) & 3) * 16 + (i & 15)) * 8 + 2 * (lane & 3))) = pk2(q0 * eg, q1 * eg);
            const unsigned g0 = f2bf(k0 * bi * eg), g1 = f2bf(k1 * bi * eg), d0 = f2bf(k0 * egl), d1 = f2bf(k1 * egl), u0 = f2bf(v0 * bi), u1 = f2bf(v1 * bi);
            if (rr & 1) { kg[0][rr >> 1] |= g0 << 16; kg[1][rr >> 1] |= g1 << 16; kd[0][rr >> 1] |= d0 << 16; kd[1][rr >> 1] |= d1 << 16; vb[0][rr >> 1] |= u0 << 16; vb[1][rr >> 1] |= u1 << 16; }
            else { kg[0][rr >> 1] = g0; kg[1][rr >> 1] = g1; kd[0][rr >> 1] = d0; kd[1][rr >> 1] = d1; vb[0][rr >> 1] = u0; vb[1][rr >> 1] = u1; }
        }
#pragma unroll
        for (int c = 0; c < 2; ++c) {
            *(LAS v4u*)(KGT + (2 * lane + c) * 72 + 8 * wave) = (v4u){kg[c][0], kg[c][1], kg[c][2], kg[c][3]};
            *(LAS v4u*)(KDT + (2 * lane + c) * 72 + 8 * wave) = (v4u){kd[c][0], kd[c][1], kd[c][2], kd[c][3]};
            *(LAS v4u*)(VT + (2 * lane + c) * 72 + 8 * wave) = (v4u){vb[c][0], vb[c][1], vb[c][2], vb[c][3]};
        }
        __syncthreads();
        if (PMODE == 2) continue;
        { const int ti = wave >> 1;
          bf16x8 kfi[4], qfi[4];
#pragma unroll
          for (int ks = 0; ks < 4; ++ks) { kfi[ks] = *(const LAS bf16x8*)(KS + (16 * ti + fr) * 136 + 32 * ks + 8 * fq); qfi[ks] = *(const LAS bf16x8*)(QS + (16 * ti + fr) * 136 + 32 * ks + 8 * fq); }
#pragma unroll
          for (int tt = 0; tt < 2; ++tt) { const int tj = 2 * (wave & 1) + tt;
              f32x4 akk = {0.f, 0.f, 0.f, 0.f}, aqk = {0.f, 0.f, 0.f, 0.f};
#pragma unroll
              for (int ks = 0; ks < 4; ++ks) { const bf16x8 kfj = *(const LAS bf16x8*)(KS + (16 * tj + fr) * 136 + 32 * ks + 8 * fq); akk = MFMA16(kfi[ks], kfj, akk); aqk = MFMA16(kfj, qfi[ks], aqk); }
              { const int j = 16 * tj + fr; const float gcj = GC[j];
#pragma unroll
                for (int r = 0; r < 4; ++r) { const int i = 16 * ti + 4 * fq + r; LM[i * 68 + j] = (i > j) ? BT[i] * akk[r] * __expf(GC[i] - gcj) : 0.f; } }
              { const int i = 16 * ti + fr; const float gci = GC[i]; float v[4];
#pragma unroll
                for (int r = 0; r < 4; ++r) { const int j = 16 * tj + 4 * fq + r; v[r] = (i >= j) ? aqk[r] * __expf(gci - GC[j]) : 0.f; }
                v2u w; w.x = pk2(v[0], v[1]); w.y = pk2(v[2], v[3]);
                *(v2u*)((bf16*)(wsp() + WS_AI) + (size_t)ch * 4096 + (((ti * 2 + (tj >> 1)) * 64 + ((2 * tj + (fq >> 1)) & 3) * 16 + fr) * 8 + 4 * (fq & 1))) = w; } } }
        __syncthreads();
        {
            LAS float* T11f = (LAS float*)(F.lds + 117248); LAS float* T22f = T11f + 1056; LAS float* Mf = T22f + 1056;
            if (wave < 2 && PMODE != 1) {
                const int cl = lane & 31;
                float x[32]; float clf = (float)cl; asm volatile("" : "+v"(clf));
                LAS float* Lh = LM + (32 * wave) * 68 + 32 * wave; asm volatile("" : "+v"(Lh));
#pragma unroll
                for (int i = 0; i < 32; ++i) x[i] = 0.f;
#pragma unroll
                for (int i = 0; i < 32; ++i) {
                    float a0 = fmaxf(0.f, 1.f - fabsf(clf - (float)i)), a1 = 0.f, a2 = 0.f, a3 = 0.f;
#pragma unroll
                    for (int j4 = 0; j4 < (i + 3) / 4; ++j4) { const f32x4 Lv = *(const LAS f32x4*)(Lh + i * 68 + 4 * j4);
                        a0 -= Lv.x * x[4 * j4]; a1 -= Lv.y * x[4 * j4 + 1]; a2 -= Lv.z * x[4 * j4 + 2]; a3 -= Lv.w * x[4 * j4 + 3]; }
                    x[i] = (a0 + a1) + (a2 + a3);
                }
                if (lane < 32) {
                    LAS float* tf = (wave ? T22f : T11f) + cl; asm volatile("" : "+v"(tf));
                    lbf tb = TB + (32 * wave) * 72 + 32 * wave + cl; asm volatile("" : "+v"(tb));
#pragma unroll
                    for (int i = 0; i < 32; ++i) { tf[i * 33] = x[i]; tb[i * 72] = (bf16)f2bf(x[i]); }
                } else if (wave == 0) {
                    lbf tz = TB + 32 + cl; asm volatile("" : "+v"(tz));
#pragma unroll
                    for (int i = 0; i < 32; ++i) tz[i * 72] = 0;
                }
            }
            __syncthreads();
            const int ti2 = F.tid >> 5, c2 = F.tid & 31;
            if (PMODE != 1) {
                float m0 = 0.f, m1 = 0.f;
#pragma unroll 8
                for (int k = 0; k < 32; ++k) { const float t = T11f[k * 33 + c2]; m0 += LM[(32 + ti2) * 68 + k] * t; m1 += LM[(48 + ti2) * 68 + k] * t; }
                Mf[ti2 * 33 + c2] = m0; Mf[(ti2 + 16) * 33 + c2] = m1;
            }
            __syncthreads();
            if (PMODE != 1) {
                float t0 = 0.f, t1 = 0.f;
#pragma unroll 8
                for (int k = 0; k < 32; ++k) { const float mm = Mf[k * 33 + c2]; t0 -= T22f[ti2 * 33 + k] * mm; t1 -= T22f[(ti2 + 16) * 33 + k] * mm; }
                TB[(32 + ti2) * 72 + c2] = (bf16)f2bf(t0); TB[(48 + ti2) * 72 + c2] = (bf16)f2bf(t1);
            }
        }
        __syncthreads();
        eat ^= touch;
        { const int ti = wave & 3;
          bf16x8 tf[2];
#pragma unroll
          for (int ks = 0; ks < 2; ++ks) tf[ks] = *(const LAS bf16x8*)(TB + (16 * ti + fr) * 72 + 32 * ks + 8 * fq);
#pragma unroll
          for (int q4 = 0; q4 < 4; ++q4) { const int te = (wave >> 2) * 4 + q4;
              f32x4 au = {0.f, 0.f, 0.f, 0.f}, aw = {0.f, 0.f, 0.f, 0.f};
#pragma unroll
              for (int ks = 0; ks < 2; ++ks) { const bf16x8 vf = *(const LAS bf16x8*)(VT + (16 * te + fr) * 72 + 32 * ks + 8 * fq), gf = *(const LAS bf16x8*)(KGT + (16 * te + fr) * 72 + 32 * ks + 8 * fq);
                  au = MFMA16(tf[ks], vf, au); aw = MFMA16(gf, tf[ks], aw); }
              v2u w; w.x = pk2(au[0], au[1]); w.y = pk2(au[2], au[3]);
              *(v2u*)((bf16*)(wsp() + WS_UT) + (size_t)ch * 8192 + ((te * 4 + ti) * 64 + lane) * 4) = w;
              w.x = pk2(aw[0], aw[1]); w.y = pk2(aw[2], aw[3]);
              *(v2u*)((bf16*)(wsp() + WS_W) + (size_t)ch * 8192 + (((ti * 4 + (te >> 1)) * 64 + ((2 * te + (fq >> 1)) & 3) * 16 + fr) * 8 + 4 * (fq & 1))) = w; }
          { const int d = F.tid >> 2, part = F.tid & 3; const LAS v4u* src = (const LAS v4u*)((LAS unsigned char*)KDT + d * 144 + part * 32);
            bf16* dstb = (bf16*)(wsp() + WS_KDT) + (size_t)ch * 8192 + (((d >> 4) * 2 + (part >> 1)) * 64 + (2 * (part & 1)) * 16 + (d & 15)) * 8; *(v4u*)dstb = src[0]; *(v4u*)(dstb + 128) = src[1]; }
          if (F.tid == 0) ((float*)(wsp() + WS_GL))[ch] = gl; }
        __syncthreads();
    }
    if (eat == 0x12345u && fq == 77) GC[0] = 1.f;
}
#undef PREP_LOAD
struct DnSetC { bf16x8 wf[4], qf[4], af[2]; v2u ut[2]; };
struct DnSetS { bf16x8 kf[2][2]; float gl; unsigned pf; };
template <int MODE>
__device__ __forceinline__ void dn_scan(Frame& F_, int sid) {
    Frame F = mkframe();
    const int bh = sid >> 2, slice = sid & 3, b = bh >> 3, h = bh & 7;
    const int lane = F.lane, wave = F.wave, fr = lane & 15, fq = lane >> 4;
    lbf ST = (lbf)(F.lds); lbf VT2 = (lbf)(F.lds + 8704);
    for (int i = F.tid; i < (8704 + 4608) / 4; i += NTHR) ((LAS unsigned*)F.lds)[i] = 0u;
    const bf16* pW = (const bf16*)(wsp() + WS_W) + (size_t)bh * 128 * 8192; const bf16* pQ = (const bf16*)(wsp() + WS_QD) + (size_t)bh * 128 * 8192;
    const bf16* pA = (const bf16*)(wsp() + WS_AI) + (size_t)bh * 128 * 4096; const bf16* pK = (const bf16*)(wsp() + WS_KDT) + (size_t)bh * 128 * 8192;
    const bf16* pU = (const bf16*)(wsp() + WS_UT) + (size_t)bh * 128 * 8192; const float* pG = (const float*)(wsp() + WS_GL) + bh * 128;
    bf16* pO = (bf16*)(wsp() + WS_XN) + (size_t)b * SEQ * D + h * 128 + 32 * slice;
    short eat = 0;
    __syncthreads();
    if (wave < 4) {
        const int mi = wave;
        const unsigned oW = (mi * 4 * 64 + lane) * 8, oA = (mi * 2 * 64 + lane) * 8, oU = ((2 * slice) * 4 + mi) * 256 + lane * 4, oO = (16 * mi + fr) * D + 4 * fq;
#define DNC_LOAD(X, nn) do { const int c_ = (nn) < 128 ? (nn) : 127; \
            X.ut[0] = *(const v2u*)(pU + (size_t)c_ * 8192 + oU); X.ut[1] = *(const v2u*)(pU + (size_t)c_ * 8192 + oU + 1024); \
            _Pragma("unroll") for (int ks = 0; ks < 4; ++ks) { X.wf[ks] = *(const bf16x8*)(pW + (size_t)c_ * 8192 + (oW + 512 * ks)); X.qf[ks] = *(const bf16x8*)(pQ + (size_t)c_ * 8192 + (oW + 512 * ks)); } \
            _Pragma("unroll") for (int ks = 0; ks < 2; ++ks) X.af[ks] = *(const bf16x8*)(pA + (size_t)c_ * 4096 + (oA + 512 * ks)); } while (0)
#define DNC_STEP(X, nn) do { \
            f32x4 c1[2], c2[2]; \
            _Pragma("unroll") for (int ni = 0; ni < 2; ++ni) { c1[ni] = (f32x4){0.f, 0.f, 0.f, 0.f}; c2[ni] = (f32x4){0.f, 0.f, 0.f, 0.f}; \
                _Pragma("unroll") for (int ks = 0; ks < 4; ++ks) { const bf16x8 sf = *(const LAS bf16x8*)(ST + (16 * ni + fr) * 136 + 32 * ks + 8 * fq); c1[ni] = MFMA16(X.wf[ks], sf, c1[ni]); c2[ni] = MFMA16(sf, X.qf[ks], c2[ni]); } \
                v2u w_; w_.x = pk2(bflo(X.ut[ni].x) - c1[ni][0], bfhi(X.ut[ni].x) - c1[ni][1]); w_.y = pk2(bflo(X.ut[ni].y) - c1[ni][2], bfhi(X.ut[ni].y) - c1[ni][3]); \
                *(LAS v2u*)(VT2 + (16 * ni + fr) * 72 + 16 * mi + 4 * fq) = w_; } \
            __syncthreads(); \
            _Pragma("unroll") for (int ni = 0; ni < 2; ++ni) { \
                _Pragma("unroll") for (int ks = 0; ks < 2; ++ks) { const bf16x8 vf = *(const LAS bf16x8*)(VT2 + (16 * ni + fr) * 72 + 32 * ks + 8 * fq); c2[ni] = MFMA16(vf, X.af[ks], c2[ni]); } \
                v2u w_; w_.x = pk2(c2[ni][0], c2[ni][1]); w_.y = pk2(c2[ni][2], c2[ni][3]); if (MODE == 0) *(v2u*)(pO + (size_t)(nn) * 64 * D + oO + 16 * ni) = w_; } \
            __syncthreads(); } while (0)
        DnSetC SA, SB, SC;
        DNC_LOAD(SA, 0); DNC_LOAD(SB, 1);
        for (int n = 0; n < 126; n += 3) {
            DNC_LOAD(SC, n + 2); __builtin_amdgcn_sched_barrier(0); DNC_STEP(SA, n); __builtin_amdgcn_sched_barrier(0);
            DNC_LOAD(SA, n + 3); __builtin_amdgcn_sched_barrier(0); DNC_STEP(SB, n + 1); __builtin_amdgcn_sched_barrier(0);
            DNC_LOAD(SB, n + 4); __builtin_amdgcn_sched_barrier(0); DNC_STEP(SC, n + 2); __builtin_amdgcn_sched_barrier(0);
        }
        DNC_STEP(SA, 126); DNC_STEP(SB, 127);
#undef DNC_LOAD
#undef DNC_STEP
    } else {
        const int dq = wave - 4;
        f32x4 accS[2][2];
#pragma unroll
        for (int k = 0; k < 2; ++k)
#pragma unroll
            for (int ni = 0; ni < 2; ++ni) accS[k][ni] = (f32x4){0.f, 0.f, 0.f, 0.f};
        const int lt = F.tid - 256, li = slice * 112 + lt; const bool toucher = lt < 144;
        const bf16* pfBase = (lt >= 112) ? pU + 2048 * slice + (lt - 112) * 64 : (li < 128) ? pW + li * 64 : (li < 256) ? pQ + (li - 128) * 64 : (li < 384) ? pK + (li - 256) * 64 : pA + (li - 384) * 64;
        const unsigned pfStride = (lt >= 112 || li < 384) ? 8192u : 4096u;
        const unsigned oK = (2 * dq * 2 * 64 + lane) * 8;
#define DNS_LOAD(X, nn) do { const int c_ = (nn) < 128 ? (nn) : 127; eat ^= (short)X.pf; X.gl = pG[c_]; \
            _Pragma("unroll") for (int ks = 0; ks < 2; ++ks) { X.kf[0][ks] = *(const bf16x8*)(pK + (size_t)c_ * 8192 + (oK + 512 * ks)); X.kf[1][ks] = *(const bf16x8*)(pK + (size_t)c_ * 8192 + (oK + 1024 + 512 * ks)); } \
            { const int c2_ = (nn) + 2 < 128 ? (nn) + 2 : 127; X.pf = toucher ? *(const unsigned*)(pfBase + (size_t)c2_ * pfStride) : 0u; } } while (0)
#define DNS_STEP(X, nn) do { \
            const float egl = __expf(X.gl); \
            __syncthreads(); \
            _Pragma("unroll") for (int ni = 0; ni < 2; ++ni) { bf16x8 vf[2]; \
                _Pragma("unroll") for (int ks = 0; ks < 2; ++ks) vf[ks] = *(const LAS bf16x8*)(VT2 + (16 * ni + fr) * 72 + 32 * ks + 8 * fq); \
                _Pragma("unroll") for (int k = 0; k < 2; ++k) { accS[k][ni] = accS[k][ni] * egl; \
                    _Pragma("unroll") for (int ks = 0; ks < 2; ++ks) accS[k][ni] = MFMA16(X.kf[k][ks], vf[ks], accS[k][ni]); \
                    v2u w_; w_.x = pk2(accS[k][ni][0], accS[k][ni][1]); w_.y = pk2(accS[k][ni][2], accS[k][ni][3]); \
                    *(LAS v2u*)(ST + (16 * ni + fr) * 136 + 16 * (2 * dq + k) + 4 * fq) = w_; } } \
            __syncthreads(); } while (0)
        DnSetS SA, SB, SC; SA.pf = 0u; SB.pf = 0u; SC.pf = 0u;
        DNS_LOAD(SA, 0); DNS_LOAD(SB, 1);
        for (int n = 0; n < 126; n += 3) {
            DNS_LOAD(SC, n + 2); __builtin_amdgcn_sched_barrier(0); DNS_STEP(SA, n); __builtin_amdgcn_sched_barrier(0);
            DNS_LOAD(SA, n + 3); __builtin_amdgcn_sched_barrier(0); DNS_STEP(SB, n + 1); __builtin_amdgcn_sched_barrier(0);
            DNS_LOAD(SB, n + 4); __builtin_amdgcn_sched_barrier(0); DNS_STEP(SC, n + 2); __builtin_amdgcn_sched_barrier(0);
        }
        DNS_STEP(SA, 126); DNS_STEP(SB, 127);
#undef DNS_LOAD
#undef DNS_STEP
    }
    if (eat == 12345 && fq == 77) VT2[0] = (bf16)eat;
}
__device__ __forceinline__ void rope16(v4u& w0, v4u& w1, const float* rp) {
    float x[8], y[8];
#pragma unroll
    for (int j = 0; j < 4; ++j) { x[2 * j] = bflo(w0[j]); x[2 * j + 1] = bfhi(w0[j]); y[2 * j] = bflo(w1[j]); y[2 * j + 1] = bfhi(w1[j]); }
    const f32x4 c0 = *(const f32x4*)rp, c1 = *(const f32x4*)(rp + 4), s0 = *(const f32x4*)(rp + 8), s1 = *(const f32x4*)(rp + 12);
    float c[8] = {c0.x, c0.y, c0.z, c0.w, c1.x, c1.y, c1.z, c1.w}, s[8] = {s0.x, s0.y, s0.z, s0.w, s1.x, s1.y, s1.z, s1.w};
#pragma unroll
    for (int j = 0; j < 8; ++j) { const float a = x[j], bb = y[j]; x[j] = a * c[j] - bb * s[j]; y[j] = bb * c[j] + a * s[j]; }
#pragma unroll
    for (int j = 0; j < 4; ++j) { w0[j] = pk2(x[2 * j], x[2 * j + 1]); w1[j] = pk2(y[2 * j], y[2 * j + 1]); }
}
__device__ __forceinline__ void swa_mfma(Frame& F_, int l, int nskip) {
    Frame F = mkframe();
    bf16* PROJ = (bf16*)(wsp() + WS_PROJ); const float* ROPE = (const float*)(wsp() + WS_ROPE);
    lbf KL = (lbf)(F.lds), VTL = (lbf)(F.lds + 29952), QL = (lbf)(F.lds + 57600 + F.wave * 9216);
    const int tid = F.tid, lane = F.lane, wave = F.wave, fr = lane & 15, fq = lane >> 4;
    for (int unit = F.bid - nskip; unit < 512; unit += F.G - nskip) {
        const int b = unit >> 8, kvh = (unit >> 7) & 1, q0 = (unit & 127) * 64;
        for (int task = tid; task < 208 * 4; task += NTHR) { const int kl = task >> 2, seg = task & 3, tk = q0 - 128 + kl; v4u w0 = {0u, 0u, 0u, 0u}, w1 = {0u, 0u, 0u, 0u};
            if (kl < 192 && tk >= 0) { const int mk = b * SEQ + tk; const v4u* p = (const v4u*)(PROJ + (size_t)mk * DINP + C_SWK + kvh * 64 + 16 * seg); w0 = p[0]; w1 = p[1];
                if (seg == 0) rope16(w0, w1, ROPE + mk * 16); }
            *(LAS v4u*)(KL + kl * 72 + 16 * seg) = w0; *(LAS v4u*)(KL + kl * 72 + 16 * seg + 8) = w1; }
        for (int task = tid; task < 192 * 8; task += NTHR) { const int kl = task >> 3, seg = task & 7, tk = q0 - 128 + kl; v4u w = {0u, 0u, 0u, 0u};
            if (tk >= 0) w = *(const v4u*)(PROJ + (size_t)(b * SEQ + tk) * DINP + C_SWV + kvh * 64 + 8 * seg);
#pragma unroll
            for (int j = 0; j < 4; ++j) { VTL[(8 * seg + 2 * j) * 216 + kl] = (bf16)(w[j] & 0xffffu); VTL[(8 * seg + 2 * j + 1) * 216 + kl] = (bf16)(w[j] >> 16); } }
        for (int i = tid; i < 1024; i += NTHR) VTL[(i >> 4) * 216 + 192 + (i & 15)] = 0;
        { const int mq = b * SEQ + q0 + lane; const v4u* qp = (const v4u*)(PROJ + (size_t)mq * DINP + C_SWQ + (kvh * 8 + wave) * 64);
          v4u w[8];
#pragma unroll
          for (int i = 0; i < 8; ++i) w[i] = qp[i];
          rope16(w[0], w[1], ROPE + mq * 16);
#pragma unroll
          for (int i = 0; i < 8; ++i) { v4u o;
#pragma unroll
              for (int j = 0; j < 4; ++j) o[j] = pk2(bflo(w[i][j]) * 0.125f, bfhi(w[i][j]) * 0.125f);
              *(LAS v4u*)(QL + lane * 72 + 8 * i) = o; } }
        __syncthreads();
        const float sink = inp(8)[l * 16 + kvh * 8 + wave];
#pragma unroll 1
        for (int qt = 0; qt < 4; ++qt) {
            bf16x8 qf[2];
#pragma unroll
            for (int ks = 0; ks < 2; ++ks) qf[ks] = *(const LAS bf16x8*)(QL + (16 * qt + fr) * 72 + 32 * ks + 8 * fq);
            f32x4 st[10];
#pragma unroll
            for (int t = 0; t < 10; ++t) { st[t] = (f32x4){0.f, 0.f, 0.f, 0.f};
#pragma unroll
                for (int ks = 0; ks < 2; ++ks) { const bf16x8 kf = *(const LAS bf16x8*)(KL + (16 * (qt + t) + fr) * 72 + 32 * ks + 8 * fq); st[t] = MFMA16(kf, qf[ks], st[t]); } }
            const int qr = 16 * qt + fr; float mx = -1e30f;
#pragma unroll
            for (int t = 0; t < 10; ++t)
#pragma unroll
                for (int r = 0; r < 4; ++r) { const int kl = 16 * (qt + t) + 4 * fq + r; const bool ok = (kl > qr) && (kl <= qr + 128) && (q0 - 128 + kl >= 0);
                    st[t][r] = ok ? st[t][r] : -1e30f; mx = fmaxf(mx, st[t][r]); }
            mx = fmaxf(mx, __shfl_xor(mx, 16)); mx = fmaxf(mx, __shfl_xor(mx, 32)); mx = fmaxf(mx, sink);
            float sum = 0.f;
#pragma unroll
            for (int t = 0; t < 10; ++t)
#pragma unroll
                for (int r = 0; r < 4; ++r) { const float p = (st[t][r] > -1e29f) ? __expf(st[t][r] - mx) : 0.f; st[t][r] = p; sum += p; }
            sum += __shfl_xor(sum, 16); sum += __shfl_xor(sum, 32);
            const float inv = 1.f / (sum + __expf(sink - mx));
            bf16x8 pf[5];
#pragma unroll
            for (int pr = 0; pr < 5; ++pr) { v4u w; w.x = pk2(st[2 * pr][0] * inv, st[2 * pr][1] * inv); w.y = pk2(st[2 * pr][2] * inv, st[2 * pr][3] * inv);
                w.z = pk2(st[2 * pr + 1][0] * inv, st[2 * pr + 1][1] * inv); w.w = pk2(st[2 * pr + 1][2] * inv, st[2 * pr + 1][3] * inv); pf[pr] = __builtin_bit_cast(bf16x8, w); }
#pragma unroll
            for (int dt = 0; dt < 4; ++dt) { f32x4 acc = {0.f, 0.f, 0.f, 0.f};
#pragma unroll
                for (int pr = 0; pr < 5; ++pr) { const v2u a0 = *(const LAS v2u*)(VTL + (16 * dt + fr) * 216 + 16 * (qt + 2 * pr) + 4 * fq), a1 = *(const LAS v2u*)(VTL + (16 * dt + fr) * 216 + 16 * (qt + 2 * pr + 1) + 4 * fq);
                    v4u aw; aw.x = a0.x; aw.y = a0.y; aw.z = a1.x; aw.w = a1.y; acc = MFMA16(__builtin_bit_cast(bf16x8, aw), pf[pr], acc); }
                v2u w; w.x = pk2(acc[0], acc[1]); w.y = pk2(acc[2], acc[3]);
                *(v2u*)(PROJ + (size_t)(b * SEQ + q0 + 16 * qt + fr) * DINP + C_SWQ + (kvh * 8 + wave) * 64 + 16 * dt + 4 * fq) = w; }
        }
        __syncthreads();
    }
}
__device__ __forceinline__ void dn_naive(Frame& F_, int l) {
    Frame F = mkframe(); const int b = F.bid >> 3, h = F.bid & 7;
    const bf16* PROJ = (const bf16*)(wsp() + WS_PROJ); bf16* ORAW = (bf16*)(wsp() + WS_XN);
    LAS float* vals = (LAS float*)F.lds;
    LAS float* part = vals + 768;
    LAS float* bg = part + 16;
    LAS float* red = bg + 4;
    LAS float* red2 = red + 1024;
    const int tid = F.tid, lane = F.lane, wave = F.wave;
    const int e = tid & 127, r = tid >> 7;
    int col; float cw0 = 0.f, cw1 = 0.f, cw2 = 0.f, cw3 = 0.f;
    if (tid < 384) { const int chan = (tid >> 7) * 1024 + h * 128 + (tid & 127); col = chan; const float* cw = inp(4) + (size_t)l * 4 * 3072;
        cw0 = cw[chan]; cw1 = cw[3072 + chan]; cw2 = cw[2 * 3072 + chan]; cw3 = cw[3 * 3072 + chan]; }
    else if (tid == 384) col = C_DNB + h; else if (tid == 385) col = C_DNA + h; else col = 0;
    const float a_neg = -__expf(inp(5)[l * 8 + h]), dtb = inp(6)[l * 8 + h];
    float S[32];
#pragma unroll
    for (int i = 0; i < 32; ++i) S[i] = 0.f;
    float x0 = 0.f, x1 = 0.f, x2 = 0.f;
    const bf16* pcol = PROJ + (size_t)b * SEQ * DINP + col;
    float cur[16], nxt[16];
#pragma unroll
    for (int i = 0; i < 16; ++i) cur[i] = bf1(pcol[(size_t)i * DINP]);
    for (int tb = 0; tb < SEQ; tb += 16) {
        if (tb + 16 < SEQ) {
#pragma unroll
            for (int i = 0; i < 16; ++i) nxt[i] = bf1(pcol[(size_t)(tb + 16 + i) * DINP]);
        }
#pragma unroll
        for (int i = 0; i < 16; ++i) {
            const int t = tb + i, buf = i & 1;
            const float xin = cur[i];
            if (tid < 384) {
                const float y = cw0 * x0 + cw1 * x1 + cw2 * x2 + cw3 * xin; x0 = x1; x1 = x2; x2 = xin;
                const float s = siluf_(y); vals[buf * 384 + tid] = s;
                const float ss = wave_sum(s * s); if (lane == 0) part[buf * 8 + wave] = ss;
            } else if (tid == 384) { bg[buf * 2 + 0] = sigmoidf_(xin); }
            else if (tid == 385) { const float z = xin + dtb; const float sp = (z > 20.f) ? z : log1pf(__expf(z)); bg[buf * 2 + 1] = __expf(a_neg * sp); }
            __syncthreads();
            const float sq = rsqrtf(part[buf * 8 + 0] + part[buf * 8 + 1] + EPS) * 0.08838834764831845f;
            const float sk = rsqrtf(part[buf * 8 + 2] + part[buf * 8 + 3] + EPS);
            const float beta = bg[buf * 2 + 0], eg = bg[buf * 2 + 1];
            const LAS float* qv = vals + buf * 384 + 32 * r; const LAS float* kv = vals + buf * 384 + 128 + 32 * r;
            float pk = 0.f, pq = 0.f, pqk = 0.f;
#pragma unroll
            for (int dd = 0; dd < 32; ++dd) { const float kd = kv[dd], qd = qv[dd]; pk += kd * S[dd]; pq += qd * S[dd]; pqk += qd * kd; }
            red[(buf * 4 + r) * 128 + e] = pk * sk; red[((1 - buf) * 4 + r) * 128 + e] = pq * sq;
            if (e == 0) red2[r] = pqk;
            __syncthreads();
            float kS = 0.f, qS = 0.f;
#pragma unroll
            for (int rr = 0; rr < 4; ++rr) { kS += red[(buf * 4 + rr) * 128 + e]; qS += red[((1 - buf) * 4 + rr) * 128 + e]; }
            const float qk = (red2[0] + red2[1] + red2[2] + red2[3]) * sq * sk;
            const float ve = vals[buf * 384 + 256 + e];
            const float delta = beta * (ve - eg * kS);
            if (r == 0) ORAW[(size_t)(b * SEQ + t) * D + h * 128 + e] = (bf16)f2bf(eg * qS + qk * delta);
            const float kdl = sk * delta;
#pragma unroll
            for (int dd = 0; dd < 32; ++dd) S[dd] = eg * S[dd] + kv[dd] * kdl;
            __syncthreads();
        }
#pragma unroll
        for (int i = 0; i < 16; ++i) cur[i] = nxt[i];
    }
}
__device__ __forceinline__ void swa_naive(Frame& F_, int l, int nskip) {
    Frame F = mkframe(); const int w0 = (F.bid - nskip) * NWAVES + F.wave, nw = (F.G - nskip) * NWAVES;
    bf16* PROJ = (bf16*)(wsp() + WS_PROJ); const float* ROPE = (const float*)(wsp() + WS_ROPE);
    LAS float* qs = (LAS float*)(F.lds + F.wave * 8192);
    LAS float* ps = qs + 512;
    const int lane = F.lane;
    for (int task = w0; task < M * 2; task += nw) {
        const int m = task >> 1, kvh = task & 1, b = m / SEQ, t = m % SEQ;
        { const float c = ROPE[m * 16 + (lane & 7)], s = ROPE[m * 16 + 8 + (lane & 7)];
#pragma unroll
          for (int g = 0; g < 8; ++g) { const float x = bf1(PROJ[(size_t)m * DINP + C_SWQ + (kvh * 8 + g) * 64 + lane]); const float p = __shfl_xor(x, 8);
              const float y = (lane < 8) ? (x * c - p * s) : ((lane < 16) ? (x * c + p * s) : x); qs[g * 64 + lane] = y * 0.125f; } }
        asm volatile("s_waitcnt lgkmcnt(0)" ::: "memory");
#pragma unroll 1
        for (int kk = 0; kk < 2; ++kk) {
            const int tk = t - 127 + lane + 64 * kk; const bool valid = tk >= 0; const int mk = b * SEQ + (valid ? tk : 0);
            float kf[64];
            const v4u* kr = (const v4u*)(PROJ + (size_t)mk * DINP + C_SWK + kvh * 64);
#pragma unroll
            for (int i = 0; i < 8; ++i) { const v4u w = kr[i];
#pragma unroll
                for (int j = 0; j < 4; ++j) { kf[8 * i + 2 * j] = bflo(w[j]); kf[8 * i + 2 * j + 1] = bfhi(w[j]); } }
#pragma unroll
            for (int j = 0; j < 8; ++j) { const float c = ROPE[mk * 16 + j], s = ROPE[mk * 16 + 8 + j]; const float a = kf[j], bb = kf[j + 8]; kf[j] = a * c - bb * s; kf[j + 8] = bb * c + a * s; }
#pragma unroll
            for (int g = 0; g < 8; ++g) { float a = 0.f;
#pragma unroll
                for (int d4 = 0; d4 < 16; ++d4) { const f32x4 q = *(const LAS f32x4*)(qs + g * 64 + 4 * d4); a += q.x * kf[4 * d4] + q.y * kf[4 * d4 + 1] + q.z * kf[4 * d4 + 2] + q.w * kf[4 * d4 + 3]; }
                ps[(lane + 64 * kk) * 8 + g] = valid ? a : -1e30f; }
        }
        asm volatile("s_waitcnt lgkmcnt(0)" ::: "memory");
#pragma unroll
        for (int g = 0; g < 8; ++g) {
            const float sink = inp(8)[l * 16 + kvh * 8 + g];
            const float s0 = ps[lane * 8 + g], s1 = ps[(lane + 64) * 8 + g];
            const float mx = fmaxf(wave_max(fmaxf(s0, s1)), sink);
            const float p0 = (s0 > -1e29f) ? __expf(s0 - mx) : 0.f, p1 = (s1 > -1e29f) ? __expf(s1 - mx) : 0.f;
            const float den = wave_sum(p0 + p1) + __expf(sink - mx); const float inv = 1.f / den;
            ps[lane * 8 + g] = p0 * inv; ps[(lane + 64) * 8 + g] = p1 * inv;
        }
        asm volatile("s_waitcnt lgkmcnt(0)" ::: "memory");
        float o[8];
#pragma unroll
        for (int g = 0; g < 8; ++g) o[g] = 0.f;
        const int j0 = (t >= 127) ? 0 : (127 - t);
        for (int j = j0; j < 128; ++j) {
            const int mk = b * SEQ + t - 127 + j;
            const float v = bf1(PROJ[(size_t)mk * DINP + C_SWV + kvh * 64 + lane]);
            const f32x4 pa = *(const LAS f32x4*)(ps + j * 8), pb = *(const LAS f32x4*)(ps + j * 8 + 4);
            o[0] += pa.x * v; o[1] += pa.y * v; o[2] += pa.z * v; o[3] += pa.w * v; o[4] += pb.x * v; o[5] += pb.y * v; o[6] += pb.z * v; o[7] += pb.w * v;
        }
#pragma unroll
        for (int g = 0; g < 8; ++g) PROJ[(size_t)m * DINP + C_SWQ + (kvh * 8 + g) * 64 + lane] = (bf16)f2bf(o[g]);
        asm volatile("s_waitcnt lgkmcnt(0)" ::: "memory");
    }
}
__device__ __forceinline__ void phase_gnorm(Frame& F_, int l) {
    Frame F = mkframe();
    bf16* PROJ = (bf16*)(wsp() + WS_PROJ); const bf16* ORAW = (const bf16*)(wsp() + WS_XN);
    const int gw = F.bid * NWAVES + F.wave, NGW = F.G * NWAVES;
    const float g0 = inp(7)[l * 128 + 2 * F.lane], g1 = inp(7)[l * 128 + 2 * F.lane + 1];
    for (int m = gw; m < M; m += NGW) {
        unsigned ow[8], zw[8];
#pragma unroll
        for (int h = 0; h < 8; ++h) { ow[h] = *(const unsigned*)(ORAW + (size_t)m * D + h * 128 + 2 * F.lane); zw[h] = *(const unsigned*)(PROJ + (size_t)m * DINP + C_DNZ + h * 128 + 2 * F.lane); }
        float ss[8];
#pragma unroll
        for (int h = 0; h < 8; ++h) { const float o0 = bflo(ow[h]), o1 = bfhi(ow[h]); ss[h] = o0 * o0 + o1 * o1; }
#pragma unroll
        for (int o = 1; o < 64; o <<= 1) {
#pragma unroll
            for (int h = 0; h < 8; ++h) ss[h] += __shfl_xor(ss[h], o); }
#pragma unroll
        for (int h = 0; h < 8; ++h) { const float r = rsqrtf(ss[h] * (1.f / 128.f) + EPS);
            *(unsigned*)(PROJ + (size_t)m * DINP + C_DNQ + h * 128 + 2 * F.lane) = pk2(bflo(ow[h]) * r * g0 * siluf_(bflo(zw[h])), bfhi(ow[h]) * r * g1 * siluf_(bfhi(zw[h]))); }
    }
}

#ifndef PROBE_ECHO
#define PROBE_ECHO 0
#endif
#define ECHO_BEGIN(k) do { if (PROBE_ECHO == (k)) echo_t0 = __builtin_amdgcn_s_memrealtime(); } while (0)
#define ECHO_END(k) do { if (PROBE_ECHO == (k)) { const unsigned long long t1_ = __builtin_amdgcn_s_memrealtime(), d_ = t1_ - echo_t0; while (__builtin_amdgcn_s_memrealtime() - t1_ < d_) __builtin_amdgcn_s_sleep(8); } } while (0)
#ifndef PROBE_DUP
#define PROBE_DUP 0
#endif
#ifndef DN_NAIVE
#define DN_NAIVE 0
#endif
struct Args { const float* in[17]; float* out; unsigned char* ws; };
__global__ void __launch_bounds__(NTHR, 2) hybrid_fwd(Args args) {
    cg::grid_group grid = cg::this_grid();
    Frame F;
    F.lds = lds_base();
    F.tid = threadIdx.x; F.lane = F.tid & 63; F.wave = __builtin_amdgcn_readfirstlane(F.tid >> 6);
    F.G = gridDim.x; F.bid = blockIdx.x;
#define PROJ ((bf16*)(wsp() + WS_PROJ))
#define XN ((bf16*)(wsp() + WS_XN))
#define YF ((float*)(wsp() + WS_YF))
#define MIX ((bf16*)(wsp() + WS_MIX))
#define HB ((bf16*)(wsp() + WS_H))

    unsigned long long echo_t0 = 0; (void)echo_t0;
    ECHO_BEGIN(9); ECHO_BEGIN(10); ECHO_BEGIN(11);
    if (F.bid == 0) { for (int i = F.tid; i < XCD_BAR_WORDS; i += NTHR) ((unsigned*)(wsp() + WS_BAR))[i] = 0u; for (int i = F.tid; i < 16384; i += NTHR) ((unsigned*)(wsp() + WS_XCNT))[i] = 0u; if (F.tid < 256) ((unsigned*)(wsp() + WS_SUBCNT))[F.tid] = 0u; }
    if (F.tid < 4) ((LAS unsigned*)(lds_base() + LDS_BARST))[F.tid] = 0u;
    grid.sync();
    ECHO_END(10);
    xcd_barrier_post();
    phase_rope(F);
    phase_norm(F, nullptr, nullptr, inp(0), outp(), inp(2), XN);
    phase_convert(F, -1, 0, 0);
    grid_bar();
    ECHO_END(9);
    for (int l = 0; l < DEPTH; ++l) {
        ECHO_BEGIN(1);
        {
            pg8::Gemm g{XN, (const bf16*)(wsp() + WS_WIN), nullptr, nullptr, M, DINP, D, D}; pg8::StaticOrder S; { Frame Fg = mkframe(); S.init(M, DINP, Fg.G, Fg.bid); }
            pg8::EpiBf16<0> E{PROJ, DINP};
            pg8::gemm_phase<pg8::EpiBf16<0>, pg8::StaticOrder, true, true>(F.lds, g, S, E);
#if PROBE_DUP == 5
            pg8::gemm_phase<pg8::EpiBf16<0>, pg8::StaticOrder, true, true>(F.lds, g, S, E);
#endif
        }
        grid_bar(); ECHO_END(1); ECHO_BEGIN(2);
#if DN_NAIVE
        if (F.bid < 16) dn_naive(F, l);
        else swa_naive(F, l, 16);
#else
#if PROBE_DUP == 1
        dn_prep<0>(F, l);
#elif PROBE_DUP == 11
        dn_prep<1>(F, l);
#elif PROBE_DUP == 12
        dn_prep<2>(F, l);
#elif PROBE_DUP == 13
        dn_prep<3>(F, l);
#elif PROBE_DUP == 14
        dn_prep<4>(F, l);
#endif
        dn_prep<0>(F, l);
        grid_bar(); ECHO_END(2); ECHO_BEGIN(3);
        { Frame Fg = mkframe(); if (Fg.bid < 64) { const int sid_ = (((Fg.bid & 7) * 2 + (Fg.bid >> 5)) << 2) | ((Fg.bid >> 3) & 3); dn_scan<0>(F, sid_);
#if PROBE_DUP == 2
            dn_scan<0>(F, sid_);
#elif PROBE_DUP == 3
            dn_scan<1>(F, sid_);
#elif PROBE_DUP == 4
            dn_scan<2>(F, sid_);
#endif
        }
        else {
            phase_convert(F, l, (l + 1 < DEPTH) ? l + 1 : -1, 64);
            __syncthreads();
            swa_mfma(F, l, 64);
            sub_bar((unsigned*)(wsp() + WS_SUBCNT) + 64 * l, (unsigned)(Fg.G - 64));
            pg8::Gemm g{PROJ + C_SWQ, (const bf16*)(wsp() + WS_WUPSW), nullptr, nullptr, M, D, D, DINP}; pg8::StaticOrder S; S.init(M, D, Fg.G - 64, Fg.bid - 64);
            pg8::EpiYb E{PROJ + C_DNK, DINP, PROJ + C_GB, DINP};
            pg8::gemm_phase<pg8::EpiYb, pg8::StaticOrder, true, true>(F.lds, g, S, E);
        } }
#endif
        grid_bar(); ECHO_END(3); ECHO_BEGIN(4);
        phase_gnorm(F, l);
#if PROBE_DUP == 6
        phase_gnorm(F, l);
#endif
        grid_bar(); ECHO_END(4); ECHO_BEGIN(5);
        {
            pg8::Gemm g{PROJ + C_DNQ, (const bf16*)(wsp() + WS_WUPDN), nullptr, nullptr, M, D, D, DINP}; pg8::StaticOrder S; { Frame Fg = mkframe(); S.init(M, D, Fg.G, Fg.bid); }
            pg8::EpiMerge2 E{MIX, D, PROJ + C_GA, PROJ + C_DNK, DINP};
            pg8::gemm_phase<pg8::EpiMerge2, pg8::StaticOrder, false, true>(F.lds, g, S, E);
        }
        grid_bar(); ECHO_END(5); ECHO_BEGIN(6);
        {
            pg8::Gemm g{MIX, (const bf16*)(wsp() + WS_WO), nullptr, nullptr, M, D, D, D}; pg8::StaticOrder S; { Frame Fg = mkframe(); S.init(M, D, Fg.G, Fg.bid); }
            pg8::RmsExchange e1{(float*)(wsp() + WS_XSLOT), (unsigned*)(wsp() + WS_XCNT) + ((l * 4 + 0) * 64) * 16}, e2{(float*)(wsp() + WS_XSLOT + 262144), (unsigned*)(wsp() + WS_XCNT) + ((l * 4 + 1) * 64) * 16};
            pg8::EpiRmsRes E{outp(), inp(12) + l * D, inp(13) + l * D, XN, e1, e2};
            pg8::gemm_phase<pg8::EpiRmsRes, pg8::StaticOrder, false, true>(F.lds, g, S, E);
        }
        grid_bar(); ECHO_END(6); ECHO_BEGIN(7);
        {
            pg8::Gemm g{XN, (const bf16*)(wsp() + WS_WFF1), nullptr, nullptr, M, FF, D, D}; pg8::StaticOrder S; { Frame Fg = mkframe(); S.init(M, FF, Fg.G, Fg.bid); }
            pg8::EpiBf16<2> E{HB, FF};
            pg8::gemm_phase<pg8::EpiBf16<2>, pg8::StaticOrder, true, true>(F.lds, g, S, E);
#if PROBE_DUP == 7
            pg8::gemm_phase<pg8::EpiBf16<2>, pg8::StaticOrder, true, true>(F.lds, g, S, E);
#endif
        }
        grid_bar(); ECHO_END(7); ECHO_BEGIN(8);
        {
            pg8::Gemm g{HB, (const bf16*)(wsp() + WS_WFF2), nullptr, nullptr, M, D, FF, FF}; pg8::StaticOrder S; { Frame Fg = mkframe(); S.init(M, D, Fg.G, Fg.bid); }
            pg8::RmsExchange e1{(float*)(wsp() + WS_XSLOT), (unsigned*)(wsp() + WS_XCNT) + ((l * 4 + 2) * 64) * 16}, e2{(float*)(wsp() + WS_XSLOT + 262144), (unsigned*)(wsp() + WS_XCNT) + ((l * 4 + 3) * 64) * 16};
            pg8::EpiRmsRes E{outp(), inp(16) + l * D, (l + 1 < DEPTH) ? inp(2) + (l + 1) * D : nullptr, XN, e1, e2};
            pg8::gemm_phase<pg8::EpiRmsRes, pg8::StaticOrder, false, true>(F.lds, g, S, E);
        }
        if (l + 1 < DEPTH) grid_bar();
        ECHO_END(8);
    }
    ECHO_END(11);
#undef PROJ
#undef XN
#undef YF
#undef MIX
#undef HB
}

extern "C" void kernel_launch(void* const* d_in, const int* in_sizes, int n_in, void* d_out, int out_size, void* d_ws, size_t ws_size, hipStream_t stream) {
    static int init = 0;
    if (!init) {
        if (n_in != 17 || out_size != M * D || ws_size < WS_END) { fprintf(stderr, "kernel_launch: unexpected shapes (n_in %d out %d ws %zu)\n", n_in, out_size, ws_size); init = -1; return; }
        if (hipFuncSetAttribute((const void*)hybrid_fwd, hipFuncAttributeMaxDynamicSharedMemorySize, LDS_BYTES) != hipSuccess) { fprintf(stderr, "hipFuncSetAttribute failed\n"); init = -1; return; }
        init = 1;
    }
    if (init < 0) return;
    Args a{};
    for (int i = 0; i < 17; ++i) a.in[i] = (const float*)d_in[i];
    a.out = (float*)d_out; a.ws = (unsigned char*)d_ws;
    void* args[] = {&a};
    hipError_t e = hipLaunchCooperativeKernel((void*)hybrid_fwd, dim3(256), dim3(NTHR), args, LDS_BYTES, stream);
    if (e != hipSuccess) fprintf(stderr, "cooperative launch failed: %s\n", hipGetErrorString(e));
}
```

```cpp
#include <hip/hip_runtime.h>
#include <hip/hip_cooperative_groups.h>
#include <cstdio>
#include <cstdint>
namespace cg = cooperative_groups;

namespace pg8 {
#define PG8_LAS __attribute__((address_space(3)))
typedef unsigned short bf16_t;
typedef short bf16x8 __attribute__((ext_vector_type(8)));
typedef float f32x4 __attribute__((ext_vector_type(4)));
typedef unsigned u32x4 __attribute__((ext_vector_type(4)));
constexpr int BM = 256, BK = 64, HALF = 128, HTB = HALF * BK * 2, STAGE_BYTES = 8 * HTB, NXCD = 8, WGM = 8;

__host__ __device__ __forceinline__ int lds_byte(int r, int c) { const int st = (r >> 4) * 2 + (c >> 5), rr = r & 15, cc = c & 31, ob = rr * 64 + cc * 2; return st * 1024 + (ob ^ (((ob >> 9) & 1) << 5)); }
__host__ __device__ __forceinline__ void stage_rc(int b, int& R, int& C) { const int st = b / 1024, sb = b % 1024, swz = sb ^ (((sb >> 9) & 1) << 5); R = (st >> 1) * 16 + swz / 64; C = (st & 1) * 32 + (swz % 64) / 2; }
__host__ __device__ __forceinline__ int perm32(int rho) { const int n = rho >> 4, i = rho & 15; return 8 * (i >> 2) + 4 * n + (i & 3); }

struct Unit { int pm, pn, src; };
struct Gemm { const bf16_t* A; const bf16_t* Bt; const bf16_t* A2; const bf16_t* Bt2; int M, N, K, lda; };

struct StaticOrder {
    int nM, nN, nwg, G, c;
    __host__ __device__ void init(int M, int N, int G_, int c_) { nM = M / BM; nN = N / BM; nwg = nM * nN; G = G_; c = c_; }
    __host__ __device__ bool tile(long L, Unit& u) const {
        if (L >= nwg) return false;
        int wgid = (int)L; { const int q = nwg / NXCD, r = nwg % NXCD, xcd = wgid % NXCD, off = wgid / NXCD; wgid = (xcd < r ? xcd * (q + 1) : r * (q + 1) + (xcd - r) * q) + off; }
        const int nig = WGM * nN, gid = wgid / nig, fm = gid * WGM, gsz = (nM - fm) < WGM ? (nM - fm) : WGM;
        u.pm = fm + ((wgid % nig) % gsz); u.pn = (wgid % nig) / gsz; u.src = 0; return true;
    }
    __host__ __device__ bool next(int i, Unit& u) const { return tile((long)i * G + c, u); }
};
struct DualOrder {
    StaticOrder S;
    __host__ __device__ bool next(int i, Unit& u) const { const bool ok = S.tile((long)(i >> 1) * S.G + S.c, u); u.src = i & 1; return ok; }
};

typedef float f32x2c __attribute__((ext_vector_type(2)));
typedef __bf16 bf16x2c __attribute__((ext_vector_type(2)));
__device__ __forceinline__ unsigned cvt_pk_bf16(float lo, float hi) { const f32x2c v = {lo, hi}; return __builtin_bit_cast(unsigned, __builtin_convertvector(v, bf16x2c)); }
__device__ __forceinline__ float bf_lo(unsigned w) { return __uint_as_float(w << 16); }
__device__ __forceinline__ float bf_hi(unsigned w) { return __uint_as_float(w & 0xffff0000u); }

template <int ACT  > struct EpiBf16 {
    static constexpr bool PERM = true, DUAL = false, AFTER_DRAIN = false;
    bf16_t* O; int ldc;
    __device__ __forceinline__ void mid(f32x4 (&acc)[2][2][4][2], const Unit& u, int wr, int wc, int fr, int fq) const {}
    __device__ __forceinline__ void operator()(const f32x4 (&acc)[2][2][4][2], const Unit& u, int wr, int wc, int fr, int fq) const {
        const int row0 = u.pm * BM + wr * 64 + fr; const int col0 = u.pn * BM + wc * 32 + 8 * fq;
#pragma unroll
        for (int ai = 0; ai < 2; ++ai)
#pragma unroll
            for (int m = 0; m < 4; ++m) { bf16_t* rowp = O + (size_t)(row0 + ai * HALF + m * 16) * ldc + col0;
#pragma unroll
                for (int bj = 0; bj < 2; ++bj) { f32x4 v0 = acc[ai][bj][m][0], v1 = acc[ai][bj][m][1];
                    if (ACT == 2) {
#pragma unroll
                        for (int e = 0; e < 4; ++e) { const float a = fmaxf(v0[e], 0.f), b = fmaxf(v1[e], 0.f); v0[e] = a * a; v1[e] = b * b; } }
                    u32x4 w; w.x = cvt_pk_bf16(v0[0], v0[1]); w.y = cvt_pk_bf16(v0[2], v0[3]); w.z = cvt_pk_bf16(v1[0], v1[1]); w.w = cvt_pk_bf16(v1[2], v1[3]);
                    *(u32x4*)(rowp + bj * HALF) = w; } }
    }
};
struct EpiF32 {
    static constexpr bool PERM = false, DUAL = false, AFTER_DRAIN = false;
    float* O; int ldc;
    __device__ __forceinline__ void mid(f32x4 (&acc)[2][2][4][2], const Unit& u, int wr, int wc, int fr, int fq) const {}
    __device__ __forceinline__ void operator()(const f32x4 (&acc)[2][2][4][2], const Unit& u, int wr, int wc, int fr, int fq) const {
        float* rowp = O + (size_t)(u.pm * BM + wr * 64 + fr) * ldc + (u.pn * BM + wc * 32 + 4 * fq);
#pragma unroll
        for (int ai = 0; ai < 2; ++ai) {
#pragma unroll
            for (int m = 0; m < 4; ++m) {
#pragma unroll
                for (int bj = 0; bj < 2; ++bj)
#pragma unroll
                    for (int n = 0; n < 2; ++n) *(f32x4*)(rowp + bj * HALF + n * 16) = acc[ai][bj][m][n];
                rowp += (size_t)16 * ldc; asm volatile("" : "+v"(rowp) :: "memory"); }
            rowp += (size_t)64 * ldc; }
    }
};
struct EpiMerge {
    static constexpr bool PERM = true, DUAL = true, AFTER_DRAIN = false;
    bf16_t* O; int ldc; const bf16_t* GA; const bf16_t* GB; int ldg;
    __device__ __forceinline__ void mid(f32x4 (&acc)[2][2][4][2], const Unit& u, int wr, int wc, int fr, int fq) const {
        const int row0 = u.pm * BM + wr * 64 + fr; const int col0 = u.pn * BM + wc * 32 + 8 * fq;
#pragma unroll
        for (int ai = 0; ai < 2; ++ai)
#pragma unroll
            for (int m = 0; m < 4; ++m) { const size_t ro = (size_t)(row0 + ai * HALF + m * 16) * ldg + col0;
#pragma unroll
                for (int bj = 0; bj < 2; ++bj) { const u32x4 ga = *(const u32x4*)(GA + ro + bj * HALF), gb = *(const u32x4*)(GB + ro + bj * HALF);
#pragma unroll
                    for (int e = 0; e < 4; ++e) { const unsigned wa = ga[e], wb = gb[e];
                        const float r0 = (1.f + __expf(-bf_lo(wb))) / (1.f + __expf(-bf_lo(wa))), r1 = (1.f + __expf(-bf_hi(wb))) / (1.f + __expf(-bf_hi(wa)));
                        if (e < 2) { acc[ai][bj][m][0][2 * e] *= r0; acc[ai][bj][m][0][2 * e + 1] *= r1; } else { acc[ai][bj][m][1][2 * (e - 2)] *= r0; acc[ai][bj][m][1][2 * (e - 2) + 1] *= r1; } } } }
    }
    __device__ __forceinline__ void operator()(const f32x4 (&acc)[2][2][4][2], const Unit& u, int wr, int wc, int fr, int fq) const {
        const int row0 = u.pm * BM + wr * 64 + fr; const int col0 = u.pn * BM + wc * 32 + 8 * fq;
#pragma unroll
        for (int ai = 0; ai < 2; ++ai)
#pragma unroll
            for (int m = 0; m < 4; ++m) { const size_t ro = (size_t)(row0 + ai * HALF + m * 16) * ldg + col0; bf16_t* rowp = O + (size_t)(row0 + ai * HALF + m * 16) * ldc + col0;
#pragma unroll
                for (int bj = 0; bj < 2; ++bj) { const u32x4 gb = *(const u32x4*)(GB + ro + bj * HALF); f32x4 v0 = acc[ai][bj][m][0], v1 = acc[ai][bj][m][1];
                    float s[8];
#pragma unroll
                    for (int e = 0; e < 4; ++e) { s[2 * e] = 1.f / (1.f + __expf(-bf_lo(gb[e]))); s[2 * e + 1] = 1.f / (1.f + __expf(-bf_hi(gb[e]))); }
                    u32x4 w; w.x = cvt_pk_bf16(v0[0] * s[0], v0[1] * s[1]); w.y = cvt_pk_bf16(v0[2] * s[2], v0[3] * s[3]); w.z = cvt_pk_bf16(v1[0] * s[4], v1[1] * s[5]); w.w = cvt_pk_bf16(v1[2] * s[6], v1[3] * s[7]);
                    *(u32x4*)(rowp + bj * HALF) = w; } }
    }
};

struct EpiYb {
    static constexpr bool PERM = true, DUAL = false, AFTER_DRAIN = false;
    bf16_t* O; int ldc; const bf16_t* GB; int ldg;
    __device__ __forceinline__ void mid(f32x4 (&acc)[2][2][4][2], const Unit& u, int wr, int wc, int fr, int fq) const {}
    __device__ __forceinline__ void operator()(const f32x4 (&acc)[2][2][4][2], const Unit& u, int wr, int wc, int fr, int fq) const {
        const int row0 = u.pm * BM + wr * 64 + fr; const int col0 = u.pn * BM + wc * 32 + 8 * fq;
        u32x4 cgb[2], ngb[2];
        { const size_t ro = (size_t)row0 * ldg + col0;
#pragma unroll
          for (int bj = 0; bj < 2; ++bj) cgb[bj] = *(const u32x4*)(GB + ro + bj * HALF); }
#pragma unroll
        for (int g = 0; g < 8; ++g) { const int ai = g >> 2, m = g & 3;
            if (g < 7) { const size_t ro = (size_t)(row0 + ((g + 1) >> 2) * HALF + ((g + 1) & 3) * 16) * ldg + col0;
#pragma unroll
                for (int bj = 0; bj < 2; ++bj) ngb[bj] = *(const u32x4*)(GB + ro + bj * HALF); }
            bf16_t* rowp = O + (size_t)(row0 + ai * HALF + m * 16) * ldc + col0;
#pragma unroll
            for (int bj = 0; bj < 2; ++bj) { const u32x4 gb = cgb[bj]; const f32x4 v0 = acc[ai][bj][m][0], v1 = acc[ai][bj][m][1];
                float s[8];
#pragma unroll
                for (int e = 0; e < 4; ++e) { s[2 * e] = __builtin_amdgcn_rcpf(1.f + __expf(-bf_lo(gb[e]))); s[2 * e + 1] = __builtin_amdgcn_rcpf(1.f + __expf(-bf_hi(gb[e]))); }
                u32x4 w; w.x = cvt_pk_bf16(v0[0] * s[0], v0[1] * s[1]); w.y = cvt_pk_bf16(v0[2] * s[2], v0[3] * s[3]); w.z = cvt_pk_bf16(v1[0] * s[4], v1[1] * s[5]); w.w = cvt_pk_bf16(v1[2] * s[6], v1[3] * s[7]);
                *(u32x4*)(rowp + bj * HALF) = w; }
#pragma unroll
            for (int bj = 0; bj < 2; ++bj) cgb[bj] = ngb[bj];
        }
    }
};
struct EpiMerge2 {
    static constexpr bool PERM = true, DUAL = false, AFTER_DRAIN = false;
    bf16_t* O; int ldc; const bf16_t* GA; const bf16_t* YB; int ldg;
    __device__ __forceinline__ void mid(f32x4 (&acc)[2][2][4][2], const Unit& u, int wr, int wc, int fr, int fq) const {}
    __device__ __forceinline__ void operator()(const f32x4 (&acc)[2][2][4][2], const Unit& u, int wr, int wc, int fr, int fq) const {
        const int row0 = u.pm * BM + wr * 64 + fr; const int col0 = u.pn * BM + wc * 32 + 8 * fq;
        u32x4 cga[2], cyb[2], nga[2], nyb[2];
        { const size_t ro = (size_t)row0 * ldg + col0;
#pragma unroll
          for (int bj = 0; bj < 2; ++bj) { cga[bj] = *(const u32x4*)(GA + ro + bj * HALF); cyb[bj] = *(const u32x4*)(YB + ro + bj * HALF); } }
#pragma unroll
        for (int g = 0; g < 8; ++g) { const int ai = g >> 2, m = g & 3;
            if (g < 7) { const size_t ro = (size_t)(row0 + ((g + 1) >> 2) * HALF + ((g + 1) & 3) * 16) * ldg + col0;
#pragma unroll
                for (int bj = 0; bj < 2; ++bj) { nga[bj] = *(const u32x4*)(GA + ro + bj * HALF); nyb[bj] = *(const u32x4*)(YB + ro + bj * HALF); } }
            bf16_t* rowp = O + (size_t)(row0 + ai * HALF + m * 16) * ldc + col0;
#pragma unroll
            for (int bj = 0; bj < 2; ++bj) { const u32x4 ga = cga[bj], yb = cyb[bj]; const f32x4 v0 = acc[ai][bj][m][0], v1 = acc[ai][bj][m][1];
                float o[8];
#pragma unroll
                for (int e = 0; e < 4; ++e) { const float a0 = (e < 2) ? v0[2 * e] : v1[2 * (e - 2)], a1 = (e < 2) ? v0[2 * e + 1] : v1[2 * (e - 2) + 1];
                    o[2 * e] = a0 * __builtin_amdgcn_rcpf(1.f + __expf(-bf_lo(ga[e]))) + bf_lo(yb[e]); o[2 * e + 1] = a1 * __builtin_amdgcn_rcpf(1.f + __expf(-bf_hi(ga[e]))) + bf_hi(yb[e]); }
                u32x4 w; w.x = cvt_pk_bf16(o[0], o[1]); w.y = cvt_pk_bf16(o[2], o[3]); w.z = cvt_pk_bf16(o[4], o[5]); w.w = cvt_pk_bf16(o[6], o[7]);
                *(u32x4*)(rowp + bj * HALF) = w; }
#pragma unroll
            for (int bj = 0; bj < 2; ++bj) { cga[bj] = nga[bj]; cyb[bj] = nyb[bj]; }
        }
    }
};
struct RmsExchange {
    float* slots;
    unsigned* cnt;
    __device__ __forceinline__ void run(const f32x4 (&v)[2][2][4][2], const Unit& u, int wr, int wc, int fr, int fq, PG8_LAS unsigned char* lds, int wid, int lane) const {
        PG8_LAS float* P = (PG8_LAS float*)lds;
        PG8_LAS float* S = (PG8_LAS float*)(lds + 4096);
#pragma unroll
        for (int ai = 0; ai < 2; ++ai)
#pragma unroll
            for (int m = 0; m < 4; ++m) { float s = 0.f;
#pragma unroll
                for (int bj = 0; bj < 2; ++bj)
#pragma unroll
                    for (int n = 0; n < 2; ++n) { const f32x4 x = v[ai][bj][m][n]; s += (x[0] * x[0] + x[1] * x[1]) + (x[2] * x[2] + x[3] * x[3]); }
                s += __shfl_xor(s, 16); s += __shfl_xor(s, 32);
                if (fq == 0) P[(ai * HALF + wr * 64 + m * 16 + fr) * 4 + wc] = s; }
        asm volatile("s_waitcnt vmcnt(0) lgkmcnt(0)" ::: "memory"); __builtin_amdgcn_s_barrier(); asm volatile("" ::: "memory");
        const int row = wid * 64 + lane;
        if (wid < 4) {
            const f32x4 p = *(const PG8_LAS f32x4*)(P + row * 4);
            __hip_atomic_store(slots + ((size_t)(u.pm * BM + row) * 4 + u.pn), (p[0] + p[1]) + (p[2] + p[3]), __ATOMIC_RELAXED, __HIP_MEMORY_SCOPE_AGENT);
            asm volatile("s_waitcnt vmcnt(0)" ::: "memory");
            if (lane == 0) __hip_atomic_fetch_add(cnt + 16 * u.pm, 1u, __ATOMIC_RELAXED, __HIP_MEMORY_SCOPE_AGENT);
        }
        if (wid == 0) {
            unsigned sp = 0;
            while ((unsigned)__builtin_amdgcn_readfirstlane(__hip_atomic_load(cnt + 16 * u.pm, __ATOMIC_RELAXED, __HIP_MEMORY_SCOPE_AGENT)) < 16u) { __builtin_amdgcn_s_sleep(1); if (++sp > (1u << 22)) break; }
            __builtin_amdgcn_fence(__ATOMIC_ACQUIRE, "agent");
        }
        asm volatile("s_waitcnt vmcnt(0) lgkmcnt(0)" ::: "memory"); __builtin_amdgcn_s_barrier(); asm volatile("" ::: "memory");
        if (wid < 4) {
            const float* sl = slots + (size_t)(u.pm * BM + row) * 4; float t = 0.f;
#pragma unroll
            for (int k = 0; k < 4; ++k) t += __hip_atomic_load(sl + k, __ATOMIC_RELAXED, __HIP_MEMORY_SCOPE_AGENT);
            S[row] = rsqrtf(t * (1.0f / 1024.0f) + 1e-6f);
        }
        asm volatile("s_waitcnt vmcnt(0) lgkmcnt(0)" ::: "memory"); __builtin_amdgcn_s_barrier(); asm volatile("" ::: "memory");
    }
};
struct EpiRmsRes {
    static constexpr bool PERM = true, DUAL = false, AFTER_DRAIN = true;
    float* x; const float* gpost; const float* gnext; bf16_t* xn; RmsExchange e1, e2;
    __device__ __forceinline__ void mid(f32x4 (&acc)[2][2][4][2], const Unit& u, int wr, int wc, int fr, int fq) const {}
    __device__ __forceinline__ void operator()(const f32x4 (&acc)[2][2][4][2], const Unit& u, int wr, int wc, int fr, int fq) const {}
    __device__ __forceinline__ void fused(f32x4 (&acc)[2][2][4][2], const Unit& u, int wr, int wc, int fr, int fq, PG8_LAS unsigned char* lds, int wid, int lane) const {
        const PG8_LAS float* S = (const PG8_LAS float*)(lds + 4096);
        const int col0 = u.pn * BM + wc * 32 + 8 * fq;
        bf16_t* xb = (bf16_t*)x;
        u32x4 pre[2][4][2];
#pragma unroll
        for (int ai = 0; ai < 2; ++ai)
#pragma unroll
            for (int m = 0; m < 4; ++m) { const bf16_t* xp = xb + (size_t)(u.pm * BM + ai * HALF + wr * 64 + m * 16 + fr) * 2048 + col0;
#pragma unroll
                for (int bj = 0; bj < 2; ++bj) pre[ai][m][bj] = *(const u32x4*)(xp + bj * HALF); }
        e1.run(acc, u, wr, wc, fr, fq, lds, wid, lane);
        f32x4 g[2][2];
#pragma unroll
        for (int bj = 0; bj < 2; ++bj)
#pragma unroll
            for (int n = 0; n < 2; ++n) g[bj][n] = *(const f32x4*)(gpost + col0 + bj * HALF + n * 4);
#pragma unroll
        for (int ai = 0; ai < 2; ++ai)
#pragma unroll
            for (int m = 0; m < 4; ++m) { const int r = ai * HALF + wr * 64 + m * 16 + fr; const float sr = S[r];
#pragma unroll
                for (int bj = 0; bj < 2; ++bj) { const u32x4 pw = pre[ai][m][bj];
                    const f32x4 x0 = {bf_lo(pw.x), bf_hi(pw.x), bf_lo(pw.y), bf_hi(pw.y)}, x1 = {bf_lo(pw.z), bf_hi(pw.z), bf_lo(pw.w), bf_hi(pw.w)};
                    const f32x4 o0 = x0 + acc[ai][bj][m][0] * sr * g[bj][0], o1 = x1 + acc[ai][bj][m][1] * sr * g[bj][1]; acc[ai][bj][m][0] = o0; acc[ai][bj][m][1] = o1;
                    if (gnext) { u32x4 w; w.x = cvt_pk_bf16(o0[0], o0[1]); w.y = cvt_pk_bf16(o0[2], o0[3]); w.z = cvt_pk_bf16(o1[0], o1[1]); w.w = cvt_pk_bf16(o1[2], o1[3]);
                        *(u32x4*)(xb + (size_t)(u.pm * BM + r) * 2048 + col0 + bj * HALF) = w; }
                    else { float* op = x + (size_t)(u.pm * BM + r) * 1024 + col0 + bj * HALF; *(f32x4*)op = o0; *(f32x4*)(op + 4) = o1; } } }
        if (gnext) {
            e2.run(acc, u, wr, wc, fr, fq, lds, wid, lane);
#pragma unroll
            for (int bj = 0; bj < 2; ++bj)
#pragma unroll
                for (int n = 0; n < 2; ++n) g[bj][n] = *(const f32x4*)(gnext + col0 + bj * HALF + n * 4);
#pragma unroll
            for (int ai = 0; ai < 2; ++ai)
#pragma unroll
                for (int m = 0; m < 4; ++m) { const int r = ai * HALF + wr * 64 + m * 16 + fr; const float sr = S[r]; bf16_t* op = xn + (size_t)(u.pm * BM + r) * 1024 + col0;
#pragma unroll
                    for (int bj = 0; bj < 2; ++bj) { const f32x4 o0 = acc[ai][bj][m][0] * sr * g[bj][0], o1 = acc[ai][bj][m][1] * sr * g[bj][1];
                        u32x4 w; w.x = cvt_pk_bf16(o0[0], o0[1]); w.y = cvt_pk_bf16(o0[2], o0[3]); w.z = cvt_pk_bf16(o1[0], o1[1]); w.w = cvt_pk_bf16(o1[2], o1[3]);
                        *(u32x4*)(op + bj * HALF) = w; } }
        }
    }
};
template <class Epi, class Sched, bool ALIGN_EPI = false, bool SP2 = false>
__device__ __forceinline__ void gemm_phase(PG8_LAS unsigned char* lds, const Gemm g, const Sched& S, const Epi& E) {
    int tid_ = threadIdx.x; asm volatile("" : "+v"(tid_)); const int tid = tid_, wid = __builtin_amdgcn_readfirstlane(tid >> 6), lane = tid & 63, wr = wid >> 2, wc = wid & 3, fr = lane & 15, fq = lane >> 4;
    const int K = g.K, nt = K / BK, lda = g.lda;
    unsigned voffA[2], voffB[2];
#pragma unroll
    for (int i = 0; i < 2; ++i) { int R, C; stage_rc(tid * 16 + i * 8192, R, C); const int Rb = Epi::PERM ? ((R & ~31) + perm32(R & 31)) : R;
        voffA[i] = (unsigned)(R * lda + C) * 2u; voffB[i] = (unsigned)(Rb * K + C) * 2u; }
    const size_t kstep = (size_t)(BK * 2);
    const size_t hstepA = (size_t)HALF * lda * 2, hstepB = (size_t)HALF * K * 2;
    const size_t tstepA = 2 * hstepA, tstepB = 2 * hstepB;
    const unsigned ldsw = (unsigned)wid * 1024u;
    const int aoff = lds_byte(wr * 64 + fr, fq * 8), boff = lds_byte(wc * 32 + fr, fq * 8);
#define PG8_SA(b, h) (((b) * 2 + (h)) * HTB)
#define PG8_SB(b, h) ((4 + (b) * 2 + (h)) * HTB)
#define PG8_STAGE(bufoff, gbase, voff) do { _Pragma("unroll") for (int _i = 0; _i < 2; ++_i) \
        __builtin_amdgcn_global_load_lds((const unsigned*)((const char*)(gbase) + (voff)[_i]), (PG8_LAS unsigned*)(lds + (bufoff) + ldsw + _i * 8192), 16, 0, 0); } while (0)
#define PG8_LDA(dst, b, h) do { _Pragma("unroll") for (int m = 0; m < 4; ++m) _Pragma("unroll") for (int k = 0; k < 2; ++k) dst[m][k] = *(const PG8_LAS bf16x8*)(lds + PG8_SA(b, h) + aoff + m * 2048 + k * 1024); } while (0)
#define PG8_LDB(dst, b, h) do { _Pragma("unroll") for (int n = 0; n < 2; ++n) _Pragma("unroll") for (int k = 0; k < 2; ++k) dst[n][k] = *(const PG8_LAS bf16x8*)(lds + PG8_SB(b, h) + boff + n * 2048 + k * 1024); } while (0)
#define PG8_MMA(ai, bj, At, Bt) do { __builtin_amdgcn_s_setprio(1); _Pragma("unroll") for (int m = 0; m < 4; ++m) _Pragma("unroll") for (int n = 0; n < 2; ++n) _Pragma("unroll") for (int k = 0; k < 2; ++k) \
        acc[ai][bj][m][n] = __builtin_amdgcn_mfma_f32_16x16x32_bf16(Bt[n][k], At[m][k], acc[ai][bj][m][n], 0, 0, 0); __builtin_amdgcn_s_setprio(0); } while (0)
#define PG8_WAIT_V(n) asm volatile("s_waitcnt vmcnt(" #n ")" ::: "memory")
#define PG8_WAIT_L(n) asm volatile("s_waitcnt lgkmcnt(" #n ")" ::: "memory")
#define PG8_BAR __builtin_amdgcn_s_barrier()
#define PG8_SCHED __builtin_amdgcn_sched_barrier(0)
    Unit cur, nxt; int ui = 0;
    if (!S.next(0, cur)) return;
    f32x4 acc[2][2][4][2];
#pragma unroll
    for (int a = 0; a < 2; ++a)
#pragma unroll
        for (int b = 0; b < 2; ++b)
#pragma unroll
            for (int m = 0; m < 4; ++m)
#pragma unroll
                for (int n = 0; n < 2; ++n) acc[a][b][m][n] = (f32x4){0.f, 0.f, 0.f, 0.f};
    bf16x8 At[4][2], B0[2][2], B1[2][2];
    const char* cA = (const char*)(cur.src ? g.A2 : g.A) + (size_t)cur.pm * tstepA; const char* cB = (const char*)(cur.src ? g.Bt2 : g.Bt) + (size_t)cur.pn * tstepB;
    if constexpr (SP2) {
        PG8_STAGE(PG8_SB(0, 0), cB, voffB); PG8_STAGE(PG8_SB(0, 1), cB + hstepB, voffB); PG8_STAGE(PG8_SA(0, 0), cA, voffA); PG8_STAGE(PG8_SA(0, 1), cA + hstepA, voffA);
        if (wr == 1) PG8_BAR;
        PG8_WAIT_V(2); PG8_BAR;
        PG8_STAGE(PG8_SB(1, 0), cB + kstep, voffB); PG8_STAGE(PG8_SA(1, 0), cA + kstep, voffA); PG8_STAGE(PG8_SB(1, 1), cB + hstepB + kstep, voffB);
        PG8_WAIT_V(6); PG8_BAR;
    } else {
        PG8_STAGE(PG8_SB(0, 0), cB, voffB); PG8_STAGE(PG8_SA(0, 0), cA, voffA); PG8_STAGE(PG8_SB(0, 1), cB + hstepB, voffB); PG8_STAGE(PG8_SA(0, 1), cA + hstepA, voffA);
        if (wr == 1) PG8_BAR;
        PG8_WAIT_V(4); PG8_BAR;
        PG8_STAGE(PG8_SB(1, 0), cB + kstep, voffB); PG8_STAGE(PG8_SA(1, 0), cA + kstep, voffA); PG8_STAGE(PG8_SB(1, 1), cB + hstepB + kstep, voffB);
        PG8_WAIT_V(6); PG8_BAR;
    }
    for (;;) {
        const bool has_next = S.next(ui + 1, nxt);
        const char* nA = has_next ? (const char*)(nxt.src ? g.A2 : g.A) + (size_t)nxt.pm * tstepA : cA; const char* nB = has_next ? (const char*)(nxt.src ? g.Bt2 : g.Bt) + (size_t)nxt.pn * tstepB : cB;
        for (int t = 0; t < nt; t += 2) {
            const bool last = (t == nt - 2);
            const char* a1 = cA + (size_t)(t + 1) * kstep;
            const char* a2 = last ? nA : cA + (size_t)(t + 2) * kstep; const char* b2 = last ? nB : cB + (size_t)(t + 2) * kstep;
            const char* a3 = a2 + kstep; const char* b3 = b2 + kstep;
            if constexpr (SP2) {
            PG8_LDB(B0, 0, 0); PG8_LDB(B1, 0, 1); PG8_SCHED; PG8_LDA(At, 0, 0); PG8_STAGE(PG8_SA(1, 1), a1 + hstepA, voffA);
            PG8_WAIT_V(8); PG8_WAIT_L(0); PG8_BAR; PG8_MMA(0, 0, At, B0); PG8_MMA(0, 1, At, B1); PG8_BAR; PG8_SCHED;
            PG8_LDA(At, 0, 1); PG8_STAGE(PG8_SB(0, 0), b2, voffB); PG8_STAGE(PG8_SB(0, 1), b2 + hstepB, voffB); PG8_STAGE(PG8_SA(0, 0), a2, voffA);
            PG8_WAIT_V(8); PG8_WAIT_L(0); PG8_BAR; PG8_MMA(1, 0, At, B0); PG8_MMA(1, 1, At, B1); PG8_BAR; PG8_SCHED;
            PG8_LDB(B0, 1, 0); PG8_LDB(B1, 1, 1); PG8_SCHED; PG8_LDA(At, 1, 0); PG8_STAGE(PG8_SA(0, 1), a2 + hstepA, voffA);
            PG8_WAIT_V(8); PG8_WAIT_L(0); PG8_BAR; PG8_MMA(0, 0, At, B0); PG8_MMA(0, 1, At, B1); PG8_BAR; PG8_SCHED;
            PG8_LDA(At, 1, 1); PG8_STAGE(PG8_SB(1, 0), b3, voffB); PG8_STAGE(PG8_SB(1, 1), b3 + hstepB, voffB); PG8_STAGE(PG8_SA(1, 0), a3, voffA);
            PG8_WAIT_V(8); PG8_WAIT_L(0); PG8_BAR; PG8_MMA(1, 0, At, B0); PG8_MMA(1, 1, At, B1); PG8_BAR; PG8_SCHED;
            } else {
            PG8_LDB(B0, 0, 0); PG8_SCHED; PG8_LDA(At, 0, 0); PG8_STAGE(PG8_SA(1, 1), a1 + hstepA, voffA);
            PG8_WAIT_L(8); PG8_BAR; PG8_WAIT_L(0); PG8_MMA(0, 0, At, B0); PG8_BAR; PG8_SCHED;
            PG8_LDB(B1, 0, 1); PG8_STAGE(PG8_SB(0, 0), b2, voffB);
            PG8_BAR; PG8_WAIT_L(0); PG8_MMA(0, 1, At, B1); PG8_BAR;
            PG8_LDA(At, 0, 1); PG8_STAGE(PG8_SA(0, 0), a2, voffA);
            PG8_BAR; PG8_WAIT_L(0); PG8_MMA(1, 0, At, B0); PG8_BAR; PG8_SCHED;
            PG8_STAGE(PG8_SB(0, 1), b2 + hstepB, voffB);
            PG8_WAIT_V(6); PG8_BAR; PG8_MMA(1, 1, At, B1); PG8_BAR;
            PG8_LDB(B0, 1, 0); PG8_SCHED; PG8_LDA(At, 1, 0); PG8_STAGE(PG8_SA(0, 1), a2 + hstepA, voffA);
            PG8_WAIT_L(8); PG8_BAR; PG8_WAIT_L(0); PG8_MMA(0, 0, At, B0); PG8_BAR; PG8_SCHED;
            PG8_LDB(B1, 1, 1); PG8_STAGE(PG8_SB(1, 0), b3, voffB);
            PG8_BAR; PG8_WAIT_L(0); PG8_MMA(0, 1, At, B1); PG8_BAR;
            PG8_LDA(At, 1, 1); PG8_STAGE(PG8_SA(1, 0), a3, voffA);
            PG8_BAR; PG8_WAIT_L(0); PG8_MMA(1, 0, At, B0); PG8_BAR; PG8_SCHED;
            PG8_STAGE(PG8_SB(1, 1), b3 + hstepB, voffB);
            PG8_WAIT_V(6); PG8_BAR; PG8_MMA(1, 1, At, B1); PG8_BAR;
            }
        }
        if constexpr (ALIGN_EPI) { if (wr == 0) PG8_BAR; }
        const bool midu = Epi::DUAL && cur.src == 0;
        if constexpr (!Epi::AFTER_DRAIN) { if (midu) E.mid(acc, cur, wr, wc, fr, fq); else E(acc, cur, wr, wc, fr, fq); }
        if (!has_next) break;
        if (!midu) {
#pragma unroll
        for (int a = 0; a < 2; ++a)
#pragma unroll
            for (int b = 0; b < 2; ++b)
#pragma unroll
                for (int m = 0; m < 4; ++m)
#pragma unroll
                    for (int n = 0; n < 2; ++n) acc[a][b][m][n] = (f32x4){0.f, 0.f, 0.f, 0.f};
        }
        cur = nxt; cA = nA; cB = nB; ++ui;
        if constexpr (ALIGN_EPI) { if (wr == 1) PG8_BAR; }
    }
    PG8_WAIT_V(0);
    if constexpr (!ALIGN_EPI) { if (wr == 0) PG8_BAR; }
    PG8_BAR;
    if constexpr (Epi::AFTER_DRAIN) E.fused(acc, cur, wr, wc, fr, fq, lds, wid, lane);
#undef PG8_SA
#undef PG8_SB
#undef PG8_STAGE
#undef PG8_LDA
#undef PG8_LDB
#undef PG8_MMA
#undef PG8_WAIT_V
#undef PG8_WAIT_L
#undef PG8_BAR
#undef PG8_SCHED
}
}

#define GAS __attribute__((address_space(1)))
#define LAS __attribute__((address_space(3)))
typedef unsigned short bf16;
typedef unsigned v4u __attribute__((ext_vector_type(4)));
typedef unsigned v2u __attribute__((ext_vector_type(2)));
typedef float f32x4 __attribute__((ext_vector_type(4)));
typedef short bf16x8 __attribute__((ext_vector_type(8)));
constexpr int NWAVES = 8, NTHR = 512;
constexpr int BATCH = 2, SEQ = 8192, D = 1024, FF = 4096, DEPTH = 4, M = BATCH * SEQ;
constexpr int DIN = 7440, DINP = 7680;
constexpr int C_DNQ = 0, C_DNK = 1024, C_DNV = 2048, C_DNZ = 3072, C_SWQ = 4096, C_GA = 5120, C_GB = 6144, C_SWK = 7168, C_SWV = 7296, C_DNB = 7424, C_DNA = 7432;
constexpr float EPS = 1e-6f;
constexpr size_t MiB = 1u << 20;
constexpr size_t WS_WIN = 1 * MiB, WS_WUPDN = 16 * MiB, WS_WUPSW = 18 * MiB, WS_WO = 20 * MiB, WS_WFF1 = 22 * MiB, WS_WFF2 = 30 * MiB, WS_ROPE = 38 * MiB;
constexpr size_t WS_PROJ = 40 * MiB, WS_H = 40 * MiB, WS_XN = 280 * MiB, WS_YF = 312 * MiB, WS_MIX = 376 * MiB, WS_END = 456 * MiB;
constexpr int LDS_BYTES = 147456;

typedef float f32x2_t __attribute__((ext_vector_type(2)));
typedef __bf16 bf16x2_t __attribute__((ext_vector_type(2)));
__device__ __forceinline__ unsigned pk2(float lo, float hi) { const f32x2_t v = {lo, hi}; return __builtin_bit_cast(unsigned, __builtin_convertvector(v, bf16x2_t)); }
__device__ __forceinline__ unsigned f2bf(float f) { return pk2(f, 0.f) & 0xffffu; }
__device__ __forceinline__ float bflo(unsigned w) { return __uint_as_float(w << 16); }
__device__ __forceinline__ float bfhi(unsigned w) { return __uint_as_float(w & 0xffff0000u); }
__device__ __forceinline__ float bf1(bf16 h) { return __uint_as_float((unsigned)h << 16); }
__device__ __forceinline__ float wave_sum(float v) {
#pragma unroll
    for (int o = 1; o < 64; o <<= 1) v += __shfl_xor(v, o);
    return v;
}
__device__ __forceinline__ float wave_max(float v) {
#pragma unroll
    for (int o = 1; o < 64; o <<= 1) v = fmaxf(v, __shfl_xor(v, o));
    return v;
}
__device__ __forceinline__ float sigmoidf_(float x) { return __builtin_amdgcn_rcpf(1.f + __expf(-x)); }
__device__ __forceinline__ float siluf_(float x) { return x * __builtin_amdgcn_rcpf(1.f + __expf(-x)); }

struct Frame {
    LAS unsigned char* lds;
    int tid, lane, wave, G, bid;
};
__device__ __forceinline__ LAS unsigned char* lds_base() { extern __shared__ __attribute__((aligned(16))) unsigned char lds_dyn[]; return (LAS unsigned char*)lds_dyn; }
__device__ __forceinline__ Frame mkframe() {
    Frame F; F.lds = lds_base(); int tid = threadIdx.x; asm volatile("" : "+v"(tid)); int bid = blockIdx.x; asm volatile("" : "+s"(bid)); int G = gridDim.x; asm volatile("" : "+s"(G));
    F.tid = tid; F.lane = tid & 63; F.wave = __builtin_amdgcn_readfirstlane(tid >> 6); F.G = G; F.bid = bid; return F; }
typedef __attribute__((address_space(4))) const unsigned char* kargp_t;
__device__ __forceinline__ kargp_t kargs() { kargp_t p = (kargp_t)__builtin_amdgcn_kernarg_segment_ptr(); asm volatile("" : "+s"(p)); return p; }
__device__ __forceinline__ const float* inp(int k) { return *(const float* __attribute__((address_space(4))) const*)(kargs() + 8 * k); }
__device__ __forceinline__ float* outp() { return *(float* __attribute__((address_space(4))) const*)(kargs() + 8 * 17); }
__device__ __forceinline__ unsigned char* wsp() { return *(unsigned char* __attribute__((address_space(4))) const*)(kargs() + 8 * 18); }

__device__ __forceinline__ int orig_col(int nc) {
    if (nc < 4096) return nc;
    if (nc < 5120) return nc - 4096 + 4112;
    if (nc < 6144) return nc - 5120 + 5392;
    if (nc < 7168) return nc - 6144 + 6416;
    if (nc < 7296) return nc - 7168 + 5136;
    if (nc < 7424) return nc - 7296 + 5264;
    if (nc < 7440) return nc - 7424 + 4096;
    return -1;
}
template <bool PERMW>
__device__ __forceinline__ void transpose_item(const float* W, int K, int ldw, int nblk, bf16* WT, LAS float* scr, int item, int lane) {
    const int kb = item / nblk, nb = item % nblk, k0 = 64 * kb, n0 = 32 * nb;
    const int ncol = n0 + (lane & 31); const int oc = PERMW ? orig_col(ncol) : ncol;
    float wv[32];
    { const float* wp = W + (size_t)(k0 + (lane >> 5)) * ldw + (oc >= 0 ? oc : 0);
#pragma unroll
      for (int i = 0; i < 32; ++i) wv[i] = wp[(size_t)(2 * i) * ldw]; }
#pragma unroll
    for (int i = 0; i < 32; ++i) scr[(2 * i + (lane >> 5)) * 33 + (lane & 31)] = (oc >= 0) ? wv[i] : 0.f;
    asm volatile("s_waitcnt lgkmcnt(0)" ::: "memory");
    const int c = lane & 7;
#pragma unroll
    for (int j = 0; j < 4; ++j) { const int n = (lane >> 3) + 8 * j; const LAS float* s = scr + (8 * c) * 33 + n;
        v4u o; o.x = pk2(s[0 * 33], s[1 * 33]); o.y = pk2(s[2 * 33], s[3 * 33]); o.z = pk2(s[4 * 33], s[5 * 33]); o.w = pk2(s[6 * 33], s[7 * 33]);
        *(v4u*)(WT + (size_t)(n0 + n) * K + k0 + 8 * c) = o; }
    asm volatile("s_waitcnt lgkmcnt(0)" ::: "memory");
}
__device__ __forceinline__ void phase_convert(Frame& F_, int lrest, int lin, int nskip) {
    Frame F = mkframe();
    LAS float* scr = (LAS float*)(F.lds + F.wave * 16384);
    const int gw = (F.bid - nskip) * NWAVES + F.wave, NGW = (F.G - nskip) * NWAVES;
    constexpr int I_IN = 16 * (DINP / 32), I_SQ = 16 * 32, I_F1 = 16 * (FF / 32), I_F2 = 64 * 32;
    const int n_in = (lin >= 0) ? I_IN : 0, n_rest = (lrest >= 0) ? 3 * I_SQ + I_F1 + I_F2 : 0;
    for (int it = gw; it < n_in + n_rest; it += NGW) {
        int r = it;
        if (r < n_in) { transpose_item<true>(inp(3) + (size_t)lin * D * DIN, D, DIN, DINP / 32, (bf16*)(wsp() + WS_WIN), scr, r, F.lane); continue; } r -= n_in;
        const int l = lrest;
        if (r < I_SQ) { transpose_item<false>(inp(9) + (size_t)l * D * D, D, D, 32, (bf16*)(wsp() + WS_WUPDN), scr, r, F.lane); continue; } r -= I_SQ;
        if (r < I_SQ) { transpose_item<false>(inp(10) + (size_t)l * D * D, D, D, 32, (bf16*)(wsp() + WS_WUPSW), scr, r, F.lane); continue; } r -= I_SQ;
        if (r < I_SQ) { transpose_item<false>(inp(11) + (size_t)l * D * D, D, D, 32, (bf16*)(wsp() + WS_WO), scr, r, F.lane); continue; } r -= I_SQ;
        if (r < I_F1) { transpose_item<false>(inp(14) + (size_t)l * D * FF, D, FF, FF / 32, (bf16*)(wsp() + WS_WFF1), scr, r, F.lane); continue; } r -= I_F1;
        transpose_item<false>(inp(15) + (size_t)l * FF * D, FF, D, 32, (bf16*)(wsp() + WS_WFF2), scr, r, F.lane);
    }
}
__device__ __forceinline__ void phase_rope(Frame& F_) {
    Frame F = mkframe();
    const int* pos = (const int*)inp(1); float* R = (float*)(wsp() + WS_ROPE);
    for (int i = F.bid * NTHR + F.tid; i < M * 8; i += F.G * NTHR) {
        const int m = i >> 3, j = i & 7;
        const float invf = exp2f(-(float)j * (0.125f * 18.931568569324174f));
        const float angf = (float)pos[m] * invf;
        const double a = (double)angf; const double n = rint(a * 0.15915494309189535);
        const float r = (float)(a - n * 6.283185307179586);
        R[m * 16 + j] = __cosf(r); R[m * 16 + 8 + j] = __sinf(r);
    }
}
__device__ __forceinline__ void phase_norm(Frame& F_, const float* y, const float* gpost, const float* xin, float* x, const float* gnext, bf16* XN) {
    Frame F = mkframe();
    const int gw = F.bid * NWAVES + F.wave, NGW = F.G * NWAVES;
    for (int m = gw; m < M; m += NGW) {
        f32x4 v[4];
        const f32x4* xr = (const f32x4*)(xin + (size_t)m * D) + F.lane;
#pragma unroll
        for (int j = 0; j < 4; ++j) v[j] = xr[64 * j];
        if (y) {
            const f32x4* yr = (const f32x4*)(y + (size_t)m * D) + F.lane; f32x4 w[4]; float s = 0.f;
#pragma unroll
            for (int j = 0; j < 4; ++j) { w[j] = yr[64 * j]; s += (w[j].x * w[j].x + w[j].y * w[j].y) + (w[j].z * w[j].z + w[j].w * w[j].w); }
            const float r = rsqrtf(wave_sum(s) * (1.f / D) + EPS);
#pragma unroll
            for (int j = 0; j < 4; ++j) { const f32x4 g = ((const f32x4*)gpost)[F.lane + 64 * j]; v[j] = v[j] + w[j] * r * g; }
        }
        v2u* xo = (v2u*)((bf16*)x + (size_t)m * 2048) + F.lane;
#pragma unroll
        for (int j = 0; j < 4; ++j) { v2u w; w.x = pk2(v[j].x, v[j].y); w.y = pk2(v[j].z, v[j].w); xo[64 * j] = w; }
        if (gnext) {
            float s = 0.f;
#pragma unroll
            for (int j = 0; j < 4; ++j) s += (v[j].x * v[j].x + v[j].y * v[j].y) + (v[j].z * v[j].z + v[j].w * v[j].w);
            const float r = rsqrtf(wave_sum(s) * (1.f / D) + EPS);
            v2u* o = (v2u*)(XN + (size_t)m * D) + F.lane;
#pragma unroll
            for (int j = 0; j < 4; ++j) { const f32x4 g = ((const f32x4*)gnext)[F.lane + 64 * j]; v2u w; w.x = pk2(v[j].x * r * g.x, v[j].y * r * g.y); w.y = pk2(v[j].z * r * g.z, v[j].w * r * g.w); o[64 * j] = w; }
        }
    }
}
constexpr size_t WS_SUBCNT = 196608, WS_BAR = 65536, WS_XCNT = 131072, WS_XSLOT = 39 * MiB;
#define XB_TMO      128
#define XB_XCNT(j)  (256  + 64 * (j))
#define XB_XSUB(j)  (1280 + 64 * (j))
#define XB_XGEN(j)  (2304 + 64 * (j))
#define XB_TOP      3328
#define XB_TOPGEN   3392
#define XCD_BAR_WORDS 3456
#define XB_SPIN_CAP (1u << 22)
constexpr int LDS_BARST = LDS_BYTES - 16;
__device__ __forceinline__ unsigned xb_ld(unsigned* p)              { return __hip_atomic_load(p, __ATOMIC_RELAXED, __HIP_MEMORY_SCOPE_AGENT); }
__device__ __forceinline__ unsigned xb_add(unsigned* p, unsigned v) { return __hip_atomic_fetch_add(p, v, __ATOMIC_RELAXED, __HIP_MEMORY_SCOPE_AGENT); }
__device__ __forceinline__ unsigned xb_xcc_id() { return (unsigned)__builtin_amdgcn_s_getreg((3 << 11) | 20) & 0xFu; }
#define XB_SPIN(cond, bar) do { unsigned _sp = 0; while (cond) { __builtin_amdgcn_s_sleep(1); \
    if ((++_sp & 255u) == 0u) { if (xb_ld(&(bar)[XB_TMO])) break; if (_sp > XB_SPIN_CAP) { atomicAdd(&(bar)[XB_TMO], 1u); break; } } } } while (0)
__device__ __forceinline__ void xcd_barrier_post() {
    if (threadIdx.x == 0) { unsigned* bar = (unsigned*)(wsp() + WS_BAR); (void)xb_add(&bar[XB_XCNT(xb_xcc_id())], 1u); }
}
__device__ __forceinline__ void xcd_barrier_complete(unsigned* bar, unsigned x, unsigned& nloc, unsigned& nx) {
    const unsigned G = gridDim.x * gridDim.y * gridDim.z;
    unsigned sum, cnt, mine, sp = 0u;
    for (;;) {
        sum = 0u; cnt = 0u; mine = 0u;
#pragma unroll
        for (unsigned j = 0; j < 16; ++j) { const unsigned c = xb_ld(&bar[XB_XCNT(j)]); sum += c; cnt += (c > 0u) ? 1u : 0u; mine = (j == x) ? c : mine; }
        if (sum == G) break;
        __builtin_amdgcn_s_sleep(1);
        if ((++sp & 255u) == 0u) { if (xb_ld(&bar[XB_TMO])) break; if (sp > XB_SPIN_CAP) { atomicAdd(&bar[XB_TMO], 1u); break; } }
    }
    nloc = mine > 0u ? mine : 1u; nx = cnt > 0u ? cnt : 1u;
}
__device__ __forceinline__ void grid_bar() {
    asm volatile("s_waitcnt vmcnt(0)" ::: "memory");
    __syncthreads();
    if (threadIdx.x == 0) {
        unsigned* bar = (unsigned*)(wsp() + WS_BAR); const unsigned x = xb_xcc_id();
        volatile LAS unsigned* st = (volatile LAS unsigned*)(lds_base() + LDS_BARST);
        __builtin_amdgcn_s_waitcnt(0);
        unsigned nloc = st[0], nx = st[1];
        if (nloc == 0u) { xcd_barrier_complete(bar, x, nloc, nx); st[0] = nloc; st[1] = nx; }
        const unsigned old = xb_add(&bar[XB_XSUB(x)], 1u);
        const unsigned gen = old / nloc;
        if (old + 1u == (gen + 1u) * nloc) {
            __builtin_amdgcn_fence(__ATOMIC_RELEASE, "agent");
            asm volatile("s_waitcnt vmcnt(0)" ::: "memory");
            const unsigned og = xb_add(&bar[XB_TOP], 1u);
            const unsigned tg = og / nx;
            if (og + 1u == (tg + 1u) * nx) xb_add(&bar[XB_TOPGEN], 1u);
            else XB_SPIN(xb_ld(&bar[XB_TOPGEN]) == tg, bar);
            __builtin_amdgcn_fence(__ATOMIC_ACQUIRE, "agent");
            xb_add(&bar[XB_XGEN(x)], 1u);
            asm volatile("s_waitcnt vmcnt(0)" ::: "memory");
        } else {
            XB_SPIN(xb_ld(&bar[XB_XGEN(x)]) == gen, bar);
            __builtin_amdgcn_fence(__ATOMIC_ACQUIRE, "agent");
            asm volatile("s_waitcnt vmcnt(0)" ::: "memory");
        }
    }
    __syncthreads();
}

__device__ __forceinline__ void sub_bar(unsigned* cnt, unsigned n) {
    asm volatile("s_waitcnt vmcnt(0)" ::: "memory");
    __syncthreads();
    if (threadIdx.x == 0) {
        __builtin_amdgcn_fence(__ATOMIC_RELEASE, "agent");
        asm volatile("s_waitcnt vmcnt(0)" ::: "memory");
        xb_add(cnt, 1u);
        unsigned sp = 0; while (xb_ld(cnt) < n) { __builtin_amdgcn_s_sleep(1); if (++sp > XB_SPIN_CAP) break; }
        __builtin_amdgcn_fence(__ATOMIC_ACQUIRE, "agent");
        asm volatile("s_waitcnt vmcnt(0)" ::: "memory");
    }
    __syncthreads();
}
#define MFMA16(a, b, c) __builtin_amdgcn_mfma_f32_16x16x32_bf16(a, b, c, 0, 0, 0)
constexpr size_t WS_GL = 0, WS_W = 312 * MiB, WS_QD = 344 * MiB, WS_KDT = 376 * MiB, WS_UT = 408 * MiB, WS_AI = 440 * MiB;
typedef LAS unsigned short* lbf;
template <int PMODE>
__device__ __forceinline__ void dn_prep(Frame& F_, int l) {
    Frame F = mkframe();
    const bf16* PROJ = (const bf16*)(wsp() + WS_PROJ);
    lbf QS = (lbf)(F.lds), KS = (lbf)(F.lds + 17408), VT = (lbf)(F.lds + 34816), KGT = (lbf)(F.lds + 53248), KDT = (lbf)(F.lds + 71680), TB = (lbf)(F.lds + 107520);
    LAS float* LM = (LAS float*)(F.lds + 90112); LAS float* GC = (LAS float*)(F.lds + 116736); LAS float* BT = (LAS float*)(F.lds + 116992);
    const int lane = F.lane, wave = F.wave, fr = lane & 15, fq = lane >> 4;
    struct PrepIn { unsigned xr[3][11]; float cw[3][4][2]; bf16 a, b; };
#define PREP_LOAD(X, chx) do { const int ch_ = (chx), h_ = (ch_ >> 7) & 7, n_ = ch_ & 127, m0_ = (ch_ >> 10) * SEQ + n_ * 64; \
        X.a = PROJ[(size_t)(m0_ + lane) * DINP + C_DNA + h_]; X.b = PROJ[(size_t)(m0_ + lane) * DINP + C_DNB + h_]; \
        _Pragma("unroll") for (int ts = 0; ts < 3; ++ts) _Pragma("unroll") for (int j = 0; j < 11; ++j) { const int ii = 8 * wave - 3 + j; \
            X.xr[ts][j] = (n_ * 64 + ii >= 0) ? *(const unsigned*)(PROJ + (size_t)(m0_ + ii) * DINP + ts * 1024 + h_ * 128 + 2 * lane) : 0u; } \
        { const float* cwp = inp(4) + (size_t)l * 4 * 3072 + h_ * 128 + 2 * lane; \
          _Pragma("unroll") for (int ts = 0; ts < 3; ++ts) _Pragma("unroll") for (int j = 0; j < 4; ++j) { const f32x2_t c2_ = *(const f32x2_t*)(cwp + j * 3072 + ts * 1024); X.cw[ts][j][0] = c2_.x; X.cw[ts][j][1] = c2_.y; } } } while (0)
    PrepIn cur; unsigned eat = 0u;
    for (int ch = F.bid; ch < 2048; ch += F.G) {
        const int b = ch >> 10, h = (ch >> 7) & 7, n = ch & 127, m0 = b * SEQ + n * 64;
        PREP_LOAD(cur, ch);
        unsigned touch = 0u;
        if (ch + F.G < 2048 && F.tid < 402) { const int cn = ch + F.G, hn = (cn >> 7) & 7, nn = cn & 127, mn = (cn >> 10) * SEQ + nn * 64; const int rowt = F.tid / 6 - 3, ln = F.tid % 6;
            if (nn * 64 + rowt >= 0) touch = *(const unsigned*)(PROJ + (size_t)(mn + rowt) * DINP + (ln >> 1) * 1024 + hn * 128 + (ln & 1) * 64); }
        const float a_neg = -__expf(inp(5)[l * 8 + h]), dtb = inp(6)[l * 8 + h];
        float gc, beta, gl;
        { const float a_in = bf1(cur.a), b_in = bf1(cur.b);
          const float z = a_in + dtb; const float sp = (z > 20.f) ? z : log1pf(__expf(z)); gc = a_neg * sp;
#pragma unroll
          for (int o = 1; o < 64; o <<= 1) { const float t = __shfl_up(gc, o); if (lane >= o) gc += t; }
          beta = sigmoidf_(b_in); gl = __shfl(gc, 63);
          if (wave == 0) { GC[lane] = gc; BT[lane] = beta; } }
        float sv[8][3][2], pp[16];
#pragma unroll
        for (int rr = 0; rr < 8; ++rr) {
#pragma unroll
            for (int ts = 0; ts < 3; ++ts) { float y0 = 0.f, y1 = 0.f;
#pragma unroll
                for (int j = 0; j < 4; ++j) { const unsigned xw = cur.xr[ts][rr + j]; y0 += cur.cw[ts][j][0] * bflo(xw); y1 += cur.cw[ts][j][1] * bfhi(xw); }
                sv[rr][ts][0] = siluf_(y0); sv[rr][ts][1] = siluf_(y1); }
            pp[2 * rr] = sv[rr][0][0] * sv[rr][0][0] + sv[rr][0][1] * sv[rr][0][1]; pp[2 * rr + 1] = sv[rr][1][0] * sv[rr][1][0] + sv[rr][1][1] * sv[rr][1][1];
        }
        float tot;
        { const bool b5 = (lane & 32) != 0, b4 = (lane & 16) != 0, b3 = (lane & 8) != 0, b2 = (lane & 4) != 0;
          float p8[8], p4[4], p2[2];
#pragma unroll
          for (int k = 0; k < 8; ++k) p8[k] = (b5 ? pp[k + 8] : pp[k]) + __shfl_xor(b5 ? pp[k] : pp[k + 8], 32);
#pragma unroll
          for (int k = 0; k < 4; ++k) p4[k] = (b4 ? p8[k + 4] : p8[k]) + __shfl_xor(b4 ? p8[k] : p8[k + 4], 16);
#pragma unroll
          for (int k = 0; k < 2; ++k) p2[k] = (b3 ? p4[k + 2] : p4[k]) + __shfl_xor(b3 ? p4[k] : p4[k + 2], 8);
          tot = (b2 ? p2[1] : p2[0]) + __shfl_xor(b2 ? p2[0] : p2[1], 4);
          tot += __shfl_xor(tot, 2); tot += __shfl_xor(tot, 1); }
        unsigned kg[2][4], kd[2][4], vb[2][4];
#pragma unroll
        for (int rr = 0; rr < 8; ++rr) {
            const int i = 8 * wave + rr;
            const float gci = __int_as_float(__builtin_amdgcn_readlane(__float_as_int(gc), i)), bi = __int_as_float(__builtin_amdgcn_readlane(__float_as_int(beta), i));
            const float scq = rsqrtf(__int_as_float(__builtin_amdgcn_readlane(__float_as_int(tot), 8 * rr)) + EPS) * 0.08838834764831845f;
            const float sck = rsqrtf(__int_as_float(__builtin_amdgcn_readlane(__float_as_int(tot), 8 * rr + 4)) + EPS);
            const float q0 = sv[rr][0][0] * scq, q1 = sv[rr][0][1] * scq, k0 = sv[rr][1][0] * sck, k1 = sv[rr][1][1] * sck, v0 = sv[rr][2][0], v1 = sv[rr][2][1];
            const float eg = __expf(gci), egl = __expf(gl - gci);
            *(LAS unsigned*)(QS + i * 136 + 2 * lane) = pk2(q0, q1); *(LAS unsigned*)(KS + i * 136 + 2 * lane) = pk2(k0, k1);
            *(unsigned*)((bf16*)(wsp() + WS_QD) + (size_t)ch * 8192 + ((((i >> 4) * 4 + (lane >> 4)) * 64 + ((lane >> 2) & 3) * 16 + (i & 15)) * 8 + 2 * (lane & 3))) = pk2(q0 * eg, q1 * eg);
            const unsigned g0 = f2bf(k0 * bi * eg), g1 = f2bf(k1 * bi * eg), d0 = f2bf(k0 * egl), d1 = f2bf(k1 * egl), u0 = f2bf(v0 * bi), u1 = f2bf(v1 * bi);
            if (rr & 1) { kg[0][rr >> 1] |= g0 << 16; kg[1][rr >> 1] |= g1 << 16; kd[0][rr >> 1] |= d0 << 16; kd[1][rr >> 1] |= d1 << 16; vb[0][rr >> 1] |= u0 << 16; vb[1][rr >> 1] |= u1 << 16; }
            else { kg[0][rr >> 1] = g0; kg[1][rr >> 1] = g1; kd[0][rr >> 1] = d0; kd[1][rr >> 1] = d1; vb[0][rr >> 1] = u0; vb[1][rr >> 1] = u1; }
        }
#pragma unroll
        for (int c = 0; c < 2; ++c) {
            *(LAS v4u*)(KGT + (2 * lane + c) * 72 + 8 * wave) = (v4u){kg[c][0], kg[c][1], kg[c][2], kg[c][3]};
            *(LAS v4u*)(KDT + (2 * lane + c) * 72 + 8 * wave) = (v4u){kd[c][0], kd[c][1], kd[c][2], kd[c][3]};
            *(LAS v4u*)(VT + (2 * lane + c) * 72 + 8 * wave) = (v4u){vb[c][0], vb[c][1], vb[c][2], vb[c][3]};
        }
        __syncthreads();
        if (PMODE == 2) continue;
        { const int ti = wave >> 1;
          bf16x8 kfi[4], qfi[4];
#pragma unroll
          for (int ks = 0; ks < 4; ++ks) { kfi[ks] = *(const LAS bf16x8*)(KS + (16 * ti + fr) * 136 + 32 * ks + 8 * fq); qfi[ks] = *(const LAS bf16x8*)(QS + (16 * ti + fr) * 136 + 32 * ks + 8 * fq); }
#pragma unroll
          for (int tt = 0; tt < 2; ++tt) { const int tj = 2 * (wave & 1) + tt;
              f32x4 akk = {0.f, 0.f, 0.f, 0.f}, aqk = {0.f, 0.f, 0.f, 0.f};
#pragma unroll
              for (int ks = 0; ks < 4; ++ks) { const bf16x8 kfj = *(const LAS bf16x8*)(KS + (16 * tj + fr) * 136 + 32 * ks + 8 * fq); akk = MFMA16(kfi[ks], kfj, akk); aqk = MFMA16(kfj, qfi[ks], aqk); }
              { const int j = 16 * tj + fr; const float gcj = GC[j];
#pragma unroll
                for (int r = 0; r < 4; ++r) { const int i = 16 * ti + 4 * fq + r; LM[i * 68 + j] = (i > j) ? BT[i] * akk[r] * __expf(GC[i] - gcj) : 0.f; } }
              { const int i = 16 * ti + fr; const float gci = GC[i]; float v[4];
#pragma unroll
                for (int r = 0; r < 4; ++r) { const int j = 16 * tj + 4 * fq + r; v[r] = (i >= j) ? aqk[r] * __expf(gci - GC[j]) : 0.f; }
                v2u w; w.x = pk2(v[0], v[1]); w.y = pk2(v[2], v[3]);
                *(v2u*)((bf16*)(wsp() + WS_AI) + (size_t)ch * 4096 + (((ti * 2 + (tj >> 1)) * 64 + ((2 * tj + (fq >> 1)) & 3) * 16 + fr) * 8 + 4 * (fq & 1))) = w; } } }
        __syncthreads();
        {
            LAS float* T11f = (LAS float*)(F.lds + 117248); LAS float* T22f = T11f + 1056; LAS float* Mf = T22f + 1056;
            if (wave < 2 && PMODE != 1) {
                const int cl = lane & 31;
                float x[32]; float clf = (float)cl; asm volatile("" : "+v"(clf));
                LAS float* Lh = LM + (32 * wave) * 68 + 32 * wave; asm volatile("" : "+v"(Lh));
#pragma unroll
                for (int i = 0; i < 32; ++i) x[i] = 0.f;
#pragma unroll
                for (int i = 0; i < 32; ++i) {
                    float a0 = fmaxf(0.f, 1.f - fabsf(clf - (float)i)), a1 = 0.f, a2 = 0.f, a3 = 0.f;
#pragma unroll
                    for (int j4 = 0; j4 < (i + 3) / 4; ++j4) { const f32x4 Lv = *(const LAS f32x4*)(Lh + i * 68 + 4 * j4);
                        a0 -= Lv.x * x[4 * j4]; a1 -= Lv.y * x[4 * j4 + 1]; a2 -= Lv.z * x[4 * j4 + 2]; a3 -= Lv.w * x[4 * j4 + 3]; }
                    x[i] = (a0 + a1) + (a2 + a3);
                }
                if (lane < 32) {
                    LAS float* tf = (wave ? T22f : T11f) + cl; asm volatile("" : "+v"(tf));
                    lbf tb = TB + (32 * wave) * 72 + 32 * wave + cl; asm volatile("" : "+v"(tb));
#pragma unroll
                    for (int i = 0; i < 32; ++i) { tf[i * 33] = x[i]; tb[i * 72] = (bf16)f2bf(x[i]); }
                } else if (wave == 0) {
                    lbf tz = TB + 32 + cl; asm volatile("" : "+v"(tz));
#pragma unroll
                    for (int i = 0; i < 32; ++i) tz[i * 72] = 0;
                }
            }
            __syncthreads();
            const int ti2 = F.tid >> 5, c2 = F.tid & 31;
            if (PMODE != 1) {
                float m0 = 0.f, m1 = 0.f;
#pragma unroll 8
                for (int k = 0; k < 32; ++k) { const float t = T11f[k * 33 + c2]; m0 += LM[(32 + ti2) * 68 + k] * t; m1 += LM[(48 + ti2) * 68 + k] * t; }
                Mf[ti2 * 33 + c2] = m0; Mf[(ti2 + 16) * 33 + c2] = m1;
            }
            __syncthreads();
            if (PMODE != 1) {
                float t0 = 0.f, t1 = 0.f;
#pragma unroll 8
                for (int k = 0; k < 32; ++k) { const float mm = Mf[k * 33 + c2]; t0 -= T22f[ti2 * 33 + k] * mm; t1 -= T22f[(ti2 + 16) * 33 + k] * mm; }
                TB[(32 + ti2) * 72 + c2] = (bf16)f2bf(t0); TB[(48 + ti2) * 72 + c2] = (bf16)f2bf(t1);
            }
        }
        __syncthreads();
        eat ^= touch;
        { const int ti = wave & 3;
          bf16x8 tf[2];
#pragma unroll
          for (int ks = 0; ks < 2; ++ks) tf[ks] = *(const LAS bf16x8*)(TB + (16 * ti + fr) * 72 + 32 * ks + 8 * fq);
#pragma unroll
          for (int q4 = 0; q4 < 4; ++q4) { const int te = (wave >> 2) * 4 + q4;
              f32x4 au = {0.f, 0.f, 0.f, 0.f}, aw = {0.f, 0.f, 0.f, 0.f};
#pragma unroll
              for (int ks = 0; ks < 2; ++ks) { const bf16x8 vf = *(const LAS bf16x8*)(VT + (16 * te + fr) * 72 + 32 * ks + 8 * fq), gf = *(const LAS bf16x8*)(KGT + (16 * te + fr) * 72 + 32 * ks + 8 * fq);
                  au = MFMA16(tf[ks], vf, au); aw = MFMA16(gf, tf[ks], aw); }
              v2u w; w.x = pk2(au[0], au[1]); w.y = pk2(au[2], au[3]);
              *(v2u*)((bf16*)(wsp() + WS_UT) + (size_t)ch * 8192 + ((te * 4 + ti) * 64 + lane) * 4) = w;
              w.x = pk2(aw[0], aw[1]); w.y = pk2(aw[2], aw[3]);
              *(v2u*)((bf16*)(wsp() + WS_W) + (size_t)ch * 8192 + (((ti * 4 + (te >> 1)) * 64 + ((2 * te + (fq >> 1)) & 3) * 16 + fr) * 8 + 4 * (fq & 1))) = w; }
          { const int d = F.tid >> 2, part = F.tid & 3; const LAS v4u* src = (const LAS v4u*)((LAS unsigned char*)KDT + d * 144 + part * 32);
            bf16* dstb = (bf16*)(wsp() + WS_KDT) + (size_t)ch * 8192 + (((d >> 4) * 2 + (part >> 1)) * 64 + (2 * (part & 1)) * 16 + (d & 15)) * 8; *(v4u*)dstb = src[0]; *(v4u*)(dstb + 128) = src[1]; }
          if (F.tid == 0) ((float*)(wsp() + WS_GL))[ch] = gl; }
        __syncthreads();
    }
    if (eat == 0x12345u && fq == 77) GC[0] = 1.f;
}
#undef PREP_LOAD
struct DnSetC { bf16x8 wf[4], qf[4], af[2]; v2u ut[2]; };
struct DnSetS { bf16x8 kf[2][2]; float gl; unsigned pf; };
template <int MODE>
__device__ __forceinline__ void dn_scan(Frame& F_, int sid) {
    Frame F = mkframe();
    const int bh = sid >> 2, slice = sid & 3, b = bh >> 3, h = bh & 7;
    const int lane = F.lane, wave = F.wave, fr = lane & 15, fq = lane >> 4;
    lbf ST = (lbf)(F.lds); lbf VT2 = (lbf)(F.lds + 8704);
    for (int i = F.tid; i < (8704 + 4608) / 4; i += NTHR) ((LAS unsigned*)F.lds)[i] = 0u;
    const bf16* pW = (const bf16*)(wsp() + WS_W) + (size_t)bh * 128 * 8192; const bf16* pQ = (const bf16*)(wsp() + WS_QD) + (size_t)bh * 128 * 8192;
    const bf16* pA = (const bf16*)(wsp() + WS_AI) + (size_t)bh * 128 * 4096; const bf16* pK = (const bf16*)(wsp() + WS_KDT) + (size_t)bh * 128 * 8192;
    const bf16* pU = (const bf16*)(wsp() + WS_UT) + (size_t)bh * 128 * 8192; const float* pG = (const float*)(wsp() + WS_GL) + bh * 128;
    bf16* pO = (bf16*)(wsp() + WS_XN) + (size_t)b * SEQ * D + h * 128 + 32 * slice;
    short eat = 0;
    __syncthreads();
    if (wave < 4) {
        const int mi = wave;
        const unsigned oW = (mi * 4 * 64 + lane) * 8, oA = (mi * 2 * 64 + lane) * 8, oU = ((2 * slice) * 4 + mi) * 256 + lane * 4, oO = (16 * mi + fr) * D + 4 * fq;
#define DNC_LOAD(X, nn) do { const int c_ = (nn) < 128 ? (nn) : 127; \
            X.ut[0] = *(const v2u*)(pU + (size_t)c_ * 8192 + oU); X.ut[1] = *(const v2u*)(pU + (size_t)c_ * 8192 + oU + 1024); \
            _Pragma("unroll") for (int ks = 0; ks < 4; ++ks) { X.wf[ks] = *(const bf16x8*)(pW + (size_t)c_ * 8192 + (oW + 512 * ks)); X.qf[ks] = *(const bf16x8*)(pQ + (size_t)c_ * 8192 + (oW + 512 * ks)); } \
            _Pragma("unroll") for (int ks = 0; ks < 2; ++ks) X.af[ks] = *(const bf16x8*)(pA + (size_t)c_ * 4096 + (oA + 512 * ks)); } while (0)
#define DNC_STEP(X, nn) do { \
            f32x4 c1[2], c2[2]; \
            _Pragma("unroll") for (int ni = 0; ni < 2; ++ni) { c1[ni] = (f32x4){0.f, 0.f, 0.f, 0.f}; c2[ni] = (f32x4){0.f, 0.f, 0.f, 0.f}; \
                _Pragma("unroll") for (int ks = 0; ks < 4; ++ks) { const bf16x8 sf = *(const LAS bf16x8*)(ST + (16 * ni + fr) * 136 + 32 * ks + 8 * fq); c1[ni] = MFMA16(X.wf[ks], sf, c1[ni]); c2[ni] = MFMA16(sf, X.qf[ks], c2[ni]); } \
                v2u w_; w_.x = pk2(bflo(X.ut[ni].x) - c1[ni][0], bfhi(X.ut[ni].x) - c1[ni][1]); w_.y = pk2(bflo(X.ut[ni].y) - c1[ni][2], bfhi(X.ut[ni].y) - c1[ni][3]); \
                *(LAS v2u*)(VT2 + (16 * ni + fr) * 72 + 16 * mi + 4 * fq) = w_; } \
            __syncthreads(); \
            _Pragma("unroll") for (int ni = 0; ni < 2; ++ni) { \
                _Pragma("unroll") for (int ks = 0; ks < 2; ++ks) { const bf16x8 vf = *(const LAS bf16x8*)(VT2 + (16 * ni + fr) * 72 + 32 * ks + 8 * fq); c2[ni] = MFMA16(vf, X.af[ks], c2[ni]); } \
                v2u w_; w_.x = pk2(c2[ni][0], c2[ni][1]); w_.y = pk2(c2[ni][2], c2[ni][3]); if (MODE == 0) *(v2u*)(pO + (size_t)(nn) * 64 * D + oO + 16 * ni) = w_; } \
            __syncthreads(); } while (0)
        DnSetC SA, SB, SC;
        DNC_LOAD(SA, 0); DNC_LOAD(SB, 1);
        for (int n = 0; n < 126; n += 3) {
            DNC_LOAD(SC, n + 2); __builtin_amdgcn_sched_barrier(0); DNC_STEP(SA, n); __builtin_amdgcn_sched_barrier(0);
            DNC_LOAD(SA, n + 3); __builtin_amdgcn_sched_barrier(0); DNC_STEP(SB, n + 1); __builtin_amdgcn_sched_barrier(0);
            DNC_LOAD(SB, n + 4); __builtin_amdgcn_sched_barrier(0); DNC_STEP(SC, n + 2); __builtin_amdgcn_sched_barrier(0);
        }
        DNC_STEP(SA, 126); DNC_STEP(SB, 127);
#undef DNC_LOAD
#undef DNC_STEP
    } else {
        const int dq = wave - 4;
        f32x4 accS[2][2];
#pragma unroll
        for (int k = 0; k < 2; ++k)
#pragma unroll
            for (int ni = 0; ni < 2; ++ni) accS[k][ni] = (f32x4){0.f, 0.f, 0.f, 0.f};
        const int lt = F.tid - 256, li = slice * 112 + lt; const bool toucher = lt < 144;
        const bf16* pfBase = (lt >= 112) ? pU + 2048 * slice + (lt - 112) * 64 : (li < 128) ? pW + li * 64 : (li < 256) ? pQ + (li - 128) * 64 : (li < 384) ? pK + (li - 256) * 64 : pA + (li - 384) * 64;
        const unsigned pfStride = (lt >= 112 || li < 384) ? 8192u : 4096u;
        const unsigned oK = (2 * dq * 2 * 64 + lane) * 8;
#define DNS_LOAD(X, nn) do { const int c_ = (nn) < 128 ? (nn) : 127; eat ^= (short)X.pf; X.gl = pG[c_]; \
            _Pragma("unroll") for (int ks = 0; ks < 2; ++ks) { X.kf[0][ks] = *(const bf16x8*)(pK + (size_t)c_ * 8192 + (oK + 512 * ks)); X.kf[1][ks] = *(const bf16x8*)(pK + (size_t)c_ * 8192 + (oK + 1024 + 512 * ks)); } \
            { const int c2_ = (nn) + 2 < 128 ? (nn) + 2 : 127; X.pf = toucher ? *(const unsigned*)(pfBase + (size_t)c2_ * pfStride) : 0u; } } while (0)
#define DNS_STEP(X, nn) do { \
            const float egl = __expf(X.gl); \
            __syncthreads(); \
            _Pragma("unroll") for (int ni = 0; ni < 2; ++ni) { bf16x8 vf[2]; \
                _Pragma("unroll") for (int ks = 0; ks < 2; ++ks) vf[ks] = *(const LAS bf16x8*)(VT2 + (16 * ni + fr) * 72 + 32 * ks + 8 * fq); \
                _Pragma("unroll") for (int k = 0; k < 2; ++k) { accS[k][ni] = accS[k][ni] * egl; \
                    _Pragma("unroll") for (int ks = 0; ks < 2; ++ks) accS[k][ni] = MFMA16(X.kf[k][ks], vf[ks], accS[k][ni]); \
                    v2u w_; w_.x = pk2(accS[k][ni][0], accS[k][ni][1]); w_.y = pk2(accS[k][ni][2], accS[k][ni][3]); \
                    *(LAS v2u*)(ST + (16 * ni + fr) * 136 + 16 * (2 * dq + k) + 4 * fq) = w_; } } \
            __syncthreads(); } while (0)
        DnSetS SA, SB, SC; SA.pf = 0u; SB.pf = 0u; SC.pf = 0u;
        DNS_LOAD(SA, 0); DNS_LOAD(SB, 1);
        for (int n = 0; n < 126; n += 3) {
            DNS_LOAD(SC, n + 2); __builtin_amdgcn_sched_barrier(0); DNS_STEP(SA, n); __builtin_amdgcn_sched_barrier(0);
            DNS_LOAD(SA, n + 3); __builtin_amdgcn_sched_barrier(0); DNS_STEP(SB, n + 1); __builtin_amdgcn_sched_barrier(0);
            DNS_LOAD(SB, n + 4); __builtin_amdgcn_sched_barrier(0); DNS_STEP(SC, n + 2); __builtin_amdgcn_sched_barrier(0);
        }
        DNS_STEP(SA, 126); DNS_STEP(SB, 127);
#undef DNS_LOAD
#undef DNS_STEP
    }
    if (eat == 12345 && fq == 77) VT2[0] = (bf16)eat;
}
__device__ __forceinline__ void rope16(v4u& w0, v4u& w1, const float* rp) {
    float x[8], y[8];
#pragma unroll
    for (int j = 0; j < 4; ++j) { x[2 * j] = bflo(w0[j]); x[2 * j + 1] = bfhi(w0[j]); y[2 * j] = bflo(w1[j]); y[2 * j + 1] = bfhi(w1[j]); }
    const f32x4 c0 = *(const f32x4*)rp, c1 = *(const f32x4*)(rp + 4), s0 = *(const f32x4*)(rp + 8), s1 = *(const f32x4*)(rp + 12);
    float c[8] = {c0.x, c0.y, c0.z, c0.w, c1.x, c1.y, c1.z, c1.w}, s[8] = {s0.x, s0.y, s0.z, s0.w, s1.x, s1.y, s1.z, s1.w};
#pragma unroll
    for (int j = 0; j < 8; ++j) { const float a = x[j], bb = y[j]; x[j] = a * c[j] - bb * s[j]; y[j] = bb * c[j] + a * s[j]; }
#pragma unroll
    for (int j = 0; j < 4; ++j) { w0[j] = pk2(x[2 * j], x[2 * j + 1]); w1[j] = pk2(y[2 * j], y[2 * j + 1]); }
}
__device__ __forceinline__ void swa_mfma(Frame& F_, int l, int nskip) {
    Frame F = mkframe();
    bf16* PROJ = (bf16*)(wsp() + WS_PROJ); const float* ROPE = (const float*)(wsp() + WS_ROPE);
    lbf KL = (lbf)(F.lds), VTL = (lbf)(F.lds + 29952), QL = (lbf)(F.lds + 57600 + F.wave * 9216);
    const int tid = F.tid, lane = F.lane, wave = F.wave, fr = lane & 15, fq = lane >> 4;
    for (int unit = F.bid - nskip; unit < 512; unit += F.G - nskip) {
        const int b = unit >> 8, kvh = (unit >> 7) & 1, q0 = (unit & 127) * 64;
        for (int task = tid; task < 208 * 4; task += NTHR) { const int kl = task >> 2, seg = task & 3, tk = q0 - 128 + kl; v4u w0 = {0u, 0u, 0u, 0u}, w1 = {0u, 0u, 0u, 0u};
            if (kl < 192 && tk >= 0) { const int mk = b * SEQ + tk; const v4u* p = (const v4u*)(PROJ + (size_t)mk * DINP + C_SWK + kvh * 64 + 16 * seg); w0 = p[0]; w1 = p[1];
                if (seg == 0) rope16(w0, w1, ROPE + mk * 16); }
            *(LAS v4u*)(KL + kl * 72 + 16 * seg) = w0; *(LAS v4u*)(KL + kl * 72 + 16 * seg + 8) = w1; }
        for (int task = tid; task < 192 * 8; task += NTHR) { const int kl = task >> 3, seg = task & 7, tk = q0 - 128 + kl; v4u w = {0u, 0u, 0u, 0u};
            if (tk >= 0) w = *(const v4u*)(PROJ + (size_t)(b * SEQ + tk) * DINP + C_SWV + kvh * 64 + 8 * seg);
#pragma unroll
            for (int j = 0; j < 4; ++j) { VTL[(8 * seg + 2 * j) * 216 + kl] = (bf16)(w[j] & 0xffffu); VTL[(8 * seg + 2 * j + 1) * 216 + kl] = (bf16)(w[j] >> 16); } }
        for (int i = tid; i < 1024; i += NTHR) VTL[(i >> 4) * 216 + 192 + (i & 15)] = 0;
        { const int mq = b * SEQ + q0 + lane; const v4u* qp = (const v4u*)(PROJ + (size_t)mq * DINP + C_SWQ + (kvh * 8 + wave) * 64);
          v4u w[8];
#pragma unroll
          for (int i = 0; i < 8; ++i) w[i] = qp[i];
          rope16(w[0], w[1], ROPE + mq * 16);
#pragma unroll
          for (int i = 0; i < 8; ++i) { v4u o;
#pragma unroll
              for (int j = 0; j < 4; ++j) o[j] = pk2(bflo(w[i][j]) * 0.125f, bfhi(w[i][j]) * 0.125f);
              *(LAS v4u*)(QL + lane * 72 + 8 * i) = o; } }
        __syncthreads();
        const float sink = inp(8)[l * 16 + kvh * 8 + wave];
#pragma unroll 1
        for (int qt = 0; qt < 4; ++qt) {
            bf16x8 qf[2];
#pragma unroll
            for (int ks = 0; ks < 2; ++ks) qf[ks] = *(const LAS bf16x8*)(QL + (16 * qt + fr) * 72 + 32 * ks + 8 * fq);
            f32x4 st[10];
#pragma unroll
            for (int t = 0; t < 10; ++t) { st[t] = (f32x4){0.f, 0.f, 0.f, 0.f};
#pragma unroll
                for (int ks = 0; ks < 2; ++ks) { const bf16x8 kf = *(const LAS bf16x8*)(KL + (16 * (qt + t) + fr) * 72 + 32 * ks + 8 * fq); st[t] = MFMA16(kf, qf[ks], st[t]); } }
            const int qr = 16 * qt + fr; float mx = -1e30f;
#pragma unroll
            for (int t = 0; t < 10; ++t)
#pragma unroll
                for (int r = 0; r < 4; ++r) { const int kl = 16 * (qt + t) + 4 * fq + r; const bool ok = (kl > qr) && (kl <= qr + 128) && (q0 - 128 + kl >= 0);
                    st[t][r] = ok ? st[t][r] : -1e30f; mx = fmaxf(mx, st[t][r]); }
            mx = fmaxf(mx, __shfl_xor(mx, 16)); mx = fmaxf(mx, __shfl_xor(mx, 32)); mx = fmaxf(mx, sink);
            float sum = 0.f;
#pragma unroll
            for (int t = 0; t < 10; ++t)
#pragma unroll
                for (int r = 0; r < 4; ++r) { const float p = (st[t][r] > -1e29f) ? __expf(st[t][r] - mx) : 0.f; st[t][r] = p; sum += p; }
            sum += __shfl_xor(sum, 16); sum += __shfl_xor(sum, 32);
            const float inv = 1.f / (sum + __expf(sink - mx));
            bf16x8 pf[5];
#pragma unroll
            for (int pr = 0; pr < 5; ++pr) { v4u w; w.x = pk2(st[2 * pr][0] * inv, st[2 * pr][1] * inv); w.y = pk2(st[2 * pr][2] * inv, st[2 * pr][3] * inv);
                w.z = pk2(st[2 * pr + 1][0] * inv, st[2 * pr + 1][1] * inv); w.w = pk2(st[2 * pr + 1][2] * inv, st[2 * pr + 1][3] * inv); pf[pr] = __builtin_bit_cast(bf16x8, w); }
#pragma unroll
            for (int dt = 0; dt < 4; ++dt) { f32x4 acc = {0.f, 0.f, 0.f, 0.f};
#pragma unroll
                for (int pr = 0; pr < 5; ++pr) { const v2u a0 = *(const LAS v2u*)(VTL + (16 * dt + fr) * 216 + 16 * (qt + 2 * pr) + 4 * fq), a1 = *(const LAS v2u*)(VTL + (16 * dt + fr) * 216 + 16 * (qt + 2 * pr + 1) + 4 * fq);
                    v4u aw; aw.x = a0.x; aw.y = a0.y; aw.z = a1.x; aw.w = a1.y; acc = MFMA16(__builtin_bit_cast(bf16x8, aw), pf[pr], acc); }
                v2u w; w.x = pk2(acc[0], acc[1]); w.y = pk2(acc[2], acc[3]);
                *(v2u*)(PROJ + (size_t)(b * SEQ + q0 + 16 * qt + fr) * DINP + C_SWQ + (kvh * 8 + wave) * 64 + 16 * dt + 4 * fq) = w; }
        }
        __syncthreads();
    }
}
__device__ __forceinline__ void dn_naive(Frame& F_, int l) {
    Frame F = mkframe(); const int b = F.bid >> 3, h = F.bid & 7;
    const bf16* PROJ = (const bf16*)(wsp() + WS_PROJ); bf16* ORAW = (bf16*)(wsp() + WS_XN);
    LAS float* vals = (LAS float*)F.lds;
    LAS float* part = vals + 768;
    LAS float* bg = part + 16;
    LAS float* red = bg + 4;
    LAS float* red2 = red + 1024;
    const int tid = F.tid, lane = F.lane, wave = F.wave;
    const int e = tid & 127, r = tid >> 7;
    int col; float cw0 = 0.f, cw1 = 0.f, cw2 = 0.f, cw3 = 0.f;
    if (tid < 384) { const int chan = (tid >> 7) * 1024 + h * 128 + (tid & 127); col = chan; const float* cw = inp(4) + (size_t)l * 4 * 3072;
        cw0 = cw[chan]; cw1 = cw[3072 + chan]; cw2 = cw[2 * 3072 + chan]; cw3 = cw[3 * 3072 + chan]; }
    else if (tid == 384) col = C_DNB + h; else if (tid == 385) col = C_DNA + h; else col = 0;
    const float a_neg = -__expf(inp(5)[l * 8 + h]), dtb = inp(6)[l * 8 + h];
    float S[32];
#pragma unroll
    for (int i = 0; i < 32; ++i) S[i] = 0.f;
    float x0 = 0.f, x1 = 0.f, x2 = 0.f;
    const bf16* pcol = PROJ + (size_t)b * SEQ * DINP + col;
    float cur[16], nxt[16];
#pragma unroll
    for (int i = 0; i < 16; ++i) cur[i] = bf1(pcol[(size_t)i * DINP]);
    for (int tb = 0; tb < SEQ; tb += 16) {
        if (tb + 16 < SEQ) {
#pragma unroll
            for (int i = 0; i < 16; ++i) nxt[i] = bf1(pcol[(size_t)(tb + 16 + i) * DINP]);
        }
#pragma unroll
        for (int i = 0; i < 16; ++i) {
            const int t = tb + i, buf = i & 1;
            const float xin = cur[i];
            if (tid < 384) {
                const float y = cw0 * x0 + cw1 * x1 + cw2 * x2 + cw3 * xin; x0 = x1; x1 = x2; x2 = xin;
                const float s = siluf_(y); vals[buf * 384 + tid] = s;
                const float ss = wave_sum(s * s); if (lane == 0) part[buf * 8 + wave] = ss;
            } else if (tid == 384) { bg[buf * 2 + 0] = sigmoidf_(xin); }
            else if (tid == 385) { const float z = xin + dtb; const float sp = (z > 20.f) ? z : log1pf(__expf(z)); bg[buf * 2 + 1] = __expf(a_neg * sp); }
            __syncthreads();
            const float sq = rsqrtf(part[buf * 8 + 0] + part[buf * 8 + 1] + EPS) * 0.08838834764831845f;
            const float sk = rsqrtf(part[buf * 8 + 2] + part[buf * 8 + 3] + EPS);
            const float beta = bg[buf * 2 + 0], eg = bg[buf * 2 + 1];
            const LAS float* qv = vals + buf * 384 + 32 * r; const LAS float* kv = vals + buf * 384 + 128 + 32 * r;
            float pk = 0.f, pq = 0.f, pqk = 0.f;
#pragma unroll
            for (int dd = 0; dd < 32; ++dd) { const float kd = kv[dd], qd = qv[dd]; pk += kd * S[dd]; pq += qd * S[dd]; pqk += qd * kd; }
            red[(buf * 4 + r) * 128 + e] = pk * sk; red[((1 - buf) * 4 + r) * 128 + e] = pq * sq;
            if (e == 0) red2[r] = pqk;
            __syncthreads();
            float kS = 0.f, qS = 0.f;
#pragma unroll
            for (int rr = 0; rr < 4; ++rr) { kS += red[(buf * 4 + rr) * 128 + e]; qS += red[((1 - buf) * 4 + rr) * 128 + e]; }
            const float qk = (red2[0] + red2[1] + red2[2] + red2[3]) * sq * sk;
            const float ve = vals[buf * 384 + 256 + e];
            const float delta = beta * (ve - eg * kS);
            if (r == 0) ORAW[(size_t)(b * SEQ + t) * D + h * 128 + e] = (bf16)f2bf(eg * qS + qk * delta);
            const float kdl = sk * delta;
#pragma unroll
            for (int dd = 0; dd < 32; ++dd) S[dd] = eg * S[dd] + kv[dd] * kdl;
            __syncthreads();
        }
#pragma unroll
        for (int i = 0; i < 16; ++i) cur[i] = nxt[i];
    }
}
__device__ __forceinline__ void swa_naive(Frame& F_, int l, int nskip) {
    Frame F = mkframe(); const int w0 = (F.bid - nskip) * NWAVES + F.wave, nw = (F.G - nskip) * NWAVES;
    bf16* PROJ = (bf16*)(wsp() + WS_PROJ); const float* ROPE = (const float*)(wsp() + WS_ROPE);
    LAS float* qs = (LAS float*)(F.lds + F.wave * 8192);
    LAS float* ps = qs + 512;
    const int lane = F.lane;
    for (int task = w0; task < M * 2; task += nw) {
        const int m = task >> 1, kvh = task & 1, b = m / SEQ, t = m % SEQ;
        { const float c = ROPE[m * 16 + (lane & 7)], s = ROPE[m * 16 + 8 + (lane & 7)];
#pragma unroll
          for (int g = 0; g < 8; ++g) { const float x = bf1(PROJ[(size_t)m * DINP + C_SWQ + (kvh * 8 + g) * 64 + lane]); const float p = __shfl_xor(x, 8);
              const float y = (lane < 8) ? (x * c - p * s) : ((lane < 16) ? (x * c + p * s) : x); qs[g * 64 + lane] = y * 0.125f; } }
        asm volatile("s_waitcnt lgkmcnt(0)" ::: "memory");
#pragma unroll 1
        for (int kk = 0; kk < 2; ++kk) {
            const int tk = t - 127 + lane + 64 * kk; const bool valid = tk >= 0; const int mk = b * SEQ + (valid ? tk : 0);
            float kf[64];
            const v4u* kr = (const v4u*)(PROJ + (size_t)mk * DINP + C_SWK + kvh * 64);
#pragma unroll
            for (int i = 0; i < 8; ++i) { const v4u w = kr[i];
#pragma unroll
                for (int j = 0; j < 4; ++j) { kf[8 * i + 2 * j] = bflo(w[j]); kf[8 * i + 2 * j + 1] = bfhi(w[j]); } }
#pragma unroll
            for (int j = 0; j < 8; ++j) { const float c = ROPE[mk * 16 + j], s = ROPE[mk * 16 + 8 + j]; const float a = kf[j], bb = kf[j + 8]; kf[j] = a * c - bb * s; kf[j + 8] = bb * c + a * s; }
#pragma unroll
            for (int g = 0; g < 8; ++g) { float a = 0.f;
#pragma unroll
                for (int d4 = 0; d4 < 16; ++d4) { const f32x4 q = *(const LAS f32x4*)(qs + g * 64 + 4 * d4); a += q.x * kf[4 * d4] + q.y * kf[4 * d4 + 1] + q.z * kf[4 * d4 + 2] + q.w * kf[4 * d4 + 3]; }
                ps[(lane + 64 * kk) * 8 + g] = valid ? a : -1e30f; }
        }
        asm volatile("s_waitcnt lgkmcnt(0)" ::: "memory");
#pragma unroll
        for (int g = 0; g < 8; ++g) {
            const float sink = inp(8)[l * 16 + kvh * 8 + g];
            const float s0 = ps[lane * 8 + g], s1 = ps[(lane + 64) * 8 + g];
            const float mx = fmaxf(wave_max(fmaxf(s0, s1)), sink);
            const float p0 = (s0 > -1e29f) ? __expf(s0 - mx) : 0.f, p1 = (s1 > -1e29f) ? __expf(s1 - mx) : 0.f;
            const float den = wave_sum(p0 + p1) + __expf(sink - mx); const float inv = 1.f / den;
            ps[lane * 8 + g] = p0 * inv; ps[(lane + 64) * 8 + g] = p1 * inv;
        }
        asm volatile("s_waitcnt lgkmcnt(0)" ::: "memory");
        float o[8];
#pragma unroll
        for (int g = 0; g < 8; ++g) o[g] = 0.f;
        const int j0 = (t >= 127) ? 0 : (127 - t);
        for (int j = j0; j < 128; ++j) {
            const int mk = b * SEQ + t - 127 + j;
            const float v = bf1(PROJ[(size_t)mk * DINP + C_SWV + kvh * 64 + lane]);
            const f32x4 pa = *(const LAS f32x4*)(ps + j * 8), pb = *(const LAS f32x4*)(ps + j * 8 + 4);
            o[0] += pa.x * v; o[1] += pa.y * v; o[2] += pa.z * v; o[3] += pa.w * v; o[4] += pb.x * v; o[5] += pb.y * v; o[6] += pb.z * v; o[7] += pb.w * v;
        }
#pragma unroll
        for (int g = 0; g < 8; ++g) PROJ[(size_t)m * DINP + C_SWQ + (kvh * 8 + g) * 64 + lane] = (bf16)f2bf(o[g]);
        asm volatile("s_waitcnt lgkmcnt(0)" ::: "memory");
    }
}
__device__ __forceinline__ void phase_gnorm(Frame& F_, int l) {
    Frame F = mkframe();
    bf16* PROJ = (bf16*)(wsp() + WS_PROJ); const bf16* ORAW = (const bf16*)(wsp() + WS_XN);
    const int gw = F.bid * NWAVES + F.wave, NGW = F.G * NWAVES;
    const int hl = F.lane >> 5, c4 = 4 * (F.lane & 31);
    const f32x4 gv = *(const f32x4*)(inp(7) + l * 128 + c4);
    for (int m = gw; m < M; m += NGW) {
        v2u ow[4], zw[4];
#pragma unroll
        for (int hh = 0; hh < 4; ++hh) { const int h = 2 * hh + hl; ow[hh] = *(const v2u*)(ORAW + (size_t)m * D + h * 128 + c4); zw[hh] = *(const v2u*)(PROJ + (size_t)m * DINP + C_DNZ + h * 128 + c4); }
        float ss[4];
#pragma unroll
        for (int hh = 0; hh < 4; ++hh) { const float o0 = bflo(ow[hh].x), o1 = bfhi(ow[hh].x), o2 = bflo(ow[hh].y), o3 = bfhi(ow[hh].y); ss[hh] = (o0 * o0 + o1 * o1) + (o2 * o2 + o3 * o3); }
#pragma unroll
        for (int o = 1; o < 32; o <<= 1) {
#pragma unroll
            for (int hh = 0; hh < 4; ++hh) ss[hh] += __shfl_xor(ss[hh], o); }
#pragma unroll
        for (int hh = 0; hh < 4; ++hh) { const int h = 2 * hh + hl; const float r = rsqrtf(ss[hh] * (1.f / 128.f) + EPS);
            v2u w; w.x = pk2(bflo(ow[hh].x) * r * gv.x * siluf_(bflo(zw[hh].x)), bfhi(ow[hh].x) * r * gv.y * siluf_(bfhi(zw[hh].x)));
            w.y = pk2(bflo(ow[hh].y) * r * gv.z * siluf_(bflo(zw[hh].y)), bfhi(ow[hh].y) * r * gv.w * siluf_(bfhi(zw[hh].y)));
            *(v2u*)(PROJ + (size_t)m * DINP + C_DNQ + h * 128 + c4) = w; }
    }
}

#ifndef PROBE_ECHO
#define PROBE_ECHO 0
#endif
#define ECHO_BEGIN(k) do { if (PROBE_ECHO == (k)) echo_t0 = __builtin_amdgcn_s_memrealtime(); } while (0)
#define ECHO_END(k) do { if (PROBE_ECHO == (k)) { const unsigned long long t1_ = __builtin_amdgcn_s_memrealtime(), d_ = t1_ - echo_t0; while (__builtin_amdgcn_s_memrealtime() - t1_ < d_) __builtin_amdgcn_s_sleep(8); } } while (0)
#ifndef PROBE_DUP
#define PROBE_DUP 0
#endif
#ifndef DN_NAIVE
#define DN_NAIVE 0
#endif
struct Args { const float* in[17]; float* out; unsigned char* ws; };
__global__ void __launch_bounds__(NTHR, 2) hybrid_fwd(Args args) {
    cg::grid_group grid = cg::this_grid();
    Frame F;
    F.lds = lds_base();
    F.tid = threadIdx.x; F.lane = F.tid & 63; F.wave = __builtin_amdgcn_readfirstlane(F.tid >> 6);
    F.G = gridDim.x; F.bid = blockIdx.x;
#define PROJ ((bf16*)(wsp() + WS_PROJ))
#define XN ((bf16*)(wsp() + WS_XN))
#define YF ((float*)(wsp() + WS_YF))
#define MIX ((bf16*)(wsp() + WS_MIX))
#define HB ((bf16*)(wsp() + WS_H))

    unsigned long long echo_t0 = 0; (void)echo_t0;
    ECHO_BEGIN(9); ECHO_BEGIN(10); ECHO_BEGIN(11);
    if (F.bid == 0) { for (int i = F.tid; i < XCD_BAR_WORDS; i += NTHR) ((unsigned*)(wsp() + WS_BAR))[i] = 0u; for (int i = F.tid; i < 16384; i += NTHR) ((unsigned*)(wsp() + WS_XCNT))[i] = 0u; if (F.tid < 256) ((unsigned*)(wsp() + WS_SUBCNT))[F.tid] = 0u; }
    if (F.tid < 4) ((LAS unsigned*)(lds_base() + LDS_BARST))[F.tid] = 0u;
    grid.sync();
    ECHO_END(10);
    xcd_barrier_post();
    phase_rope(F);
    phase_norm(F, nullptr, nullptr, inp(0), outp(), inp(2), XN);
    phase_convert(F, -1, 0, 0);
    grid_bar();
    ECHO_END(9);
    for (int l = 0; l < DEPTH; ++l) {
        ECHO_BEGIN(1);
        {
            pg8::Gemm g{XN, (const bf16*)(wsp() + WS_WIN), nullptr, nullptr, M, DINP, D, D}; pg8::StaticOrder S; { Frame Fg = mkframe(); S.init(M, DINP, Fg.G, Fg.bid); }
            pg8::EpiBf16<0> E{PROJ, DINP};
            pg8::gemm_phase<pg8::EpiBf16<0>, pg8::StaticOrder, true, true>(F.lds, g, S, E);
#if PROBE_DUP == 5
            pg8::gemm_phase<pg8::EpiBf16<0>, pg8::StaticOrder, true, true>(F.lds, g, S, E);
#endif
        }
        grid_bar(); ECHO_END(1); ECHO_BEGIN(2);
#if DN_NAIVE
        if (F.bid < 16) dn_naive(F, l);
        else swa_naive(F, l, 16);
#else
#if PROBE_DUP == 1
        dn_prep<0>(F, l);
#elif PROBE_DUP == 11
        dn_prep<1>(F, l);
#elif PROBE_DUP == 12
        dn_prep<2>(F, l);
#elif PROBE_DUP == 13
        dn_prep<3>(F, l);
#elif PROBE_DUP == 14
        dn_prep<4>(F, l);
#endif
        dn_prep<0>(F, l);
        grid_bar(); ECHO_END(2); ECHO_BEGIN(3);
        { Frame Fg = mkframe(); if (Fg.bid < 64) { const int sid_ = (((Fg.bid & 7) * 2 + (Fg.bid >> 5)) << 2) | ((Fg.bid >> 3) & 3); dn_scan<0>(F, sid_);
#if PROBE_DUP == 2
            dn_scan<0>(F, sid_);
#elif PROBE_DUP == 3
            dn_scan<1>(F, sid_);
#elif PROBE_DUP == 4
            dn_scan<2>(F, sid_);
#endif
        }
        else {
            phase_convert(F, l, (l + 1 < DEPTH) ? l + 1 : -1, 64);
            __syncthreads();
            swa_mfma(F, l, 64);
            sub_bar((unsigned*)(wsp() + WS_SUBCNT) + 64 * l, (unsigned)(Fg.G - 64));
            pg8::Gemm g{PROJ + C_SWQ, (const bf16*)(wsp() + WS_WUPSW), nullptr, nullptr, M, D, D, DINP}; pg8::StaticOrder S; S.init(M, D, Fg.G - 64, Fg.bid - 64);
            pg8::EpiYb E{PROJ + C_DNK, DINP, PROJ + C_GB, DINP};
            pg8::gemm_phase<pg8::EpiYb, pg8::StaticOrder, true, true>(F.lds, g, S, E);
        } }
#endif
        grid_bar(); ECHO_END(3); ECHO_BEGIN(4);
        phase_gnorm(F, l);
#if PROBE_DUP == 6
        phase_gnorm(F, l);
#endif
        grid_bar(); ECHO_END(4); ECHO_BEGIN(5);
        {
            pg8::Gemm g{PROJ + C_DNQ, (const bf16*)(wsp() + WS_WUPDN), nullptr, nullptr, M, D, D, DINP}; pg8::StaticOrder S; { Frame Fg = mkframe(); S.init(M, D, Fg.G, Fg.bid); }
            pg8::EpiMerge2 E{MIX, D, PROJ + C_GA, PROJ + C_DNK, DINP};
            pg8::gemm_phase<pg8::EpiMerge2, pg8::StaticOrder, false, true>(F.lds, g, S, E);
        }
        grid_bar(); ECHO_END(5); ECHO_BEGIN(6);
        {
            pg8::Gemm g{MIX, (const bf16*)(wsp() + WS_WO), nullptr, nullptr, M, D, D, D}; pg8::StaticOrder S; { Frame Fg = mkframe(); S.init(M, D, Fg.G, Fg.bid); }
            pg8::RmsExchange e1{(float*)(wsp() + WS_XSLOT), (unsigned*)(wsp() + WS_XCNT) + ((l * 4 + 0) * 64) * 16}, e2{(float*)(wsp() + WS_XSLOT + 262144), (unsigned*)(wsp() + WS_XCNT) + ((l * 4 + 1) * 64) * 16};
            pg8::EpiRmsRes E{outp(), inp(12) + l * D, inp(13) + l * D, XN, e1, e2};
            pg8::gemm_phase<pg8::EpiRmsRes, pg8::StaticOrder, false, true>(F.lds, g, S, E);
        }
        grid_bar(); ECHO_END(6); ECHO_BEGIN(7);
        {
            pg8::Gemm g{XN, (const bf16*)(wsp() + WS_WFF1), nullptr, nullptr, M, FF, D, D}; pg8::StaticOrder S; { Frame Fg = mkframe(); S.init(M, FF, Fg.G, Fg.bid); }
            pg8::EpiBf16<2> E{HB, FF};
            pg8::gemm_phase<pg8::EpiBf16<2>, pg8::StaticOrder, true, true>(F.lds, g, S, E);
#if PROBE_DUP == 7
            pg8::gemm_phase<pg8::EpiBf16<2>, pg8::StaticOrder, true, true>(F.lds, g, S, E);
#endif
        }
        grid_bar(); ECHO_END(7); ECHO_BEGIN(8);
        {
            pg8::Gemm g{HB, (const bf16*)(wsp() + WS_WFF2), nullptr, nullptr, M, D, FF, FF}; pg8::StaticOrder S; { Frame Fg = mkframe(); S.init(M, D, Fg.G, Fg.bid); }
            pg8::RmsExchange e1{(float*)(wsp() + WS_XSLOT), (unsigned*)(wsp() + WS_XCNT) + ((l * 4 + 2) * 64) * 16}, e2{(float*)(wsp() + WS_XSLOT + 262144), (unsigned*)(wsp() + WS_XCNT) + ((l * 4 + 3) * 64) * 16};
            pg8::EpiRmsRes E{outp(), inp(16) + l * D, (l + 1 < DEPTH) ? inp(2) + (l + 1) * D : nullptr, XN, e1, e2};
            pg8::gemm_phase<pg8::EpiRmsRes, pg8::StaticOrder, false, true>(F.lds, g, S, E);
        }
        if (l + 1 < DEPTH) grid_bar();
        ECHO_END(8);
    }
    ECHO_END(11);
#undef PROJ
#undef XN
#undef YF
#undef MIX
#undef HB
}

extern "C" void kernel_launch(void* const* d_in, const int* in_sizes, int n_in, void* d_out, int out_size, void* d_ws, size_t ws_size, hipStream_t stream) {
    static int init = 0;
    if (!init) {
        if (n_in != 17 || out_size != M * D || ws_size < WS_END) { fprintf(stderr, "kernel_launch: unexpected shapes (n_in %d out %d ws %zu)\n", n_in, out_size, ws_size); init = -1; return; }
        if (hipFuncSetAttribute((const void*)hybrid_fwd, hipFuncAttributeMaxDynamicSharedMemorySize, LDS_BYTES) != hipSuccess) { fprintf(stderr, "hipFuncSetAttribute failed\n"); init = -1; return; }
        init = 1;
    }
    if (init < 0) return;
    Args a{};
    for (int i = 0; i < 17; ++i) a.in[i] = (const float*)d_in[i];
    a.out = (float*)d_out; a.ws = (unsigned char*)d_ws;
    void* args[] = {&a};
    hipError_t e = hipLaunchCooperativeKernel((void*)hybrid_fwd, dim3(256), dim3(NTHR), args, LDS_BYTES, stream);
    if (e != hipSuccess) fprintf(stderr, "cooperative launch failed: %s\n", hipGetErrorString(e));
}
```

```cpp
#include <hip/hip_runtime.h>
#include <hip/hip_cooperative_groups.h>
#include <cstdio>
#include <cstdint>
namespace cg = cooperative_groups;

namespace pg8 {
#define PG8_LAS __attribute__((address_space(3)))
typedef unsigned short bf16_t;
typedef short bf16x8 __attribute__((ext_vector_type(8)));
typedef float f32x4 __attribute__((ext_vector_type(4)));
typedef unsigned u32x4 __attribute__((ext_vector_type(4)));
constexpr int BM = 256, BK = 64, HALF = 128, HTB = HALF * BK * 2, STAGE_BYTES = 8 * HTB, NXCD = 8, WGM = 8;

__host__ __device__ __forceinline__ int lds_byte(int r, int c) { const int st = (r >> 4) * 2 + (c >> 5), rr = r & 15, cc = c & 31, ob = rr * 64 + cc * 2; return st * 1024 + (ob ^ (((ob >> 9) & 1) << 5)); }
__host__ __device__ __forceinline__ void stage_rc(int b, int& R, int& C) { const int st = b / 1024, sb = b % 1024, swz = sb ^ (((sb >> 9) & 1) << 5); R = (st >> 1) * 16 + swz / 64; C = (st & 1) * 32 + (swz % 64) / 2; }
__host__ __device__ __forceinline__ int perm32(int rho) { const int n = rho >> 4, i = rho & 15; return 8 * (i >> 2) + 4 * n + (i & 3); }

struct Unit { int pm, pn, src; };
struct Gemm { const bf16_t* A; const bf16_t* Bt; const bf16_t* A2; const bf16_t* Bt2; int M, N, K, lda; };

struct StaticOrder {
    int nM, nN, nwg, G, c;
    __host__ __device__ void init(int M, int N, int G_, int c_) { nM = M / BM; nN = N / BM; nwg = nM * nN; G = G_; c = c_; }
    __host__ __device__ bool tile(long L, Unit& u) const {
        if (L >= nwg) return false;
        int wgid = (int)L; { const int q = nwg / NXCD, r = nwg % NXCD, xcd = wgid % NXCD, off = wgid / NXCD; wgid = (xcd < r ? xcd * (q + 1) : r * (q + 1) + (xcd - r) * q) + off; }
        const int nig = WGM * nN, gid = wgid / nig, fm = gid * WGM, gsz = (nM - fm) < WGM ? (nM - fm) : WGM;
        u.pm = fm + ((wgid % nig) % gsz); u.pn = (wgid % nig) / gsz; u.src = 0; return true;
    }
    __host__ __device__ bool next(int i, Unit& u) const { return tile((long)i * G + c, u); }
};
struct DualOrder {
    StaticOrder S;
    __host__ __device__ bool next(int i, Unit& u) const { const bool ok = S.tile((long)(i >> 1) * S.G + S.c, u); u.src = i & 1; return ok; }
};

typedef float f32x2c __attribute__((ext_vector_type(2)));
typedef __bf16 bf16x2c __attribute__((ext_vector_type(2)));
__device__ __forceinline__ unsigned cvt_pk_bf16(float lo, float hi) { const f32x2c v = {lo, hi}; return __builtin_bit_cast(unsigned, __builtin_convertvector(v, bf16x2c)); }
__device__ __forceinline__ float bf_lo(unsigned w) { return __uint_as_float(w << 16); }
__device__ __forceinline__ float bf_hi(unsigned w) { return __uint_as_float(w & 0xffff0000u); }

template <int ACT  > struct EpiBf16 {
    static constexpr bool PERM = true, DUAL = false, AFTER_DRAIN = false;
    bf16_t* O; int ldc;
    __device__ __forceinline__ void mid(f32x4 (&acc)[2][2][4][2], const Unit& u, int wr, int wc, int fr, int fq) const {}
    __device__ __forceinline__ void operator()(const f32x4 (&acc)[2][2][4][2], const Unit& u, int wr, int wc, int fr, int fq) const {
        const int row0 = u.pm * BM + wr * 64 + fr; const int col0 = u.pn * BM + wc * 32 + 8 * fq;
#pragma unroll
        for (int ai = 0; ai < 2; ++ai)
#pragma unroll
            for (int m = 0; m < 4; ++m) { bf16_t* rowp = O + (size_t)(row0 + ai * HALF + m * 16) * ldc + col0;
#pragma unroll
                for (int bj = 0; bj < 2; ++bj) { f32x4 v0 = acc[ai][bj][m][0], v1 = acc[ai][bj][m][1];
                    if (ACT == 2) {
#pragma unroll
                        for (int e = 0; e < 4; ++e) { const float a = fmaxf(v0[e], 0.f), b = fmaxf(v1[e], 0.f); v0[e] = a * a; v1[e] = b * b; } }
                    u32x4 w; w.x = cvt_pk_bf16(v0[0], v0[1]); w.y = cvt_pk_bf16(v0[2], v0[3]); w.z = cvt_pk_bf16(v1[0], v1[1]); w.w = cvt_pk_bf16(v1[2], v1[3]);
                    *(u32x4*)(rowp + bj * HALF) = w; } }
    }
};
struct EpiF32 {
    static constexpr bool PERM = false, DUAL = false, AFTER_DRAIN = false;
    float* O; int ldc;
    __device__ __forceinline__ void mid(f32x4 (&acc)[2][2][4][2], const Unit& u, int wr, int wc, int fr, int fq) const {}
    __device__ __forceinline__ void operator()(const f32x4 (&acc)[2][2][4][2], const Unit& u, int wr, int wc, int fr, int fq) const {
        float* rowp = O + (size_t)(u.pm * BM + wr * 64 + fr) * ldc + (u.pn * BM + wc * 32 + 4 * fq);
#pragma unroll
        for (int ai = 0; ai < 2; ++ai) {
#pragma unroll
            for (int m = 0; m < 4; ++m) {
#pragma unroll
                for (int bj = 0; bj < 2; ++bj)
#pragma unroll
                    for (int n = 0; n < 2; ++n) *(f32x4*)(rowp + bj * HALF + n * 16) = acc[ai][bj][m][n];
                rowp += (size_t)16 * ldc; asm volatile("" : "+v"(rowp) :: "memory"); }
            rowp += (size_t)64 * ldc; }
    }
};
struct EpiMerge {
    static constexpr bool PERM = true, DUAL = true, AFTER_DRAIN = false;
    bf16_t* O; int ldc; const bf16_t* GA; const bf16_t* GB; int ldg;
    __device__ __forceinline__ void mid(f32x4 (&acc)[2][2][4][2], const Unit& u, int wr, int wc, int fr, int fq) const {
        const int row0 = u.pm * BM + wr * 64 + fr; const int col0 = u.pn * BM + wc * 32 + 8 * fq;
#pragma unroll
        for (int ai = 0; ai < 2; ++ai)
#pragma unroll
            for (int m = 0; m < 4; ++m) { const size_t ro = (size_t)(row0 + ai * HALF + m * 16) * ldg + col0;
#pragma unroll
                for (int bj = 0; bj < 2; ++bj) { const u32x4 ga = *(const u32x4*)(GA + ro + bj * HALF), gb = *(const u32x4*)(GB + ro + bj * HALF);
#pragma unroll
                    for (int e = 0; e < 4; ++e) { const unsigned wa = ga[e], wb = gb[e];
                        const float r0 = (1.f + __expf(-bf_lo(wb))) / (1.f + __expf(-bf_lo(wa))), r1 = (1.f + __expf(-bf_hi(wb))) / (1.f + __expf(-bf_hi(wa)));
                        if (e < 2) { acc[ai][bj][m][0][2 * e] *= r0; acc[ai][bj][m][0][2 * e + 1] *= r1; } else { acc[ai][bj][m][1][2 * (e - 2)] *= r0; acc[ai][bj][m][1][2 * (e - 2) + 1] *= r1; } } } }
    }
    __device__ __forceinline__ void operator()(const f32x4 (&acc)[2][2][4][2], const Unit& u, int wr, int wc, int fr, int fq) const {
        const int row0 = u.pm * BM + wr * 64 + fr; const int col0 = u.pn * BM + wc * 32 + 8 * fq;
#pragma unroll
        for (int ai = 0; ai < 2; ++ai)
#pragma unroll
            for (int m = 0; m < 4; ++m) { const size_t ro = (size_t)(row0 + ai * HALF + m * 16) * ldg + col0; bf16_t* rowp = O + (size_t)(row0 + ai * HALF + m * 16) * ldc + col0;
#pragma unroll
                for (int bj = 0; bj < 2; ++bj) { const u32x4 gb = *(const u32x4*)(GB + ro + bj * HALF); f32x4 v0 = acc[ai][bj][m][0], v1 = acc[ai][bj][m][1];
                    float s[8];
#pragma unroll
                    for (int e = 0; e < 4; ++e) { s[2 * e] = 1.f / (1.f + __expf(-bf_lo(gb[e]))); s[2 * e + 1] = 1.f / (1.f + __expf(-bf_hi(gb[e]))); }
                    u32x4 w; w.x = cvt_pk_bf16(v0[0] * s[0], v0[1] * s[1]); w.y = cvt_pk_bf16(v0[2] * s[2], v0[3] * s[3]); w.z = cvt_pk_bf16(v1[0] * s[4], v1[1] * s[5]); w.w = cvt_pk_bf16(v1[2] * s[6], v1[3] * s[7]);
                    *(u32x4*)(rowp + bj * HALF) = w; } }
    }
};

struct EpiYb {
    static constexpr bool PERM = true, DUAL = false, AFTER_DRAIN = false;
    bf16_t* O; int ldc; const bf16_t* GB; int ldg;
    __device__ __forceinline__ void mid(f32x4 (&acc)[2][2][4][2], const Unit& u, int wr, int wc, int fr, int fq) const {}
    __device__ __forceinline__ void operator()(const f32x4 (&acc)[2][2][4][2], const Unit& u, int wr, int wc, int fr, int fq) const {
        const int row0 = u.pm * BM + wr * 64 + fr; const int col0 = u.pn * BM + wc * 32 + 8 * fq;
        u32x4 cgb[2], ngb[2];
        { const size_t ro = (size_t)row0 * ldg + col0;
#pragma unroll
          for (int bj = 0; bj < 2; ++bj) cgb[bj] = *(const u32x4*)(GB + ro + bj * HALF); }
#pragma unroll
        for (int g = 0; g < 8; ++g) { const int ai = g >> 2, m = g & 3;
            if (g < 7) { const size_t ro = (size_t)(row0 + ((g + 1) >> 2) * HALF + ((g + 1) & 3) * 16) * ldg + col0;
#pragma unroll
                for (int bj = 0; bj < 2; ++bj) ngb[bj] = *(const u32x4*)(GB + ro + bj * HALF); }
            bf16_t* rowp = O + (size_t)(row0 + ai * HALF + m * 16) * ldc + col0;
#pragma unroll
            for (int bj = 0; bj < 2; ++bj) { const u32x4 gb = cgb[bj]; const f32x4 v0 = acc[ai][bj][m][0], v1 = acc[ai][bj][m][1];
                float s[8];
#pragma unroll
                for (int e = 0; e < 4; ++e) { s[2 * e] = __builtin_amdgcn_rcpf(1.f + __expf(-bf_lo(gb[e]))); s[2 * e + 1] = __builtin_amdgcn_rcpf(1.f + __expf(-bf_hi(gb[e]))); }
                u32x4 w; w.x = cvt_pk_bf16(v0[0] * s[0], v0[1] * s[1]); w.y = cvt_pk_bf16(v0[2] * s[2], v0[3] * s[3]); w.z = cvt_pk_bf16(v1[0] * s[4], v1[1] * s[5]); w.w = cvt_pk_bf16(v1[2] * s[6], v1[3] * s[7]);
                *(u32x4*)(rowp + bj * HALF) = w; }
#pragma unroll
            for (int bj = 0; bj < 2; ++bj) cgb[bj] = ngb[bj];
        }
    }
};
struct EpiMerge2 {
    static constexpr bool PERM = true, DUAL = false, AFTER_DRAIN = false;
    bf16_t* O; int ldc; const bf16_t* GA; const bf16_t* YB; int ldg;
    __device__ __forceinline__ void mid(f32x4 (&acc)[2][2][4][2], const Unit& u, int wr, int wc, int fr, int fq) const {}
    __device__ __forceinline__ void operator()(const f32x4 (&acc)[2][2][4][2], const Unit& u, int wr, int wc, int fr, int fq) const {
        const int row0 = u.pm * BM + wr * 64 + fr; const int col0 = u.pn * BM + wc * 32 + 8 * fq;
        u32x4 cga[2], cyb[2], nga[2], nyb[2];
        { const size_t ro = (size_t)row0 * ldg + col0;
#pragma unroll
          for (int bj = 0; bj < 2; ++bj) { cga[bj] = *(const u32x4*)(GA + ro + bj * HALF); cyb[bj] = *(const u32x4*)(YB + ro + bj * HALF); } }
#pragma unroll
        for (int g = 0; g < 8; ++g) { const int ai = g >> 2, m = g & 3;
            if (g < 7) { const size_t ro = (size_t)(row0 + ((g + 1) >> 2) * HALF + ((g + 1) & 3) * 16) * ldg + col0;
#pragma unroll
                for (int bj = 0; bj < 2; ++bj) { nga[bj] = *(const u32x4*)(GA + ro + bj * HALF); nyb[bj] = *(const u32x4*)(YB + ro + bj * HALF); } }
            bf16_t* rowp = O + (size_t)(row0 + ai * HALF + m * 16) * ldc + col0;
#pragma unroll
            for (int bj = 0; bj < 2; ++bj) { const u32x4 ga = cga[bj], yb = cyb[bj]; const f32x4 v0 = acc[ai][bj][m][0], v1 = acc[ai][bj][m][1];
                float o[8];
#pragma unroll
                for (int e = 0; e < 4; ++e) { const float a0 = (e < 2) ? v0[2 * e] : v1[2 * (e - 2)], a1 = (e < 2) ? v0[2 * e + 1] : v1[2 * (e - 2) + 1];
                    o[2 * e] = a0 * __builtin_amdgcn_rcpf(1.f + __expf(-bf_lo(ga[e]))) + bf_lo(yb[e]); o[2 * e + 1] = a1 * __builtin_amdgcn_rcpf(1.f + __expf(-bf_hi(ga[e]))) + bf_hi(yb[e]); }
                u32x4 w; w.x = cvt_pk_bf16(o[0], o[1]); w.y = cvt_pk_bf16(o[2], o[3]); w.z = cvt_pk_bf16(o[4], o[5]); w.w = cvt_pk_bf16(o[6], o[7]);
                *(u32x4*)(rowp + bj * HALF) = w; }
#pragma unroll
            for (int bj = 0; bj < 2; ++bj) { cga[bj] = nga[bj]; cyb[bj] = nyb[bj]; }
        }
    }
};
struct RmsExchange {
    float* slots;
    unsigned* cnt;
    __device__ __forceinline__ void run(const f32x4 (&v)[2][2][4][2], const Unit& u, int wr, int wc, int fr, int fq, PG8_LAS unsigned char* lds, int wid, int lane) const {
        PG8_LAS float* P = (PG8_LAS float*)lds;
        PG8_LAS float* S = (PG8_LAS float*)(lds + 4096);
#pragma unroll
        for (int ai = 0; ai < 2; ++ai)
#pragma unroll
            for (int m = 0; m < 4; ++m) { float s = 0.f;
#pragma unroll
                for (int bj = 0; bj < 2; ++bj)
#pragma unroll
                    for (int n = 0; n < 2; ++n) { const f32x4 x = v[ai][bj][m][n]; s += (x[0] * x[0] + x[1] * x[1]) + (x[2] * x[2] + x[3] * x[3]); }
                s += __shfl_xor(s, 16); s += __shfl_xor(s, 32);
                if (fq == 0) P[(ai * HALF + wr * 64 + m * 16 + fr) * 4 + wc] = s; }
        asm volatile("s_waitcnt vmcnt(0) lgkmcnt(0)" ::: "memory"); __builtin_amdgcn_s_barrier(); asm volatile("" ::: "memory");
        const int row = wid * 64 + lane;
        if (wid < 4) {
            const f32x4 p = *(const PG8_LAS f32x4*)(P + row * 4);
            __hip_atomic_store(slots + ((size_t)(u.pm * BM + row) * 4 + u.pn), (p[0] + p[1]) + (p[2] + p[3]), __ATOMIC_RELAXED, __HIP_MEMORY_SCOPE_AGENT);
            asm volatile("s_waitcnt vmcnt(0)" ::: "memory");
            if (lane == 0) __hip_atomic_fetch_add(cnt + 16 * u.pm, 1u, __ATOMIC_RELAXED, __HIP_MEMORY_SCOPE_AGENT);
        }
        if (wid == 0) {
            unsigned sp = 0;
            while ((unsigned)__builtin_amdgcn_readfirstlane(__hip_atomic_load(cnt + 16 * u.pm, __ATOMIC_RELAXED, __HIP_MEMORY_SCOPE_AGENT)) < 16u) { __builtin_amdgcn_s_sleep(1); if (++sp > (1u << 22)) break; }
            __builtin_amdgcn_fence(__ATOMIC_ACQUIRE, "agent");
        }
        asm volatile("s_waitcnt vmcnt(0) lgkmcnt(0)" ::: "memory"); __builtin_amdgcn_s_barrier(); asm volatile("" ::: "memory");
        if (wid < 4) {
            const float* sl = slots + (size_t)(u.pm * BM + row) * 4; float t = 0.f;
#pragma unroll
            for (int k = 0; k < 4; ++k) t += __hip_atomic_load(sl + k, __ATOMIC_RELAXED, __HIP_MEMORY_SCOPE_AGENT);
            S[row] = rsqrtf(t * (1.0f / 1024.0f) + 1e-6f);
        }
        asm volatile("s_waitcnt vmcnt(0) lgkmcnt(0)" ::: "memory"); __builtin_amdgcn_s_barrier(); asm volatile("" ::: "memory");
    }
};
struct EpiRmsRes {
    static constexpr bool PERM = true, DUAL = false, AFTER_DRAIN = true;
    float* x; const float* gpost; const float* gnext; bf16_t* xn; RmsExchange e1, e2;
    __device__ __forceinline__ void mid(f32x4 (&acc)[2][2][4][2], const Unit& u, int wr, int wc, int fr, int fq) const {}
    __device__ __forceinline__ void operator()(const f32x4 (&acc)[2][2][4][2], const Unit& u, int wr, int wc, int fr, int fq) const {}
    __device__ __forceinline__ void fused(f32x4 (&acc)[2][2][4][2], const Unit& u, int wr, int wc, int fr, int fq, PG8_LAS unsigned char* lds, int wid, int lane) const {
        const PG8_LAS float* S = (const PG8_LAS float*)(lds + 4096);
        const int col0 = u.pn * BM + wc * 32 + 8 * fq;
        bf16_t* xb = (bf16_t*)x;
        u32x4 pre[2][4][2];
#pragma unroll
        for (int ai = 0; ai < 2; ++ai)
#pragma unroll
            for (int m = 0; m < 4; ++m) { const bf16_t* xp = xb + (size_t)(u.pm * BM + ai * HALF + wr * 64 + m * 16 + fr) * 2048 + col0;
#pragma unroll
                for (int bj = 0; bj < 2; ++bj) pre[ai][m][bj] = *(const u32x4*)(xp + bj * HALF); }
        e1.run(acc, u, wr, wc, fr, fq, lds, wid, lane);
        f32x4 g[2][2];
#pragma unroll
        for (int bj = 0; bj < 2; ++bj)
#pragma unroll
            for (int n = 0; n < 2; ++n) g[bj][n] = *(const f32x4*)(gpost + col0 + bj * HALF + n * 4);
#pragma unroll
        for (int ai = 0; ai < 2; ++ai)
#pragma unroll
            for (int m = 0; m < 4; ++m) { const int r = ai * HALF + wr * 64 + m * 16 + fr; const float sr = S[r];
#pragma unroll
                for (int bj = 0; bj < 2; ++bj) { const u32x4 pw = pre[ai][m][bj];
                    const f32x4 x0 = {bf_lo(pw.x), bf_hi(pw.x), bf_lo(pw.y), bf_hi(pw.y)}, x1 = {bf_lo(pw.z), bf_hi(pw.z), bf_lo(pw.w), bf_hi(pw.w)};
                    const f32x4 o0 = x0 + acc[ai][bj][m][0] * sr * g[bj][0], o1 = x1 + acc[ai][bj][m][1] * sr * g[bj][1]; acc[ai][bj][m][0] = o0; acc[ai][bj][m][1] = o1;
                    if (gnext) { u32x4 w; w.x = cvt_pk_bf16(o0[0], o0[1]); w.y = cvt_pk_bf16(o0[2], o0[3]); w.z = cvt_pk_bf16(o1[0], o1[1]); w.w = cvt_pk_bf16(o1[2], o1[3]);
                        *(u32x4*)(xb + (size_t)(u.pm * BM + r) * 2048 + col0 + bj * HALF) = w; }
                    else { float* op = x + (size_t)(u.pm * BM + r) * 1024 + col0 + bj * HALF; *(f32x4*)op = o0; *(f32x4*)(op + 4) = o1; } } }
        if (gnext) {
            e2.run(acc, u, wr, wc, fr, fq, lds, wid, lane);
#pragma unroll
            for (int bj = 0; bj < 2; ++bj)
#pragma unroll
                for (int n = 0; n < 2; ++n) g[bj][n] = *(const f32x4*)(gnext + col0 + bj * HALF + n * 4);
#pragma unroll
            for (int ai = 0; ai < 2; ++ai)
#pragma unroll
                for (int m = 0; m < 4; ++m) { const int r = ai * HALF + wr * 64 + m * 16 + fr; const float sr = S[r]; bf16_t* op = xn + (size_t)(u.pm * BM + r) * 1024 + col0;
#pragma unroll
                    for (int bj = 0; bj < 2; ++bj) { const f32x4 o0 = acc[ai][bj][m][0] * sr * g[bj][0], o1 = acc[ai][bj][m][1] * sr * g[bj][1];
                        u32x4 w; w.x = cvt_pk_bf16(o0[0], o0[1]); w.y = cvt_pk_bf16(o0[2], o0[3]); w.z = cvt_pk_bf16(o1[0], o1[1]); w.w = cvt_pk_bf16(o1[2], o1[3]);
                        *(u32x4*)(op + bj * HALF) = w; } }
        }
    }
};
template <class Epi, class Sched, bool ALIGN_EPI = false, bool SP2 = false>
__device__ __forceinline__ void gemm_phase(PG8_LAS unsigned char* lds, const Gemm g, const Sched& S, const Epi& E) {
    int tid_ = threadIdx.x; asm volatile("" : "+v"(tid_)); const int tid = tid_, wid = __builtin_amdgcn_readfirstlane(tid >> 6), lane = tid & 63, wr = wid >> 2, wc = wid & 3, fr = lane & 15, fq = lane >> 4;
    const int K = g.K, nt = K / BK, lda = g.lda;
    unsigned voffA[2], voffB[2];
#pragma unroll
    for (int i = 0; i < 2; ++i) { int R, C; stage_rc(tid * 16 + i * 8192, R, C); const int Rb = Epi::PERM ? ((R & ~31) + perm32(R & 31)) : R;
        voffA[i] = (unsigned)(R * lda + C) * 2u; voffB[i] = (unsigned)(Rb * K + C) * 2u; }
    const size_t kstep = (size_t)(BK * 2);
    const size_t hstepA = (size_t)HALF * lda * 2, hstepB = (size_t)HALF * K * 2;
    const size_t tstepA = 2 * hstepA, tstepB = 2 * hstepB;
    const unsigned ldsw = (unsigned)wid * 1024u;
    const int aoff = lds_byte(wr * 64 + fr, fq * 8), boff = lds_byte(wc * 32 + fr, fq * 8);
#define PG8_SA(b, h) (((b) * 2 + (h)) * HTB)
#define PG8_SB(b, h) ((4 + (b) * 2 + (h)) * HTB)
#define PG8_STAGE(bufoff, gbase, voff) do { _Pragma("unroll") for (int _i = 0; _i < 2; ++_i) \
        __builtin_amdgcn_global_load_lds((const unsigned*)((const char*)(gbase) + (voff)[_i]), (PG8_LAS unsigned*)(lds + (bufoff) + ldsw + _i * 8192), 16, 0, 0); } while (0)
#define PG8_LDA(dst, b, h) do { _Pragma("unroll") for (int m = 0; m < 4; ++m) _Pragma("unroll") for (int k = 0; k < 2; ++k) dst[m][k] = *(const PG8_LAS bf16x8*)(lds + PG8_SA(b, h) + aoff + m * 2048 + k * 1024); } while (0)
#define PG8_LDB(dst, b, h) do { _Pragma("unroll") for (int n = 0; n < 2; ++n) _Pragma("unroll") for (int k = 0; k < 2; ++k) dst[n][k] = *(const PG8_LAS bf16x8*)(lds + PG8_SB(b, h) + boff + n * 2048 + k * 1024); } while (0)
#define PG8_MMA(ai, bj, At, Bt) do { __builtin_amdgcn_s_setprio(1); _Pragma("unroll") for (int m = 0; m < 4; ++m) _Pragma("unroll") for (int n = 0; n < 2; ++n) _Pragma("unroll") for (int k = 0; k < 2; ++k) \
        acc[ai][bj][m][n] = __builtin_amdgcn_mfma_f32_16x16x32_bf16(Bt[n][k], At[m][k], acc[ai][bj][m][n], 0, 0, 0); __builtin_amdgcn_s_setprio(0); } while (0)
#define PG8_WAIT_V(n) asm volatile("s_waitcnt vmcnt(" #n ")" ::: "memory")
#define PG8_WAIT_L(n) asm volatile("s_waitcnt lgkmcnt(" #n ")" ::: "memory")
#define PG8_BAR __builtin_amdgcn_s_barrier()
#define PG8_SCHED __builtin_amdgcn_sched_barrier(0)
    Unit cur, nxt; int ui = 0;
    if (!S.next(0, cur)) return;
    f32x4 acc[2][2][4][2];
#pragma unroll
    for (int a = 0; a < 2; ++a)
#pragma unroll
        for (int b = 0; b < 2; ++b)
#pragma unroll
            for (int m = 0; m < 4; ++m)
#pragma unroll
                for (int n = 0; n < 2; ++n) acc[a][b][m][n] = (f32x4){0.f, 0.f, 0.f, 0.f};
    bf16x8 At[4][2], B0[2][2], B1[2][2];
    const char* cA = (const char*)(cur.src ? g.A2 : g.A) + (size_t)cur.pm * tstepA; const char* cB = (const char*)(cur.src ? g.Bt2 : g.Bt) + (size_t)cur.pn * tstepB;
    if constexpr (SP2) {
        PG8_STAGE(PG8_SB(0, 0), cB, voffB); PG8_STAGE(PG8_SB(0, 1), cB + hstepB, voffB); PG8_STAGE(PG8_SA(0, 0), cA, voffA); PG8_STAGE(PG8_SA(0, 1), cA + hstepA, voffA);
        if (wr == 1) PG8_BAR;
        PG8_WAIT_V(2); PG8_BAR;
        PG8_STAGE(PG8_SB(1, 0), cB + kstep, voffB); PG8_STAGE(PG8_SA(1, 0), cA + kstep, voffA); PG8_STAGE(PG8_SB(1, 1), cB + hstepB + kstep, voffB);
        PG8_WAIT_V(6); PG8_BAR;
    } else {
        PG8_STAGE(PG8_SB(0, 0), cB, voffB); PG8_STAGE(PG8_SA(0, 0), cA, voffA); PG8_STAGE(PG8_SB(0, 1), cB + hstepB, voffB); PG8_STAGE(PG8_SA(0, 1), cA + hstepA, voffA);
        if (wr == 1) PG8_BAR;
        PG8_WAIT_V(4); PG8_BAR;
        PG8_STAGE(PG8_SB(1, 0), cB + kstep, voffB); PG8_STAGE(PG8_SA(1, 0), cA + kstep, voffA); PG8_STAGE(PG8_SB(1, 1), cB + hstepB + kstep, voffB);
        PG8_WAIT_V(6); PG8_BAR;
    }
    for (;;) {
        const bool has_next = S.next(ui + 1, nxt);
        const char* nA = has_next ? (const char*)(nxt.src ? g.A2 : g.A) + (size_t)nxt.pm * tstepA : cA; const char* nB = has_next ? (const char*)(nxt.src ? g.Bt2 : g.Bt) + (size_t)nxt.pn * tstepB : cB;
        for (int t = 0; t < nt; t += 2) {
            const bool last = (t == nt - 2);
            const char* a1 = cA + (size_t)(t + 1) * kstep;
            const char* a2 = last ? nA : cA + (size_t)(t + 2) * kstep; const char* b2 = last ? nB : cB + (size_t)(t + 2) * kstep;
            const char* a3 = a2 + kstep; const char* b3 = b2 + kstep;
            if constexpr (SP2) {
            PG8_LDB(B0, 0, 0); PG8_LDB(B1, 0, 1); PG8_SCHED; PG8_LDA(At, 0, 0); PG8_STAGE(PG8_SA(1, 1), a1 + hstepA, voffA);
            PG8_WAIT_V(8); PG8_WAIT_L(0); PG8_BAR; PG8_MMA(0, 0, At, B0); PG8_MMA(0, 1, At, B1); PG8_BAR; PG8_SCHED;
            PG8_LDA(At, 0, 1); PG8_STAGE(PG8_SB(0, 0), b2, voffB); PG8_STAGE(PG8_SB(0, 1), b2 + hstepB, voffB); PG8_STAGE(PG8_SA(0, 0), a2, voffA);
            PG8_WAIT_V(8); PG8_WAIT_L(0); PG8_BAR; PG8_MMA(1, 0, At, B0); PG8_MMA(1, 1, At, B1); PG8_BAR; PG8_SCHED;
            PG8_LDB(B0, 1, 0); PG8_LDB(B1, 1, 1); PG8_SCHED; PG8_LDA(At, 1, 0); PG8_STAGE(PG8_SA(0, 1), a2 + hstepA, voffA);
            PG8_WAIT_V(8); PG8_WAIT_L(0); PG8_BAR; PG8_MMA(0, 0, At, B0); PG8_MMA(0, 1, At, B1); PG8_BAR; PG8_SCHED;
            PG8_LDA(At, 1, 1); PG8_STAGE(PG8_SB(1, 0), b3, voffB); PG8_STAGE(PG8_SB(1, 1), b3 + hstepB, voffB); PG8_STAGE(PG8_SA(1, 0), a3, voffA);
            PG8_WAIT_V(8); PG8_WAIT_L(0); PG8_BAR; PG8_MMA(1, 0, At, B0); PG8_MMA(1, 1, At, B1); PG8_BAR; PG8_SCHED;
            } else {
            PG8_LDB(B0, 0, 0); PG8_SCHED; PG8_LDA(At, 0, 0); PG8_STAGE(PG8_SA(1, 1), a1 + hstepA, voffA);
            PG8_WAIT_L(8); PG8_BAR; PG8_WAIT_L(0); PG8_MMA(0, 0, At, B0); PG8_BAR; PG8_SCHED;
            PG8_LDB(B1, 0, 1); PG8_STAGE(PG8_SB(0, 0), b2, voffB);
            PG8_BAR; PG8_WAIT_L(0); PG8_MMA(0, 1, At, B1); PG8_BAR;
            PG8_LDA(At, 0, 1); PG8_STAGE(PG8_SA(0, 0), a2, voffA);
            PG8_BAR; PG8_WAIT_L(0); PG8_MMA(1, 0, At, B0); PG8_BAR; PG8_SCHED;
            PG8_STAGE(PG8_SB(0, 1), b2 + hstepB, voffB);
            PG8_WAIT_V(6); PG8_BAR; PG8_MMA(1, 1, At, B1); PG8_BAR;
            PG8_LDB(B0, 1, 0); PG8_SCHED; PG8_LDA(At, 1, 0); PG8_STAGE(PG8_SA(0, 1), a2 + hstepA, voffA);
            PG8_WAIT_L(8); PG8_BAR; PG8_WAIT_L(0); PG8_MMA(0, 0, At, B0); PG8_BAR; PG8_SCHED;
            PG8_LDB(B1, 1, 1); PG8_STAGE(PG8_SB(1, 0), b3, voffB);
            PG8_BAR; PG8_WAIT_L(0); PG8_MMA(0, 1, At, B1); PG8_BAR;
            PG8_LDA(At, 1, 1); PG8_STAGE(PG8_SA(1, 0), a3, voffA);
            PG8_BAR; PG8_WAIT_L(0); PG8_MMA(1, 0, At, B0); PG8_BAR; PG8_SCHED;
            PG8_STAGE(PG8_SB(1, 1), b3 + hstepB, voffB);
            PG8_WAIT_V(6); PG8_BAR; PG8_MMA(1, 1, At, B1); PG8_BAR;
            }
        }
        if constexpr (ALIGN_EPI) { if (wr == 0) PG8_BAR; }
        const bool midu = Epi::DUAL && cur.src == 0;
        if constexpr (!Epi::AFTER_DRAIN) { if (midu) E.mid(acc, cur, wr, wc, fr, fq); else E(acc, cur, wr, wc, fr, fq); }
        if (!has_next) break;
        if (!midu) {
#pragma unroll
        for (int a = 0; a < 2; ++a)
#pragma unroll
            for (int b = 0; b < 2; ++b)
#pragma unroll
                for (int m = 0; m < 4; ++m)
#pragma unroll
                    for (int n = 0; n < 2; ++n) acc[a][b][m][n] = (f32x4){0.f, 0.f, 0.f, 0.f};
        }
        cur = nxt; cA = nA; cB = nB; ++ui;
        if constexpr (ALIGN_EPI) { if (wr == 1) PG8_BAR; }
    }
    PG8_WAIT_V(0);
    if constexpr (!ALIGN_EPI) { if (wr == 0) PG8_BAR; }
    PG8_BAR;
    if constexpr (Epi::AFTER_DRAIN) E.fused(acc, cur, wr, wc, fr, fq, lds, wid, lane);
#undef PG8_SA
#undef PG8_SB
#undef PG8_STAGE
#undef PG8_LDA
#undef PG8_LDB
#undef PG8_MMA
#undef PG8_WAIT_V
#undef PG8_WAIT_L
#undef PG8_BAR
#undef PG8_SCHED
}
}

#define GAS __attribute__((address_space(1)))
#define LAS __attribute__((address_space(3)))
typedef unsigned short bf16;
typedef unsigned v4u __attribute__((ext_vector_type(4)));
typedef unsigned v2u __attribute__((ext_vector_type(2)));
typedef float f32x4 __attribute__((ext_vector_type(4)));
typedef short bf16x8 __attribute__((ext_vector_type(8)));
constexpr int NWAVES = 8, NTHR = 512;
constexpr int BATCH = 2, SEQ = 8192, D = 1024, FF = 4096, DEPTH = 4, M = BATCH * SEQ;
constexpr int DIN = 7440, DINP = 7680;
constexpr int C_DNQ = 0, C_DNK = 1024, C_DNV = 2048, C_DNZ = 3072, C_SWQ = 4096, C_GA = 5120, C_GB = 6144, C_SWK = 7168, C_SWV = 7296, C_DNB = 7424, C_DNA = 7432;
constexpr float EPS = 1e-6f;
constexpr size_t MiB = 1u << 20;
constexpr size_t WS_WIN = 1 * MiB, WS_WUPDN = 16 * MiB, WS_WUPSW = 18 * MiB, WS_WO = 20 * MiB, WS_WFF1 = 22 * MiB, WS_WFF2 = 30 * MiB, WS_ROPE = 38 * MiB;
constexpr size_t WS_PROJ = 40 * MiB, WS_H = 40 * MiB, WS_XN = 280 * MiB, WS_YF = 312 * MiB, WS_MIX = 376 * MiB, WS_END = 456 * MiB;
constexpr int LDS_BYTES = 147456;

typedef float f32x2_t __attribute__((ext_vector_type(2)));
typedef __bf16 bf16x2_t __attribute__((ext_vector_type(2)));
__device__ __forceinline__ unsigned pk2(float lo, float hi) { const f32x2_t v = {lo, hi}; return __builtin_bit_cast(unsigned, __builtin_convertvector(v, bf16x2_t)); }
__device__ __forceinline__ unsigned f2bf(float f) { return pk2(f, 0.f) & 0xffffu; }
__device__ __forceinline__ float bflo(unsigned w) { return __uint_as_float(w << 16); }
__device__ __forceinline__ float bfhi(unsigned w) { return __uint_as_float(w & 0xffff0000u); }
__device__ __forceinline__ float bf1(bf16 h) { return __uint_as_float((unsigned)h << 16); }
__device__ __forceinline__ float wave_sum(float v) {
#pragma unroll
    for (int o = 1; o < 64; o <<= 1) v += __shfl_xor(v, o);
    return v;
}
__device__ __forceinline__ float wave_max(float v) {
#pragma unroll
    for (int o = 1; o < 64; o <<= 1) v = fmaxf(v, __shfl_xor(v, o));
    return v;
}
__device__ __forceinline__ float sigmoidf_(float x) { return __builtin_amdgcn_rcpf(1.f + __expf(-x)); }
__device__ __forceinline__ float siluf_(float x) { return x * __builtin_amdgcn_rcpf(1.f + __expf(-x)); }

struct Frame {
    LAS unsigned char* lds;
    int tid, lane, wave, G, bid;
};
__device__ __forceinline__ LAS unsigned char* lds_base() { extern __shared__ __attribute__((aligned(16))) unsigned char lds_dyn[]; return (LAS unsigned char*)lds_dyn; }
__device__ __forceinline__ Frame mkframe() {
    Frame F; F.lds = lds_base(); int tid = threadIdx.x; asm volatile("" : "+v"(tid)); int bid = blockIdx.x; asm volatile("" : "+s"(bid)); int G = gridDim.x; asm volatile("" : "+s"(G));
    F.tid = tid; F.lane = tid & 63; F.wave = __builtin_amdgcn_readfirstlane(tid >> 6); F.G = G; F.bid = bid; return F; }
typedef __attribute__((address_space(4))) const unsigned char* kargp_t;
__device__ __forceinline__ kargp_t kargs() { kargp_t p = (kargp_t)__builtin_amdgcn_kernarg_segment_ptr(); asm volatile("" : "+s"(p)); return p; }
__device__ __forceinline__ const float* inp(int k) { return *(const float* __attribute__((address_space(4))) const*)(kargs() + 8 * k); }
__device__ __forceinline__ float* outp() { return *(float* __attribute__((address_space(4))) const*)(kargs() + 8 * 17); }
__device__ __forceinline__ unsigned char* wsp() { return *(unsigned char* __attribute__((address_space(4))) const*)(kargs() + 8 * 18); }

__device__ __forceinline__ int orig_col(int nc) {
    if (nc < 4096) return nc;
    if (nc < 5120) return nc - 4096 + 4112;
    if (nc < 6144) return nc - 5120 + 5392;
    if (nc < 7168) return nc - 6144 + 6416;
    if (nc < 7296) return nc - 7168 + 5136;
    if (nc < 7424) return nc - 7296 + 5264;
    if (nc < 7440) return nc - 7424 + 4096;
    return -1;
}
template <bool PERMW>
__device__ __forceinline__ void transpose_item(const float* W, int K, int ldw, int nblk, bf16* WT, LAS float* scr, int item, int lane) {
    const int kb = item / nblk, nb = item % nblk, k0 = 64 * kb, n0 = 32 * nb;
    const int ncol = n0 + (lane & 31); const int oc = PERMW ? orig_col(ncol) : ncol;
    float wv[32];
    { const float* wp = W + (size_t)(k0 + (lane >> 5)) * ldw + (oc >= 0 ? oc : 0);
#pragma unroll
      for (int i = 0; i < 32; ++i) wv[i] = wp[(size_t)(2 * i) * ldw]; }
#pragma unroll
    for (int i = 0; i < 32; ++i) scr[(2 * i + (lane >> 5)) * 33 + (lane & 31)] = (oc >= 0) ? wv[i] : 0.f;
    asm volatile("s_waitcnt lgkmcnt(0)" ::: "memory");
    const int c = lane & 7;
#pragma unroll
    for (int j = 0; j < 4; ++j) { const int n = (lane >> 3) + 8 * j; const LAS float* s = scr + (8 * c) * 33 + n;
        v4u o; o.x = pk2(s[0 * 33], s[1 * 33]); o.y = pk2(s[2 * 33], s[3 * 33]); o.z = pk2(s[4 * 33], s[5 * 33]); o.w = pk2(s[6 * 33], s[7 * 33]);
        *(v4u*)(WT + (size_t)(n0 + n) * K + k0 + 8 * c) = o; }
    asm volatile("s_waitcnt lgkmcnt(0)" ::: "memory");
}
__device__ __forceinline__ void phase_convert(Frame& F_, int lrest, int lin, int nskip) {
    Frame F = mkframe();
    LAS float* scr = (LAS float*)(F.lds + F.wave * 16384);
    const int gw = (F.bid - nskip) * NWAVES + F.wave, NGW = (F.G - nskip) * NWAVES;
    constexpr int I_IN = 16 * (DINP / 32), I_SQ = 16 * 32, I_F1 = 16 * (FF / 32), I_F2 = 64 * 32;
    const int n_in = (lin >= 0) ? I_IN : 0, n_rest = (lrest >= 0) ? 3 * I_SQ + I_F1 + I_F2 : 0;
    for (int it = gw; it < n_in + n_rest; it += NGW) {
        int r = it;
        if (r < n_in) { transpose_item<true>(inp(3) + (size_t)lin * D * DIN, D, DIN, DINP / 32, (bf16*)(wsp() + WS_WIN), scr, r, F.lane); continue; } r -= n_in;
        const int l = lrest;
        if (r < I_SQ) { transpose_item<false>(inp(9) + (size_t)l * D * D, D, D, 32, (bf16*)(wsp() + WS_WUPDN), scr, r, F.lane); continue; } r -= I_SQ;
        if (r < I_SQ) { transpose_item<false>(inp(10) + (size_t)l * D * D, D, D, 32, (bf16*)(wsp() + WS_WUPSW), scr, r, F.lane); continue; } r -= I_SQ;
        if (r < I_SQ) { transpose_item<false>(inp(11) + (size_t)l * D * D, D, D, 32, (bf16*)(wsp() + WS_WO), scr, r, F.lane); continue; } r -= I_SQ;
        if (r < I_F1) { transpose_item<false>(inp(14) + (size_t)l * D * FF, D, FF, FF / 32, (bf16*)(wsp() + WS_WFF1), scr, r, F.lane); continue; } r -= I_F1;
        transpose_item<false>(inp(15) + (size_t)l * FF * D, FF, D, 32, (bf16*)(wsp() + WS_WFF2), scr, r, F.lane);
    }
}
__device__ __forceinline__ void phase_rope(Frame& F_) {
    Frame F = mkframe();
    const int* pos = (const int*)inp(1); float* R = (float*)(wsp() + WS_ROPE);
    for (int i = F.bid * NTHR + F.tid; i < M * 8; i += F.G * NTHR) {
        const int m = i >> 3, j = i & 7;
        const float invf = exp2f(-(float)j * (0.125f * 18.931568569324174f));
        const float angf = (float)pos[m] * invf;
        const double a = (double)angf; const double n = rint(a * 0.15915494309189535);
        const float r = (float)(a - n * 6.283185307179586);
        R[m * 16 + j] = __cosf(r); R[m * 16 + 8 + j] = __sinf(r);
    }
}
__device__ __forceinline__ void phase_norm(Frame& F_, const float* y, const float* gpost, const float* xin, float* x, const float* gnext, bf16* XN) {
    Frame F = mkframe();
    const int gw = F.bid * NWAVES + F.wave, NGW = F.G * NWAVES;
    for (int m = gw; m < M; m += 2 * NGW) {
        f32x4 v[2][4];
#pragma unroll
        for (int q = 0; q < 2; ++q) { const f32x4* xr = (const f32x4*)(xin + (size_t)(m + q * NGW) * D) + F.lane;
#pragma unroll
            for (int j = 0; j < 4; ++j) v[q][j] = xr[64 * j]; }
#pragma unroll
        for (int q = 0; q < 2; ++q) { const int mm = m + q * NGW;
            v2u* xo = (v2u*)((bf16*)x + (size_t)mm * 2048) + F.lane;
#pragma unroll
            for (int j = 0; j < 4; ++j) { v2u w; w.x = pk2(v[q][j].x, v[q][j].y); w.y = pk2(v[q][j].z, v[q][j].w); xo[64 * j] = w; }
            float s = 0.f;
#pragma unroll
            for (int j = 0; j < 4; ++j) s += (v[q][j].x * v[q][j].x + v[q][j].y * v[q][j].y) + (v[q][j].z * v[q][j].z + v[q][j].w * v[q][j].w);
            const float r = rsqrtf(wave_sum(s) * (1.f / D) + EPS);
            v2u* o = (v2u*)(XN + (size_t)mm * D) + F.lane;
#pragma unroll
            for (int j = 0; j < 4; ++j) { const f32x4 g = ((const f32x4*)gnext)[F.lane + 64 * j]; v2u w; w.x = pk2(v[q][j].x * r * g.x, v[q][j].y * r * g.y); w.y = pk2(v[q][j].z * r * g.z, v[q][j].w * r * g.w); o[64 * j] = w; } }
    }
}
constexpr size_t WS_SUBCNT = 196608, WS_BAR = 65536, WS_XCNT = 131072, WS_XSLOT = 39 * MiB;
#define XB_TMO      128
#define XB_XCNT(j)  (256  + 64 * (j))
#define XB_XSUB(j)  (1280 + 64 * (j))
#define XB_XGEN(j)  (2304 + 64 * (j))
#define XB_TOP      3328
#define XB_TOPGEN   3392
#define XCD_BAR_WORDS 3456
#define XB_SPIN_CAP (1u << 22)
constexpr int LDS_BARST = LDS_BYTES - 16;
__device__ __forceinline__ unsigned xb_ld(unsigned* p)              { return __hip_atomic_load(p, __ATOMIC_RELAXED, __HIP_MEMORY_SCOPE_AGENT); }
__device__ __forceinline__ unsigned xb_add(unsigned* p, unsigned v) { return __hip_atomic_fetch_add(p, v, __ATOMIC_RELAXED, __HIP_MEMORY_SCOPE_AGENT); }
__device__ __forceinline__ unsigned xb_xcc_id() { return (unsigned)__builtin_amdgcn_s_getreg((3 << 11) | 20) & 0xFu; }
#define XB_SPIN(cond, bar) do { unsigned _sp = 0; while (cond) { __builtin_amdgcn_s_sleep(1); \
    if ((++_sp & 255u) == 0u) { if (xb_ld(&(bar)[XB_TMO])) break; if (_sp > XB_SPIN_CAP) { atomicAdd(&(bar)[XB_TMO], 1u); break; } } } } while (0)
__device__ __forceinline__ void xcd_barrier_post() {
    if (threadIdx.x == 0) { unsigned* bar = (unsigned*)(wsp() + WS_BAR); (void)xb_add(&bar[XB_XCNT(xb_xcc_id())], 1u); }
}
__device__ __forceinline__ void xcd_barrier_complete(unsigned* bar, unsigned x, unsigned& nloc, unsigned& nx) {
    const unsigned G = gridDim.x * gridDim.y * gridDim.z;
    unsigned sum, cnt, mine, sp = 0u;
    for (;;) {
        sum = 0u; cnt = 0u; mine = 0u;
#pragma unroll
        for (unsigned j = 0; j < 16; ++j) { const unsigned c = xb_ld(&bar[XB_XCNT(j)]); sum += c; cnt += (c > 0u) ? 1u : 0u; mine = (j == x) ? c : mine; }
        if (sum == G) break;
        __builtin_amdgcn_s_sleep(1);
        if ((++sp & 255u) == 0u) { if (xb_ld(&bar[XB_TMO])) break; if (sp > XB_SPIN_CAP) { atomicAdd(&bar[XB_TMO], 1u); break; } }
    }
    nloc = mine > 0u ? mine : 1u; nx = cnt > 0u ? cnt : 1u;
}
__device__ __forceinline__ void grid_bar() {
    asm volatile("s_waitcnt vmcnt(0)" ::: "memory");
    __syncthreads();
    if (threadIdx.x == 0) {
        unsigned* bar = (unsigned*)(wsp() + WS_BAR); const unsigned x = xb_xcc_id();
        volatile LAS unsigned* st = (volatile LAS unsigned*)(lds_base() + LDS_BARST);
        __builtin_amdgcn_s_waitcnt(0);
        unsigned nloc = st[0], nx = st[1];
        if (nloc == 0u) { xcd_barrier_complete(bar, x, nloc, nx); st[0] = nloc; st[1] = nx; }
        const unsigned old = xb_add(&bar[XB_XSUB(x)], 1u);
        const unsigned gen = old / nloc;
        if (old + 1u == (gen + 1u) * nloc) {
            __builtin_amdgcn_fence(__ATOMIC_RELEASE, "agent");
            asm volatile("s_waitcnt vmcnt(0)" ::: "memory");
            const unsigned og = xb_add(&bar[XB_TOP], 1u);
            const unsigned tg = og / nx;
            if (og + 1u == (tg + 1u) * nx) xb_add(&bar[XB_TOPGEN], 1u);
            else XB_SPIN(xb_ld(&bar[XB_TOPGEN]) == tg, bar);
            __builtin_amdgcn_fence(__ATOMIC_ACQUIRE, "agent");
            xb_add(&bar[XB_XGEN(x)], 1u);
            asm volatile("s_waitcnt vmcnt(0)" ::: "memory");
        } else {
            XB_SPIN(xb_ld(&bar[XB_XGEN(x)]) == gen, bar);
            __builtin_amdgcn_fence(__ATOMIC_ACQUIRE, "agent");
            asm volatile("s_waitcnt vmcnt(0)" ::: "memory");
        }
    }
    __syncthreads();
}

__device__ __forceinline__ void sub_bar(unsigned* cnt, unsigned n) {
    asm volatile("s_waitcnt vmcnt(0)" ::: "memory");
    __syncthreads();
    if (threadIdx.x == 0) {
        __builtin_amdgcn_fence(__ATOMIC_RELEASE, "agent");
        asm volatile("s_waitcnt vmcnt(0)" ::: "memory");
        xb_add(cnt, 1u);
        unsigned sp = 0; while (xb_ld(cnt) < n) { __builtin_amdgcn_s_sleep(1); if (++sp > XB_SPIN_CAP) break; }
        __builtin_amdgcn_fence(__ATOMIC_ACQUIRE, "agent");
        asm volatile("s_waitcnt vmcnt(0)" ::: "memory");
    }
    __syncthreads();
}
#define MFMA16(a, b, c) __builtin_amdgcn_mfma_f32_16x16x32_bf16(a, b, c, 0, 0, 0)
constexpr size_t WS_GL = 0, WS_W = 312 * MiB, WS_QD = 344 * MiB, WS_KDT = 376 * MiB, WS_UT = 408 * MiB, WS_AI = 440 * MiB;
typedef LAS unsigned short* lbf;
template <int PMODE>
__device__ __forceinline__ void dn_prep(Frame& F_, int l) {
    Frame F = mkframe();
    const bf16* PROJ = (const bf16*)(wsp() + WS_PROJ);
    lbf QS = (lbf)(F.lds), KS = (lbf)(F.lds + 17408), VT = (lbf)(F.lds + 34816), KGT = (lbf)(F.lds + 53248), KDT = (lbf)(F.lds + 71680), TB = (lbf)(F.lds + 107520);
    LAS float* LM = (LAS float*)(F.lds + 90112); LAS float* GC = (LAS float*)(F.lds + 116736); LAS float* BT = (LAS float*)(F.lds + 116992);
    const int lane = F.lane, wave = F.wave, fr = lane & 15, fq = lane >> 4;
    struct PrepIn { unsigned xr[3][11]; float cw[3][4][2]; bf16 a, b; };
#define PREP_LOAD(X, chx) do { const int ch_ = (chx), h_ = (ch_ >> 7) & 7, n_ = ch_ & 127, m0_ = (ch_ >> 10) * SEQ + n_ * 64; \
        X.a = PROJ[(size_t)(m0_ + lane) * DINP + C_DNA + h_]; X.b = PROJ[(size_t)(m0_ + lane) * DINP + C_DNB + h_]; \
        _Pragma("unroll") for (int ts = 0; ts < 3; ++ts) _Pragma("unroll") for (int j = 0; j < 11; ++j) { const int ii = 8 * wave - 3 + j; \
            X.xr[ts][j] = (n_ * 64 + ii >= 0) ? *(const unsigned*)(PROJ + (size_t)(m0_ + ii) * DINP + ts * 1024 + h_ * 128 + 2 * lane) : 0u; } \
        { const float* cwp = inp(4) + (size_t)l * 4 * 3072 + h_ * 128 + 2 * lane; \
          _Pragma("unroll") for (int ts = 0; ts < 3; ++ts) _Pragma("unroll") for (int j = 0; j < 4; ++j) { const f32x2_t c2_ = *(const f32x2_t*)(cwp + j * 3072 + ts * 1024); X.cw[ts][j][0] = c2_.x; X.cw[ts][j][1] = c2_.y; } } } while (0)
    PrepIn cur; unsigned eat = 0u;
    for (int ch = F.bid; ch < 2048; ch += F.G) {
        const int b = ch >> 10, h = (ch >> 7) & 7, n = ch & 127, m0 = b * SEQ + n * 64;
        PREP_LOAD(cur, ch);
        unsigned touch = 0u;
        if (ch + F.G < 2048 && F.tid < 402) { const int cn = ch + F.G, hn = (cn >> 7) & 7, nn = cn & 127, mn = (cn >> 10) * SEQ + nn * 64; const int rowt = F.tid / 6 - 3, ln = F.tid % 6;
            if (nn * 64 + rowt >= 0) touch = *(const unsigned*)(PROJ + (size_t)(mn + rowt) * DINP + (ln >> 1) * 1024 + hn * 128 + (ln & 1) * 64); }
        const float a_neg = -__expf(inp(5)[l * 8 + h]), dtb = inp(6)[l * 8 + h];
        float gc, beta, gl;
        { const float a_in = bf1(cur.a), b_in = bf1(cur.b);
          const float z = a_in + dtb; const float sp = (z > 20.f) ? z : log1pf(__expf(z)); gc = a_neg * sp;
#pragma unroll
          for (int o = 1; o < 64; o <<= 1) { const float t = __shfl_up(gc, o); if (lane >= o) gc += t; }
          beta = sigmoidf_(b_in); gl = __shfl(gc, 63);
          if (wave == 0) { GC[lane] = gc; BT[lane] = beta; } }
        float sv[8][3][2], pp[16];
#pragma unroll
        for (int rr = 0; rr < 8; ++rr) {
#pragma unroll
            for (int ts = 0; ts < 3; ++ts) { float y0 = 0.f, y1 = 0.f;
#pragma unroll
                for (int j = 0; j < 4; ++j) { const unsigned xw = cur.xr[ts][rr + j]; y0 += cur.cw[ts][j][0] * bflo(xw); y1 += cur.cw[ts][j][1] * bfhi(xw); }
                sv[rr][ts][0] = siluf_(y0); sv[rr][ts][1] = siluf_(y1); }
            pp[2 * rr] = sv[rr][0][0] * sv[rr][0][0] + sv[rr][0][1] * sv[rr][0][1]; pp[2 * rr + 1] = sv[rr][1][0] * sv[rr][1][0] + sv[rr][1][1] * sv[rr][1][1];
        }
        float tot;
        { const bool b5 = (lane & 32) != 0, b4 = (lane & 16) != 0, b3 = (lane & 8) != 0, b2 = (lane & 4) != 0;
          float p8[8], p4[4], p2[2];
#pragma unroll
          for (int k = 0; k < 8; ++k) p8[k] = (b5 ? pp[k + 8] : pp[k]) + __shfl_xor(b5 ? pp[k] : pp[k + 8], 32);
#pragma unroll
          for (int k = 0; k < 4; ++k) p4[k] = (b4 ? p8[k + 4] : p8[k]) + __shfl_xor(b4 ? p8[k] : p8[k + 4], 16);
#pragma unroll
          for (int k = 0; k < 2; ++k) p2[k] = (b3 ? p4[k + 2] : p4[k]) + __shfl_xor(b3 ? p4[k] : p4[k + 2], 8);
          tot = (b2 ? p2[1] : p2[0]) + __shfl_xor(b2 ? p2[0] : p2[1], 4);
          tot += __shfl_xor(tot, 2); tot += __shfl_xor(tot, 1); }
        unsigned kg[2][4], kd[2][4], vb[2][4];
#pragma unroll
        for (int rr = 0; rr < 8; ++rr) {
            const int i = 8 * wave + rr;
            const float gci = __int_as_float(__builtin_amdgcn_readlane(__float_as_int(gc), i)), bi = __int_as_float(__builtin_amdgcn_readlane(__float_as_int(beta), i));
            const float scq = rsqrtf(__int_as_float(__builtin_amdgcn_readlane(__float_as_int(tot), 8 * rr)) + EPS) * 0.08838834764831845f;
            const float sck = rsqrtf(__int_as_float(__builtin_amdgcn_readlane(__float_as_int(tot), 8 * rr + 4)) + EPS);
            const float q0 = sv[rr][0][0] * scq, q1 = sv[rr][0][1] * scq, k0 = sv[rr][1][0] * sck, k1 = sv[rr][1][1] * sck, v0 = sv[rr][2][0], v1 = sv[rr][2][1];
            const float eg = __expf(gci), egl = __expf(gl - gci);
            *(LAS unsigned*)(QS + i * 136 + 2 * lane) = pk2(q0, q1); *(LAS unsigned*)(KS + i * 136 + 2 * lane) = pk2(k0, k1);
            *(unsigned*)((bf16*)(wsp() + WS_QD) + (size_t)ch * 8192 + ((((i >> 4) * 4 + (lane >> 4)) * 64 + ((lane >> 2) & 3) * 16 + (i & 15)) * 8 + 2 * (lane & 3))) = pk2(q0 * eg, q1 * eg);
            const unsigned g0 = f2bf(k0 * bi * eg), g1 = f2bf(k1 * bi * eg), d0 = f2bf(k0 * egl), d1 = f2bf(k1 * egl), u0 = f2bf(v0 * bi), u1 = f2bf(v1 * bi);
            if (rr & 1) { kg[0][rr >> 1] |= g0 << 16; kg[1][rr >> 1] |= g1 << 16; kd[0][rr >> 1] |= d0 << 16; kd[1][rr >> 1] |= d1 << 16; vb[0][rr >> 1] |= u0 << 16; vb[1][rr >> 1] |= u1 << 16; }
            else { kg[0][rr >> 1] = g0; kg[1][rr >> 1] = g1; kd[0][rr >> 1] = d0; kd[1][rr >> 1] = d1; vb[0][rr >> 1] = u0; vb[1][rr >> 1] = u1; }
        }
#pragma unroll
        for (int c = 0; c < 2; ++c) {
            *(LAS v4u*)(KGT + (2 * lane + c) * 72 + 8 * wave) = (v4u){kg[c][0], kg[c][1], kg[c][2], kg[c][3]};
            *(LAS v4u*)(KDT + (2 * lane + c) * 72 + 8 * wave) = (v4u){kd[c][0], kd[c][1], kd[c][2], kd[c][3]};
            *(LAS v4u*)(VT + (2 * lane + c) * 72 + 8 * wave) = (v4u){vb[c][0], vb[c][1], vb[c][2], vb[c][3]};
        }
        __syncthreads();
        if (PMODE == 2) continue;
        { const int ti = wave >> 1;
          bf16x8 kfi[4], qfi[4];
#pragma unroll
          for (int ks = 0; ks < 4; ++ks) { kfi[ks] = *(const LAS bf16x8*)(KS + (16 * ti + fr) * 136 + 32 * ks + 8 * fq); qfi[ks] = *(const LAS bf16x8*)(QS + (16 * ti + fr) * 136 + 32 * ks + 8 * fq); }
#pragma unroll
          for (int tt = 0; tt < 2; ++tt) { const int tj = 2 * (wave & 1) + tt;
              f32x4 akk = {0.f, 0.f, 0.f, 0.f}, aqk = {0.f, 0.f, 0.f, 0.f};
#pragma unroll
              for (int ks = 0; ks < 4; ++ks) { const bf16x8 kfj = *(const LAS bf16x8*)(KS + (16 * tj + fr) * 136 + 32 * ks + 8 * fq); akk = MFMA16(kfi[ks], kfj, akk); aqk = MFMA16(kfj, qfi[ks], aqk); }
              { const int j = 16 * tj + fr; const float gcj = GC[j];
#pragma unroll
                for (int r = 0; r < 4; ++r) { const int i = 16 * ti + 4 * fq + r; LM[i * 68 + j] = (i > j) ? BT[i] * akk[r] * __expf(GC[i] - gcj) : 0.f; } }
              { const int i = 16 * ti + fr; const float gci = GC[i]; float v[4];
#pragma unroll
                for (int r = 0; r < 4; ++r) { const int j = 16 * tj + 4 * fq + r; v[r] = (i >= j) ? aqk[r] * __expf(gci - GC[j]) : 0.f; }
                v2u w; w.x = pk2(v[0], v[1]); w.y = pk2(v[2], v[3]);
                *(v2u*)((bf16*)(wsp() + WS_AI) + (size_t)ch * 4096 + (((ti * 2 + (tj >> 1)) * 64 + ((2 * tj + (fq >> 1)) & 3) * 16 + fr) * 8 + 4 * (fq & 1))) = w; } } }
        __syncthreads();
        {
            LAS float* T11f = (LAS float*)(F.lds + 117248); LAS float* T22f = T11f + 1056; LAS float* Mf = T22f + 1056;
            if (wave < 2 && PMODE != 1) {
                const int cl = lane & 31;
                float x[32]; float clf = (float)cl; asm volatile("" : "+v"(clf));
                LAS float* Lh = LM + (32 * wave) * 68 + 32 * wave; asm volatile("" : "+v"(Lh));
#pragma unroll
                for (int i = 0; i < 32; ++i) x[i] = 0.f;
#pragma unroll
                for (int i = 0; i < 32; ++i) {
                    float a0 = fmaxf(0.f, 1.f - fabsf(clf - (float)i)), a1 = 0.f, a2 = 0.f, a3 = 0.f;
#pragma unroll
                    for (int j4 = 0; j4 < (i + 3) / 4; ++j4) { const f32x4 Lv = *(const LAS f32x4*)(Lh + i * 68 + 4 * j4);
                        a0 -= Lv.x * x[4 * j4]; a1 -= Lv.y * x[4 * j4 + 1]; a2 -= Lv.z * x[4 * j4 + 2]; a3 -= Lv.w * x[4 * j4 + 3]; }
                    x[i] = (a0 + a1) + (a2 + a3);
                }
                if (lane < 32) {
                    LAS float* tf = (wave ? T22f : T11f) + cl; asm volatile("" : "+v"(tf));
                    lbf tb = TB + (32 * wave) * 72 + 32 * wave + cl; asm volatile("" : "+v"(tb));
#pragma unroll
                    for (int i = 0; i < 32; ++i) { tf[i * 33] = x[i]; tb[i * 72] = (bf16)f2bf(x[i]); }
                } else if (wave == 0) {
                    lbf tz = TB + 32 + cl; asm volatile("" : "+v"(tz));
#pragma unroll
                    for (int i = 0; i < 32; ++i) tz[i * 72] = 0;
                }
            }
            __syncthreads();
            const int ti2 = F.tid >> 5, c2 = F.tid & 31;
            if (PMODE != 1) {
                float m0 = 0.f, m1 = 0.f;
#pragma unroll 8
                for (int k = 0; k < 32; ++k) { const float t = T11f[k * 33 + c2]; m0 += LM[(32 + ti2) * 68 + k] * t; m1 += LM[(48 + ti2) * 68 + k] * t; }
                Mf[ti2 * 33 + c2] = m0; Mf[(ti2 + 16) * 33 + c2] = m1;
            }
            __syncthreads();
            if (PMODE != 1) {
                float t0 = 0.f, t1 = 0.f;
#pragma unroll 8
                for (int k = 0; k < 32; ++k) { const float mm = Mf[k * 33 + c2]; t0 -= T22f[ti2 * 33 + k] * mm; t1 -= T22f[(ti2 + 16) * 33 + k] * mm; }
                TB[(32 + ti2) * 72 + c2] = (bf16)f2bf(t0); TB[(48 + ti2) * 72 + c2] = (bf16)f2bf(t1);
            }
        }
        __syncthreads();
        eat ^= touch;
        { const int ti = wave & 3;
          bf16x8 tf[2];
#pragma unroll
          for (int ks = 0; ks < 2; ++ks) tf[ks] = *(const LAS bf16x8*)(TB + (16 * ti + fr) * 72 + 32 * ks + 8 * fq);
#pragma unroll
          for (int q4 = 0; q4 < 4; ++q4) { const int te = (wave >> 2) * 4 + q4;
              f32x4 au = {0.f, 0.f, 0.f, 0.f}, aw = {0.f, 0.f, 0.f, 0.f};
#pragma unroll
              for (int ks = 0; ks < 2; ++ks) { const bf16x8 vf = *(const LAS bf16x8*)(VT + (16 * te + fr) * 72 + 32 * ks + 8 * fq), gf = *(const LAS bf16x8*)(KGT + (16 * te + fr) * 72 + 32 * ks + 8 * fq);
                  au = MFMA16(tf[ks], vf, au); aw = MFMA16(gf, tf[ks], aw); }
              v2u w; w.x = pk2(au[0], au[1]); w.y = pk2(au[2], au[3]);
              *(v2u*)((bf16*)(wsp() + WS_UT) + (size_t)ch * 8192 + ((te * 4 + ti) * 64 + lane) * 4) = w;
              w.x = pk2(aw[0], aw[1]); w.y = pk2(aw[2], aw[3]);
              *(v2u*)((bf16*)(wsp() + WS_W) + (size_t)ch * 8192 + (((ti * 4 + (te >> 1)) * 64 + ((2 * te + (fq >> 1)) & 3) * 16 + fr) * 8 + 4 * (fq & 1))) = w; }
          { const int d = F.tid >> 2, part = F.tid & 3; const LAS v4u* src = (const LAS v4u*)((LAS unsigned char*)KDT + d * 144 + part * 32);
            bf16* dstb = (bf16*)(wsp() + WS_KDT) + (size_t)ch * 8192 + (((d >> 4) * 2 + (part >> 1)) * 64 + (2 * (part & 1)) * 16 + (d & 15)) * 8; *(v4u*)dstb = src[0]; *(v4u*)(dstb + 128) = src[1]; }
          if (F.tid == 0) ((float*)(wsp() + WS_GL))[ch] = gl; }
        __syncthreads();
    }
    if (eat == 0x12345u && fq == 77) GC[0] = 1.f;
}
#undef PREP_LOAD
struct DnSetC { bf16x8 wf[4], qf[4], af[2]; v2u ut[2]; };
struct DnSetS { bf16x8 kf[2][2]; float gl; unsigned pf; };
template <int MODE>
__device__ __forceinline__ void dn_scan(Frame& F_, int sid) {
    Frame F = mkframe();
    const int bh = sid >> 2, slice = sid & 3, b = bh >> 3, h = bh & 7;
    const int lane = F.lane, wave = F.wave, fr = lane & 15, fq = lane >> 4;
    lbf ST = (lbf)(F.lds); lbf VT2 = (lbf)(F.lds + 8704);
    for (int i = F.tid; i < (8704 + 4608) / 4; i += NTHR) ((LAS unsigned*)F.lds)[i] = 0u;
    const bf16* pW = (const bf16*)(wsp() + WS_W) + (size_t)bh * 128 * 8192; const bf16* pQ = (const bf16*)(wsp() + WS_QD) + (size_t)bh * 128 * 8192;
    const bf16* pA = (const bf16*)(wsp() + WS_AI) + (size_t)bh * 128 * 4096; const bf16* pK = (const bf16*)(wsp() + WS_KDT) + (size_t)bh * 128 * 8192;
    const bf16* pU = (const bf16*)(wsp() + WS_UT) + (size_t)bh * 128 * 8192; const float* pG = (const float*)(wsp() + WS_GL) + bh * 128;
    bf16* pO = (bf16*)(wsp() + WS_XN) + (size_t)b * SEQ * D + h * 128 + 32 * slice;
    short eat = 0;
    __syncthreads();
    if (wave < 4) {
        const int mi = wave;
        const unsigned oW = (mi * 4 * 64 + lane) * 8, oA = (mi * 2 * 64 + lane) * 8, oU = ((2 * slice) * 4 + mi) * 256 + lane * 4, oO = (16 * mi + fr) * D + 4 * fq;
#define DNC_LOAD(X, nn) do { const int c_ = (nn) < 128 ? (nn) : 127; \
            X.ut[0] = *(const v2u*)(pU + (size_t)c_ * 8192 + oU); X.ut[1] = *(const v2u*)(pU + (size_t)c_ * 8192 + oU + 1024); \
            _Pragma("unroll") for (int ks = 0; ks < 4; ++ks) { X.wf[ks] = *(const bf16x8*)(pW + (size_t)c_ * 8192 + (oW + 512 * ks)); X.qf[ks] = *(const bf16x8*)(pQ + (size_t)c_ * 8192 + (oW + 512 * ks)); } \
            _Pragma("unroll") for (int ks = 0; ks < 2; ++ks) X.af[ks] = *(const bf16x8*)(pA + (size_t)c_ * 4096 + (oA + 512 * ks)); } while (0)
#define DNC_STEP(X, nn) do { \
            f32x4 c1[2], c2[2]; \
            _Pragma("unroll") for (int ni = 0; ni < 2; ++ni) { c1[ni] = (f32x4){0.f, 0.f, 0.f, 0.f}; c2[ni] = (f32x4){0.f, 0.f, 0.f, 0.f}; \
                _Pragma("unroll") for (int ks = 0; ks < 4; ++ks) { const bf16x8 sf = *(const LAS bf16x8*)(ST + (16 * ni + fr) * 136 + 32 * ks + 8 * fq); c1[ni] = MFMA16(X.wf[ks], sf, c1[ni]); c2[ni] = MFMA16(sf, X.qf[ks], c2[ni]); } \
                v2u w_; w_.x = pk2(bflo(X.ut[ni].x) - c1[ni][0], bfhi(X.ut[ni].x) - c1[ni][1]); w_.y = pk2(bflo(X.ut[ni].y) - c1[ni][2], bfhi(X.ut[ni].y) - c1[ni][3]); \
                *(LAS v2u*)(VT2 + (16 * ni + fr) * 72 + 16 * mi + 4 * fq) = w_; } \
            __syncthreads(); \
            _Pragma("unroll") for (int ni = 0; ni < 2; ++ni) { \
                _Pragma("unroll") for (int ks = 0; ks < 2; ++ks) { const bf16x8 vf = *(const LAS bf16x8*)(VT2 + (16 * ni + fr) * 72 + 32 * ks + 8 * fq); c2[ni] = MFMA16(vf, X.af[ks], c2[ni]); } \
                v2u w_; w_.x = pk2(c2[ni][0], c2[ni][1]); w_.y = pk2(c2[ni][2], c2[ni][3]); if (MODE == 0) *(v2u*)(pO + (size_t)(nn) * 64 * D + oO + 16 * ni) = w_; } \
            __syncthreads(); } while (0)
        DnSetC SA, SB, SC;
        DNC_LOAD(SA, 0); DNC_LOAD(SB, 1);
        for (int n = 0; n < 126; n += 3) {
            DNC_LOAD(SC, n + 2); __builtin_amdgcn_sched_barrier(0); DNC_STEP(SA, n); __builtin_amdgcn_sched_barrier(0);
            DNC_LOAD(SA, n + 3); __builtin_amdgcn_sched_barrier(0); DNC_STEP(SB, n + 1); __builtin_amdgcn_sched_barrier(0);
            DNC_LOAD(SB, n + 4); __builtin_amdgcn_sched_barrier(0); DNC_STEP(SC, n + 2); __builtin_amdgcn_sched_barrier(0);
        }
        DNC_STEP(SA, 126); DNC_STEP(SB, 127);
#undef DNC_LOAD
#undef DNC_STEP
    } else {
        const int dq = wave - 4;
        f32x4 accS[2][2];
#pragma unroll
        for (int k = 0; k < 2; ++k)
#pragma unroll
            for (int ni = 0; ni < 2; ++ni) accS[k][ni] = (f32x4){0.f, 0.f, 0.f, 0.f};
        const int lt = F.tid - 256, li = slice * 112 + lt; const bool toucher = lt < 144;
        const bf16* pfBase = (lt >= 112) ? pU + 2048 * slice + (lt - 112) * 64 : (li < 128) ? pW + li * 64 : (li < 256) ? pQ + (li - 128) * 64 : (li < 384) ? pK + (li - 256) * 64 : pA + (li - 384) * 64;
        const unsigned pfStride = (lt >= 112 || li < 384) ? 8192u : 4096u;
        const unsigned oK = (2 * dq * 2 * 64 + lane) * 8;
#define DNS_LOAD(X, nn) do { const int c_ = (nn) < 128 ? (nn) : 127; eat ^= (short)X.pf; X.gl = pG[c_]; \
            _Pragma("unroll") for (int ks = 0; ks < 2; ++ks) { X.kf[0][ks] = *(const bf16x8*)(pK + (size_t)c_ * 8192 + (oK + 512 * ks)); X.kf[1][ks] = *(const bf16x8*)(pK + (size_t)c_ * 8192 + (oK + 1024 + 512 * ks)); } \
            { const int c2_ = (nn) + 2 < 128 ? (nn) + 2 : 127; X.pf = toucher ? *(const unsigned*)(pfBase + (size_t)c2_ * pfStride) : 0u; } } while (0)
#define DNS_STEP(X, nn) do { \
            const float egl = __expf(X.gl); \
            __syncthreads(); \
            _Pragma("unroll") for (int ni = 0; ni < 2; ++ni) { bf16x8 vf[2]; \
                _Pragma("unroll") for (int ks = 0; ks < 2; ++ks) vf[ks] = *(const LAS bf16x8*)(VT2 + (16 * ni + fr) * 72 + 32 * ks + 8 * fq); \
                _Pragma("unroll") for (int k = 0; k < 2; ++k) { accS[k][ni] = accS[k][ni] * egl; \
                    _Pragma("unroll") for (int ks = 0; ks < 2; ++ks) accS[k][ni] = MFMA16(X.kf[k][ks], vf[ks], accS[k][ni]); \
                    v2u w_; w_.x = pk2(accS[k][ni][0], accS[k][ni][1]); w_.y = pk2(accS[k][ni][2], accS[k][ni][3]); \
                    *(LAS v2u*)(ST + (16 * ni + fr) * 136 + 16 * (2 * dq + k) + 4 * fq) = w_; } } \
            __syncthreads(); } while (0)
        DnSetS SA, SB, SC; SA.pf = 0u; SB.pf = 0u; SC.pf = 0u;
        DNS_LOAD(SA, 0); DNS_LOAD(SB, 1);
        for (int n = 0; n < 126; n += 3) {
            DNS_LOAD(SC, n + 2); __builtin_amdgcn_sched_barrier(0); DNS_STEP(SA, n); __builtin_amdgcn_sched_barrier(0);
            DNS_LOAD(SA, n + 3); __builtin_amdgcn_sched_barrier(0); DNS_STEP(SB, n + 1); __builtin_amdgcn_sched_barrier(0);
            DNS_LOAD(SB, n + 4); __builtin_amdgcn_sched_barrier(0); DNS_STEP(SC, n + 2); __builtin_amdgcn_sched_barrier(0);
        }
        DNS_STEP(SA, 126); DNS_STEP(SB, 127);
#undef DNS_LOAD
#undef DNS_STEP
    }
    if (eat == 12345 && fq == 77) VT2[0] = (bf16)eat;
}
__device__ __forceinline__ void rope16(v4u& w0, v4u& w1, const float* rp) {
    float x[8], y[8];
#pragma unroll
    for (int j = 0; j < 4; ++j) { x[2 * j] = bflo(w0[j]); x[2 * j + 1] = bfhi(w0[j]); y[2 * j] = bflo(w1[j]); y[2 * j + 1] = bfhi(w1[j]); }
    const f32x4 c0 = *(const f32x4*)rp, c1 = *(const f32x4*)(rp + 4), s0 = *(const f32x4*)(rp + 8), s1 = *(const f32x4*)(rp + 12);
    float c[8] = {c0.x, c0.y, c0.z, c0.w, c1.x, c1.y, c1.z, c1.w}, s[8] = {s0.x, s0.y, s0.z, s0.w, s1.x, s1.y, s1.z, s1.w};
#pragma unroll
    for (int j = 0; j < 8; ++j) { const float a = x[j], bb = y[j]; x[j] = a * c[j] - bb * s[j]; y[j] = bb * c[j] + a * s[j]; }
#pragma unroll
    for (int j = 0; j < 4; ++j) { w0[j] = pk2(x[2 * j], x[2 * j + 1]); w1[j] = pk2(y[2 * j], y[2 * j + 1]); }
}
__device__ __forceinline__ void swa_mfma(Frame& F_, int l, int nskip) {
    Frame F = mkframe();
    bf16* PROJ = (bf16*)(wsp() + WS_PROJ); const float* ROPE = (const float*)(wsp() + WS_ROPE);
    lbf KL = (lbf)(F.lds), VTL = (lbf)(F.lds + 29952), QL = (lbf)(F.lds + 57600 + F.wave * 9216);
    const int tid = F.tid, lane = F.lane, wave = F.wave, fr = lane & 15, fq = lane >> 4;
    for (int unit = F.bid - nskip; unit < 512; unit += F.G - nskip) {
        const int b = unit >> 8, kvh = (unit >> 7) & 1, q0 = (unit & 127) * 64;
        for (int task = tid; task < 208 * 4; task += NTHR) { const int kl = task >> 2, seg = task & 3, tk = q0 - 128 + kl; v4u w0 = {0u, 0u, 0u, 0u}, w1 = {0u, 0u, 0u, 0u};
            if (kl < 192 && tk >= 0) { const int mk = b * SEQ + tk; const v4u* p = (const v4u*)(PROJ + (size_t)mk * DINP + C_SWK + kvh * 64 + 16 * seg); w0 = p[0]; w1 = p[1];
                if (seg == 0) rope16(w0, w1, ROPE + mk * 16); }
            *(LAS v4u*)(KL + kl * 72 + 16 * seg) = w0; *(LAS v4u*)(KL + kl * 72 + 16 * seg + 8) = w1; }
        for (int task = tid; task < 192 * 8; task += NTHR) { const int kl = task >> 3, seg = task & 7, tk = q0 - 128 + kl; v4u w = {0u, 0u, 0u, 0u};
            if (tk >= 0) w = *(const v4u*)(PROJ + (size_t)(b * SEQ + tk) * DINP + C_SWV + kvh * 64 + 8 * seg);
#pragma unroll
            for (int j = 0; j < 4; ++j) { VTL[(8 * seg + 2 * j) * 216 + kl] = (bf16)(w[j] & 0xffffu); VTL[(8 * seg + 2 * j + 1) * 216 + kl] = (bf16)(w[j] >> 16); } }
        for (int i = tid; i < 1024; i += NTHR) VTL[(i >> 4) * 216 + 192 + (i & 15)] = 0;
        { const int mq = b * SEQ + q0 + lane; const v4u* qp = (const v4u*)(PROJ + (size_t)mq * DINP + C_SWQ + (kvh * 8 + wave) * 64);
          v4u w[8];
#pragma unroll
          for (int i = 0; i < 8; ++i) w[i] = qp[i];
          rope16(w[0], w[1], ROPE + mq * 16);
#pragma unroll
          for (int i = 0; i < 8; ++i) { v4u o;
#pragma unroll
              for (int j = 0; j < 4; ++j) o[j] = pk2(bflo(w[i][j]) * 0.125f, bfhi(w[i][j]) * 0.125f);
              *(LAS v4u*)(QL + lane * 72 + 8 * i) = o; } }
        __syncthreads();
        const float sink = inp(8)[l * 16 + kvh * 8 + wave];
#pragma unroll 1
        for (int qt = 0; qt < 4; ++qt) {
            bf16x8 qf[2];
#pragma unroll
            for (int ks = 0; ks < 2; ++ks) qf[ks] = *(const LAS bf16x8*)(QL + (16 * qt + fr) * 72 + 32 * ks + 8 * fq);
            f32x4 st[10];
#pragma unroll
            for (int t = 0; t < 10; ++t) { st[t] = (f32x4){0.f, 0.f, 0.f, 0.f};
#pragma unroll
                for (int ks = 0; ks < 2; ++ks) { const bf16x8 kf = *(const LAS bf16x8*)(KL + (16 * (qt + t) + fr) * 72 + 32 * ks + 8 * fq); st[t] = MFMA16(kf, qf[ks], st[t]); } }
            const int qr = 16 * qt + fr; float mx = -1e30f;
#pragma unroll
            for (int t = 0; t < 10; ++t)
#pragma unroll
                for (int r = 0; r < 4; ++r) { const int kl = 16 * (qt + t) + 4 * fq + r; const bool ok = (kl > qr) && (kl <= qr + 128) && (q0 - 128 + kl >= 0);
                    st[t][r] = ok ? st[t][r] : -1e30f; mx = fmaxf(mx, st[t][r]); }
            mx = fmaxf(mx, __shfl_xor(mx, 16)); mx = fmaxf(mx, __shfl_xor(mx, 32)); mx = fmaxf(mx, sink);
            float sum = 0.f;
#pragma unroll
            for (int t = 0; t < 10; ++t)
#pragma unroll
                for (int r = 0; r < 4; ++r) { const float p = (st[t][r] > -1e29f) ? __expf(st[t][r] - mx) : 0.f; st[t][r] = p; sum += p; }
            sum += __shfl_xor(sum, 16); sum += __shfl_xor(sum, 32);
            const float inv = 1.f / (sum + __expf(sink - mx));
            bf16x8 pf[5];
#pragma unroll
            for (int pr = 0; pr < 5; ++pr) { v4u w; w.x = pk2(st[2 * pr][0] * inv, st[2 * pr][1] * inv); w.y = pk2(st[2 * pr][2] * inv, st[2 * pr][3] * inv);
                w.z = pk2(st[2 * pr + 1][0] * inv, st[2 * pr + 1][1] * inv); w.w = pk2(st[2 * pr + 1][2] * inv, st[2 * pr + 1][3] * inv); pf[pr] = __builtin_bit_cast(bf16x8, w); }
#pragma unroll
            for (int dt = 0; dt < 4; ++dt) { f32x4 acc = {0.f, 0.f, 0.f, 0.f};
#pragma unroll
                for (int pr = 0; pr < 5; ++pr) { const v2u a0 = *(const LAS v2u*)(VTL + (16 * dt + fr) * 216 + 16 * (qt + 2 * pr) + 4 * fq), a1 = *(const LAS v2u*)(VTL + (16 * dt + fr) * 216 + 16 * (qt + 2 * pr + 1) + 4 * fq);
                    v4u aw; aw.x = a0.x; aw.y = a0.y; aw.z = a1.x; aw.w = a1.y; acc = MFMA16(__builtin_bit_cast(bf16x8, aw), pf[pr], acc); }
                v2u w; w.x = pk2(acc[0], acc[1]); w.y = pk2(acc[2], acc[3]);
                *(v2u*)(PROJ + (size_t)(b * SEQ + q0 + 16 * qt + fr) * DINP + C_SWQ + (kvh * 8 + wave) * 64 + 16 * dt + 4 * fq) = w; }
        }
        __syncthreads();
    }
}
__device__ __forceinline__ void dn_naive(Frame& F_, int l) {
    Frame F = mkframe(); const int b = F.bid >> 3, h = F.bid & 7;
    const bf16* PROJ = (const bf16*)(wsp() + WS_PROJ); bf16* ORAW = (bf16*)(wsp() + WS_XN);
    LAS float* vals = (LAS float*)F.lds;
    LAS float* part = vals + 768;
    LAS float* bg = part + 16;
    LAS float* red = bg + 4;
    LAS float* red2 = red + 1024;
    const int tid = F.tid, lane = F.lane, wave = F.wave;
    const int e = tid & 127, r = tid >> 7;
    int col; float cw0 = 0.f, cw1 = 0.f, cw2 = 0.f, cw3 = 0.f;
    if (tid < 384) { const int chan = (tid >> 7) * 1024 + h * 128 + (tid & 127); col = chan; const float* cw = inp(4) + (size_t)l * 4 * 3072;
        cw0 = cw[chan]; cw1 = cw[3072 + chan]; cw2 = cw[2 * 3072 + chan]; cw3 = cw[3 * 3072 + chan]; }
    else if (tid == 384) col = C_DNB + h; else if (tid == 385) col = C_DNA + h; else col = 0;
    const float a_neg = -__expf(inp(5)[l * 8 + h]), dtb = inp(6)[l * 8 + h];
    float S[32];
#pragma unroll
    for (int i = 0; i < 32; ++i) S[i] = 0.f;
    float x0 = 0.f, x1 = 0.f, x2 = 0.f;
    const bf16* pcol = PROJ + (size_t)b * SEQ * DINP + col;
    float cur[16], nxt[16];
#pragma unroll
    for (int i = 0; i < 16; ++i) cur[i] = bf1(pcol[(size_t)i * DINP]);
    for (int tb = 0; tb < SEQ; tb += 16) {
        if (tb + 16 < SEQ) {
#pragma unroll
            for (int i = 0; i < 16; ++i) nxt[i] = bf1(pcol[(size_t)(tb + 16 + i) * DINP]);
        }
#pragma unroll
        for (int i = 0; i < 16; ++i) {
            const int t = tb + i, buf = i & 1;
            const float xin = cur[i];
            if (tid < 384) {
                const float y = cw0 * x0 + cw1 * x1 + cw2 * x2 + cw3 * xin; x0 = x1; x1 = x2; x2 = xin;
                const float s = siluf_(y); vals[buf * 384 + tid] = s;
                const float ss = wave_sum(s * s); if (lane == 0) part[buf * 8 + wave] = ss;
            } else if (tid == 384) { bg[buf * 2 + 0] = sigmoidf_(xin); }
            else if (tid == 385) { const float z = xin + dtb; const float sp = (z > 20.f) ? z : log1pf(__expf(z)); bg[buf * 2 + 1] = __expf(a_neg * sp); }
            __syncthreads();
            const float sq = rsqrtf(part[buf * 8 + 0] + part[buf * 8 + 1] + EPS) * 0.08838834764831845f;
            const float sk = rsqrtf(part[buf * 8 + 2] + part[buf * 8 + 3] + EPS);
            const float beta = bg[buf * 2 + 0], eg = bg[buf * 2 + 1];
            const LAS float* qv = vals + buf * 384 + 32 * r; const LAS float* kv = vals + buf * 384 + 128 + 32 * r;
            float pk = 0.f, pq = 0.f, pqk = 0.f;
#pragma unroll
            for (int dd = 0; dd < 32; ++dd) { const float kd = kv[dd], qd = qv[dd]; pk += kd * S[dd]; pq += qd * S[dd]; pqk += qd * kd; }
            red[(buf * 4 + r) * 128 + e] = pk * sk; red[((1 - buf) * 4 + r) * 128 + e] = pq * sq;
            if (e == 0) red2[r] = pqk;
            __syncthreads();
            float kS = 0.f, qS = 0.f;
#pragma unroll
            for (int rr = 0; rr < 4; ++rr) { kS += red[(buf * 4 + rr) * 128 + e]; qS += red[((1 - buf) * 4 + rr) * 128 + e]; }
            const float qk = (red2[0] + red2[1] + red2[2] + red2[3]) * sq * sk;
            const float ve = vals[buf * 384 + 256 + e];
            const float delta = beta * (ve - eg * kS);
            if (r == 0) ORAW[(size_t)(b * SEQ + t) * D + h * 128 + e] = (bf16)f2bf(eg * qS + qk * delta);
            const float kdl = sk * delta;
#pragma unroll
            for (int dd = 0; dd < 32; ++dd) S[dd] = eg * S[dd] + kv[dd] * kdl;
            __syncthreads();
        }
#pragma unroll
        for (int i = 0; i < 16; ++i) cur[i] = nxt[i];
    }
}
__device__ __forceinline__ void swa_naive(Frame& F_, int l, int nskip) {
    Frame F = mkframe(); const int w0 = (F.bid - nskip) * NWAVES + F.wave, nw = (F.G - nskip) * NWAVES;
    bf16* PROJ = (bf16*)(wsp() + WS_PROJ); const float* ROPE = (const float*)(wsp() + WS_ROPE);
    LAS float* qs = (LAS float*)(F.lds + F.wave * 8192);
    LAS float* ps = qs + 512;
    const int lane = F.lane;
    for (int task = w0; task < M * 2; task += nw) {
        const int m = task >> 1, kvh = task & 1, b = m / SEQ, t = m % SEQ;
        { const float c = ROPE[m * 16 + (lane & 7)], s = ROPE[m * 16 + 8 + (lane & 7)];
#pragma unroll
          for (int g = 0; g < 8; ++g) { const float x = bf1(PROJ[(size_t)m * DINP + C_SWQ + (kvh * 8 + g) * 64 + lane]); const float p = __shfl_xor(x, 8);
              const float y = (lane < 8) ? (x * c - p * s) : ((lane < 16) ? (x * c + p * s) : x); qs[g * 64 + lane] = y * 0.125f; } }
        asm volatile("s_waitcnt lgkmcnt(0)" ::: "memory");
#pragma unroll 1
        for (int kk = 0; kk < 2; ++kk) {
            const int tk = t - 127 + lane + 64 * kk; const bool valid = tk >= 0; const int mk = b * SEQ + (valid ? tk : 0);
            float kf[64];
            const v4u* kr = (const v4u*)(PROJ + (size_t)mk * DINP + C_SWK + kvh * 64);
#pragma unroll
            for (int i = 0; i < 8; ++i) { const v4u w = kr[i];
#pragma unroll
                for (int j = 0; j < 4; ++j) { kf[8 * i + 2 * j] = bflo(w[j]); kf[8 * i + 2 * j + 1] = bfhi(w[j]); } }
#pragma unroll
            for (int j = 0; j < 8; ++j) { const float c = ROPE[mk * 16 + j], s = ROPE[mk * 16 + 8 + j]; const float a = kf[j], bb = kf[j + 8]; kf[j] = a * c - bb * s; kf[j + 8] = bb * c + a * s; }
#pragma unroll
            for (int g = 0; g < 8; ++g) { float a = 0.f;
#pragma unroll
                for (int d4 = 0; d4 < 16; ++d4) { const f32x4 q = *(const LAS f32x4*)(qs + g * 64 + 4 * d4); a += q.x * kf[4 * d4] + q.y * kf[4 * d4 + 1] + q.z * kf[4 * d4 + 2] + q.w * kf[4 * d4 + 3]; }
                ps[(lane + 64 * kk) * 8 + g] = valid ? a : -1e30f; }
        }
        asm volatile("s_waitcnt lgkmcnt(0)" ::: "memory");
#pragma unroll
        for (int g = 0; g < 8; ++g) {
            const float sink = inp(8)[l * 16 + kvh * 8 + g];
            const float s0 = ps[lane * 8 + g], s1 = ps[(lane + 64) * 8 + g];
            const float mx = fmaxf(wave_max(fmaxf(s0, s1)), sink);
            const float p0 = (s0 > -1e29f) ? __expf(s0 - mx) : 0.f, p1 = (s1 > -1e29f) ? __expf(s1 - mx) : 0.f;
            const float den = wave_sum(p0 + p1) + __expf(sink - mx); const float inv = 1.f / den;
            ps[lane * 8 + g] = p0 * inv; ps[(lane + 64) * 8 + g] = p1 * inv;
        }
        asm volatile("s_waitcnt lgkmcnt(0)" ::: "memory");
        float o[8];
#pragma unroll
        for (int g = 0; g < 8; ++g) o[g] = 0.f;
        const int j0 = (t >= 127) ? 0 : (127 - t);
        for (int j = j0; j < 128; ++j) {
            const int mk = b * SEQ + t - 127 + j;
            const float v = bf1(PROJ[(size_t)mk * DINP + C_SWV + kvh * 64 + lane]);
            const f32x4 pa = *(const LAS f32x4*)(ps + j * 8), pb = *(const LAS f32x4*)(ps + j * 8 + 4);
            o[0] += pa.x * v; o[1] += pa.y * v; o[2] += pa.z * v; o[3] += pa.w * v; o[4] += pb.x * v; o[5] += pb.y * v; o[6] += pb.z * v; o[7] += pb.w * v;
        }
#pragma unroll
        for (int g = 0; g < 8; ++g) PROJ[(size_t)m * DINP + C_SWQ + (kvh * 8 + g) * 64 + lane] = (bf16)f2bf(o[g]);
        asm volatile("s_waitcnt lgkmcnt(0)" ::: "memory");
    }
}
__device__ __forceinline__ void phase_gnorm(Frame& F_, int l) {
    Frame F = mkframe();
    bf16* PROJ = (bf16*)(wsp() + WS_PROJ); const bf16* ORAW = (const bf16*)(wsp() + WS_XN);
    const int gw = F.bid * NWAVES + F.wave, NGW = F.G * NWAVES;
    const int hl = F.lane >> 5, c4 = 4 * (F.lane & 31);
    const f32x4 gv = *(const f32x4*)(inp(7) + l * 128 + c4);
    for (int m = gw; m < M; m += NGW) {
        v2u ow[4], zw[4];
#pragma unroll
        for (int hh = 0; hh < 4; ++hh) { const int h = 2 * hh + hl; ow[hh] = *(const v2u*)(ORAW + (size_t)m * D + h * 128 + c4); zw[hh] = *(const v2u*)(PROJ + (size_t)m * DINP + C_DNZ + h * 128 + c4); }
        float ss[4];
#pragma unroll
        for (int hh = 0; hh < 4; ++hh) { const float o0 = bflo(ow[hh].x), o1 = bfhi(ow[hh].x), o2 = bflo(ow[hh].y), o3 = bfhi(ow[hh].y); ss[hh] = (o0 * o0 + o1 * o1) + (o2 * o2 + o3 * o3); }
#pragma unroll
        for (int o = 1; o < 32; o <<= 1) {
#pragma unroll
            for (int hh = 0; hh < 4; ++hh) ss[hh] += __shfl_xor(ss[hh], o); }
#pragma unroll
        for (int hh = 0; hh < 4; ++hh) { const int h = 2 * hh + hl; const float r = rsqrtf(ss[hh] * (1.f / 128.f) + EPS);
            v2u w; w.x = pk2(bflo(ow[hh].x) * r * gv.x * siluf_(bflo(zw[hh].x)), bfhi(ow[hh].x) * r * gv.y * siluf_(bfhi(zw[hh].x)));
            w.y = pk2(bflo(ow[hh].y) * r * gv.z * siluf_(bflo(zw[hh].y)), bfhi(ow[hh].y) * r * gv.w * siluf_(bfhi(zw[hh].y)));
            *(v2u*)(PROJ + (size_t)m * DINP + C_DNQ + h * 128 + c4) = w; }
    }
}

#ifndef PROBE_ECHO
#define PROBE_ECHO 0
#endif
#define ECHO_BEGIN(k) do { if (PROBE_ECHO == (k)) echo_t0 = __builtin_amdgcn_s_memrealtime(); } while (0)
#define ECHO_END(k) do { if (PROBE_ECHO == (k)) { const unsigned long long t1_ = __builtin_amdgcn_s_memrealtime(), d_ = t1_ - echo_t0; while (__builtin_amdgcn_s_memrealtime() - t1_ < d_) __builtin_amdgcn_s_sleep(8); } } while (0)
#ifndef PROBE_DUP
#define PROBE_DUP 0
#endif
#ifndef DN_NAIVE
#define DN_NAIVE 0
#endif
struct Args { const float* in[17]; float* out; unsigned char* ws; };
__global__ void __launch_bounds__(NTHR, 2) hybrid_fwd(Args args) {
    cg::grid_group grid = cg::this_grid();
    Frame F;
    F.lds = lds_base();
    F.tid = threadIdx.x; F.lane = F.tid & 63; F.wave = __builtin_amdgcn_readfirstlane(F.tid >> 6);
    F.G = gridDim.x; F.bid = blockIdx.x;
#define PROJ ((bf16*)(wsp() + WS_PROJ))
#define XN ((bf16*)(wsp() + WS_XN))
#define YF ((float*)(wsp() + WS_YF))
#define MIX ((bf16*)(wsp() + WS_MIX))
#define HB ((bf16*)(wsp() + WS_H))

    unsigned long long echo_t0 = 0; (void)echo_t0;
    ECHO_BEGIN(9); ECHO_BEGIN(10); ECHO_BEGIN(11);
    if (F.bid == 0) { for (int i = F.tid; i < XCD_BAR_WORDS; i += NTHR) ((unsigned*)(wsp() + WS_BAR))[i] = 0u; for (int i = F.tid; i < 16384; i += NTHR) ((unsigned*)(wsp() + WS_XCNT))[i] = 0u; if (F.tid < 256) ((unsigned*)(wsp() + WS_SUBCNT))[F.tid] = 0u; }
    if (F.tid < 4) ((LAS unsigned*)(lds_base() + LDS_BARST))[F.tid] = 0u;
    grid.sync();
    ECHO_END(10);
    xcd_barrier_post();
    phase_rope(F);
    phase_norm(F, nullptr, nullptr, inp(0), outp(), inp(2), XN);
    phase_convert(F, -1, 0, 0);
    grid_bar();
    ECHO_END(9);
    for (int l = 0; l < DEPTH; ++l) {
        ECHO_BEGIN(1);
        {
            pg8::Gemm g{XN, (const bf16*)(wsp() + WS_WIN), nullptr, nullptr, M, DINP, D, D}; pg8::StaticOrder S; { Frame Fg = mkframe(); S.init(M, DINP, Fg.G, Fg.bid); }
            pg8::EpiBf16<0> E{PROJ, DINP};
            pg8::gemm_phase<pg8::EpiBf16<0>, pg8::StaticOrder, true, true>(F.lds, g, S, E);
#if PROBE_DUP == 5
            pg8::gemm_phase<pg8::EpiBf16<0>, pg8::StaticOrder, true, true>(F.lds, g, S, E);
#endif
        }
        grid_bar(); ECHO_END(1); ECHO_BEGIN(2);
#if DN_NAIVE
        if (F.bid < 16) dn_naive(F, l);
        else swa_naive(F, l, 16);
#else
#if PROBE_DUP == 1
        dn_prep<0>(F, l);
#elif PROBE_DUP == 11
        dn_prep<1>(F, l);
#elif PROBE_DUP == 12
        dn_prep<2>(F, l);
#elif PROBE_DUP == 13
        dn_prep<3>(F, l);
#elif PROBE_DUP == 14
        dn_prep<4>(F, l);
#endif
        dn_prep<0>(F, l);
        grid_bar(); ECHO_END(2); ECHO_BEGIN(3);
        { Frame Fg = mkframe(); if (Fg.bid < 64) { const int sid_ = (((Fg.bid & 7) * 2 + (Fg.bid >> 5)) << 2) | ((Fg.bid >> 3) & 3); dn_scan<0>(F, sid_);
#if PROBE_DUP == 2
            dn_scan<0>(F, sid_);
#elif PROBE_DUP == 3
            dn_scan<1>(F, sid_);
#elif PROBE_DUP == 4
            dn_scan<2>(F, sid_);
#endif
        }
        else {
            phase_convert(F, l, (l + 1 < DEPTH) ? l + 1 : -1, 64);
            __syncthreads();
            swa_mfma(F, l, 64);
            sub_bar((unsigned*)(wsp() + WS_SUBCNT) + 64 * l, (unsigned)(Fg.G - 64));
            pg8::Gemm g{PROJ + C_SWQ, (const bf16*)(wsp() + WS_WUPSW), nullptr, nullptr, M, D, D, DINP}; pg8::StaticOrder S; S.init(M, D, Fg.G - 64, Fg.bid - 64);
            pg8::EpiYb E{PROJ + C_DNK, DINP, PROJ + C_GB, DINP};
            pg8::gemm_phase<pg8::EpiYb, pg8::StaticOrder, true, true>(F.lds, g, S, E);
        } }
#endif
        grid_bar(); ECHO_END(3); ECHO_BEGIN(4);
        phase_gnorm(F, l);
#if PROBE_DUP == 6
        phase_gnorm(F, l);
#endif
        grid_bar(); ECHO_END(4); ECHO_BEGIN(5);
        {
            pg8::Gemm g{PROJ + C_DNQ, (const bf16*)(wsp() + WS_WUPDN), nullptr, nullptr, M, D, D, DINP}; pg8::StaticOrder S; { Frame Fg = mkframe(); S.init(M, D, Fg.G, Fg.bid); }
            pg8::EpiMerge2 E{MIX, D, PROJ + C_GA, PROJ + C_DNK, DINP};
            pg8::gemm_phase<pg8::EpiMerge2, pg8::StaticOrder, false, true>(F.lds, g, S, E);
        }
        grid_bar(); ECHO_END(5); ECHO_BEGIN(6);
        {
            pg8::Gemm g{MIX, (const bf16*)(wsp() + WS_WO), nullptr, nullptr, M, D, D, D}; pg8::StaticOrder S; { Frame Fg = mkframe(); S.init(M, D, Fg.G, Fg.bid); }
            pg8::RmsExchange e1{(float*)(wsp() + WS_XSLOT), (unsigned*)(wsp() + WS_XCNT) + ((l * 4 + 0) * 64) * 16}, e2{(float*)(wsp() + WS_XSLOT + 262144), (unsigned*)(wsp() + WS_XCNT) + ((l * 4 + 1) * 64) * 16};
            pg8::EpiRmsRes E{outp(), inp(12) + l * D, inp(13) + l * D, XN, e1, e2};
            pg8::gemm_phase<pg8::EpiRmsRes, pg8::StaticOrder, false, true>(F.lds, g, S, E);
        }
        grid_bar(); ECHO_END(6); ECHO_BEGIN(7);
        {
            pg8::Gemm g{XN, (const bf16*)(wsp() + WS_WFF1), nullptr, nullptr, M, FF, D, D}; pg8::StaticOrder S; { Frame Fg = mkframe(); S.init(M, FF, Fg.G, Fg.bid); }
            pg8::EpiBf16<2> E{HB, FF};
            pg8::gemm_phase<pg8::EpiBf16<2>, pg8::StaticOrder, true, true>(F.lds, g, S, E);
#if PROBE_DUP == 7
            pg8::gemm_phase<pg8::EpiBf16<2>, pg8::StaticOrder, true, true>(F.lds, g, S, E);
#endif
        }
        grid_bar(); ECHO_END(7); ECHO_BEGIN(8);
        {
            pg8::Gemm g{HB, (const bf16*)(wsp() + WS_WFF2), nullptr, nullptr, M, D, FF, FF}; pg8::StaticOrder S; { Frame Fg = mkframe(); S.init(M, D, Fg.G, Fg.bid); }
            pg8::RmsExchange e1{(float*)(wsp() + WS_XSLOT), (unsigned*)(wsp() + WS_XCNT) + ((l * 4 + 2) * 64) * 16}, e2{(float*)(wsp() + WS_XSLOT + 262144), (unsigned*)(wsp() + WS_XCNT) + ((l * 4 + 3) * 64) * 16};
            pg8::EpiRmsRes E{outp(), inp(16) + l * D, (l + 1 < DEPTH) ? inp(2) + (l + 1) * D : nullptr, XN, e1, e2};
            pg8::gemm_phase<pg8::EpiRmsRes, pg8::StaticOrder, false, true>(F.lds, g, S, E);
        }
        if (l + 1 < DEPTH) grid_bar();
        ECHO_END(8);
    }
    ECHO_END(11);
#undef PROJ
#undef XN
#undef YF
#undef MIX
#undef HB
}

extern "C" void kernel_launch(void* const* d_in, const int* in_sizes, int n_in, void* d_out, int out_size, void* d_ws, size_t ws_size, hipStream_t stream) {
    static int init = 0;
    if (!init) {
        if (n_in != 17 || out_size != M * D || ws_size < WS_END) { fprintf(stderr, "kernel_launch: unexpected shapes (n_in %d out %d ws %zu)\n", n_in, out_size, ws_size); init = -1; return; }
        if (hipFuncSetAttribute((const void*)hybrid_fwd, hipFuncAttributeMaxDynamicSharedMemorySize, LDS_BYTES) != hipSuccess) { fprintf(stderr, "hipFuncSetAttribute failed\n"); init = -1; return; }
        init = 1;
    }
    if (init < 0) return;
    Args a{};
    for (int i = 0; i < 17; ++i) a.in[i] = (const float*)d_in[i];
    a.out = (float*)d_out; a.ws = (unsigned char*)d_ws;
    void* args[] = {&a};
    hipError_t e = hipLaunchCooperativeKernel((void*)hybrid_fwd, dim3(256), dim3(NTHR), args, LDS_BYTES, stream);
    if (e != hipSuccess) fprintf(stderr, "cooperative launch failed: %s\n", hipGetErrorString(e));
}
```
